# Optimizing an MI355X kernel written in HIP

```python
import jax, jax.numpy as jnp
from jax import lax
import numpy as np

D_MODEL = 1024
BATCH = 2
SEQ = 16384
DEPTH = 1

ATT_Q_HEADS = 8
ATT_KV_HEADS = 2
ATT_HEAD_DIM = 64
WINDOW = 128
ATT_BLOCK = 128
GLA_HEADS = 4
GLA_DK = 64
GLA_DV = 128
GLA_GATE_RANK = 16
GLA_GATE_NORMALIZER = 16.0
GLA_CHUNK = 64
N_EXPERTS = 32
TOP_K = 4
D_EXPERT = 1024
SWIGLU_LIMIT = 7.0
SWIGLU_ALPHA = 1.702
MOE_BLOCK = 128
NORM_EPS = 1e-6

ATT_WIDTH = ATT_Q_HEADS * ATT_HEAD_DIM
ATT_KV_WIDTH = ATT_KV_HEADS * ATT_HEAD_DIM
GLA_K_WIDTH = GLA_HEADS * GLA_DK
GLA_V_WIDTH = GLA_HEADS * GLA_DV
MIX_WIDTH = ATT_WIDTH + GLA_V_WIDTH
IN_SPLITS = (ATT_WIDTH, ATT_KV_WIDTH, ATT_KV_WIDTH, GLA_K_WIDTH, GLA_K_WIDTH, GLA_V_WIDTH, GLA_V_WIDTH, GLA_GATE_RANK)
IN_WIDTH = 2 * ATT_WIDTH + 2 * ATT_KV_WIDTH + 2 * GLA_K_WIDTH + 2 * GLA_V_WIDTH + GLA_GATE_RANK - ATT_WIDTH

kernel_name = "hymba_swa_sink_gla_moe_sandwich_adaln"


def rms_norm(t, g):
    tf = t.astype(jnp.float32)
    tf = tf * lax.rsqrt(jnp.mean(tf * tf, axis=-1, keepdims=True) + NORM_EPS)
    return (tf * g.astype(jnp.float32)).astype(t.dtype)


def split_cols(t, sizes):
    idx = np.cumsum(sizes)[:-1].tolist()
    return jnp.split(t, idx, axis=-1)


def sliding_window_sink_attention(q, k, v, sinks):
    B, S = q.shape[0], q.shape[1]
    nb = S // ATT_BLOCK
    G = ATT_Q_HEADS // ATT_KV_HEADS
    qb = q.reshape(B, nb, ATT_BLOCK, ATT_KV_HEADS, G, ATT_HEAD_DIM)

    def with_prev(t):
        tb = t.reshape(B, nb, ATT_BLOCK, ATT_KV_HEADS, ATT_HEAD_DIM)
        prev = jnp.pad(tb[:, :-1], ((0, 0), (1, 0), (0, 0), (0, 0), (0, 0)))
        return jnp.concatenate([prev, tb], axis=2)

    kb, vb = with_prev(k), with_prev(v)
    scale = ATT_HEAD_DIM ** -0.5
    s = jnp.einsum('bnqhgd,bnkhd->bnhgqk', qb, kb).astype(jnp.float32) * scale
    qi = jnp.arange(ATT_BLOCK)[:, None]
    kj = jnp.arange(2 * ATT_BLOCK)[None, :]
    rel = qi + ATT_BLOCK - kj
    blk = jnp.arange(nb)[:, None, None]
    valid = (rel >= 0) & (rel < WINDOW) & ((blk > 0) | (kj >= ATT_BLOCK))
    s = jnp.where(valid[None, :, None, None], s, -jnp.inf)
    sink = sinks.astype(jnp.float32).reshape(ATT_KV_HEADS, G)[None, None, :, :, None, None]
    m = jnp.maximum(jnp.max(s, axis=-1, keepdims=True), sink)
    p = jnp.exp(s - m)
    p = p / (jnp.sum(p, axis=-1, keepdims=True) + jnp.exp(sink - m))
    o = jnp.einsum('bnhgqk,bnkhd->bnqhgd', p.astype(v.dtype), vb)
    return o.reshape(B, S, ATT_WIDTH)


def gla_chunked(q, k, v, g):
    B, S, H, dk = q.shape
    dv = v.shape[-1]
    C = GLA_CHUNK
    n = S // C
    r = lambda t: t.astype(jnp.float32).reshape(B, n, C, H, t.shape[-1])
    q, k, v, g = r(q), r(k), r(v), r(g)
    b = jnp.cumsum(g, axis=2)
    b_last = b[:, :, -1:]
    b_mid = b[:, :, C // 2 - 1:C // 2]
    A = jnp.einsum('bnihd,bnjhd->bnhij', q * jnp.exp(b - b_mid), k * jnp.exp(b_mid - b))
    causal = jnp.tril(jnp.ones((C, C), dtype=bool))
    A = jnp.where(causal, A, 0.0)
    o = jnp.einsum('bnhij,bnjhv->bnihv', A, v)
    kv = jnp.einsum('bnjhd,bnjhv->bnhdv', k * jnp.exp(b_last - b), v)
    decay = jnp.exp(b_last[:, :, 0])

    def step(state, inp):
        d, u = inp
        return d[..., None] * state + u, state

    _, states = lax.scan(step, jnp.zeros((B, H, dk, dv), jnp.float32),
                         (jnp.moveaxis(decay, 1, 0), jnp.moveaxis(kv, 1, 0)))
    states = jnp.moveaxis(states, 0, 1)
    o = o + jnp.einsum('bnihd,bnhdv->bnihv', q * jnp.exp(b), states)
    return o.reshape(B, S, H, dv)


def hybrid_mixer(h, w_in, w_gla_gate_up, b_gla_gate, g_gla_norm, sinks, w_out):
    B, S, _ = h.shape
    proj = h @ w_in
    aq, ak, av, gq, gk, gv, gg, ga = split_cols(proj, IN_SPLITS)
    att = sliding_window_sink_attention(
        aq.reshape(B, S, ATT_Q_HEADS, ATT_HEAD_DIM),
        ak.reshape(B, S, ATT_KV_HEADS, ATT_HEAD_DIM),
        av.reshape(B, S, ATT_KV_HEADS, ATT_HEAD_DIM), sinks)
    glog = jax.nn.log_sigmoid((ga @ w_gla_gate_up + b_gla_gate).astype(jnp.float32)) / GLA_GATE_NORMALIZER
    o = gla_chunked(gq.reshape(B, S, GLA_HEADS, GLA_DK) * (GLA_DK ** -0.5),
                    gk.reshape(B, S, GLA_HEADS, GLA_DK),
                    gv.reshape(B, S, GLA_HEADS, GLA_DV),
                    glog.reshape(B, S, GLA_HEADS, GLA_DK))
    o = rms_norm(o, g_gla_norm).reshape(B, S, GLA_V_WIDTH).astype(h.dtype) * jax.nn.silu(gg)
    return jnp.concatenate([att.astype(h.dtype), o], axis=-1) @ w_out


def moe_ffn(h, w_router, b_router, w_mlp1, b_mlp1, w_mlp2, b_mlp2):
    T, D = h.shape
    logits = (h @ w_router).astype(jnp.float32) + b_router.astype(jnp.float32)
    top_v, top_i = lax.top_k(logits, TOP_K)
    gates = jax.nn.softmax(top_v, axis=-1)
    n_assign = T * TOP_K
    flat_e = top_i.reshape(-1)
    order = jnp.argsort(flat_e)
    sorted_e = flat_e[order]
    counts = jnp.bincount(flat_e, length=N_EXPERTS)
    padded = (counts + MOE_BLOCK - 1) // MOE_BLOCK * MOE_BLOCK
    start = jnp.cumsum(counts) - counts
    pstart = jnp.cumsum(padded) - padded
    dest = pstart[sorted_e] + jnp.arange(n_assign) - start[sorted_e]
    n_slots = n_assign + N_EXPERTS * MOE_BLOCK
    n_blocks = n_slots // MOE_BLOCK
    slot_assign = jnp.full((n_slots,), n_assign, jnp.int32).at[dest].set(order.astype(jnp.int32))
    slot_tok = slot_assign // TOP_K
    slot_gate = jnp.concatenate([gates.reshape(-1), jnp.zeros((1,), jnp.float32)])[slot_assign]
    block_e = jnp.minimum(jnp.searchsorted(jnp.cumsum(padded), jnp.arange(n_blocks) * MOE_BLOCK, side='right'),
                          N_EXPERTS - 1)
    h_pad = jnp.concatenate([h, jnp.zeros((1, D), h.dtype)], axis=0)
    xs = h_pad[slot_tok].reshape(n_blocks, MOE_BLOCK, D)

    def expert_block(args):
        xb, e = args
        u = xb @ w_mlp1[e] + b_mlp1[e]
        x_glu = jnp.minimum(u[..., ::2], SWIGLU_LIMIT)
        x_lin = jnp.clip(u[..., 1::2], -SWIGLU_LIMIT, SWIGLU_LIMIT)
        a = x_glu * jax.nn.sigmoid(SWIGLU_ALPHA * x_glu) * (x_lin + 1)
        return a @ w_mlp2[e] + b_mlp2[e]

    ys = lax.map(expert_block, (xs, block_e)).reshape(n_slots, D)
    out = jnp.zeros((T + 1, D), jnp.float32).at[slot_tok].add(ys.astype(jnp.float32) * slot_gate[:, None])
    return out[:T].astype(h.dtype)


def setup_inputs(seed: int = 0) -> dict:
    key = jax.random.key(seed)
    ks = jax.random.split(key, 24)
    nrm = lambda k, shape, s: jax.random.normal(k, shape, jnp.float32) * s
    L, D, E, F = DEPTH, D_MODEL, N_EXPERTS, D_EXPERT
    return {
        "x": nrm(ks[0], (BATCH, SEQ, D), 1.0),
        "c": nrm(ks[1], (BATCH, D), 1.0),
        "w_ada": nrm(ks[2], (L, D, 6 * D), 0.5 * D ** -0.5),
        "b_ada": nrm(ks[3], (L, 6 * D), 0.02),
        "g_pre_mix": 1.0 + nrm(ks[4], (L, D), 0.02),
        "g_post_mix": 1.0 + nrm(ks[5], (L, D), 0.02),
        "g_pre_ffn": 1.0 + nrm(ks[6], (L, D), 0.02),
        "g_post_ffn": 1.0 + nrm(ks[7], (L, D), 0.02),
        "w_in": nrm(ks[8], (L, D, IN_WIDTH), D ** -0.5),
        "w_gla_gate_up": nrm(ks[9], (L, GLA_GATE_RANK, GLA_K_WIDTH), GLA_GATE_RANK ** -0.5),
        "b_gla_gate": nrm(ks[10], (L, GLA_K_WIDTH), 0.1),
        "g_gla_norm": 1.0 + nrm(ks[11], (L, GLA_DV), 0.02),
        "sinks": nrm(ks[12], (L, ATT_Q_HEADS), 1.0),
        "w_out": nrm(ks[13], (L, MIX_WIDTH, D), MIX_WIDTH ** -0.5),
        "w_router": nrm(ks[14], (L, D, E), D ** -0.5),
        "b_router": nrm(ks[15], (L, E), 0.01),
        "w_mlp1": nrm(ks[16], (L, E, D, 2 * F), D ** -0.5),
        "b_mlp1": nrm(ks[17], (L, E, 2 * F), 0.02),
        "w_mlp2": nrm(ks[18], (L, E, F, D), F ** -0.5),
        "b_mlp2": nrm(ks[19], (L, E, D), 0.02),
    }


def reference(x, c, w_ada, b_ada, g_pre_mix, g_post_mix, g_pre_ffn, g_post_ffn, w_in, w_gla_gate_up,
              b_gla_gate, g_gla_norm, sinks, w_out, w_router, b_router, w_mlp1, b_mlp1, w_mlp2, b_mlp2):
    B, S, D = x.shape
    for l in range(DEPTH):
        mod = jax.nn.silu(c) @ w_ada[l] + b_ada[l]
        sh1, sc1, gt1, sh2, sc2, gt2 = [m[:, None, :] for m in jnp.split(mod, 6, axis=-1)]
        h = rms_norm(x, g_pre_mix[l]) * (1 + sc1) + sh1
        y = hybrid_mixer(h, w_in[l], w_gla_gate_up[l], b_gla_gate[l], g_gla_norm[l], sinks[l], w_out[l])
        x = x + gt1 * rms_norm(y, g_post_mix[l])
        h = rms_norm(x, g_pre_ffn[l]) * (1 + sc2) + sh2
        y = moe_ffn(h.reshape(B * S, D), w_router[l], b_router[l], w_mlp1[l], b_mlp1[l],
                    w_mlp2[l], b_mlp2[l]).reshape(B, S, D)
        x = x + gt2 * rms_norm(y, g_post_ffn[l])
    return x
```

```cpp
#include <hip/hip_runtime.h>
#include <cstdio>
#include <cstdint>

#ifndef MK_ONE_LAUNCH
#define MK_ONE_LAUNCH 1
#endif

#define LAS __attribute__((address_space(3)))
typedef unsigned short bf16;
typedef short bf16x8 __attribute__((ext_vector_type(8)));
typedef short s16x4 __attribute__((ext_vector_type(4)));
typedef float f32x4 __attribute__((ext_vector_type(4)));
typedef unsigned u32x4 __attribute__((ext_vector_type(4)));
typedef unsigned u32x2 __attribute__((ext_vector_type(2)));

constexpr int D = 1024, NB = 2, S = 16384, T = NB * S;
constexpr int INW = 2320, INP = 2560;
constexpr int AQ_OFF = 0, AK_OFF = 512, AV_OFF = 640, GQ_OFF = 768, GK_OFF = 1024, GV_OFF = 1280, GG_OFF = 1792, GA_OFF = 2304;
constexpr int NCH = 256;
constexpr int NE = 32, FF = 1024;
constexpr int NSLOT_MAX = T * 4 + NE * 256;
constexpr float EPS = 1e-6f;
constexpr int NWAVES = 8, NTHREADS = 512, GRID = 256;

constexpr size_t MiB = 1u << 20;
constexpr size_t WS_CTL = 0, CTL_ZERO_BYTES = 1 * MiB;
constexpr size_t WS_MOD = 1 * MiB;
constexpr size_t WS_DECAY = 2 * MiB;
constexpr size_t WS_ROUTE = 3 * MiB;
constexpr size_t WS_TOK_E = WS_ROUTE, WS_TOK_LPOS = WS_ROUTE + 512 * 1024, WS_TOK_GATE = WS_ROUTE + 1024 * 1024;
constexpr size_t WS_BLK_CNT = WS_ROUTE + 1536 * 1024, WS_MOE_OFF = WS_BLK_CNT + 32 * 1024, WS_TILE_E = WS_MOE_OFF + 4096;
constexpr size_t WS_SLOT_ASSIGN = WS_ROUTE + 2 * MiB, WS_SLOT_GATE = WS_ROUTE + 3 * MiB;
constexpr size_t WS_WIN = 8 * MiB, WS_WOUT = 13 * MiB, WS_W2T = 16 * MiB, WS_W1T = 80 * MiB;
constexpr size_t WS_H = 208 * MiB, WS_KV = 272 * MiB, WS_YS = 80 * MiB;
constexpr size_t WS_X1 = 336 * MiB, WS_PROJ = 464 * MiB, WS_MIX = 624 * MiB, WS_Y = 688 * MiB, WS_A = 464 * MiB;
constexpr size_t WS_END = 752 * MiB;
constexpr int CW_BAR = 4096;

constexpr int LDS_BYTES = 147456, SMALL_OFF = 132096, MISC_OFF = 131072 + 320;

__device__ __forceinline__ float bf2f(unsigned v) { return __uint_as_float(v << 16); }
__device__ __forceinline__ unsigned f2bf(float f) { unsigned u = __float_as_uint(f); return (u + 0x7fffu + ((u >> 16) & 1u)) >> 16; }
__device__ __forceinline__ unsigned pk2(float lo, float hi) { return f2bf(lo) | (f2bf(hi) << 16); }
__device__ __forceinline__ float wave_sum(float v) {
#pragma unroll
    for (int o = 1; o < 64; o <<= 1) v += __shfl_xor(v, o);
    return v;
}
__device__ __forceinline__ f32x4 unpack4(u32x2 r) { return (f32x4){bf2f(r.x & 0xffffu), bf2f(r.x >> 16), bf2f(r.y & 0xffffu), bf2f(r.y >> 16)}; }
__device__ __forceinline__ float dot4(f32x4 a) { return (a[0] * a[0] + a[1] * a[1]) + (a[2] * a[2] + a[3] * a[3]); }
typedef short v4i16_t __attribute__((ext_vector_type(4)));
__device__ __forceinline__ s16x4 trr(LAS const unsigned char* p) { return __builtin_bit_cast(s16x4, __builtin_amdgcn_ds_read_tr16_b64_v4i16((LAS v4i16_t*)p)); }
__device__ __forceinline__ bf16x8 cat8(s16x4 lo, s16x4 hi) { return __builtin_shufflevector(lo, hi, 0, 1, 2, 3, 4, 5, 6, 7); }
__device__ __forceinline__ bf16x8 pack8(f32x4 a, f32x4 b) { u32x4 w; w.x = pk2(a[0], a[1]); w.y = pk2(a[2], a[3]); w.z = pk2(b[0], b[1]); w.w = pk2(b[2], b[3]); return __builtin_bit_cast(bf16x8, w); }
#define MFMA(a, b, c) __builtin_amdgcn_mfma_f32_16x16x32_bf16((a), (b), (c), 0, 0, 0)

#define XB_TMO      128
#define XB_XCNT(j)  (256  + 64 * (j))
#define XB_XSUB(j)  (1280 + 64 * (j))
#define XB_XGEN(j)  (2304 + 64 * (j))
#define XB_TOP      3328
#define XB_TOPGEN   3392
#define XCD_BAR_WORDS 3456
#define XB_SPIN_CAP (1u << 18)
__device__ __forceinline__ unsigned xb_ld(unsigned* p)              { return __hip_atomic_load(p, __ATOMIC_RELAXED, __HIP_MEMORY_SCOPE_AGENT); }
__device__ __forceinline__ unsigned xb_add(unsigned* p, unsigned v) { return __hip_atomic_fetch_add(p, v, __ATOMIC_RELAXED, __HIP_MEMORY_SCOPE_AGENT); }
__device__ __forceinline__ unsigned xb_xcc_id() { return (unsigned)__builtin_amdgcn_s_getreg((3 << 11) | 20) & 0xFu; }
#define XB_SPIN(cond, bar) do { unsigned _sp = 0; while (cond) { __builtin_amdgcn_s_sleep(1); \
    if ((++_sp & 255u) == 0u) { if (xb_ld(&(bar)[XB_TMO])) break; if (_sp > XB_SPIN_CAP) { atomicAdd(&(bar)[XB_TMO], 1u); break; } } } } while (0)
struct XcdBarrier { unsigned* bar; unsigned x; volatile LAS unsigned* st; };
__device__ __forceinline__ XcdBarrier xcd_barrier_post(unsigned* bar, volatile LAS unsigned* st) {
    XcdBarrier b; b.bar = bar; b.x = xb_xcc_id(); b.st = st;
    if (threadIdx.x == 0) (void)xb_add(&bar[XB_XCNT(b.x)], 1u);
    return b;
}
__device__ __forceinline__ void xcd_barrier_complete(unsigned* bar, unsigned x, unsigned& nloc, unsigned& nx) {
    const unsigned G = gridDim.x * gridDim.y * gridDim.z;
    unsigned sum, cnt, mine, sp = 0u;
    for (;;) {
        sum = 0u; cnt = 0u; mine = 0u;
#pragma unroll
        for (unsigned j = 0; j < 16; ++j) { const unsigned c = xb_ld(&bar[XB_XCNT(j)]); sum += c; cnt += (c > 0u) ? 1u : 0u; mine = (j == x) ? c : mine; }
        if (sum == G) break;
        __builtin_amdgcn_s_sleep(1);
        if ((++sp & 255u) == 0u) { if (xb_ld(&bar[XB_TMO])) break; if (sp > XB_SPIN_CAP) { atomicAdd(&bar[XB_TMO], 1u); break; } }
    }
    nloc = mine > 0u ? mine : 1u; nx = cnt > 0u ? cnt : 1u;
}
__device__ __forceinline__ void xcd_barrier(const XcdBarrier& b) {
    asm volatile("s_waitcnt vmcnt(0)" ::: "memory");
    __syncthreads();
    if (threadIdx.x == 0) {
        unsigned* bar = b.bar;
        __builtin_amdgcn_s_waitcnt(0);
        unsigned nloc = b.st[0], nx = b.st[1];
        if (nloc == 0u) { xcd_barrier_complete(bar, b.x, nloc, nx); b.st[0] = nloc; b.st[1] = nx; }
        const unsigned old = xb_add(&bar[XB_XSUB(b.x)], 1u);
        const unsigned gen = old / nloc;
        if (old + 1u == (gen + 1u) * nloc) {
            __builtin_amdgcn_fence(__ATOMIC_RELEASE, "agent");
            asm volatile("s_waitcnt vmcnt(0)" ::: "memory");
            const unsigned og = xb_add(&bar[XB_TOP], 1u);
            const unsigned tg = og / nx;
            if (og + 1u == (tg + 1u) * nx) xb_add(&bar[XB_TOPGEN], 1u);
            else XB_SPIN(xb_ld(&bar[XB_TOPGEN]) == tg, bar);
            __builtin_amdgcn_fence(__ATOMIC_ACQUIRE, "agent");
            xb_add(&bar[XB_XGEN(b.x)], 1u);
            asm volatile("s_waitcnt vmcnt(0)" ::: "memory");
        } else {
            XB_SPIN(xb_ld(&bar[XB_XGEN(b.x)]) == gen, bar);
            __builtin_amdgcn_fence(__ATOMIC_ACQUIRE, "agent");
            asm volatile("s_waitcnt vmcnt(0)" ::: "memory");
        }
    }
    __syncthreads();
}

struct Frame {
    LAS unsigned char* lds;
    int tid, lane, wave, bx, G;
    const float *x, *c, *w_ada, *b_ada, *g_pre_mix, *g_post_mix, *g_pre_ffn, *g_post_ffn, *w_in, *w_gate_up, *b_gate, *g_gla_norm, *sinks, *w_out,
                *w_router, *b_router, *w_mlp1, *b_mlp1, *w_mlp2, *b_mlp2;
    float* out;
    unsigned char* ws;
};
#define WSP(type, off) ((type*)(F.ws + (off)))

__device__ __forceinline__ void tr_item(const float* W, int N, bf16* WT, int nblk, LAS float* scr, int item, int lane) {
    const int kb = item / nblk, nb = item % nblk, k0 = 64 * kb, n0 = 32 * nb;
    const int n = n0 + (lane & 31);
#pragma unroll 8
    for (int i = 0; i < 32; ++i) { const int kk = 2 * i + (lane >> 5); scr[kk * 33 + (lane & 31)] = (n < N) ? W[(size_t)(k0 + kk) * N + n] : 0.f; }
    asm volatile("s_waitcnt lgkmcnt(0)" ::: "memory");
    const int c = lane & 7;
#pragma unroll
    for (int j = 0; j < 4; ++j) { const int nn = (lane >> 3) + 8 * j; const LAS float* s = scr + (8 * c) * 33 + nn;
        u32x4 o; o.x = pk2(s[0 * 33], s[1 * 33]); o.y = pk2(s[2 * 33], s[3 * 33]); o.z = pk2(s[4 * 33], s[5 * 33]); o.w = pk2(s[6 * 33], s[7 * 33]);
        *(u32x4*)(WT + (size_t)(n0 + nn) * 1024 + k0 + 8 * c) = o; }
    asm volatile("s_waitcnt lgkmcnt(0)" ::: "memory");
}
__device__ __forceinline__ void p0_prologue(const Frame& F) {
    float* mod = WSP(float, WS_MOD);
    if (F.bx < 192) {
        LAS float* red = (LAS float*)(F.lds + 98304);
        const int cl = F.tid & 31, ks = F.tid >> 5, col = F.bx * 32 + cl;
        float a0 = 0.f, a1 = 0.f;
#pragma unroll 8
        for (int k = ks * 64; k < ks * 64 + 64; ++k) {
            const float w = F.w_ada[(size_t)k * 6144 + col];
            const float c0 = F.c[k], c1 = F.c[1024 + k];
            a0 += c0 / (1.f + __expf(-c0)) * w; a1 += c1 / (1.f + __expf(-c1)) * w;
        }
        red[(0 * 16 + ks) * 32 + cl] = a0; red[(1 * 16 + ks) * 32 + cl] = a1;
        __syncthreads();
        if (F.tid < 64) { const int b = F.tid >> 5; float s = 0.f;
#pragma unroll
            for (int i = 0; i < 16; ++i) s += red[(b * 16 + i) * 32 + cl];
            mod[b * 6144 + col] = s + F.b_ada[col]; }
        __syncthreads();
    }
    LAS float* scr = (LAS float*)(F.lds + F.wave * 8704);
    const int gw = F.bx * NWAVES + F.wave, NGW = F.G * NWAVES;
    constexpr int I_IN = 16 * 80, I_OUT = 16 * 32, I_1 = 16 * 64, I_2 = 16 * 32;
    constexpr int NITEMS = I_IN + I_OUT + NE * I_1 + NE * I_2;
    for (int it = gw; it < NITEMS; it += NGW) {
        int r = it;
        if (r < I_IN) { tr_item(F.w_in, INW, WSP(bf16, WS_WIN), 80, scr, r, F.lane); continue; } r -= I_IN;
        if (r < I_OUT) { tr_item(F.w_out, 1024, WSP(bf16, WS_WOUT), 32, scr, r, F.lane); continue; } r -= I_OUT;
        if (r < NE * I_1) { const int e = r / I_1; tr_item(F.w_mlp1 + (size_t)e * 1024 * 2048, 2048, WSP(bf16, WS_W1T) + (size_t)e * 2048 * 1024, 64, scr, r % I_1, F.lane); continue; } r -= NE * I_1;
        { const int e = r / I_2; tr_item(F.w_mlp2 + (size_t)e * 1024 * 1024, 1024, WSP(bf16, WS_W2T) + (size_t)e * 1024 * 1024, 32, scr, r % I_2, F.lane); }
    }
}

__device__ __forceinline__ void p1_norm(const Frame& F) {
    const float* mod = WSP(float, WS_MOD); bf16* h = WSP(bf16, WS_H);
    const int gw = F.bx * NWAVES + F.wave, NGW = F.G * NWAVES;
    for (int m = gw; m < T; m += NGW) {
        const int b = m >> 14; const float* modb = mod + b * 6144;
        f32x4 v[4]; float ss = 0.f;
#pragma unroll
        for (int j = 0; j < 4; ++j) { v[j] = *(const f32x4*)(F.x + (size_t)m * D + 4 * F.lane + 256 * j); ss += dot4(v[j]); }
        const float r = rsqrtf(wave_sum(ss) * (1.f / D) + EPS);
#pragma unroll
        for (int j = 0; j < 4; ++j) { const int idx = 4 * F.lane + 256 * j;
            const f32x4 g = *(const f32x4*)(F.g_pre_mix + idx), sc = *(const f32x4*)(modb + 1024 + idx), sh = *(const f32x4*)(modb + idx);
            const f32x4 hv = v[j] * r * g * (sc + 1.f) + sh;
            u32x2 o; o.x = pk2(hv[0], hv[1]); o.y = pk2(hv[2], hv[3]);
            *(u32x2*)(h + (size_t)m * D + idx) = o; }
    }
}

template <class Epi, class RowMap, class BSel>
__device__ __forceinline__ void simple_gemm(const Frame& F, const bf16* A, int lda, int M, int N, int K, const RowMap& rm, const BSel& bs, const Epi& E) {
    const int fr = F.lane & 15, fq = F.lane >> 4;
    const int ncg = N / 512, nbt = (M / 64) * ncg;
    for (int bt = F.bx; bt < nbt; bt += F.G) {
        const int mt = bt / ncg, cg = bt % ncg, m0 = mt * 64, n0 = cg * 512 + F.wave * 64;
        const bf16* Bt = bs(m0);
        const bf16* ap[4]; const bf16* bp[4];
#pragma unroll
        for (int i = 0; i < 4; ++i) { ap[i] = A + (size_t)rm(m0 + 16 * i + fr) * lda + 8 * fq; bp[i] = Bt + (size_t)(n0 + 16 * i + fr) * K + 8 * fq; }
        f32x4 acc[4][4];
#pragma unroll
        for (int i = 0; i < 4; ++i)
#pragma unroll
            for (int j = 0; j < 4; ++j) acc[i][j] = (f32x4){0.f, 0.f, 0.f, 0.f};
#pragma unroll 2
        for (int k0 = 0; k0 < K; k0 += 32) {
            bf16x8 a[4], b[4];
#pragma unroll
            for (int i = 0; i < 4; ++i) { a[i] = *(const bf16x8*)(ap[i] + k0); b[i] = *(const bf16x8*)(bp[i] + k0); }
#pragma unroll
            for (int i = 0; i < 4; ++i)
#pragma unroll
                for (int j = 0; j < 4; ++j) acc[i][j] = MFMA(b[j], a[i], acc[i][j]);
        }
#pragma unroll
        for (int i = 0; i < 4; ++i)
#pragma unroll
            for (int j = 0; j < 4; ++j) E(m0 + 16 * i + fr, n0 + 16 * j + 4 * fq, acc[i][j]);
    }
}
struct RowId { __device__ __forceinline__ int operator()(int m) const { return m; } };
struct RowGather { const int* slot_assign; __device__ __forceinline__ int operator()(int m) const { const int a = slot_assign[m]; return a < 0 ? 0 : (a >> 2); } };
struct BFixed { const bf16* Bt; __device__ __forceinline__ const bf16* operator()(int) const { return Bt; } };
struct BExpert { const bf16* Bt; const int* tile_e; size_t stride; __device__ __forceinline__ const bf16* operator()(int m0) const { return Bt + (size_t)tile_e[m0 >> 8] * stride; } };
struct EpiStore { bf16* O; int ldo;
    __device__ __forceinline__ void operator()(int m, int n, f32x4 v) const { u32x2 w; w.x = pk2(v[0], v[1]); w.y = pk2(v[2], v[3]); *(u32x2*)(O + (size_t)m * ldo + n) = w; } };
__device__ __forceinline__ float swiglu(float g, float l) {
    const float xg = fminf(g, 7.f), xl = fminf(fmaxf(l, -7.f), 7.f);
    return xg / (1.f + __expf(-1.702f * xg)) * (xl + 1.f);
}
struct EpiSwiglu { bf16* Aout; const float* b1; const int* tile_e;
    __device__ __forceinline__ void operator()(int m, int n, f32x4 v) const {
        const int e = tile_e[m >> 8]; const f32x4 bb = *(const f32x4*)(b1 + (size_t)e * 2048 + n);
        const float a0 = swiglu(v[0] + bb[0], v[1] + bb[1]), a1 = swiglu(v[2] + bb[2], v[3] + bb[3]);
        *(unsigned*)(Aout + (size_t)m * FF + (n >> 1)) = pk2(a0, a1); } };
struct EpiMoe2 { bf16* ys; const float* b2; const int* tile_e; const int* slot_assign; const float* slot_gate;
    __device__ __forceinline__ void operator()(int m, int n, f32x4 v) const {
        const int asg = slot_assign[m]; if (asg < 0) return;
        const int e = tile_e[m >> 8]; const f32x4 bb = *(const f32x4*)(b2 + (size_t)e * D + n); const float g = slot_gate[m];
        u32x2 w; w.x = pk2((v[0] + bb[0]) * g, (v[1] + bb[1]) * g); w.y = pk2((v[2] + bb[2]) * g, (v[3] + bb[3]) * g);
        *(u32x2*)(ys + (size_t)asg * D + n) = w; } };

__device__ __forceinline__ void attn_unit(const Frame& F, int u) {
    const int qblk = u & 127, kvh = (u >> 7) & 1, b = u >> 8;
    LAS unsigned char* Ks = F.lds; LAS unsigned char* Vs = F.lds + 256 * 144;
    const bf16* proj = WSP(bf16, WS_PROJ); bf16* mix = WSP(bf16, WS_MIX);
    const int tok0 = b * S + qblk * 128;
#pragma unroll
    for (int i = 0; i < 4; ++i) {
        const int cid = F.tid + 512 * i, row = cid >> 3, ch = cid & 7;
        u32x4 kv = (u32x4){0u, 0u, 0u, 0u}, vv = (u32x4){0u, 0u, 0u, 0u};
        if (qblk > 0 || row >= 128) {
            const bf16* rp = proj + (size_t)(tok0 - 128 + row) * INP;
            kv = *(const u32x4*)(rp + AK_OFF + kvh * 64 + ch * 8);
            vv = *(const u32x4*)(rp + AV_OFF + kvh * 64 + ch * 8);
        }
        *(LAS u32x4*)(Ks + row * 144 + ch * 16) = kv;
        *(LAS u32x4*)(Vs + row * 144 + ch * 16) = vv;
    }
    __syncthreads();
    const int g = F.wave >> 1, hw = F.wave & 1, hq = kvh * 4 + g;
    const int lane = F.lane, fr = lane & 15, fq = lane >> 4;
    const float sink = F.sinks[hq];
    const float NEG_INF = -__builtin_inff();
    for (int qb = 0; qb < 4; ++qb) {
        const int i = 64 * hw + 16 * qb + fr;
        const bf16* qp = proj + (size_t)(tok0 + i) * INP + AQ_OFF + hq * 64 + 8 * fq;
        const bf16x8 q0 = *(const bf16x8*)qp, q1 = *(const bf16x8*)(qp + 32);
        f32x4 st[12];
#pragma unroll
        for (int kt = 0; kt < 12; ++kt) {
            LAS const unsigned char* kp = Ks + (64 * hw + 16 * kt + fr) * 144 + fq * 16;
            const bf16x8 k0 = *(LAS const bf16x8*)kp, k1 = *(LAS const bf16x8*)(kp + 64);
            f32x4 z = (f32x4){0.f, 0.f, 0.f, 0.f}; z = MFMA(k0, q0, z); z = MFMA(k1, q1, z); st[kt] = z;
        }
        float mx = NEG_INF;
#pragma unroll
        for (int kt = 0; kt < 12; ++kt)
#pragma unroll
            for (int r = 0; r < 4; ++r) {
                const int j = 64 * hw + 16 * kt + 4 * fq + r, rel = i + 128 - j;
                const bool ok = (rel >= 0) && (rel < 128) && (qblk > 0 || j >= 128);
                const float s = ok ? st[kt][r] * 0.125f : NEG_INF;
                st[kt][r] = s; mx = fmaxf(mx, s);
            }
        mx = fmaxf(mx, __shfl_xor(mx, 16)); mx = fmaxf(mx, __shfl_xor(mx, 32)); mx = fmaxf(mx, sink);
        float sum = 0.f;
#pragma unroll
        for (int kt = 0; kt < 12; ++kt)
#pragma unroll
            for (int r = 0; r < 4; ++r) { const float p = __expf(st[kt][r] - mx); st[kt][r] = p; sum += p; }
        sum += __shfl_xor(sum, 16); sum += __shfl_xor(sum, 32); sum += __expf(sink - mx);
        const float inv = 1.f / sum;
        f32x4 o[4];
#pragma unroll
        for (int c = 0; c < 4; ++c) o[c] = (f32x4){0.f, 0.f, 0.f, 0.f};
#pragma unroll
        for (int ks = 0; ks < 6; ++ks) {
            const bf16x8 pf = pack8(st[2 * ks], st[2 * ks + 1]);
            const int rb = 64 * hw + 32 * ks + 4 * fq + (fr >> 2);
#pragma unroll
            for (int c = 0; c < 4; ++c) {
                LAS const unsigned char* vp = Vs + rb * 144 + (16 * c + 4 * (lane & 3)) * 2;
                const bf16x8 vf = cat8(trr(vp), trr(vp + 16 * 144));
                o[c] = MFMA(pf, vf, o[c]);
            }
        }
#pragma unroll
        for (int r = 0; r < 4; ++r) {
            const int qrow = 4 * fq + r; const float iv = __shfl(inv, qrow);
            bf16* op = mix + (size_t)(tok0 + 64 * hw + 16 * qb + qrow) * D + hq * 64 + fr;
#pragma unroll
            for (int c = 0; c < 4; ++c) op[16 * c] = (bf16)f2bf(o[c][r] * iv);
        }
    }
    __syncthreads();
}

__device__ __forceinline__ void gla_gate_prefix(const Frame& F, const bf16* proj, int t0, int h, LAS float* ga_s, LAS float* tot_s, float (&bv)[8], float& b_mid, float& b_last) {
#pragma unroll
    for (int i = 0; i < 2; ++i) { const int idx = F.tid + 512 * i, t = idx >> 4, r = idx & 15; ga_s[idx] = bf2f(proj[(size_t)(t0 + t) * INP + GA_OFF + r]); }
    float wu[16];
#pragma unroll
    for (int r = 0; r < 16; ++r) wu[r] = F.w_gate_up[r * 256 + h * 64 + F.lane];
    const float bg = F.b_gate[h * 64 + F.lane];
    __syncthreads();
    float run = 0.f;
#pragma unroll
    for (int i = 0; i < 8; ++i) {
        const int t = 8 * F.wave + i; float z = bg;
#pragma unroll
        for (int r = 0; r < 16; ++r) z += ga_s[t * 16 + r] * wu[r];
        const float ls = fminf(z, 0.f) - __logf(1.f + __expf(-fabsf(z)));
        run += ls * (1.f / 16.f); bv[i] = run;
    }
    tot_s[F.wave * 64 + F.lane] = run;
    __syncthreads();
    float pre = 0.f, mid = 0.f, all = 0.f;
#pragma unroll
    for (int w = 0; w < 8; ++w) { const float tv = tot_s[w * 64 + F.lane]; pre += (w < F.wave) ? tv : 0.f; mid += (w < 4) ? tv : 0.f; all += tv; }
#pragma unroll
    for (int i = 0; i < 8; ++i) bv[i] += pre;
    b_mid = mid; b_last = all;
}
__device__ __forceinline__ void gla_kv_unit(const Frame& F, int u) {
    const int h = u & 3, n = (u >> 2) & 255, b = u >> 10, t0 = b * S + n * 64;
    const bf16* proj = WSP(bf16, WS_PROJ);
    LAS unsigned char* kd_s = F.lds; LAS unsigned char* v_s = F.lds + 9216;
    LAS float* ga_s = (LAS float*)(F.lds + 26624); LAS float* tot_s = (LAS float*)(F.lds + 30720);
    const int lane = F.lane, fr = lane & 15, fq = lane >> 4;
#pragma unroll
    for (int i = 0; i < 2; ++i) { const int cid = F.tid + 512 * i, row = cid >> 4, ch = cid & 15;
        *(LAS u32x4*)(v_s + row * 272 + ch * 16) = *(const u32x4*)(proj + (size_t)(t0 + row) * INP + GV_OFF + h * 128 + ch * 8); }
    float bv[8], b_mid, b_last;
    gla_gate_prefix(F, proj, t0, h, ga_s, tot_s, bv, b_mid, b_last);
#pragma unroll
    for (int i = 0; i < 8; ++i) { const int t = 8 * F.wave + i;
        const float kx = bf2f(proj[(size_t)(t0 + t) * INP + GK_OFF + h * 64 + lane]);
        *(LAS bf16*)(kd_s + t * 144 + lane * 2) = (bf16)f2bf(kx * __expf(b_last - bv[i])); }
    if (F.wave == 0) WSP(float, WS_DECAY)[((size_t)(b * NCH + n) * 4 + h) * 64 + lane] = __expf(b_last);
    __syncthreads();
    const int c = F.wave;
    f32x4 acc[4];
#pragma unroll
    for (int d = 0; d < 4; ++d) acc[d] = (f32x4){0.f, 0.f, 0.f, 0.f};
#pragma unroll
    for (int ks = 0; ks < 2; ++ks) {
        const int rb = 32 * ks + 8 * fq + (fr >> 2);
        LAS const unsigned char* vp = v_s + rb * 272 + (16 * c + 4 * (lane & 3)) * 2;
        const bf16x8 vf = cat8(trr(vp), trr(vp + 4 * 272));
#pragma unroll
        for (int d = 0; d < 4; ++d) {
            LAS const unsigned char* kp = kd_s + rb * 144 + (16 * d + 4 * (lane & 3)) * 2;
            const bf16x8 kf = cat8(trr(kp), trr(kp + 4 * 144));
            acc[d] = MFMA(kf, vf, acc[d]);
        }
    }
    float* kvp = WSP(float, WS_KV) + (((size_t)(b * NCH + n) * 4 + h) * 128 + 16 * c + fr) * 64;
#pragma unroll
    for (int d = 0; d < 4; ++d) *(f32x4*)(kvp + 16 * d + 4 * fq) = acc[d];
    __syncthreads();
}
__device__ __forceinline__ void gla_scan(const Frame& F) {
    float* kv = WSP(float, WS_KV); const float* decay = WSP(float, WS_DECAY);
    if (F.tid >= 256) return;
    for (int idx = F.bx * 256 + F.tid; idx < 65536; idx += F.G * 256) {
        const int b = idx >> 15, h = (idx >> 13) & 3, dvdk = idx & 8191, dk = idx & 63;
        float* p = kv + ((size_t)(b * NCH) * 4 + h) * 8192 + dvdk;
        const float* dp = decay + ((size_t)(b * NCH) * 4 + h) * 64 + dk;
        float state = 0.f;
        for (int n = 0; n < NCH; n += 8) {
            float tv[8], dv[8];
#pragma unroll
            for (int i = 0; i < 8; ++i) { tv[i] = p[(size_t)(n + i) * 4 * 8192]; dv[i] = dp[(size_t)(n + i) * 4 * 64]; }
#pragma unroll
            for (int i = 0; i < 8; ++i) { p[(size_t)(n + i) * 4 * 8192] = state; state = dv[i] * state + tv[i]; }
        }
    }
}
__device__ __forceinline__ void gla_out_unit(const Frame& F, int u) {
    const int h = u & 3, n = (u >> 2) & 255, b = u >> 10, t0 = b * S + n * 64;
    const bf16* proj = WSP(bf16, WS_PROJ); bf16* mix = WSP(bf16, WS_MIX);
    LAS unsigned char* qd_s = F.lds; LAS unsigned char* kk_s = F.lds + 9216; LAS unsigned char* qe_s = F.lds + 18432;
    LAS unsigned char* v_s = F.lds + 27648; LAS unsigned char* st_s = F.lds + 45056;
    LAS float* ga_s = (LAS float*)(F.lds + 63488); LAS float* tot_s = (LAS float*)(F.lds + 67584); LAS float* ssq_s = (LAS float*)(F.lds + 69632);
    const int lane = F.lane, fr = lane & 15, fq = lane >> 4;
#pragma unroll
    for (int i = 0; i < 2; ++i) { const int cid = F.tid + 512 * i, row = cid >> 4, ch = cid & 15;
        *(LAS u32x4*)(v_s + row * 272 + ch * 16) = *(const u32x4*)(proj + (size_t)(t0 + row) * INP + GV_OFF + h * 128 + ch * 8); }
    const float* stg = WSP(float, WS_KV) + ((size_t)(b * NCH + n) * 4 + h) * 8192;
#pragma unroll
    for (int i = 0; i < 4; ++i) { const int i4 = F.tid + 512 * i, dv = i4 >> 4, dk4 = (i4 & 15) * 4;
        const f32x4 sv = *(const f32x4*)(stg + dv * 64 + dk4);
        u32x2 w; w.x = pk2(sv[0], sv[1]); w.y = pk2(sv[2], sv[3]);
        *(LAS u32x2*)(st_s + dv * 144 + dk4 * 2) = w; }
    float bv[8], b_mid, b_last;
    gla_gate_prefix(F, proj, t0, h, ga_s, tot_s, bv, b_mid, b_last);
#pragma unroll
    for (int i = 0; i < 8; ++i) { const int t = 8 * F.wave + i; const bf16* rp = proj + (size_t)(t0 + t) * INP + h * 64 + lane;
        const float qx = bf2f(rp[GQ_OFF]) * 0.125f, kx = bf2f(rp[GK_OFF]);
        *(LAS bf16*)(qd_s + t * 144 + lane * 2) = (bf16)f2bf(qx * __expf(bv[i] - b_mid));
        *(LAS bf16*)(kk_s + t * 144 + lane * 2) = (bf16)f2bf(kx * __expf(b_mid - bv[i]));
        *(LAS bf16*)(qe_s + t * 144 + lane * 2) = (bf16)f2bf(qx * __expf(bv[i])); }
    __syncthreads();
    const int ib = F.wave >> 1, dvh = F.wave & 1;
    bf16x8 qdf[2], qef[2];
#pragma unroll
    for (int ks = 0; ks < 2; ++ks) { qdf[ks] = *(LAS const bf16x8*)(qd_s + (16 * ib + fr) * 144 + (32 * ks + 8 * fq) * 2);
                                     qef[ks] = *(LAS const bf16x8*)(qe_s + (16 * ib + fr) * 144 + (32 * ks + 8 * fq) * 2); }
    f32x4 at[4];
#pragma unroll
    for (int jt = 0; jt < 4; ++jt) {
        LAS const unsigned char* kp = kk_s + (16 * jt + fr) * 144 + (8 * fq) * 2;
        const bf16x8 k0 = *(LAS const bf16x8*)kp, k1 = *(LAS const bf16x8*)(kp + 64);
        f32x4 z = (f32x4){0.f, 0.f, 0.f, 0.f}; z = MFMA(k0, qdf[0], z); z = MFMA(k1, qdf[1], z);
#pragma unroll
        for (int r = 0; r < 4; ++r) if (16 * jt + 4 * fq + r > 16 * ib + fr) z[r] = 0.f;
        at[jt] = z;
    }
    bf16x8 pf[2];
    pf[0] = pack8(at[0], at[1]); pf[1] = pack8(at[2], at[3]);
    f32x4 o[4];
#pragma unroll
    for (int c = 0; c < 4; ++c) {
        const int dvt = 4 * dvh + c; f32x4 z = (f32x4){0.f, 0.f, 0.f, 0.f};
#pragma unroll
        for (int ks = 0; ks < 2; ++ks) {
            const int rb = 32 * ks + 4 * fq + (fr >> 2);
            LAS const unsigned char* vp = v_s + rb * 272 + (16 * dvt + 4 * (lane & 3)) * 2;
            z = MFMA(pf[ks], cat8(trr(vp), trr(vp + 16 * 272)), z);
        }
#pragma unroll
        for (int ks = 0; ks < 2; ++ks) {
            const bf16x8 sf = *(LAS const bf16x8*)(st_s + (16 * dvt + fr) * 144 + (32 * ks + 8 * fq) * 2);
            z = MFMA(qef[ks], sf, z);
        }
        o[c] = z;
    }
    float ssq[4];
#pragma unroll
    for (int r = 0; r < 4; ++r) { float s = 0.f;
#pragma unroll
        for (int c = 0; c < 4; ++c) s += o[c][r] * o[c][r];
        s += __shfl_xor(s, 1); s += __shfl_xor(s, 2); s += __shfl_xor(s, 4); s += __shfl_xor(s, 8);
        ssq[r] = s; if (fr == 0) ssq_s[F.wave * 16 + 4 * fq + r] = s; }
    __syncthreads();
#pragma unroll
    for (int r = 0; r < 4; ++r) {
        const float tot = ssq[r] + ssq_s[(F.wave ^ 1) * 16 + 4 * fq + r];
        const float rinv = rsqrtf(tot * (1.f / 128.f) + EPS);
        const int t = t0 + 16 * ib + 4 * fq + r;
#pragma unroll
        for (int c = 0; c < 4; ++c) { const int dv = 16 * (4 * dvh + c) + fr;
            const float gg = bf2f(proj[(size_t)t * INP + GG_OFF + h * 128 + dv]);
            const float val = o[c][r] * rinv * F.g_gla_norm[dv] * (gg / (1.f + __expf(-gg)));
            mix[(size_t)t * D + 512 + h * 128 + dv] = (bf16)f2bf(val); }
    }
    __syncthreads();
}

__device__ __forceinline__ void p7_norm_router(const Frame& F) {
    const float* mod = WSP(float, WS_MOD); const bf16* y = WSP(bf16, WS_Y); float* x1 = WSP(float, WS_X1); bf16* h2 = WSP(bf16, WS_H);
    int* tok_e = WSP(int, WS_TOK_E); int* tok_lpos = WSP(int, WS_TOK_LPOS); float* tok_gate = WSP(float, WS_TOK_GATE);
    LAS float* wr_s = (LAS float*)F.lds; LAS float* lg_s = (LAS float*)(F.lds + SMALL_OFF); LAS int* cnt_s = (LAS int*)(F.lds + SMALL_OFF + 1024);
    const int lane = F.lane;
#pragma unroll
    for (int i = 0; i < 16; ++i) { const int idx = (F.tid + 512 * i) * 4, k = idx >> 5, e0 = idx & 31;
        *(LAS f32x4*)(wr_s + k * 32 + ((((e0 >> 2) ^ ((k >> 2) & 7))) << 2)) = *(const f32x4*)(F.w_router + idx); }
    if (F.tid < 32) cnt_s[F.tid] = 0;
    __syncthreads();
    const float NEG_INF = -__builtin_inff();
    for (int it = 0; it < 16; ++it) {
        const int m = F.bx * 128 + F.wave * 16 + it, b = m >> 14; const float* modb = mod + b * 6144;
        f32x4 xv[4], hv[4]; float ss = 0.f;
#pragma unroll
        for (int j = 0; j < 4; ++j) { hv[j] = unpack4(*(const u32x2*)(y + (size_t)m * D + 4 * lane + 256 * j)); ss += dot4(hv[j]); }
        const float ry = rsqrtf(wave_sum(ss) * (1.f / D) + EPS);
        float s2 = 0.f;
#pragma unroll
        for (int j = 0; j < 4; ++j) { const int idx = 4 * lane + 256 * j;
            const f32x4 g = *(const f32x4*)(F.g_post_mix + idx), gt = *(const f32x4*)(modb + 2048 + idx), xx = *(const f32x4*)(F.x + (size_t)m * D + idx);
            xv[j] = xx + gt * (hv[j] * ry * g); *(f32x4*)(x1 + (size_t)m * D + idx) = xv[j]; s2 += dot4(xv[j]); }
        const float rx = rsqrtf(wave_sum(s2) * (1.f / D) + EPS);
#pragma unroll
        for (int j = 0; j < 4; ++j) { const int idx = 4 * lane + 256 * j;
            const f32x4 g = *(const f32x4*)(F.g_pre_ffn + idx), sc = *(const f32x4*)(modb + 4096 + idx), sh = *(const f32x4*)(modb + 3072 + idx);
            hv[j] = xv[j] * rx * g * (sc + 1.f) + sh;
            u32x2 o; o.x = pk2(hv[j][0], hv[j][1]); o.y = pk2(hv[j][2], hv[j][3]);
            *(u32x2*)(h2 + (size_t)m * D + idx) = o; }
        float acc[32];
#pragma unroll
        for (int e = 0; e < 32; ++e) acc[e] = 0.f;
#pragma unroll
        for (int j = 0; j < 4; ++j)
#pragma unroll
            for (int c = 0; c < 4; ++c) { const int k = 4 * lane + 256 * j + c; const float hvv = hv[j][c]; LAS const float* wp = wr_s + k * 32;
#pragma unroll
                for (int ch = 0; ch < 8; ++ch) { const f32x4 w = *(LAS const f32x4*)(wp + ((ch ^ (lane & 7)) << 2));
                    acc[4 * ch + 0] += hvv * w[0]; acc[4 * ch + 1] += hvv * w[1]; acc[4 * ch + 2] += hvv * w[2]; acc[4 * ch + 3] += hvv * w[3]; } }
#define RED_STEP(HALF, BIT) _Pragma("unroll") for (int i2 = 0; i2 < HALF; ++i2) { const bool hi = (lane & BIT) != 0; \
            const float keep = hi ? acc[i2 + HALF] : acc[i2]; const float send = hi ? acc[i2] : acc[i2 + HALF]; acc[i2] = keep + __shfl_xor(send, BIT); }
        RED_STEP(16, 32) RED_STEP(8, 16) RED_STEP(4, 8) RED_STEP(2, 4) RED_STEP(1, 2)
#undef RED_STEP
        acc[0] += __shfl_xor(acc[0], 1);
        const int my_exp = lane >> 1;
        if ((lane & 1) == 0) lg_s[F.wave * 32 + my_exp] = acc[0] + F.b_router[my_exp];
        float v[32];
#pragma unroll
        for (int ch = 0; ch < 8; ++ch) { const f32x4 w = *(LAS const f32x4*)(lg_s + F.wave * 32 + 4 * ch); v[4 * ch] = w[0]; v[4 * ch + 1] = w[1]; v[4 * ch + 2] = w[2]; v[4 * ch + 3] = w[3]; }
        int se[4]; float sv[4];
#pragma unroll
        for (int r = 0; r < 4; ++r) { float best = v[0]; int bi = 0;
#pragma unroll
            for (int e = 1; e < 32; ++e) if (v[e] > best) { best = v[e]; bi = e; }
            se[r] = bi; sv[r] = best;
#pragma unroll
            for (int e = 0; e < 32; ++e) v[e] = (e == bi) ? NEG_INF : v[e]; }
        const float p1 = __expf(sv[1] - sv[0]), p2 = __expf(sv[2] - sv[0]), p3 = __expf(sv[3] - sv[0]);
        const float rs = 1.f / (1.f + p1 + p2 + p3);
        if (lane < 4) {
            const int my_e = lane == 0 ? se[0] : lane == 1 ? se[1] : lane == 2 ? se[2] : se[3];
            const float my_g = (lane == 0 ? 1.f : lane == 1 ? p1 : lane == 2 ? p2 : p3) * rs;
            const int lpos = __hip_atomic_fetch_add(cnt_s + my_e, 1, __ATOMIC_RELAXED, __HIP_MEMORY_SCOPE_WORKGROUP);
            tok_e[m * 4 + lane] = my_e; tok_lpos[m * 4 + lane] = lpos; tok_gate[m * 4 + lane] = my_g;
        }
    }
    __syncthreads();
    if (F.tid < 32) WSP(int, WS_BLK_CNT)[F.bx * 32 + F.tid] = cnt_s[F.tid];
}

__device__ __forceinline__ void p8_slots(const Frame& F) {
    const int* blk_cnt = WSP(int, WS_BLK_CNT);
    LAS int* tot_p = (LAS int*)F.lds; LAS int* pre_p = tot_p + 512; LAS int* total_s = pre_p + 512; LAS int* pre_s = total_s + 32; LAS int* off_s = pre_s + 32;
    { const int e = F.tid & 31, part = F.tid >> 5; int s = 0, sp = 0;
        for (int bb = part * 16; bb < part * 16 + 16; ++bb) { const int c = blk_cnt[bb * 32 + e]; s += c; sp += (bb < F.bx) ? c : 0; }
        tot_p[part * 32 + e] = s; pre_p[part * 32 + e] = sp; }
    __syncthreads();
    if (F.tid < 32) { int s = 0, sp = 0;
        for (int p = 0; p < 16; ++p) { s += tot_p[p * 32 + F.tid]; sp += pre_p[p * 32 + F.tid]; }
        total_s[F.tid] = s; pre_s[F.tid] = sp; }
    __syncthreads();
    if (F.tid == 0) { int off = 0; for (int e = 0; e < 32; ++e) { off_s[e] = off; off += (total_s[e] + 255) & ~255; } off_s[32] = off; }
    __syncthreads();
    int* slot_assign = WSP(int, WS_SLOT_ASSIGN); float* slot_gate = WSP(float, WS_SLOT_GATE);
    { const int t = F.bx * 128 + (F.tid >> 2), k = F.tid & 3;
        const int e = WSP(int, WS_TOK_E)[t * 4 + k];
        const int slot = off_s[e] + pre_s[e] + WSP(int, WS_TOK_LPOS)[t * 4 + k];
        slot_assign[slot] = t * 4 + k; slot_gate[slot] = WSP(float, WS_TOK_GATE)[t * 4 + k]; }
    if (F.bx < 32) { const int e = F.bx; for (int s = off_s[e] + total_s[e] + F.tid; s < off_s[e + 1]; s += NTHREADS) { slot_assign[s] = -1; slot_gate[s] = 0.f; } }
    if (F.bx == 0) {
        if (F.tid <= 32) WSP(int, WS_MOE_OFF)[F.tid] = off_s[F.tid];
        const int ntile = off_s[32] >> 8;
        for (int rt = F.tid; rt < ntile; rt += NTHREADS) { int e = 0;
            for (int q = 1; q < 32; ++q) e = (off_s[q] <= rt * 256) ? q : e;
            WSP(int, WS_TILE_E)[rt] = e; }
    }
}

__device__ __forceinline__ void p11_combine(const Frame& F) {
    const float* mod = WSP(float, WS_MOD); const bf16* ys = WSP(bf16, WS_YS); const float* x1 = WSP(float, WS_X1);
    const int gw = F.bx * NWAVES + F.wave, NGW = F.G * NWAVES, lane = F.lane;
    for (int m = gw; m < T; m += NGW) {
        const int b = m >> 14; const float* modb = mod + b * 6144;
        f32x4 yv[4]; float ss = 0.f;
#pragma unroll
        for (int j = 0; j < 4; ++j) { f32x4 a = (f32x4){0.f, 0.f, 0.f, 0.f};
#pragma unroll
            for (int k4 = 0; k4 < 4; ++k4) a += unpack4(*(const u32x2*)(ys + ((size_t)m * 4 + k4) * D + 4 * lane + 256 * j));
            yv[j] = a; ss += dot4(a); }
        const float ry = rsqrtf(wave_sum(ss) * (1.f / D) + EPS);
#pragma unroll
        for (int j = 0; j < 4; ++j) { const int idx = 4 * lane + 256 * j;
            const f32x4 g = *(const f32x4*)(F.g_post_ffn + idx), gt = *(const f32x4*)(modb + 5120 + idx), xx = *(const f32x4*)(x1 + (size_t)m * D + idx);
            *(f32x4*)(F.out + (size_t)m * D + idx) = xx + gt * (yv[j] * ry * g); }
    }
}

constexpr int NPHASE = 12;
struct Args { const float* in[20]; float* out; unsigned char* ws; int ph_lo, ph_hi; };
__global__ void __launch_bounds__(NTHREADS, 2) fwd(Args args) {
    extern __shared__ __attribute__((aligned(16))) unsigned char lds[];
    Frame F;
    F.lds = (LAS unsigned char*)lds;
    F.tid = threadIdx.x; F.lane = F.tid & 63; F.wave = __builtin_amdgcn_readfirstlane(F.tid >> 6); F.bx = blockIdx.x; F.G = gridDim.x;
    F.x = args.in[0]; F.c = args.in[1]; F.w_ada = args.in[2]; F.b_ada = args.in[3]; F.g_pre_mix = args.in[4]; F.g_post_mix = args.in[5];
    F.g_pre_ffn = args.in[6]; F.g_post_ffn = args.in[7]; F.w_in = args.in[8]; F.w_gate_up = args.in[9]; F.b_gate = args.in[10]; F.g_gla_norm = args.in[11];
    F.sinks = args.in[12]; F.w_out = args.in[13]; F.w_router = args.in[14]; F.b_router = args.in[15]; F.w_mlp1 = args.in[16]; F.b_mlp1 = args.in[17];
    F.w_mlp2 = args.in[18]; F.b_mlp2 = args.in[19]; F.out = args.out; F.ws = args.ws;
    volatile LAS unsigned* MISC = (volatile LAS unsigned*)(F.lds + MISC_OFF);
    if (F.tid < 32) MISC[F.tid] = 0u;
    __syncthreads();
    const int lo = args.ph_lo, hi = args.ph_hi;
    XcdBarrier bar; bar.bar = (unsigned*)(F.ws + WS_CTL) + CW_BAR; bar.x = 0; bar.st = nullptr;
    if (hi - lo > 1) bar = xcd_barrier_post((unsigned*)(F.ws + WS_CTL) + CW_BAR, MISC + 8);
#define IN(k) (lo <= (k) && (k) < hi)
#define SEAM(k) do { if (IN(k) && IN((k) + 1)) xcd_barrier(bar); } while (0)

    if (IN(0)) { p0_prologue(F); } SEAM(0);
    if (IN(1)) { p1_norm(F); } SEAM(1);
    if (IN(2)) { simple_gemm(F, WSP(bf16, WS_H), D, T, INP, D, RowId{}, BFixed{WSP(bf16, WS_WIN)}, EpiStore{WSP(bf16, WS_PROJ), INP}); } SEAM(2);
    if (IN(3)) { for (int u = F.bx; u < 512; u += F.G) attn_unit(F, u);
                 for (int u = F.bx; u < 2048; u += F.G) gla_kv_unit(F, u); } SEAM(3);
    if (IN(4)) { gla_scan(F); } SEAM(4);
    if (IN(5)) { for (int u = F.bx; u < 2048; u += F.G) gla_out_unit(F, u); } SEAM(5);
    if (IN(6)) { simple_gemm(F, WSP(bf16, WS_MIX), D, T, D, D, RowId{}, BFixed{WSP(bf16, WS_WOUT)}, EpiStore{WSP(bf16, WS_Y), D}); } SEAM(6);
    if (IN(7)) { p7_norm_router(F); } SEAM(7);
    if (IN(8)) { p8_slots(F); } SEAM(8);
    if (IN(9)) { const int M = WSP(int, WS_MOE_OFF)[32];
                 simple_gemm(F, WSP(bf16, WS_H), D, M, 2048, D, RowGather{WSP(int, WS_SLOT_ASSIGN)}, BExpert{WSP(bf16, WS_W1T), WSP(int, WS_TILE_E), (size_t)2048 * 1024},
                             EpiSwiglu{WSP(bf16, WS_A), F.b_mlp1, WSP(int, WS_TILE_E)}); } SEAM(9);
    if (IN(10)) { const int M = WSP(int, WS_MOE_OFF)[32];
                  simple_gemm(F, WSP(bf16, WS_A), FF, M, D, FF, RowId{}, BExpert{WSP(bf16, WS_W2T), WSP(int, WS_TILE_E), (size_t)1024 * 1024},
                              EpiMoe2{WSP(bf16, WS_YS), F.b_mlp2, WSP(int, WS_TILE_E), WSP(int, WS_SLOT_ASSIGN), WSP(float, WS_SLOT_GATE)}); } SEAM(10);
    if (IN(11)) { p11_combine(F); }
#undef IN
#undef SEAM
}

extern "C" void kernel_launch(void* const* d_in, const int* in_sizes, int n_in, void* d_out, int out_size, void* d_ws, size_t ws_size, hipStream_t stream) {
    static int ready = 0;
    if (ready == 0) {
        if (n_in != 20 || out_size != T * D || ws_size < WS_END) { fprintf(stderr, "kernel_launch: unexpected problem (n_in %d, out %d, ws %zu)\n", n_in, out_size, ws_size); ready = -1; return; }
        if (hipFuncSetAttribute((const void*)fwd, hipFuncAttributeMaxDynamicSharedMemorySize, LDS_BYTES) != hipSuccess) { fprintf(stderr, "kernel_launch: hipFuncSetAttribute failed\n"); ready = -1; return; }
        int per_cu = 0;
        if (hipOccupancyMaxActiveBlocksPerMultiprocessor(&per_cu, (const void*)fwd, NTHREADS, LDS_BYTES) != hipSuccess || per_cu < 1) fprintf(stderr, "kernel_launch: occupancy query says %d\n", per_cu);
        (void)hipGetLastError();
        ready = 1;
    }
    if (ready < 0) return;
    (void)hipMemsetAsync((char*)d_ws + WS_CTL, 0, CTL_ZERO_BYTES, stream);
    Args a{};
    for (int i = 0; i < 20; ++i) a.in[i] = (const float*)d_in[i];
    a.out = (float*)d_out; a.ws = (unsigned char*)d_ws;
#if MK_ONE_LAUNCH
    a.ph_lo = 0; a.ph_hi = NPHASE;
    hipLaunchKernelGGL(fwd, dim3(GRID), dim3(NTHREADS), LDS_BYTES, stream, a);
#else
    for (int p = 0; p < NPHASE; ++p) { a.ph_lo = p; a.ph_hi = p + 1; hipLaunchKernelGGL(fwd, dim3(GRID), dim3(NTHREADS), LDS_BYTES, stream, a); }
#endif
}
```

```cpp
#include <hip/hip_runtime.h>
#include <cstdio>
#include <cstdint>

#ifndef MK_ONE_LAUNCH
#define MK_ONE_LAUNCH 1
#endif

#define LAS __attribute__((address_space(3)))
typedef unsigned short bf16;
typedef short bf16x8 __attribute__((ext_vector_type(8)));
typedef short s16x4 __attribute__((ext_vector_type(4)));
typedef float f32x4 __attribute__((ext_vector_type(4)));
typedef unsigned u32x4 __attribute__((ext_vector_type(4)));
typedef unsigned u32x2 __attribute__((ext_vector_type(2)));

constexpr int D = 1024, NB = 2, S = 16384, T = NB * S;
constexpr int INW = 2320, INP = 2560;
constexpr int AQ_OFF = 0, AK_OFF = 512, AV_OFF = 640, GQ_OFF = 768, GK_OFF = 1024, GV_OFF = 1280, GG_OFF = 1792, GA_OFF = 2304;
constexpr int NCH = 256;
constexpr int NE = 32, FF = 1024;
constexpr int NSLOT_MAX = T * 4 + NE * 256;
constexpr float EPS = 1e-6f;
constexpr int NWAVES = 8, NTHREADS = 512, GRID = 256;

constexpr size_t MiB = 1u << 20;
constexpr size_t WS_CTL = 0, CTL_ZERO_BYTES = 1 * MiB;
constexpr size_t WS_MOD = 1 * MiB;
constexpr size_t WS_DECAY = 2 * MiB;
constexpr size_t WS_ROUTE = 3 * MiB;
constexpr size_t WS_TOK_E = WS_ROUTE, WS_TOK_LPOS = WS_ROUTE + 512 * 1024, WS_TOK_GATE = WS_ROUTE + 1024 * 1024;
constexpr size_t WS_BLK_CNT = WS_ROUTE + 1536 * 1024, WS_MOE_OFF = WS_BLK_CNT + 32 * 1024, WS_TILE_E = WS_MOE_OFF + 4096;
constexpr size_t WS_SLOT_ASSIGN = WS_ROUTE + 2 * MiB, WS_SLOT_GATE = WS_ROUTE + 3 * MiB;
constexpr size_t WS_WIN = 8 * MiB, WS_WOUT = 13 * MiB, WS_W2T = 16 * MiB, WS_W1T = 80 * MiB;
constexpr size_t WS_H = 208 * MiB, WS_KV = 272 * MiB, WS_YS = 80 * MiB;
constexpr size_t WS_X1 = 336 * MiB, WS_PROJ = 464 * MiB, WS_MIX = 624 * MiB, WS_Y = 688 * MiB, WS_A = 464 * MiB;
constexpr size_t WS_END = 752 * MiB;
constexpr int CW_BAR = 4096;

constexpr int LDS_BYTES = 147456, SMALL_OFF = 132096, MISC_OFF = 131072 + 320;

__device__ __forceinline__ float bf2f(unsigned v) { return __uint_as_float(v << 16); }
__device__ __forceinline__ unsigned f2bf(float f) { unsigned u = __float_as_uint(f); return (u + 0x7fffu + ((u >> 16) & 1u)) >> 16; }
__device__ __forceinline__ unsigned pk2(float lo, float hi) { return f2bf(lo) | (f2bf(hi) << 16); }
__device__ __forceinline__ float wave_sum(float v) {
#pragma unroll
    for (int o = 1; o < 64; o <<= 1) v += __shfl_xor(v, o);
    return v;
}
__device__ __forceinline__ f32x4 unpack4(u32x2 r) { return (f32x4){bf2f(r.x & 0xffffu), bf2f(r.x >> 16), bf2f(r.y & 0xffffu), bf2f(r.y >> 16)}; }
__device__ __forceinline__ float dot4(f32x4 a) { return (a[0] * a[0] + a[1] * a[1]) + (a[2] * a[2] + a[3] * a[3]); }
typedef short v4i16_t __attribute__((ext_vector_type(4)));
__device__ __forceinline__ s16x4 trr(LAS const unsigned char* p) { return __builtin_bit_cast(s16x4, __builtin_amdgcn_ds_read_tr16_b64_v4i16((LAS v4i16_t*)p)); }
__device__ __forceinline__ bf16x8 cat8(s16x4 lo, s16x4 hi) { return __builtin_shufflevector(lo, hi, 0, 1, 2, 3, 4, 5, 6, 7); }
__device__ __forceinline__ bf16x8 pack8(f32x4 a, f32x4 b) { u32x4 w; w.x = pk2(a[0], a[1]); w.y = pk2(a[2], a[3]); w.z = pk2(b[0], b[1]); w.w = pk2(b[2], b[3]); return __builtin_bit_cast(bf16x8, w); }
#define MFMA(a, b, c) __builtin_amdgcn_mfma_f32_16x16x32_bf16((a), (b), (c), 0, 0, 0)

#define XB_TMO      128
#define XB_XCNT(j)  (256  + 64 * (j))
#define XB_XSUB(j)  (1280 + 64 * (j))
#define XB_XGEN(j)  (2304 + 64 * (j))
#define XB_TOP      3328
#define XB_TOPGEN   3392
#define XCD_BAR_WORDS 3456
#define XB_SPIN_CAP (1u << 18)
__device__ __forceinline__ unsigned xb_ld(unsigned* p)              { return __hip_atomic_load(p, __ATOMIC_RELAXED, __HIP_MEMORY_SCOPE_AGENT); }
__device__ __forceinline__ unsigned xb_add(unsigned* p, unsigned v) { return __hip_atomic_fetch_add(p, v, __ATOMIC_RELAXED, __HIP_MEMORY_SCOPE_AGENT); }
__device__ __forceinline__ unsigned xb_xcc_id() { return (unsigned)__builtin_amdgcn_s_getreg((3 << 11) | 20) & 0xFu; }
#define XB_SPIN(cond, bar) do { unsigned _sp = 0; while (cond) { __builtin_amdgcn_s_sleep(1); \
    if ((++_sp & 255u) == 0u) { if (xb_ld(&(bar)[XB_TMO])) break; if (_sp > XB_SPIN_CAP) { atomicAdd(&(bar)[XB_TMO], 1u); break; } } } } while (0)
struct XcdBarrier { unsigned* bar; unsigned x; volatile LAS unsigned* st; };
__device__ __forceinline__ XcdBarrier xcd_barrier_post(unsigned* bar, volatile LAS unsigned* st) {
    XcdBarrier b; b.bar = bar; b.x = xb_xcc_id(); b.st = st;
    if (threadIdx.x == 0) (void)xb_add(&bar[XB_XCNT(b.x)], 1u);
    return b;
}
__device__ __forceinline__ void xcd_barrier_complete(unsigned* bar, unsigned x, unsigned& nloc, unsigned& nx) {
    const unsigned G = gridDim.x * gridDim.y * gridDim.z;
    unsigned sum, cnt, mine, sp = 0u;
    for (;;) {
        sum = 0u; cnt = 0u; mine = 0u;
#pragma unroll
        for (unsigned j = 0; j < 16; ++j) { const unsigned c = xb_ld(&bar[XB_XCNT(j)]); sum += c; cnt += (c > 0u) ? 1u : 0u; mine = (j == x) ? c : mine; }
        if (sum == G) break;
        __builtin_amdgcn_s_sleep(1);
        if ((++sp & 255u) == 0u) { if (xb_ld(&bar[XB_TMO])) break; if (sp > XB_SPIN_CAP) { atomicAdd(&bar[XB_TMO], 1u); break; } }
    }
    nloc = mine > 0u ? mine : 1u; nx = cnt > 0u ? cnt : 1u;
}
__device__ __forceinline__ void xcd_barrier(const XcdBarrier& b) {
    asm volatile("s_waitcnt vmcnt(0)" ::: "memory");
    __syncthreads();
    if (threadIdx.x == 0) {
        unsigned* bar = b.bar;
        __builtin_amdgcn_s_waitcnt(0);
        unsigned nloc = b.st[0], nx = b.st[1];
        if (nloc == 0u) { xcd_barrier_complete(bar, b.x, nloc, nx); b.st[0] = nloc; b.st[1] = nx; }
        const unsigned old = xb_add(&bar[XB_XSUB(b.x)], 1u);
        const unsigned gen = old / nloc;
        if (old + 1u == (gen + 1u) * nloc) {
            __builtin_amdgcn_fence(__ATOMIC_RELEASE, "agent");
            asm volatile("s_waitcnt vmcnt(0)" ::: "memory");
            const unsigned og = xb_add(&bar[XB_TOP], 1u);
            const unsigned tg = og / nx;
            if (og + 1u == (tg + 1u) * nx) xb_add(&bar[XB_TOPGEN], 1u);
            else XB_SPIN(xb_ld(&bar[XB_TOPGEN]) == tg, bar);
            __builtin_amdgcn_fence(__ATOMIC_ACQUIRE, "agent");
            xb_add(&bar[XB_XGEN(b.x)], 1u);
            asm volatile("s_waitcnt vmcnt(0)" ::: "memory");
        } else {
            XB_SPIN(xb_ld(&bar[XB_XGEN(b.x)]) == gen, bar);
            __builtin_amdgcn_fence(__ATOMIC_ACQUIRE, "agent");
            asm volatile("s_waitcnt vmcnt(0)" ::: "memory");
        }
    }
    __syncthreads();
}

struct Frame {
    LAS unsigned char* lds;
    int tid, lane, wave, bx, G;
    const float *x, *c, *w_ada, *b_ada, *g_pre_mix, *g_post_mix, *g_pre_ffn, *g_post_ffn, *w_in, *w_gate_up, *b_gate, *g_gla_norm, *sinks, *w_out,
                *w_router, *b_router, *w_mlp1, *b_mlp1, *w_mlp2, *b_mlp2;
    float* out;
    unsigned char* ws;
};
#define WSP(type, off) ((type*)(F.ws + (off)))

__device__ __forceinline__ void tr_item(const float* W, int N, bf16* WT, int nblk, LAS float* scr, int item, int lane) {
    const int kb = item / nblk, nb = item % nblk, k0 = 64 * kb, n0 = 32 * nb;
    const int n = n0 + (lane & 31);
#pragma unroll 8
    for (int i = 0; i < 32; ++i) { const int kk = 2 * i + (lane >> 5); scr[kk * 33 + (lane & 31)] = (n < N) ? W[(size_t)(k0 + kk) * N + n] : 0.f; }
    asm volatile("s_waitcnt lgkmcnt(0)" ::: "memory");
    const int c = lane & 7;
#pragma unroll
    for (int j = 0; j < 4; ++j) { const int nn = (lane >> 3) + 8 * j; const LAS float* s = scr + (8 * c) * 33 + nn;
        u32x4 o; o.x = pk2(s[0 * 33], s[1 * 33]); o.y = pk2(s[2 * 33], s[3 * 33]); o.z = pk2(s[4 * 33], s[5 * 33]); o.w = pk2(s[6 * 33], s[7 * 33]);
        *(u32x4*)(WT + (size_t)(n0 + nn) * 1024 + k0 + 8 * c) = o; }
    asm volatile("s_waitcnt lgkmcnt(0)" ::: "memory");
}
__device__ __forceinline__ void p0_prologue(const Frame& F) {
    float* mod = WSP(float, WS_MOD);
    if (F.bx < 192) {
        LAS float* red = (LAS float*)(F.lds + 98304);
        const int cl = F.tid & 31, ks = F.tid >> 5, col = F.bx * 32 + cl;
        float a0 = 0.f, a1 = 0.f;
#pragma unroll 8
        for (int k = ks * 64; k < ks * 64 + 64; ++k) {
            const float w = F.w_ada[(size_t)k * 6144 + col];
            const float c0 = F.c[k], c1 = F.c[1024 + k];
            a0 += c0 / (1.f + __expf(-c0)) * w; a1 += c1 / (1.f + __expf(-c1)) * w;
        }
        red[(0 * 16 + ks) * 32 + cl] = a0; red[(1 * 16 + ks) * 32 + cl] = a1;
        __syncthreads();
        if (F.tid < 64) { const int b = F.tid >> 5; float s = 0.f;
#pragma unroll
            for (int i = 0; i < 16; ++i) s += red[(b * 16 + i) * 32 + cl];
            mod[b * 6144 + col] = s + F.b_ada[col]; }
        __syncthreads();
    }
    LAS float* scr = (LAS float*)(F.lds + F.wave * 8704);
    const int gw = F.bx * NWAVES + F.wave, NGW = F.G * NWAVES;
    constexpr int I_IN = 16 * 80, I_OUT = 16 * 32, I_1 = 16 * 64, I_2 = 16 * 32;
    constexpr int NITEMS = I_IN + I_OUT + NE * I_1 + NE * I_2;
    for (int it = gw; it < NITEMS; it += NGW) {
        int r = it;
        if (r < I_IN) { tr_item(F.w_in, INW, WSP(bf16, WS_WIN), 80, scr, r, F.lane); continue; } r -= I_IN;
        if (r < I_OUT) { tr_item(F.w_out, 1024, WSP(bf16, WS_WOUT), 32, scr, r, F.lane); continue; } r -= I_OUT;
        if (r < NE * I_1) { const int e = r / I_1; tr_item(F.w_mlp1 + (size_t)e * 1024 * 2048, 2048, WSP(bf16, WS_W1T) + (size_t)e * 2048 * 1024, 64, scr, r % I_1, F.lane); continue; } r -= NE * I_1;
        { const int e = r / I_2; tr_item(F.w_mlp2 + (size_t)e * 1024 * 1024, 1024, WSP(bf16, WS_W2T) + (size_t)e * 1024 * 1024, 32, scr, r % I_2, F.lane); }
    }
}

__device__ __forceinline__ void p1_norm(const Frame& F) {
    const float* mod = WSP(float, WS_MOD); bf16* h = WSP(bf16, WS_H);
    const int gw = F.bx * NWAVES + F.wave, NGW = F.G * NWAVES;
    for (int m = gw; m < T; m += NGW) {
        const int b = m >> 14; const float* modb = mod + b * 6144;
        f32x4 v[4]; float ss = 0.f;
#pragma unroll
        for (int j = 0; j < 4; ++j) { v[j] = *(const f32x4*)(F.x + (size_t)m * D + 4 * F.lane + 256 * j); ss += dot4(v[j]); }
        const float r = rsqrtf(wave_sum(ss) * (1.f / D) + EPS);
#pragma unroll
        for (int j = 0; j < 4; ++j) { const int idx = 4 * F.lane + 256 * j;
            const f32x4 g = *(const f32x4*)(F.g_pre_mix + idx), sc = *(const f32x4*)(modb + 1024 + idx), sh = *(const f32x4*)(modb + idx);
            const f32x4 hv = v[j] * r * g * (sc + 1.f) + sh;
            u32x2 o; o.x = pk2(hv[0], hv[1]); o.y = pk2(hv[2], hv[3]);
            *(u32x2*)(h + (size_t)m * D + idx) = o; }
    }
}

template <class Epi, class RowMap, class BSel>
__device__ __forceinline__ void simple_gemm(const Frame& F, const bf16* A, int lda, int M, int N, int K, const RowMap& rm, const BSel& bs, const Epi& E) {
    const int fr = F.lane & 15, fq = F.lane >> 4;
    const int ncg = N / 512, nbt = (M / 64) * ncg;
    for (int bt = F.bx; bt < nbt; bt += F.G) {
        const int mt = bt / ncg, cg = bt % ncg, m0 = mt * 64, n0 = cg * 512 + F.wave * 64;
        const bf16* Bt = bs(m0);
        const bf16* ap[4]; const bf16* bp[4];
#pragma unroll
        for (int i = 0; i < 4; ++i) { ap[i] = A + (size_t)rm(m0 + 16 * i + fr) * lda + 8 * fq; bp[i] = Bt + (size_t)(n0 + 16 * i + fr) * K + 8 * fq; }
        f32x4 acc[4][4];
#pragma unroll
        for (int i = 0; i < 4; ++i)
#pragma unroll
            for (int j = 0; j < 4; ++j) acc[i][j] = (f32x4){0.f, 0.f, 0.f, 0.f};
#pragma unroll 2
        for (int k0 = 0; k0 < K; k0 += 32) {
            bf16x8 a[4], b[4];
#pragma unroll
            for (int i = 0; i < 4; ++i) { a[i] = *(const bf16x8*)(ap[i] + k0); b[i] = *(const bf16x8*)(bp[i] + k0); }
#pragma unroll
            for (int i = 0; i < 4; ++i)
#pragma unroll
                for (int j = 0; j < 4; ++j) acc[i][j] = MFMA(b[j], a[i], acc[i][j]);
        }
#pragma unroll
        for (int i = 0; i < 4; ++i)
#pragma unroll
            for (int j = 0; j < 4; ++j) E(m0 + 16 * i + fr, n0 + 16 * j + 4 * fq, acc[i][j]);
    }
}
struct RowId { __device__ __forceinline__ int operator()(int m) const { return m; } };
struct RowGather { const int* slot_assign; __device__ __forceinline__ int operator()(int m) const { const int a = slot_assign[m]; return a < 0 ? 0 : (a >> 2); } };
struct BFixed { const bf16* Bt; __device__ __forceinline__ const bf16* operator()(int) const { return Bt; } };
struct BExpert { const bf16* Bt; const int* tile_e; size_t stride; __device__ __forceinline__ const bf16* operator()(int m0) const { return Bt + (size_t)tile_e[m0 >> 8] * stride; } };
struct EpiStore { bf16* O; int ldo;
    __device__ __forceinline__ void operator()(int m, int n, f32x4 v) const { u32x2 w; w.x = pk2(v[0], v[1]); w.y = pk2(v[2], v[3]); *(u32x2*)(O + (size_t)m * ldo + n) = w; } };
__device__ __forceinline__ float swiglu(float g, float l) {
    const float xg = fminf(g, 7.f), xl = fminf(fmaxf(l, -7.f), 7.f);
    return xg / (1.f + __expf(-1.702f * xg)) * (xl + 1.f);
}
struct EpiSwiglu { bf16* Aout; const float* b1; const int* tile_e;
    __device__ __forceinline__ void operator()(int m, int n, f32x4 v) const {
        const int e = tile_e[m >> 8]; const f32x4 bb = *(const f32x4*)(b1 + (size_t)e * 2048 + n);
        const float a0 = swiglu(v[0] + bb[0], v[1] + bb[1]), a1 = swiglu(v[2] + bb[2], v[3] + bb[3]);
        *(unsigned*)(Aout + (size_t)m * FF + (n >> 1)) = pk2(a0, a1); } };
struct EpiMoe2 { bf16* ys; const float* b2; const int* tile_e; const int* slot_assign; const float* slot_gate;
    __device__ __forceinline__ void operator()(int m, int n, f32x4 v) const {
        const int asg = slot_assign[m]; if (asg < 0) return;
        const int e = tile_e[m >> 8]; const f32x4 bb = *(const f32x4*)(b2 + (size_t)e * D + n); const float g = slot_gate[m];
        u32x2 w; w.x = pk2((v[0] + bb[0]) * g, (v[1] + bb[1]) * g); w.y = pk2((v[2] + bb[2]) * g, (v[3] + bb[3]) * g);
        *(u32x2*)(ys + (size_t)asg * D + n) = w; } };

namespace pg8 {
constexpr int BM = 256, BK = 64, HALF = 128, HTB = HALF * BK * 2, NXCD = 8, WGM = 8;
__device__ __forceinline__ int lds_byte(int r, int c) { const int st = (r >> 4) * 2 + (c >> 5), rr = r & 15, cc = c & 31, ob = rr * 64 + cc * 2; return st * 1024 + (ob ^ (((ob >> 9) & 1) << 5)); }
__device__ __forceinline__ void stage_rc(int b, int& R, int& C) { const int st = b / 1024, sb = b % 1024, swz = sb ^ (((sb >> 9) & 1) << 5); R = (st >> 1) * 16 + swz / 64; C = (st & 1) * 32 + (swz % 64) / 2; }
__device__ __forceinline__ int perm32(int rho) { const int n = rho >> 4, i = rho & 15; return 8 * (i >> 2) + 4 * n + (i & 3); }
struct Unit { int pm, pn; };
struct StaticOrder {
    int nM, nN, nwg, G, c;
    __device__ __forceinline__ void init(int nM_, int nN_, int G_, int c_) { nM = nM_; nN = nN_; nwg = nM * nN; G = G_; c = c_; }
    __device__ __forceinline__ bool next(int i, Unit& u) const {
        const long L = (long)i * G + c; if (L >= nwg) return false;
        int wgid = (int)L; { const int q = nwg / NXCD, r = nwg % NXCD, xcd = wgid % NXCD, off = wgid / NXCD; wgid = (xcd < r ? xcd * (q + 1) : r * (q + 1) + (xcd - r) * q) + off; }
        const int nig = WGM * nN, gid = wgid / nig, fm = gid * WGM, gsz = (nM - fm) < WGM ? (nM - fm) : WGM;
        u.pm = fm + ((wgid % nig) % gsz); u.pn = (wgid % nig) / gsz; return true;
    }
};
template <bool GATHER, class Epi, class Sched, class AB>
__device__ __forceinline__ void gemm_phase(LAS unsigned char* lds, const int K, const Sched& S, const AB& ab, const Epi& E) {
    const int tid = threadIdx.x, wid = __builtin_amdgcn_readfirstlane(tid >> 6), lane = tid & 63, wr = wid >> 2, wc = wid & 3, fr = lane & 15, fq = lane >> 4;
    const int nt = K / BK;
    int sR[2], sC[2]; unsigned voffB[2], vA[2][2], nvA[2][2];
#pragma unroll
    for (int i = 0; i < 2; ++i) { int R, C; stage_rc(tid * 16 + i * 8192, R, C); sR[i] = R; sC[i] = C; const int Rb = (R & ~31) + perm32(R & 31); voffB[i] = (unsigned)(Rb * K + C) * 2u; }
    const size_t kstep = (size_t)(BK * 2);
    const size_t hstep = (size_t)HALF * K * 2;
    const unsigned ldsw = (unsigned)wid * 1024u;
    const int aoff = lds_byte(wr * 64 + fr, fq * 8), boff = lds_byte(wc * 32 + fr, fq * 8);
#define PG8_SA(b, h) (((b) * 2 + (h)) * HTB)
#define PG8_SB(b, h) ((4 + (b) * 2 + (h)) * HTB)
#define PG8_STAGE(bufoff, gbase, voff) do { _Pragma("unroll") for (int _i = 0; _i < 2; ++_i) \
        __builtin_amdgcn_global_load_lds((const unsigned*)((const char*)(gbase) + (voff)[_i]), (LAS unsigned*)(lds + (bufoff) + ldsw + _i * 8192), 16, 0, 0); } while (0)
#define PG8_LDA(dst, b, h) do { _Pragma("unroll") for (int m = 0; m < 4; ++m) _Pragma("unroll") for (int k = 0; k < 2; ++k) dst[m][k] = *(const LAS bf16x8*)(lds + PG8_SA(b, h) + aoff + m * 2048 + k * 1024); } while (0)
#define PG8_LDB(dst, b, h) do { _Pragma("unroll") for (int n = 0; n < 2; ++n) _Pragma("unroll") for (int k = 0; k < 2; ++k) dst[n][k] = *(const LAS bf16x8*)(lds + PG8_SB(b, h) + boff + n * 2048 + k * 1024); } while (0)
#define PG8_MMA(ai, bj, At, Bt) do { __builtin_amdgcn_s_setprio(1); _Pragma("unroll") for (int m = 0; m < 4; ++m) _Pragma("unroll") for (int n = 0; n < 2; ++n) _Pragma("unroll") for (int k = 0; k < 2; ++k) \
        acc[ai][bj][m][n] = __builtin_amdgcn_mfma_f32_16x16x32_bf16(Bt[n][k], At[m][k], acc[ai][bj][m][n], 0, 0, 0); __builtin_amdgcn_s_setprio(0); } while (0)
#define PG8_WAIT_V(n) asm volatile("s_waitcnt vmcnt(" #n ")" ::: "memory")
#define PG8_WAIT_L(n) asm volatile("s_waitcnt lgkmcnt(" #n ")" ::: "memory")
#define PG8_BAR __builtin_amdgcn_s_barrier()
#define PG8_SCHED __builtin_amdgcn_sched_barrier(0)
#define PG8_AOFF(dst, u) do { _Pragma("unroll") for (int _h = 0; _h < 2; ++_h) _Pragma("unroll") for (int _i = 0; _i < 2; ++_i) \
        dst[_h][_i] = GATHER ? (unsigned)(ab.a_row((u).pm * BM + _h * HALF + sR[_i]) * K + sC[_i]) * 2u : (unsigned)((_h * HALF + sR[_i]) * K + sC[_i]) * 2u; } while (0)
    Unit cur, nxt; int ui = 0;
    if (!S.next(0, cur)) return;
    f32x4 acc[2][2][4][2];
#pragma unroll
    for (int a = 0; a < 2; ++a)
#pragma unroll
        for (int b = 0; b < 2; ++b)
#pragma unroll
            for (int m = 0; m < 4; ++m)
#pragma unroll
                for (int n = 0; n < 2; ++n) acc[a][b][m][n] = (f32x4){0.f, 0.f, 0.f, 0.f};
    bf16x8 At[4][2], B0[2][2], B1[2][2];
    const char* cA = ab.a_base(cur); const char* cB = ab.b_base(cur);
    PG8_AOFF(vA, cur);
    PG8_STAGE(PG8_SB(0, 0), cB, voffB); PG8_STAGE(PG8_SB(0, 1), cB + hstep, voffB); PG8_STAGE(PG8_SA(0, 0), cA, vA[0]); PG8_STAGE(PG8_SA(0, 1), cA, vA[1]);
    if (wr == 1) PG8_BAR;
    PG8_WAIT_V(2); PG8_BAR;
    PG8_STAGE(PG8_SB(1, 0), cB + kstep, voffB); PG8_STAGE(PG8_SA(1, 0), cA + kstep, vA[0]); PG8_STAGE(PG8_SB(1, 1), cB + hstep + kstep, voffB);
    PG8_WAIT_V(6); PG8_BAR;
    for (;;) {
        const bool has_next = S.next(ui + 1, nxt);
        const char* nA = has_next ? ab.a_base(nxt) : cA; const char* nB = has_next ? ab.b_base(nxt) : cB;
        if (GATHER) { if (has_next) { PG8_AOFF(nvA, nxt); } else {
#pragma unroll
            for (int h = 0; h < 2; ++h)
#pragma unroll
                for (int i = 0; i < 2; ++i) nvA[h][i] = vA[h][i]; } }
        for (int t = 0; t < nt; t += 2) {
            const bool last = (t == nt - 2);
            const char* a1 = cA + (size_t)(t + 1) * kstep;
            const char* a2 = last ? nA : cA + (size_t)(t + 2) * kstep; const char* b2 = last ? nB : cB + (size_t)(t + 2) * kstep;
            const char* a3 = a2 + kstep; const char* b3 = b2 + kstep;
            unsigned o2[2][2];
#pragma unroll
            for (int h = 0; h < 2; ++h)
#pragma unroll
                for (int i = 0; i < 2; ++i) o2[h][i] = (GATHER && last) ? nvA[h][i] : vA[h][i];
            PG8_LDB(B0, 0, 0); PG8_LDB(B1, 0, 1); PG8_SCHED; PG8_LDA(At, 0, 0); PG8_STAGE(PG8_SA(1, 1), a1, vA[1]);
            PG8_WAIT_V(8); PG8_WAIT_L(0); PG8_BAR; PG8_MMA(0, 0, At, B0); PG8_MMA(0, 1, At, B1); PG8_BAR; PG8_SCHED;
            PG8_LDA(At, 0, 1); PG8_STAGE(PG8_SB(0, 0), b2, voffB); PG8_STAGE(PG8_SB(0, 1), b2 + hstep, voffB); PG8_STAGE(PG8_SA(0, 0), a2, o2[0]);
            PG8_WAIT_V(8); PG8_WAIT_L(0); PG8_BAR; PG8_MMA(1, 0, At, B0); PG8_MMA(1, 1, At, B1); PG8_BAR; PG8_SCHED;
            PG8_LDB(B0, 1, 0); PG8_LDB(B1, 1, 1); PG8_SCHED; PG8_LDA(At, 1, 0); PG8_STAGE(PG8_SA(0, 1), a2, o2[1]);
            PG8_WAIT_V(8); PG8_WAIT_L(0); PG8_BAR; PG8_MMA(0, 0, At, B0); PG8_MMA(0, 1, At, B1); PG8_BAR; PG8_SCHED;
            PG8_LDA(At, 1, 1); PG8_STAGE(PG8_SB(1, 0), b3, voffB); PG8_STAGE(PG8_SB(1, 1), b3 + hstep, voffB); PG8_STAGE(PG8_SA(1, 0), a3, o2[0]);
            PG8_WAIT_V(8); PG8_WAIT_L(0); PG8_BAR; PG8_MMA(1, 0, At, B0); PG8_MMA(1, 1, At, B1); PG8_BAR; PG8_SCHED;
        }
        if (wr == 0) PG8_BAR;
        E(acc, cur, wr, wc, fr, fq);
        if (!has_next) break;
#pragma unroll
        for (int a = 0; a < 2; ++a)
#pragma unroll
            for (int b = 0; b < 2; ++b)
#pragma unroll
                for (int m = 0; m < 4; ++m)
#pragma unroll
                    for (int n = 0; n < 2; ++n) acc[a][b][m][n] = (f32x4){0.f, 0.f, 0.f, 0.f};
        cur = nxt; cA = nA; cB = nB; ++ui;
        if (GATHER) {
#pragma unroll
            for (int h = 0; h < 2; ++h)
#pragma unroll
                for (int i = 0; i < 2; ++i) vA[h][i] = nvA[h][i]; }
        if (wr == 1) PG8_BAR;
    }
    PG8_WAIT_V(0);
    PG8_BAR;
#undef PG8_SA
#undef PG8_SB
#undef PG8_STAGE
#undef PG8_LDA
#undef PG8_LDB
#undef PG8_MMA
#undef PG8_WAIT_V
#undef PG8_WAIT_L
#undef PG8_BAR
#undef PG8_SCHED
#undef PG8_AOFF
}
__device__ __forceinline__ unsigned cvt_pk_bf16(float lo, float hi) { unsigned r; asm volatile("v_cvt_pk_bf16_f32 %0, %1, %2" : "=v"(r) : "v"(lo), "v"(hi)); return r; }
struct ABDense { const bf16* A; const bf16* Bt; int K;
    __device__ __forceinline__ const char* a_base(const Unit& u) const { return (const char*)(A + (size_t)u.pm * BM * K); }
    __device__ __forceinline__ const char* b_base(const Unit& u) const { return (const char*)(Bt + (size_t)u.pn * BM * K); }
    __device__ __forceinline__ int a_row(int) const { return 0; } };
struct EpiStoreT { bf16* O; int ldo;
    __device__ __forceinline__ void operator()(const f32x4 (&acc)[2][2][4][2], const Unit& u, int wr, int wc, int fr, int fq) const {
        const int row0 = u.pm * BM + wr * 64 + fr, col0 = u.pn * BM + wc * 32 + 8 * fq;
#pragma unroll
        for (int ai = 0; ai < 2; ++ai)
#pragma unroll
            for (int m = 0; m < 4; ++m) { bf16* rowp = O + (size_t)(row0 + ai * HALF + m * 16) * ldo + col0;
#pragma unroll
                for (int bj = 0; bj < 2; ++bj) { const f32x4 v0 = acc[ai][bj][m][0], v1 = acc[ai][bj][m][1];
                    u32x4 w; w.x = cvt_pk_bf16(v0[0], v0[1]); w.y = cvt_pk_bf16(v0[2], v0[3]); w.z = cvt_pk_bf16(v1[0], v1[1]); w.w = cvt_pk_bf16(v1[2], v1[3]);
                    *(u32x4*)(rowp + bj * HALF) = w; } }
    } };
struct ABMoe1 { const bf16* H; const bf16* W; const int* tile_e; const int* slot_assign; int K;
    __device__ __forceinline__ const char* a_base(const Unit&) const { return (const char*)H; }
    __device__ __forceinline__ const char* b_base(const Unit& u) const { return (const char*)(W + (size_t)tile_e[u.pm] * 2048 * 1024 + (size_t)u.pn * BM * K); }
    __device__ __forceinline__ int a_row(int r) const { const int a = slot_assign[r]; return a < 0 ? 0 : (a >> 2); } };
struct ABMoe2 { const bf16* A; const bf16* W; const int* tile_e; int K;
    __device__ __forceinline__ const char* a_base(const Unit& u) const { return (const char*)(A + (size_t)u.pm * BM * K); }
    __device__ __forceinline__ const char* b_base(const Unit& u) const { return (const char*)(W + (size_t)tile_e[u.pm] * 1024 * 1024 + (size_t)u.pn * BM * K); }
    __device__ __forceinline__ int a_row(int) const { return 0; } };
struct EpiSwigluT { bf16* Aout; const float* b1; const int* tile_e;
    __device__ __forceinline__ void operator()(const f32x4 (&acc)[2][2][4][2], const Unit& u, int wr, int wc, int fr, int fq) const {
        const int row0 = u.pm * BM + wr * 64 + fr, col0 = u.pn * BM + wc * 32 + 8 * fq;
        const float* bp = b1 + (size_t)tile_e[u.pm] * 2048 + col0;
        f32x4 bv[2][2];
#pragma unroll
        for (int bj = 0; bj < 2; ++bj)
#pragma unroll
            for (int n = 0; n < 2; ++n) bv[bj][n] = *(const f32x4*)(bp + bj * HALF + 4 * n);
#pragma unroll
        for (int ai = 0; ai < 2; ++ai)
#pragma unroll
            for (int m = 0; m < 4; ++m) { bf16* rowp = Aout + (size_t)(row0 + ai * HALF + m * 16) * FF + (col0 >> 1);
#pragma unroll
                for (int bj = 0; bj < 2; ++bj) { const f32x4 v0 = acc[ai][bj][m][0] + bv[bj][0], v1 = acc[ai][bj][m][1] + bv[bj][1];
                    u32x2 w; w.x = cvt_pk_bf16(swiglu(v0[0], v0[1]), swiglu(v0[2], v0[3])); w.y = cvt_pk_bf16(swiglu(v1[0], v1[1]), swiglu(v1[2], v1[3]));
                    *(u32x2*)(rowp + bj * (HALF / 2)) = w; } }
    } };
struct EpiMoe2T { bf16* ys; const float* b2; const int* tile_e; const int* slot_assign; const float* slot_gate;
    __device__ __forceinline__ void operator()(const f32x4 (&acc)[2][2][4][2], const Unit& u, int wr, int wc, int fr, int fq) const {
        const int row0 = u.pm * BM + wr * 64 + fr, col0 = u.pn * BM + wc * 32 + 8 * fq;
        const float* bp = b2 + (size_t)tile_e[u.pm] * D + col0;
        f32x4 bv[2][2];
#pragma unroll
        for (int bj = 0; bj < 2; ++bj)
#pragma unroll
            for (int n = 0; n < 2; ++n) bv[bj][n] = *(const f32x4*)(bp + bj * HALF + 4 * n);
#pragma unroll
        for (int ai = 0; ai < 2; ++ai)
#pragma unroll
            for (int m = 0; m < 4; ++m) { const int row = row0 + ai * HALF + m * 16; const int asg = slot_assign[row]; const float g = slot_gate[row];
                if (asg >= 0) { bf16* rowp = ys + (size_t)asg * D + col0;
#pragma unroll
                    for (int bj = 0; bj < 2; ++bj) { const f32x4 v0 = (acc[ai][bj][m][0] + bv[bj][0]) * g, v1 = (acc[ai][bj][m][1] + bv[bj][1]) * g;
                        u32x4 w; w.x = cvt_pk_bf16(v0[0], v0[1]); w.y = cvt_pk_bf16(v0[2], v0[3]); w.z = cvt_pk_bf16(v1[0], v1[1]); w.w = cvt_pk_bf16(v1[2], v1[3]);
                        *(u32x4*)(rowp + bj * HALF) = w; } } }
    } };
}

__device__ __forceinline__ void attn_unit(const Frame& F, int u) {
    const int qblk = u & 127, kvh = (u >> 7) & 1, b = u >> 8;
    LAS unsigned char* Ks = F.lds; LAS unsigned char* Vs = F.lds + 256 * 144;
    const bf16* proj = WSP(bf16, WS_PROJ); bf16* mix = WSP(bf16, WS_MIX);
    const int tok0 = b * S + qblk * 128;
#pragma unroll
    for (int i = 0; i < 4; ++i) {
        const int cid = F.tid + 512 * i, row = cid >> 3, ch = cid & 7;
        u32x4 kv = (u32x4){0u, 0u, 0u, 0u}, vv = (u32x4){0u, 0u, 0u, 0u};
        if (qblk > 0 || row >= 128) {
            const bf16* rp = proj + (size_t)(tok0 - 128 + row) * INP;
            kv = *(const u32x4*)(rp + AK_OFF + kvh * 64 + ch * 8);
            vv = *(const u32x4*)(rp + AV_OFF + kvh * 64 + ch * 8);
        }
        *(LAS u32x4*)(Ks + row * 144 + ch * 16) = kv;
        *(LAS u32x4*)(Vs + row * 144 + ch * 16) = vv;
    }
    __syncthreads();
    const int g = F.wave >> 1, hw = F.wave & 1, hq = kvh * 4 + g;
    const int lane = F.lane, fr = lane & 15, fq = lane >> 4;
    const float sink = F.sinks[hq];
    const float NEG_INF = -__builtin_inff();
    for (int qb = 0; qb < 4; ++qb) {
        const int i = 64 * hw + 16 * qb + fr;
        const bf16* qp = proj + (size_t)(tok0 + i) * INP + AQ_OFF + hq * 64 + 8 * fq;
        const bf16x8 q0 = *(const bf16x8*)qp, q1 = *(const bf16x8*)(qp + 32);
        f32x4 st[12];
#pragma unroll
        for (int kt = 0; kt < 12; ++kt) {
            LAS const unsigned char* kp = Ks + (64 * hw + 16 * kt + fr) * 144 + fq * 16;
            const bf16x8 k0 = *(LAS const bf16x8*)kp, k1 = *(LAS const bf16x8*)(kp + 64);
            f32x4 z = (f32x4){0.f, 0.f, 0.f, 0.f}; z = MFMA(k0, q0, z); z = MFMA(k1, q1, z); st[kt] = z;
        }
        float mx = NEG_INF;
#pragma unroll
        for (int kt = 0; kt < 12; ++kt)
#pragma unroll
            for (int r = 0; r < 4; ++r) {
                const int j = 64 * hw + 16 * kt + 4 * fq + r, rel = i + 128 - j;
                const bool ok = (rel >= 0) && (rel < 128) && (qblk > 0 || j >= 128);
                const float s = ok ? st[kt][r] * 0.125f : NEG_INF;
                st[kt][r] = s; mx = fmaxf(mx, s);
            }
        mx = fmaxf(mx, __shfl_xor(mx, 16)); mx = fmaxf(mx, __shfl_xor(mx, 32)); mx = fmaxf(mx, sink);
        float sum = 0.f;
#pragma unroll
        for (int kt = 0; kt < 12; ++kt)
#pragma unroll
            for (int r = 0; r < 4; ++r) { const float p = __expf(st[kt][r] - mx); st[kt][r] = p; sum += p; }
        sum += __shfl_xor(sum, 16); sum += __shfl_xor(sum, 32); sum += __expf(sink - mx);
        const float inv = 1.f / sum;
        f32x4 o[4];
#pragma unroll
        for (int c = 0; c < 4; ++c) o[c] = (f32x4){0.f, 0.f, 0.f, 0.f};
#pragma unroll
        for (int ks = 0; ks < 6; ++ks) {
            const bf16x8 pf = pack8(st[2 * ks], st[2 * ks + 1]);
            const int rb = 64 * hw + 32 * ks + 4 * fq + (fr >> 2);
#pragma unroll
            for (int c = 0; c < 4; ++c) {
                LAS const unsigned char* vp = Vs + rb * 144 + (16 * c + 4 * (lane & 3)) * 2;
                const bf16x8 vf = cat8(trr(vp), trr(vp + 16 * 144));
                o[c] = MFMA(pf, vf, o[c]);
            }
        }
#pragma unroll
        for (int r = 0; r < 4; ++r) {
            const int qrow = 4 * fq + r; const float iv = __shfl(inv, qrow);
            bf16* op = mix + (size_t)(tok0 + 64 * hw + 16 * qb + qrow) * D + hq * 64 + fr;
#pragma unroll
            for (int c = 0; c < 4; ++c) op[16 * c] = (bf16)f2bf(o[c][r] * iv);
        }
    }
    __syncthreads();
}

__device__ __forceinline__ void gla_gate_prefix(const Frame& F, const bf16* proj, int t0, int h, LAS float* ga_s, LAS float* tot_s, float (&bv)[8], float& b_mid, float& b_last) {
#pragma unroll
    for (int i = 0; i < 2; ++i) { const int idx = F.tid + 512 * i, t = idx >> 4, r = idx & 15; ga_s[idx] = bf2f(proj[(size_t)(t0 + t) * INP + GA_OFF + r]); }
    float wu[16];
#pragma unroll
    for (int r = 0; r < 16; ++r) wu[r] = F.w_gate_up[r * 256 + h * 64 + F.lane];
    const float bg = F.b_gate[h * 64 + F.lane];
    __syncthreads();
    float run = 0.f;
#pragma unroll
    for (int i = 0; i < 8; ++i) {
        const int t = 8 * F.wave + i; float z = bg;
#pragma unroll
        for (int r = 0; r < 16; ++r) z += ga_s[t * 16 + r] * wu[r];
        const float ls = fminf(z, 0.f) - __logf(1.f + __expf(-fabsf(z)));
        run += ls * (1.f / 16.f); bv[i] = run;
    }
    tot_s[F.wave * 64 + F.lane] = run;
    __syncthreads();
    float pre = 0.f, mid = 0.f, all = 0.f;
#pragma unroll
    for (int w = 0; w < 8; ++w) { const float tv = tot_s[w * 64 + F.lane]; pre += (w < F.wave) ? tv : 0.f; mid += (w < 4) ? tv : 0.f; all += tv; }
#pragma unroll
    for (int i = 0; i < 8; ++i) bv[i] += pre;
    b_mid = mid; b_last = all;
}
__device__ __forceinline__ void gla_kv_unit(const Frame& F, int u) {
    const int h = u & 3, n = (u >> 2) & 255, b = u >> 10, t0 = b * S + n * 64;
    const bf16* proj = WSP(bf16, WS_PROJ);
    LAS unsigned char* kd_s = F.lds; LAS unsigned char* v_s = F.lds + 9216;
    LAS float* ga_s = (LAS float*)(F.lds + 26624); LAS float* tot_s = (LAS float*)(F.lds + 30720);
    const int lane = F.lane, fr = lane & 15, fq = lane >> 4;
#pragma unroll
    for (int i = 0; i < 2; ++i) { const int cid = F.tid + 512 * i, row = cid >> 4, ch = cid & 15;
        *(LAS u32x4*)(v_s + row * 272 + ch * 16) = *(const u32x4*)(proj + (size_t)(t0 + row) * INP + GV_OFF + h * 128 + ch * 8); }
    float bv[8], b_mid, b_last;
    gla_gate_prefix(F, proj, t0, h, ga_s, tot_s, bv, b_mid, b_last);
#pragma unroll
    for (int i = 0; i < 8; ++i) { const int t = 8 * F.wave + i;
        const float kx = bf2f(proj[(size_t)(t0 + t) * INP + GK_OFF + h * 64 + lane]);
        *(LAS bf16*)(kd_s + t * 144 + lane * 2) = (bf16)f2bf(kx * __expf(b_last - bv[i])); }
    if (F.wave == 0) WSP(float, WS_DECAY)[((size_t)(b * NCH + n) * 4 + h) * 64 + lane] = __expf(b_last);
    __syncthreads();
    const int c = F.wave;
    f32x4 acc[4];
#pragma unroll
    for (int d = 0; d < 4; ++d) acc[d] = (f32x4){0.f, 0.f, 0.f, 0.f};
#pragma unroll
    for (int ks = 0; ks < 2; ++ks) {
        const int rb = 32 * ks + 8 * fq + (fr >> 2);
        LAS const unsigned char* vp = v_s + rb * 272 + (16 * c + 4 * (lane & 3)) * 2;
        const bf16x8 vf = cat8(trr(vp), trr(vp + 4 * 272));
#pragma unroll
        for (int d = 0; d < 4; ++d) {
            LAS const unsigned char* kp = kd_s + rb * 144 + (16 * d + 4 * (lane & 3)) * 2;
            const bf16x8 kf = cat8(trr(kp), trr(kp + 4 * 144));
            acc[d] = MFMA(kf, vf, acc[d]);
        }
    }
    float* kvp = WSP(float, WS_KV) + (((size_t)(b * NCH + n) * 4 + h) * 128 + 16 * c + fr) * 64;
#pragma unroll
    for (int d = 0; d < 4; ++d) *(f32x4*)(kvp + 16 * d + 4 * fq) = acc[d];
    __syncthreads();
}
__device__ __forceinline__ void gla_scan(const Frame& F) {
    float* kv = WSP(float, WS_KV); const float* decay = WSP(float, WS_DECAY);
    if (F.tid >= 256) return;
    for (int idx = F.bx * 256 + F.tid; idx < 65536; idx += F.G * 256) {
        const int b = idx >> 15, h = (idx >> 13) & 3, dvdk = idx & 8191, dk = idx & 63;
        float* p = kv + ((size_t)(b * NCH) * 4 + h) * 8192 + dvdk;
        const float* dp = decay + ((size_t)(b * NCH) * 4 + h) * 64 + dk;
        float state = 0.f;
        for (int n = 0; n < NCH; n += 8) {
            float tv[8], dv[8];
#pragma unroll
            for (int i = 0; i < 8; ++i) { tv[i] = p[(size_t)(n + i) * 4 * 8192]; dv[i] = dp[(size_t)(n + i) * 4 * 64]; }
#pragma unroll
            for (int i = 0; i < 8; ++i) { p[(size_t)(n + i) * 4 * 8192] = state; state = dv[i] * state + tv[i]; }
        }
    }
}
__device__ __forceinline__ void gla_out_unit(const Frame& F, int u) {
    const int h = u & 3, n = (u >> 2) & 255, b = u >> 10, t0 = b * S + n * 64;
    const bf16* proj = WSP(bf16, WS_PROJ); bf16* mix = WSP(bf16, WS_MIX);
    LAS unsigned char* qd_s = F.lds; LAS unsigned char* kk_s = F.lds + 9216; LAS unsigned char* qe_s = F.lds + 18432;
    LAS unsigned char* v_s = F.lds + 27648; LAS unsigned char* st_s = F.lds + 45056;
    LAS float* ga_s = (LAS float*)(F.lds + 63488); LAS float* tot_s = (LAS float*)(F.lds + 67584); LAS float* ssq_s = (LAS float*)(F.lds + 69632);
    const int lane = F.lane, fr = lane & 15, fq = lane >> 4;
#pragma unroll
    for (int i = 0; i < 2; ++i) { const int cid = F.tid + 512 * i, row = cid >> 4, ch = cid & 15;
        *(LAS u32x4*)(v_s + row * 272 + ch * 16) = *(const u32x4*)(proj + (size_t)(t0 + row) * INP + GV_OFF + h * 128 + ch * 8); }
    const float* stg = WSP(float, WS_KV) + ((size_t)(b * NCH + n) * 4 + h) * 8192;
#pragma unroll
    for (int i = 0; i < 4; ++i) { const int i4 = F.tid + 512 * i, dv = i4 >> 4, dk4 = (i4 & 15) * 4;
        const f32x4 sv = *(const f32x4*)(stg + dv * 64 + dk4);
        u32x2 w; w.x = pk2(sv[0], sv[1]); w.y = pk2(sv[2], sv[3]);
        *(LAS u32x2*)(st_s + dv * 144 + dk4 * 2) = w; }
    float bv[8], b_mid, b_last;
    gla_gate_prefix(F, proj, t0, h, ga_s, tot_s, bv, b_mid, b_last);
#pragma unroll
    for (int i = 0; i < 8; ++i) { const int t = 8 * F.wave + i; const bf16* rp = proj + (size_t)(t0 + t) * INP + h * 64 + lane;
        const float qx = bf2f(rp[GQ_OFF]) * 0.125f, kx = bf2f(rp[GK_OFF]);
        *(LAS bf16*)(qd_s + t * 144 + lane * 2) = (bf16)f2bf(qx * __expf(bv[i] - b_mid));
        *(LAS bf16*)(kk_s + t * 144 + lane * 2) = (bf16)f2bf(kx * __expf(b_mid - bv[i]));
        *(LAS bf16*)(qe_s + t * 144 + lane * 2) = (bf16)f2bf(qx * __expf(bv[i])); }
    __syncthreads();
    const int ib = F.wave >> 1, dvh = F.wave & 1;
    bf16x8 qdf[2], qef[2];
#pragma unroll
    for (int ks = 0; ks < 2; ++ks) { qdf[ks] = *(LAS const bf16x8*)(qd_s + (16 * ib + fr) * 144 + (32 * ks + 8 * fq) * 2);
                                     qef[ks] = *(LAS const bf16x8*)(qe_s + (16 * ib + fr) * 144 + (32 * ks + 8 * fq) * 2); }
    f32x4 at[4];
#pragma unroll
    for (int jt = 0; jt < 4; ++jt) {
        LAS const unsigned char* kp = kk_s + (16 * jt + fr) * 144 + (8 * fq) * 2;
        const bf16x8 k0 = *(LAS const bf16x8*)kp, k1 = *(LAS const bf16x8*)(kp + 64);
        f32x4 z = (f32x4){0.f, 0.f, 0.f, 0.f}; z = MFMA(k0, qdf[0], z); z = MFMA(k1, qdf[1], z);
#pragma unroll
        for (int r = 0; r < 4; ++r) if (16 * jt + 4 * fq + r > 16 * ib + fr) z[r] = 0.f;
        at[jt] = z;
    }
    bf16x8 pf[2];
    pf[0] = pack8(at[0], at[1]); pf[1] = pack8(at[2], at[3]);
    f32x4 o[4];
#pragma unroll
    for (int c = 0; c < 4; ++c) {
        const int dvt = 4 * dvh + c; f32x4 z = (f32x4){0.f, 0.f, 0.f, 0.f};
#pragma unroll
        for (int ks = 0; ks < 2; ++ks) {
            const int rb = 32 * ks + 4 * fq + (fr >> 2);
            LAS const unsigned char* vp = v_s + rb * 272 + (16 * dvt + 4 * (lane & 3)) * 2;
            z = MFMA(pf[ks], cat8(trr(vp), trr(vp + 16 * 272)), z);
        }
#pragma unroll
        for (int ks = 0; ks < 2; ++ks) {
            const bf16x8 sf = *(LAS const bf16x8*)(st_s + (16 * dvt + fr) * 144 + (32 * ks + 8 * fq) * 2);
            z = MFMA(qef[ks], sf, z);
        }
        o[c] = z;
    }
    float ssq[4];
#pragma unroll
    for (int r = 0; r < 4; ++r) { float s = 0.f;
#pragma unroll
        for (int c = 0; c < 4; ++c) s += o[c][r] * o[c][r];
        s += __shfl_xor(s, 1); s += __shfl_xor(s, 2); s += __shfl_xor(s, 4); s += __shfl_xor(s, 8);
        ssq[r] = s; if (fr == 0) ssq_s[F.wave * 16 + 4 * fq + r] = s; }
    __syncthreads();
#pragma unroll
    for (int r = 0; r < 4; ++r) {
        const float tot = ssq[r] + ssq_s[(F.wave ^ 1) * 16 + 4 * fq + r];
        const float rinv = rsqrtf(tot * (1.f / 128.f) + EPS);
        const int t = t0 + 16 * ib + 4 * fq + r;
#pragma unroll
        for (int c = 0; c < 4; ++c) { const int dv = 16 * (4 * dvh + c) + fr;
            const float gg = bf2f(proj[(size_t)t * INP + GG_OFF + h * 128 + dv]);
            const float val = o[c][r] * rinv * F.g_gla_norm[dv] * (gg / (1.f + __expf(-gg)));
            mix[(size_t)t * D + 512 + h * 128 + dv] = (bf16)f2bf(val); }
    }
    __syncthreads();
}

__device__ __forceinline__ void p7_norm_router(const Frame& F) {
    const float* mod = WSP(float, WS_MOD); const bf16* y = WSP(bf16, WS_Y); float* x1 = WSP(float, WS_X1); bf16* h2 = WSP(bf16, WS_H);
    int* tok_e = WSP(int, WS_TOK_E); int* tok_lpos = WSP(int, WS_TOK_LPOS); float* tok_gate = WSP(float, WS_TOK_GATE);
    LAS float* wr_s = (LAS float*)F.lds; LAS float* lg_s = (LAS float*)(F.lds + SMALL_OFF); LAS int* cnt_s = (LAS int*)(F.lds + SMALL_OFF + 1024);
    const int lane = F.lane;
#pragma unroll
    for (int i = 0; i < 16; ++i) { const int idx = (F.tid + 512 * i) * 4, k = idx >> 5, e0 = idx & 31;
        *(LAS f32x4*)(wr_s + k * 32 + ((((e0 >> 2) ^ ((k >> 2) & 7))) << 2)) = *(const f32x4*)(F.w_router + idx); }
    if (F.tid < 32) cnt_s[F.tid] = 0;
    __syncthreads();
    const float NEG_INF = -__builtin_inff();
    for (int it = 0; it < 16; ++it) {
        const int m = F.bx * 128 + F.wave * 16 + it, b = m >> 14; const float* modb = mod + b * 6144;
        f32x4 xv[4], hv[4]; float ss = 0.f;
#pragma unroll
        for (int j = 0; j < 4; ++j) { hv[j] = unpack4(*(const u32x2*)(y + (size_t)m * D + 4 * lane + 256 * j)); ss += dot4(hv[j]); }
        const float ry = rsqrtf(wave_sum(ss) * (1.f / D) + EPS);
        float s2 = 0.f;
#pragma unroll
        for (int j = 0; j < 4; ++j) { const int idx = 4 * lane + 256 * j;
            const f32x4 g = *(const f32x4*)(F.g_post_mix + idx), gt = *(const f32x4*)(modb + 2048 + idx), xx = *(const f32x4*)(F.x + (size_t)m * D + idx);
            xv[j] = xx + gt * (hv[j] * ry * g); *(f32x4*)(x1 + (size_t)m * D + idx) = xv[j]; s2 += dot4(xv[j]); }
        const float rx = rsqrtf(wave_sum(s2) * (1.f / D) + EPS);
#pragma unroll
        for (int j = 0; j < 4; ++j) { const int idx = 4 * lane + 256 * j;
            const f32x4 g = *(const f32x4*)(F.g_pre_ffn + idx), sc = *(const f32x4*)(modb + 4096 + idx), sh = *(const f32x4*)(modb + 3072 + idx);
            hv[j] = xv[j] * rx * g * (sc + 1.f) + sh;
            u32x2 o; o.x = pk2(hv[j][0], hv[j][1]); o.y = pk2(hv[j][2], hv[j][3]);
            *(u32x2*)(h2 + (size_t)m * D + idx) = o; }
        float acc[32];
#pragma unroll
        for (int e = 0; e < 32; ++e) acc[e] = 0.f;
#pragma unroll
        for (int j = 0; j < 4; ++j)
#pragma unroll
            for (int c = 0; c < 4; ++c) { const int k = 4 * lane + 256 * j + c; const float hvv = hv[j][c]; LAS const float* wp = wr_s + k * 32;
#pragma unroll
                for (int ch = 0; ch < 8; ++ch) { const f32x4 w = *(LAS const f32x4*)(wp + ((ch ^ (lane & 7)) << 2));
                    acc[4 * ch + 0] += hvv * w[0]; acc[4 * ch + 1] += hvv * w[1]; acc[4 * ch + 2] += hvv * w[2]; acc[4 * ch + 3] += hvv * w[3]; } }
#define RED_STEP(HALF, BIT) _Pragma("unroll") for (int i2 = 0; i2 < HALF; ++i2) { const bool hi = (lane & BIT) != 0; \
            const float keep = hi ? acc[i2 + HALF] : acc[i2]; const float send = hi ? acc[i2] : acc[i2 + HALF]; acc[i2] = keep + __shfl_xor(send, BIT); }
        RED_STEP(16, 32) RED_STEP(8, 16) RED_STEP(4, 8) RED_STEP(2, 4) RED_STEP(1, 2)
#undef RED_STEP
        acc[0] += __shfl_xor(acc[0], 1);
        const int my_exp = lane >> 1;
        if ((lane & 1) == 0) lg_s[F.wave * 32 + my_exp] = acc[0] + F.b_router[my_exp];
        float v[32];
#pragma unroll
        for (int ch = 0; ch < 8; ++ch) { const f32x4 w = *(LAS const f32x4*)(lg_s + F.wave * 32 + 4 * ch); v[4 * ch] = w[0]; v[4 * ch + 1] = w[1]; v[4 * ch + 2] = w[2]; v[4 * ch + 3] = w[3]; }
        int se[4]; float sv[4];
#pragma unroll
        for (int r = 0; r < 4; ++r) { float best = v[0]; int bi = 0;
#pragma unroll
            for (int e = 1; e < 32; ++e) if (v[e] > best) { best = v[e]; bi = e; }
            se[r] = bi; sv[r] = best;
#pragma unroll
            for (int e = 0; e < 32; ++e) v[e] = (e == bi) ? NEG_INF : v[e]; }
        const float p1 = __expf(sv[1] - sv[0]), p2 = __expf(sv[2] - sv[0]), p3 = __expf(sv[3] - sv[0]);
        const float rs = 1.f / (1.f + p1 + p2 + p3);
        if (lane < 4) {
            const int my_e = lane == 0 ? se[0] : lane == 1 ? se[1] : lane == 2 ? se[2] : se[3];
            const float my_g = (lane == 0 ? 1.f : lane == 1 ? p1 : lane == 2 ? p2 : p3) * rs;
            const int lpos = __hip_atomic_fetch_add(cnt_s + my_e, 1, __ATOMIC_RELAXED, __HIP_MEMORY_SCOPE_WORKGROUP);
            tok_e[m * 4 + lane] = my_e; tok_lpos[m * 4 + lane] = lpos; tok_gate[m * 4 + lane] = my_g;
        }
    }
    __syncthreads();
    if (F.tid < 32) WSP(int, WS_BLK_CNT)[F.bx * 32 + F.tid] = cnt_s[F.tid];
}

__device__ __forceinline__ void p8_slots(const Frame& F) {
    const int* blk_cnt = WSP(int, WS_BLK_CNT);
    LAS int* tot_p = (LAS int*)F.lds; LAS int* pre_p = tot_p + 512; LAS int* total_s = pre_p + 512; LAS int* pre_s = total_s + 32; LAS int* off_s = pre_s + 32;
    { const int e = F.tid & 31, part = F.tid >> 5; int s = 0, sp = 0;
        for (int bb = part * 16; bb < part * 16 + 16; ++bb) { const int c = blk_cnt[bb * 32 + e]; s += c; sp += (bb < F.bx) ? c : 0; }
        tot_p[part * 32 + e] = s; pre_p[part * 32 + e] = sp; }
    __syncthreads();
    if (F.tid < 32) { int s = 0, sp = 0;
        for (int p = 0; p < 16; ++p) { s += tot_p[p * 32 + F.tid]; sp += pre_p[p * 32 + F.tid]; }
        total_s[F.tid] = s; pre_s[F.tid] = sp; }
    __syncthreads();
    if (F.tid == 0) { int off = 0; for (int e = 0; e < 32; ++e) { off_s[e] = off; off += (total_s[e] + 255) & ~255; } off_s[32] = off; }
    __syncthreads();
    int* slot_assign = WSP(int, WS_SLOT_ASSIGN); float* slot_gate = WSP(float, WS_SLOT_GATE);
    { const int t = F.bx * 128 + (F.tid >> 2), k = F.tid & 3;
        const int e = WSP(int, WS_TOK_E)[t * 4 + k];
        const int slot = off_s[e] + pre_s[e] + WSP(int, WS_TOK_LPOS)[t * 4 + k];
        slot_assign[slot] = t * 4 + k; slot_gate[slot] = WSP(float, WS_TOK_GATE)[t * 4 + k]; }
    if (F.bx < 32) { const int e = F.bx; for (int s = off_s[e] + total_s[e] + F.tid; s < off_s[e + 1]; s += NTHREADS) { slot_assign[s] = -1; slot_gate[s] = 0.f; } }
    if (F.bx == 0) {
        if (F.tid <= 32) WSP(int, WS_MOE_OFF)[F.tid] = off_s[F.tid];
        const int ntile = off_s[32] >> 8;
        for (int rt = F.tid; rt < ntile; rt += NTHREADS) { int e = 0;
            for (int q = 1; q < 32; ++q) e = (off_s[q] <= rt * 256) ? q : e;
            WSP(int, WS_TILE_E)[rt] = e; }
    }
}

__device__ __forceinline__ void p11_combine(const Frame& F) {
    const float* mod = WSP(float, WS_MOD); const bf16* ys = WSP(bf16, WS_YS); const float* x1 = WSP(float, WS_X1);
    const int gw = F.bx * NWAVES + F.wave, NGW = F.G * NWAVES, lane = F.lane;
    for (int m = gw; m < T; m += NGW) {
        const int b = m >> 14; const float* modb = mod + b * 6144;
        f32x4 yv[4]; float ss = 0.f;
#pragma unroll
        for (int j = 0; j < 4; ++j) { f32x4 a = (f32x4){0.f, 0.f, 0.f, 0.f};
#pragma unroll
            for (int k4 = 0; k4 < 4; ++k4) a += unpack4(*(const u32x2*)(ys + ((size_t)m * 4 + k4) * D + 4 * lane + 256 * j));
            yv[j] = a; ss += dot4(a); }
        const float ry = rsqrtf(wave_sum(ss) * (1.f / D) + EPS);
#pragma unroll
        for (int j = 0; j < 4; ++j) { const int idx = 4 * lane + 256 * j;
            const f32x4 g = *(const f32x4*)(F.g_post_ffn + idx), gt = *(const f32x4*)(modb + 5120 + idx), xx = *(const f32x4*)(x1 + (size_t)m * D + idx);
            *(f32x4*)(F.out + (size_t)m * D + idx) = xx + gt * (yv[j] * ry * g); }
    }
}

constexpr int NPHASE = 12;
struct Args { const float* in[20]; float* out; unsigned char* ws; int ph_lo, ph_hi; };
__global__ void __launch_bounds__(NTHREADS, 2) fwd(Args args) {
    extern __shared__ __attribute__((aligned(16))) unsigned char lds[];
    Frame F;
    F.lds = (LAS unsigned char*)lds;
    F.tid = threadIdx.x; F.lane = F.tid & 63; F.wave = __builtin_amdgcn_readfirstlane(F.tid >> 6); F.bx = blockIdx.x; F.G = gridDim.x;
    F.x = args.in[0]; F.c = args.in[1]; F.w_ada = args.in[2]; F.b_ada = args.in[3]; F.g_pre_mix = args.in[4]; F.g_post_mix = args.in[5];
    F.g_pre_ffn = args.in[6]; F.g_post_ffn = args.in[7]; F.w_in = args.in[8]; F.w_gate_up = args.in[9]; F.b_gate = args.in[10]; F.g_gla_norm = args.in[11];
    F.sinks = args.in[12]; F.w_out = args.in[13]; F.w_router = args.in[14]; F.b_router = args.in[15]; F.w_mlp1 = args.in[16]; F.b_mlp1 = args.in[17];
    F.w_mlp2 = args.in[18]; F.b_mlp2 = args.in[19]; F.out = args.out; F.ws = args.ws;
    volatile LAS unsigned* MISC = (volatile LAS unsigned*)(F.lds + MISC_OFF);
    if (F.tid < 32) MISC[F.tid] = 0u;
    __syncthreads();
    const int lo = args.ph_lo, hi = args.ph_hi;
    XcdBarrier bar; bar.bar = (unsigned*)(F.ws + WS_CTL) + CW_BAR; bar.x = 0; bar.st = nullptr;
    if (hi - lo > 1) bar = xcd_barrier_post((unsigned*)(F.ws + WS_CTL) + CW_BAR, MISC + 8);
#define IN(k) (lo <= (k) && (k) < hi)
#define SEAM(k) do { if (IN(k) && IN((k) + 1)) xcd_barrier(bar); } while (0)

    if (IN(0)) { p0_prologue(F); } SEAM(0);
    if (IN(1)) { p1_norm(F); } SEAM(1);
    if (IN(2)) { pg8::StaticOrder So; So.init(T / 256, INP / 256, F.G, F.bx);
                 pg8::gemm_phase<false>(F.lds, D, So, pg8::ABDense{WSP(bf16, WS_H), WSP(bf16, WS_WIN), D}, pg8::EpiStoreT{WSP(bf16, WS_PROJ), INP}); } SEAM(2);
    if (IN(3)) { for (int u = F.bx; u < 512; u += F.G) attn_unit(F, u);
                 for (int u = F.bx; u < 2048; u += F.G) gla_kv_unit(F, u); } SEAM(3);
    if (IN(4)) { gla_scan(F); } SEAM(4);
    if (IN(5)) { for (int u = F.bx; u < 2048; u += F.G) gla_out_unit(F, u); } SEAM(5);
    if (IN(6)) { pg8::StaticOrder So; So.init(T / 256, D / 256, F.G, F.bx);
                 pg8::gemm_phase<false>(F.lds, D, So, pg8::ABDense{WSP(bf16, WS_MIX), WSP(bf16, WS_WOUT), D}, pg8::EpiStoreT{WSP(bf16, WS_Y), D}); } SEAM(6);
    if (IN(7)) { p7_norm_router(F); } SEAM(7);
    if (IN(8)) { p8_slots(F); } SEAM(8);
    if (IN(9)) { const int nM = WSP(int, WS_MOE_OFF)[32] >> 8; pg8::StaticOrder So; So.init(nM, 2048 / 256, F.G, F.bx);
                 pg8::gemm_phase<true>(F.lds, D, So, pg8::ABMoe1{WSP(bf16, WS_H), WSP(bf16, WS_W1T), WSP(int, WS_TILE_E), WSP(int, WS_SLOT_ASSIGN), D},
                                       pg8::EpiSwigluT{WSP(bf16, WS_A), F.b_mlp1, WSP(int, WS_TILE_E)}); } SEAM(9);
    if (IN(10)) { const int nM = WSP(int, WS_MOE_OFF)[32] >> 8; pg8::StaticOrder So; So.init(nM, D / 256, F.G, F.bx);
                  pg8::gemm_phase<false>(F.lds, FF, So, pg8::ABMoe2{WSP(bf16, WS_A), WSP(bf16, WS_W2T), WSP(int, WS_TILE_E), FF},
                                         pg8::EpiMoe2T{WSP(bf16, WS_YS), F.b_mlp2, WSP(int, WS_TILE_E), WSP(int, WS_SLOT_ASSIGN), WSP(float, WS_SLOT_GATE)}); } SEAM(10);
    if (IN(11)) { p11_combine(F); }
#undef IN
#undef SEAM
}

extern "C" void kernel_launch(void* const* d_in, const int* in_sizes, int n_in, void* d_out, int out_size, void* d_ws, size_t ws_size, hipStream_t stream) {
    static int ready = 0;
    if (ready == 0) {
        if (n_in != 20 || out_size != T * D || ws_size < WS_END) { fprintf(stderr, "kernel_launch: unexpected problem (n_in %d, out %d, ws %zu)\n", n_in, out_size, ws_size); ready = -1; return; }
        if (hipFuncSetAttribute((const void*)fwd, hipFuncAttributeMaxDynamicSharedMemorySize, LDS_BYTES) != hipSuccess) { fprintf(stderr, "kernel_launch: hipFuncSetAttribute failed\n"); ready = -1; return; }
        int per_cu = 0;
        if (hipOccupancyMaxActiveBlocksPerMultiprocessor(&per_cu, (const void*)fwd, NTHREADS, LDS_BYTES) != hipSuccess || per_cu < 1) fprintf(stderr, "kernel_launch: occupancy query says %d\n", per_cu);
        (void)hipGetLastError();
        ready = 1;
    }
    if (ready < 0) return;
    (void)hipMemsetAsync((char*)d_ws + WS_CTL, 0, CTL_ZERO_BYTES, stream);
    Args a{};
    for (int i = 0; i < 20; ++i) a.in[i] = (const float*)d_in[i];
    a.out = (float*)d_out; a.ws = (unsigned char*)d_ws;
#if MK_ONE_LAUNCH
    a.ph_lo = 0; a.ph_hi = NPHASE;
    hipLaunchKernelGGL(fwd, dim3(GRID), dim3(NTHREADS), LDS_BYTES, stream, a);
#else
    for (int p = 0; p < NPHASE; ++p) { a.ph_lo = p; a.ph_hi = p + 1; hipLaunchKernelGGL(fwd, dim3(GRID), dim3(NTHREADS), LDS_BYTES, stream, a); }
#endif
}
```

```cpp
#include <hip/hip_runtime.h>
#include <cstdio>
#include <cstdint>

#ifndef MK_ONE_LAUNCH
#define MK_ONE_LAUNCH 1
#endif

#ifndef DUPMASK
#define DUPMASK 0
#endif
#define LAS __attribute__((address_space(3)))
typedef unsigned short bf16;
typedef short bf16x8 __attribute__((ext_vector_type(8)));
typedef short s16x4 __attribute__((ext_vector_type(4)));
typedef float f32x4 __attribute__((ext_vector_type(4)));
typedef unsigned u32x4 __attribute__((ext_vector_type(4)));
typedef unsigned u32x2 __attribute__((ext_vector_type(2)));

constexpr int D = 1024, NB = 2, S = 16384, T = NB * S;
constexpr int INW = 2320, INP = 2560;
constexpr int AQ_OFF = 0, AK_OFF = 512, AV_OFF = 640, GQ_OFF = 768, GK_OFF = 1024, GV_OFF = 1280, GG_OFF = 1792, GA_OFF = 2304;
constexpr int NCH = 256;
constexpr int NE = 32, FF = 1024;
constexpr int NSLOT_MAX = T * 4 + NE * 256;
constexpr float EPS = 1e-6f;
constexpr int NWAVES = 8, NTHREADS = 512, GRID = 256;

constexpr size_t MiB = 1u << 20;
constexpr size_t WS_CTL = 0, CTL_ZERO_BYTES = 1 * MiB;
constexpr size_t WS_MOD = 1 * MiB;
constexpr size_t WS_DECAY = 2 * MiB;
constexpr size_t WS_ROUTE = 3 * MiB;
constexpr size_t WS_TOK_E = WS_ROUTE, WS_TOK_LPOS = WS_ROUTE + 512 * 1024, WS_TOK_GATE = WS_ROUTE + 1024 * 1024;
constexpr size_t WS_BLK_CNT = WS_ROUTE + 1536 * 1024, WS_MOE_OFF = WS_BLK_CNT + 32 * 1024, WS_TILE_E = WS_MOE_OFF + 4096;
constexpr size_t WS_SLOT_ASSIGN = WS_ROUTE + 2 * MiB, WS_SLOT_GATE = WS_ROUTE + 3 * MiB;
constexpr size_t WS_WIN = 8 * MiB, WS_WOUT = 13 * MiB, WS_W2T = 16 * MiB, WS_W1T = 80 * MiB;
constexpr size_t WS_H = 208 * MiB, WS_KV = 272 * MiB, WS_YS = 80 * MiB;
constexpr size_t WS_X1 = 336 * MiB, WS_PROJ = 464 * MiB, WS_MIX = 624 * MiB, WS_Y = 688 * MiB, WS_A = 464 * MiB;
constexpr size_t WS_XS = 608 * MiB;
constexpr size_t WS_END = 752 * MiB;
constexpr int CW_BAR = 4096;

constexpr int LDS_BYTES = 147456, SMALL_OFF = 132096, MISC_OFF = 131072 + 320;

__device__ __forceinline__ float bf2f(unsigned v) { return __uint_as_float(v << 16); }
__device__ __forceinline__ unsigned f2bf(float f) { unsigned u = __float_as_uint(f); return (u + 0x7fffu + ((u >> 16) & 1u)) >> 16; }
__device__ __forceinline__ unsigned pk2(float lo, float hi) { return f2bf(lo) | (f2bf(hi) << 16); }
__device__ __forceinline__ float wave_sum(float v) {
#pragma unroll
    for (int o = 1; o < 64; o <<= 1) v += __shfl_xor(v, o);
    return v;
}
__device__ __forceinline__ f32x4 unpack4(u32x2 r) { return (f32x4){bf2f(r.x & 0xffffu), bf2f(r.x >> 16), bf2f(r.y & 0xffffu), bf2f(r.y >> 16)}; }
__device__ __forceinline__ float dot4(f32x4 a) { return (a[0] * a[0] + a[1] * a[1]) + (a[2] * a[2] + a[3] * a[3]); }
typedef short v4i16_t __attribute__((ext_vector_type(4)));
__device__ __forceinline__ s16x4 trr(LAS const unsigned char* p) { return __builtin_bit_cast(s16x4, __builtin_amdgcn_ds_read_tr16_b64_v4i16((LAS v4i16_t*)p)); }
__device__ __forceinline__ bf16x8 cat8(s16x4 lo, s16x4 hi) { return __builtin_shufflevector(lo, hi, 0, 1, 2, 3, 4, 5, 6, 7); }
__device__ __forceinline__ bf16x8 pack8(f32x4 a, f32x4 b) { u32x4 w; w.x = pk2(a[0], a[1]); w.y = pk2(a[2], a[3]); w.z = pk2(b[0], b[1]); w.w = pk2(b[2], b[3]); return __builtin_bit_cast(bf16x8, w); }
#define MFMA(a, b, c) __builtin_amdgcn_mfma_f32_16x16x32_bf16((a), (b), (c), 0, 0, 0)
typedef int i32x4 __attribute__((ext_vector_type(4)));
typedef int i32x8 __attribute__((ext_vector_type(8)));
__device__ __forceinline__ float clamp8(float v) { return fminf(fmaxf(v, -448.f), 448.f); }
__device__ __forceinline__ unsigned pk4_fp8(float a, float b, float c, float d) {
    int w = 0; w = __builtin_amdgcn_cvt_pk_fp8_f32(clamp8(a), clamp8(b), w, false); w = __builtin_amdgcn_cvt_pk_fp8_f32(clamp8(c), clamp8(d), w, true); return (unsigned)w; }
constexpr float W8_SCALE = 64.f, H8_SCALE = 16.f, A8_SCALE = 4.f;
constexpr int W8_E8M0 = 0x79797979  , H8_E8M0 = 0x7b7b7b7b  , A8_E8M0 = 0x7d7d7d7d  ;

#define XB_TMO      128
#define XB_XCNT(j)  (256  + 64 * (j))
#define XB_XSUB(j)  (1280 + 64 * (j))
#define XB_XGEN(j)  (2304 + 64 * (j))
#define XB_TOP      3328
#define XB_TOPGEN   3392
#define XCD_BAR_WORDS 3456
#define XB_SPIN_CAP (1u << 18)
__device__ __forceinline__ unsigned xb_ld(unsigned* p)              { return __hip_atomic_load(p, __ATOMIC_RELAXED, __HIP_MEMORY_SCOPE_AGENT); }
__device__ __forceinline__ unsigned xb_add(unsigned* p, unsigned v) { return __hip_atomic_fetch_add(p, v, __ATOMIC_RELAXED, __HIP_MEMORY_SCOPE_AGENT); }
__device__ __forceinline__ unsigned xb_xcc_id() { return (unsigned)__builtin_amdgcn_s_getreg((3 << 11) | 20) & 0xFu; }
#define XB_SPIN(cond, bar) do { unsigned _sp = 0; while (cond) { __builtin_amdgcn_s_sleep(1); \
    if ((++_sp & 255u) == 0u) { if (xb_ld(&(bar)[XB_TMO])) break; if (_sp > XB_SPIN_CAP) { atomicAdd(&(bar)[XB_TMO], 1u); break; } } } } while (0)
struct XcdBarrier { unsigned* bar; unsigned x; volatile LAS unsigned* st; };
__device__ __forceinline__ XcdBarrier xcd_barrier_post(unsigned* bar, volatile LAS unsigned* st) {
    XcdBarrier b; b.bar = bar; b.x = xb_xcc_id(); b.st = st;
    if (threadIdx.x == 0) (void)xb_add(&bar[XB_XCNT(b.x)], 1u);
    return b;
}
__device__ __forceinline__ void xcd_barrier_complete(unsigned* bar, unsigned x, unsigned& nloc, unsigned& nx) {
    const unsigned G = gridDim.x * gridDim.y * gridDim.z;
    unsigned sum, cnt, mine, sp = 0u;
    for (;;) {
        sum = 0u; cnt = 0u; mine = 0u;
#pragma unroll
        for (unsigned j = 0; j < 16; ++j) { const unsigned c = xb_ld(&bar[XB_XCNT(j)]); sum += c; cnt += (c > 0u) ? 1u : 0u; mine = (j == x) ? c : mine; }
        if (sum == G) break;
        __builtin_amdgcn_s_sleep(1);
        if ((++sp & 255u) == 0u) { if (xb_ld(&bar[XB_TMO])) break; if (sp > XB_SPIN_CAP) { atomicAdd(&bar[XB_TMO], 1u); break; } }
    }
    nloc = mine > 0u ? mine : 1u; nx = cnt > 0u ? cnt : 1u;
}
__device__ __forceinline__ void xcd_barrier(const XcdBarrier& b) {
    asm volatile("s_waitcnt vmcnt(0)" ::: "memory");
    __syncthreads();
    if (threadIdx.x == 0) {
        unsigned* bar = b.bar;
        __builtin_amdgcn_s_waitcnt(0);
        unsigned nloc = b.st[0], nx = b.st[1];
        if (nloc == 0u) { xcd_barrier_complete(bar, b.x, nloc, nx); b.st[0] = nloc; b.st[1] = nx; }
        const unsigned old = xb_add(&bar[XB_XSUB(b.x)], 1u);
        const unsigned gen = old / nloc;
        if (old + 1u == (gen + 1u) * nloc) {
            __builtin_amdgcn_fence(__ATOMIC_RELEASE, "agent");
            asm volatile("s_waitcnt vmcnt(0)" ::: "memory");
            const unsigned og = xb_add(&bar[XB_TOP], 1u);
            const unsigned tg = og / nx;
            if (og + 1u == (tg + 1u) * nx) xb_add(&bar[XB_TOPGEN], 1u);
            else XB_SPIN(xb_ld(&bar[XB_TOPGEN]) == tg, bar);
            __builtin_amdgcn_fence(__ATOMIC_ACQUIRE, "agent");
            xb_add(&bar[XB_XGEN(b.x)], 1u);
            asm volatile("s_waitcnt vmcnt(0)" ::: "memory");
        } else {
            XB_SPIN(xb_ld(&bar[XB_XGEN(b.x)]) == gen, bar);
            __builtin_amdgcn_fence(__ATOMIC_ACQUIRE, "agent");
            asm volatile("s_waitcnt vmcnt(0)" ::: "memory");
        }
    }
    __syncthreads();
}

struct Frame {
    LAS unsigned char* lds;
    int tid, lane, wave, bx, G;
    const float *x, *c, *w_ada, *b_ada, *g_pre_mix, *g_post_mix, *g_pre_ffn, *g_post_ffn, *w_in, *w_gate_up, *b_gate, *g_gla_norm, *sinks, *w_out,
                *w_router, *b_router, *w_mlp1, *b_mlp1, *w_mlp2, *b_mlp2;
    float* out;
    unsigned char* ws;
};
#define WSP(type, off) ((type*)(F.ws + (off)))

__device__ __forceinline__ void tr_item(const float* W, int N, bf16* WT, int nblk, LAS float* scr, int item, int lane) {
    const int kb = item / nblk, nb = item % nblk, k0 = 64 * kb, n0 = 32 * nb;
    const int n = n0 + (lane & 31);
#pragma unroll 8
    for (int i = 0; i < 32; ++i) { const int kk = 2 * i + (lane >> 5); scr[kk * 33 + (lane & 31)] = (n < N) ? W[(size_t)(k0 + kk) * N + n] : 0.f; }
    asm volatile("s_waitcnt lgkmcnt(0)" ::: "memory");
    const int c = lane & 7;
#pragma unroll
    for (int j = 0; j < 4; ++j) { const int nn = (lane >> 3) + 8 * j; const LAS float* s = scr + (8 * c) * 33 + nn;
        u32x4 o; o.x = pk2(s[0 * 33], s[1 * 33]); o.y = pk2(s[2 * 33], s[3 * 33]); o.z = pk2(s[4 * 33], s[5 * 33]); o.w = pk2(s[6 * 33], s[7 * 33]);
        *(u32x4*)(WT + (size_t)(n0 + nn) * 1024 + k0 + 8 * c) = o; }
    asm volatile("s_waitcnt lgkmcnt(0)" ::: "memory");
}
template <bool DEINT>
__device__ __forceinline__ void tr_item8(const float* W, int N, unsigned char* WT, int nblk, LAS float* scr, int item, int lane) {
    const int kb = item / nblk, nb = item % nblk, k0 = 64 * kb, n0 = 32 * nb;
#pragma unroll 8
    for (int i = 0; i < 32; ++i) { const int kk = 2 * i + (lane >> 5); scr[kk * 33 + (lane & 31)] = W[(size_t)(k0 + kk) * N + n0 + (lane & 31)]; }
    asm volatile("s_waitcnt lgkmcnt(0)" ::: "memory");
    const int c = lane & 7;
#pragma unroll
    for (int j = 0; j < 4; ++j) { const int nn = (lane >> 3) + 8 * j; const LAS float* s = scr + (8 * c) * 33 + nn;
        u32x2 o; o.x = pk4_fp8(s[0 * 33] * W8_SCALE, s[1 * 33] * W8_SCALE, s[2 * 33] * W8_SCALE, s[3 * 33] * W8_SCALE);
                 o.y = pk4_fp8(s[4 * 33] * W8_SCALE, s[5 * 33] * W8_SCALE, s[6 * 33] * W8_SCALE, s[7 * 33] * W8_SCALE);
        const int n = n0 + nn; int row = n;
        if (DEINT) { const int jj = n >> 1; row = 256 * (jj >> 7) + 128 * (n & 1) + (jj & 127); }
        *(u32x2*)(WT + (size_t)row * 1024 + k0 + 8 * c) = o; }
    asm volatile("s_waitcnt lgkmcnt(0)" ::: "memory");
}
__device__ __forceinline__ void p0_prologue(const Frame& F) {
    float* mod = WSP(float, WS_MOD);
    if (F.bx < 192) {
        LAS float* red = (LAS float*)(F.lds + 98304);
        const int cl = F.tid & 31, ks = F.tid >> 5, col = F.bx * 32 + cl;
        float a0 = 0.f, a1 = 0.f;
#pragma unroll 8
        for (int k = ks * 64; k < ks * 64 + 64; ++k) {
            const float w = F.w_ada[(size_t)k * 6144 + col];
            const float c0 = F.c[k], c1 = F.c[1024 + k];
            a0 += c0 / (1.f + __expf(-c0)) * w; a1 += c1 / (1.f + __expf(-c1)) * w;
        }
        red[(0 * 16 + ks) * 32 + cl] = a0; red[(1 * 16 + ks) * 32 + cl] = a1;
        __syncthreads();
        if (F.tid < 64) { const int b = F.tid >> 5; float s = 0.f;
#pragma unroll
            for (int i = 0; i < 16; ++i) s += red[(b * 16 + i) * 32 + cl];
            mod[b * 6144 + col] = s + F.b_ada[col]; }
        __syncthreads();
    }
    LAS float* scr = (LAS float*)(F.lds + F.wave * 8704);
    const int gw = F.bx * NWAVES + F.wave, NGW = F.G * NWAVES;
    constexpr int I_IN = 16 * 80, I_OUT = 16 * 32, I_1 = 16 * 64, I_2 = 16 * 32;
    constexpr int NITEMS = I_IN + I_OUT + NE * I_1 + NE * I_2;
    for (int it = gw; it < NITEMS; it += NGW) {
        int r = it;
        if (r < I_IN) { tr_item(F.w_in, INW, WSP(bf16, WS_WIN), 80, scr, r, F.lane); continue; } r -= I_IN;
        if (r < I_OUT) { tr_item(F.w_out, 1024, WSP(bf16, WS_WOUT), 32, scr, r, F.lane); continue; } r -= I_OUT;
        if (r < NE * I_1) { const int e = r / I_1; tr_item8<true>(F.w_mlp1 + (size_t)e * 1024 * 2048, 2048, WSP(unsigned char, WS_W1T) + (size_t)e * 2048 * 1024, 64, scr, r % I_1, F.lane); continue; } r -= NE * I_1;
        { const int e = r / I_2; tr_item8<false>(F.w_mlp2 + (size_t)e * 1024 * 1024, 1024, WSP(unsigned char, WS_W2T) + (size_t)e * 1024 * 1024, 32, scr, r % I_2, F.lane); }
    }
}

__device__ __forceinline__ void p1_norm(const Frame& F) {
    const float* mod = WSP(float, WS_MOD); bf16* h = WSP(bf16, WS_H);
    const int gw = F.bx * NWAVES + F.wave, NGW = F.G * NWAVES;
    for (int m = gw; m < T; m += NGW) {
        const int b = m >> 14; const float* modb = mod + b * 6144;
        f32x4 v[4]; float ss = 0.f;
#pragma unroll
        for (int j = 0; j < 4; ++j) { v[j] = *(const f32x4*)(F.x + (size_t)m * D + 4 * F.lane + 256 * j); ss += dot4(v[j]); }
        const float r = rsqrtf(wave_sum(ss) * (1.f / D) + EPS);
#pragma unroll
        for (int j = 0; j < 4; ++j) { const int idx = 4 * F.lane + 256 * j;
            const f32x4 g = *(const f32x4*)(F.g_pre_mix + idx), sc = *(const f32x4*)(modb + 1024 + idx), sh = *(const f32x4*)(modb + idx);
            const f32x4 hv = v[j] * r * g * (sc + 1.f) + sh;
            u32x2 o; o.x = pk2(hv[0], hv[1]); o.y = pk2(hv[2], hv[3]);
            *(u32x2*)(h + (size_t)m * D + idx) = o; }
    }
}

template <class Epi, class RowMap, class BSel>
__device__ __forceinline__ void simple_gemm(const Frame& F, const bf16* A, int lda, int M, int N, int K, const RowMap& rm, const BSel& bs, const Epi& E) {
    const int fr = F.lane & 15, fq = F.lane >> 4;
    const int ncg = N / 512, nbt = (M / 64) * ncg;
    for (int bt = F.bx; bt < nbt; bt += F.G) {
        const int mt = bt / ncg, cg = bt % ncg, m0 = mt * 64, n0 = cg * 512 + F.wave * 64;
        const bf16* Bt = bs(m0);
        const bf16* ap[4]; const bf16* bp[4];
#pragma unroll
        for (int i = 0; i < 4; ++i) { ap[i] = A + (size_t)rm(m0 + 16 * i + fr) * lda + 8 * fq; bp[i] = Bt + (size_t)(n0 + 16 * i + fr) * K + 8 * fq; }
        f32x4 acc[4][4];
#pragma unroll
        for (int i = 0; i < 4; ++i)
#pragma unroll
            for (int j = 0; j < 4; ++j) acc[i][j] = (f32x4){0.f, 0.f, 0.f, 0.f};
#pragma unroll 2
        for (int k0 = 0; k0 < K; k0 += 32) {
            bf16x8 a[4], b[4];
#pragma unroll
            for (int i = 0; i < 4; ++i) { a[i] = *(const bf16x8*)(ap[i] + k0); b[i] = *(const bf16x8*)(bp[i] + k0); }
#pragma unroll
            for (int i = 0; i < 4; ++i)
#pragma unroll
                for (int j = 0; j < 4; ++j) acc[i][j] = MFMA(b[j], a[i], acc[i][j]);
        }
#pragma unroll
        for (int i = 0; i < 4; ++i)
#pragma unroll
            for (int j = 0; j < 4; ++j) E(m0 + 16 * i + fr, n0 + 16 * j + 4 * fq, acc[i][j]);
    }
}
struct RowId { __device__ __forceinline__ int operator()(int m) const { return m; } };
struct RowGather { const int* slot_assign; __device__ __forceinline__ int operator()(int m) const { const int a = slot_assign[m]; return a < 0 ? 0 : (a >> 2); } };
struct BFixed { const bf16* Bt; __device__ __forceinline__ const bf16* operator()(int) const { return Bt; } };
struct BExpert { const bf16* Bt; const int* tile_e; size_t stride; __device__ __forceinline__ const bf16* operator()(int m0) const { return Bt + (size_t)tile_e[m0 >> 8] * stride; } };
struct EpiStore { bf16* O; int ldo;
    __device__ __forceinline__ void operator()(int m, int n, f32x4 v) const { u32x2 w; w.x = pk2(v[0], v[1]); w.y = pk2(v[2], v[3]); *(u32x2*)(O + (size_t)m * ldo + n) = w; } };
__device__ __forceinline__ float swiglu(float g, float l) {
    const float xg = fminf(g, 7.f), xl = fminf(fmaxf(l, -7.f), 7.f);
    return xg / (1.f + __expf(-1.702f * xg)) * (xl + 1.f);
}
struct EpiSwiglu { bf16* Aout; const float* b1; const int* tile_e;
    __device__ __forceinline__ void operator()(int m, int n, f32x4 v) const {
        const int e = tile_e[m >> 8]; const f32x4 bb = *(const f32x4*)(b1 + (size_t)e * 2048 + n);
        const float a0 = swiglu(v[0] + bb[0], v[1] + bb[1]), a1 = swiglu(v[2] + bb[2], v[3] + bb[3]);
        *(unsigned*)(Aout + (size_t)m * FF + (n >> 1)) = pk2(a0, a1); } };
struct EpiMoe2 { bf16* ys; const float* b2; const int* tile_e; const int* slot_assign; const float* slot_gate;
    __device__ __forceinline__ void operator()(int m, int n, f32x4 v) const {
        const int asg = slot_assign[m]; if (asg < 0) return;
        const int e = tile_e[m >> 8]; const f32x4 bb = *(const f32x4*)(b2 + (size_t)e * D + n); const float g = slot_gate[m];
        u32x2 w; w.x = pk2((v[0] + bb[0]) * g, (v[1] + bb[1]) * g); w.y = pk2((v[2] + bb[2]) * g, (v[3] + bb[3]) * g);
        *(u32x2*)(ys + (size_t)asg * D + n) = w; } };

namespace pg8 {
constexpr int BM = 256, BK = 64, HALF = 128, HTB = HALF * BK * 2, NXCD = 8, WGM = 8;
__device__ __forceinline__ int lds_byte(int r, int c) { const int st = (r >> 4) * 2 + (c >> 5), rr = r & 15, cc = c & 31, ob = rr * 64 + cc * 2; return st * 1024 + (ob ^ (((ob >> 9) & 1) << 5)); }
__device__ __forceinline__ void stage_rc(int b, int& R, int& C) { const int st = b / 1024, sb = b % 1024, swz = sb ^ (((sb >> 9) & 1) << 5); R = (st >> 1) * 16 + swz / 64; C = (st & 1) * 32 + (swz % 64) / 2; }
__device__ __forceinline__ int perm32(int rho) { const int n = rho >> 4, i = rho & 15; return 8 * (i >> 2) + 4 * n + (i & 3); }
struct Unit { int pm, pn; };
struct StaticOrder {
    int nM, nN, nwg, G, c;
    __device__ __forceinline__ void init(int nM_, int nN_, int G_, int c_) { nM = nM_; nN = nN_; nwg = nM * nN; G = G_; c = c_; }
    __device__ __forceinline__ bool next(int i, Unit& u) const {
        const long L = (long)i * G + c; if (L >= nwg) return false;
        int wgid = (int)L; { const int q = nwg / NXCD, r = nwg % NXCD, xcd = wgid % NXCD, off = wgid / NXCD; wgid = (xcd < r ? xcd * (q + 1) : r * (q + 1) + (xcd - r) * q) + off; }
        const int nig = WGM * nN, gid = wgid / nig, fm = gid * WGM, gsz = (nM - fm) < WGM ? (nM - fm) : WGM;
        u.pm = fm + ((wgid % nig) % gsz); u.pn = (wgid % nig) / gsz; return true;
    }
};
template <bool GATHER, int FP8, int SCW, int SCX, class Epi, class Sched, class AB>
__device__ __forceinline__ void gemm_phase(LAS unsigned char* lds, const int K, const Sched& S, const AB& ab, const Epi& E) {
    const int tid = threadIdx.x, wid = __builtin_amdgcn_readfirstlane(tid >> 6), lane = tid & 63, wr = wid >> 2, wc = wid & 3, fr = lane & 15, fq = lane >> 4;
    const int nt = K / BK;
    int sR[2], sC[2]; unsigned voffB[2], vA[2][2], nvA[2][2];
#pragma unroll
    for (int i = 0; i < 2; ++i) { int R, C; stage_rc(tid * 16 + i * 8192, R, C); sR[i] = R; sC[i] = C; const int Rb = (R & ~31) + perm32(R & 31); voffB[i] = (unsigned)(Rb * K + C) * 2u; }
    const size_t kstep = (size_t)(BK * 2);
    const size_t hstep = (size_t)HALF * K * 2;
    const unsigned ldsw = (unsigned)wid * 1024u;
    const int aoff = lds_byte(wr * 64 + fr, fq * 8), boff = lds_byte(wc * 32 + fr, fq * 8);
#define PG8_SA(b, h) (((b) * 2 + (h)) * HTB)
#define PG8_SB(b, h) ((4 + (b) * 2 + (h)) * HTB)
#define PG8_STAGE(bufoff, gbase, voff) do { _Pragma("unroll") for (int _i = 0; _i < 2; ++_i) \
        __builtin_amdgcn_global_load_lds((const unsigned*)((const char*)(gbase) + (voff)[_i]), (LAS unsigned*)(lds + (bufoff) + ldsw + _i * 8192), 16, 0, 0); } while (0)
#define PG8_LDA(dst, b, h) do { _Pragma("unroll") for (int m = 0; m < 4; ++m) _Pragma("unroll") for (int k = 0; k < 2; ++k) dst[m][k] = *(const LAS bf16x8*)(lds + PG8_SA(b, h) + aoff + m * 2048 + k * 1024); } while (0)
#define PG8_LDB(dst, b, h) do { _Pragma("unroll") for (int n = 0; n < 2; ++n) _Pragma("unroll") for (int k = 0; k < 2; ++k) dst[n][k] = *(const LAS bf16x8*)(lds + PG8_SB(b, h) + boff + n * 2048 + k * 1024); } while (0)
#define PG8_C8(x) __builtin_shufflevector(__builtin_bit_cast(i32x4, (x)[0]), __builtin_bit_cast(i32x4, (x)[1]), 0, 1, 2, 3, 4, 5, 6, 7)
#define PG8_MMA(ai, bj, At, Bt) do { __builtin_amdgcn_s_setprio(1); _Pragma("unroll") for (int m = 0; m < 4; ++m) _Pragma("unroll") for (int n = 0; n < 2; ++n) { \
        if (FP8) asm volatile("v_mfma_scale_f32_16x16x128_f8f6f4 %0, %1, %2, %0, %3, %4 op_sel_hi:[0,0,0]" : "+v"(acc[ai][bj][m][n]) : "v"(PG8_C8(Bt[n])), "v"(PG8_C8(At[m])), "v"(scw), "v"(scx)); \
        else { _Pragma("unroll") for (int k = 0; k < 2; ++k) asm volatile("v_mfma_f32_16x16x32_bf16 %0, %1, %2, %0" : "+v"(acc[ai][bj][m][n]) : "v"(Bt[n][k]), "v"(At[m][k])); } } \
        __builtin_amdgcn_s_setprio(0); } while (0)
#define PG8_WAIT_V(n) asm volatile("s_waitcnt vmcnt(" #n ")" ::: "memory")
#define PG8_WAIT_L(n) asm volatile("s_waitcnt lgkmcnt(" #n ")" ::: "memory")
#define PG8_BAR __builtin_amdgcn_s_barrier()
#define PG8_SCHED __builtin_amdgcn_sched_barrier(0)
#define PG8_AOFF(dst, u) do { _Pragma("unroll") for (int _h = 0; _h < 2; ++_h) _Pragma("unroll") for (int _i = 0; _i < 2; ++_i) \
        dst[_h][_i] = GATHER ? (unsigned)(ab.a_row((u).pm * BM + _h * HALF + sR[_i]) * K + sC[_i]) * 2u : (unsigned)((_h * HALF + sR[_i]) * K + sC[_i]) * 2u; } while (0)
    Unit cur, nxt; int ui = 0;
    if (!S.next(0, cur)) return;
    const int scw = SCW, scx = SCX;
    f32x4 acc[2][2][4][2];
#pragma unroll
    for (int a = 0; a < 2; ++a)
#pragma unroll
        for (int b = 0; b < 2; ++b)
#pragma unroll
            for (int m = 0; m < 4; ++m)
#pragma unroll
                for (int n = 0; n < 2; ++n) acc[a][b][m][n] = (f32x4){0.f, 0.f, 0.f, 0.f};
    bf16x8 At[4][2], B0[2][2], B1[2][2];
    const char* cA = ab.a_base(cur); const char* cB = ab.b_base(cur);
    PG8_AOFF(vA, cur);
    PG8_STAGE(PG8_SB(0, 0), cB, voffB); PG8_STAGE(PG8_SB(0, 1), cB + hstep, voffB); PG8_STAGE(PG8_SA(0, 0), cA, vA[0]); PG8_STAGE(PG8_SA(0, 1), cA, vA[1]);
    if (wr == 1) PG8_BAR;
    PG8_WAIT_V(2); PG8_BAR;
    PG8_STAGE(PG8_SB(1, 0), cB + kstep, voffB); PG8_STAGE(PG8_SA(1, 0), cA + kstep, vA[0]); PG8_STAGE(PG8_SB(1, 1), cB + hstep + kstep, voffB);
    PG8_WAIT_V(6); PG8_BAR;
    for (;;) {
        const bool has_next = S.next(ui + 1, nxt);
        const char* nA = has_next ? ab.a_base(nxt) : cA; const char* nB = has_next ? ab.b_base(nxt) : cB;
        if (GATHER) { if (has_next) { PG8_AOFF(nvA, nxt); } else {
#pragma unroll
            for (int h = 0; h < 2; ++h)
#pragma unroll
                for (int i = 0; i < 2; ++i) nvA[h][i] = vA[h][i]; } }
#pragma unroll 1
        for (int t = 0; t < nt; t += 2) {
            const bool last = (t == nt - 2);
            const char* a1 = cA + (size_t)(t + 1) * kstep;
            const char* a2 = last ? nA : cA + (size_t)(t + 2) * kstep; const char* b2 = last ? nB : cB + (size_t)(t + 2) * kstep;
            const char* a3 = a2 + kstep; const char* b3 = b2 + kstep;
            unsigned o2[2][2];
#pragma unroll
            for (int h = 0; h < 2; ++h)
#pragma unroll
                for (int i = 0; i < 2; ++i) o2[h][i] = (GATHER && last) ? nvA[h][i] : vA[h][i];
            PG8_LDB(B0, 0, 0); PG8_LDB(B1, 0, 1); PG8_SCHED; PG8_LDA(At, 0, 0); PG8_STAGE(PG8_SA(1, 1), a1, vA[1]);
            PG8_WAIT_V(8); PG8_WAIT_L(0); PG8_BAR; PG8_MMA(0, 0, At, B0); PG8_MMA(0, 1, At, B1); PG8_BAR; PG8_SCHED;
            PG8_LDA(At, 0, 1); PG8_STAGE(PG8_SB(0, 0), b2, voffB); PG8_STAGE(PG8_SB(0, 1), b2 + hstep, voffB); PG8_STAGE(PG8_SA(0, 0), a2, o2[0]);
            PG8_WAIT_V(8); PG8_WAIT_L(0); PG8_BAR; PG8_MMA(1, 0, At, B0); PG8_MMA(1, 1, At, B1); PG8_BAR; PG8_SCHED;
            PG8_LDB(B0, 1, 0); PG8_LDB(B1, 1, 1); PG8_SCHED; PG8_LDA(At, 1, 0); PG8_STAGE(PG8_SA(0, 1), a2, o2[1]);
            PG8_WAIT_V(8); PG8_WAIT_L(0); PG8_BAR; PG8_MMA(0, 0, At, B0); PG8_MMA(0, 1, At, B1); PG8_BAR; PG8_SCHED;
            PG8_LDA(At, 1, 1); PG8_STAGE(PG8_SB(1, 0), b3, voffB); PG8_STAGE(PG8_SB(1, 1), b3 + hstep, voffB); PG8_STAGE(PG8_SA(1, 0), a3, o2[0]);
            PG8_WAIT_V(8); PG8_WAIT_L(0); PG8_BAR; PG8_MMA(1, 0, At, B0); PG8_MMA(1, 1, At, B1); PG8_BAR; PG8_SCHED;
        }
        if (wr == 0) PG8_BAR;
        asm volatile("s_nop 15\n\ts_nop 15" ::: "memory");
        E(acc, cur, wr, wc, fr, fq);
        if (!has_next) break;
#pragma unroll
        for (int a = 0; a < 2; ++a)
#pragma unroll
            for (int b = 0; b < 2; ++b)
#pragma unroll
                for (int m = 0; m < 4; ++m)
#pragma unroll
                    for (int n = 0; n < 2; ++n) acc[a][b][m][n] = (f32x4){0.f, 0.f, 0.f, 0.f};
        cur = nxt; cA = nA; cB = nB; ++ui;
        if (GATHER) {
#pragma unroll
            for (int h = 0; h < 2; ++h)
#pragma unroll
                for (int i = 0; i < 2; ++i) vA[h][i] = nvA[h][i]; }
        if (wr == 1) PG8_BAR;
    }
    PG8_WAIT_V(0);
    PG8_BAR;
#undef PG8_SA
#undef PG8_SB
#undef PG8_STAGE
#undef PG8_LDA
#undef PG8_LDB
#undef PG8_MMA
#undef PG8_C8
#undef PG8_WAIT_V
#undef PG8_WAIT_L
#undef PG8_BAR
#undef PG8_SCHED
#undef PG8_AOFF
}
__device__ __forceinline__ unsigned cvt_pk_bf16(float lo, float hi) { unsigned r; asm volatile("v_cvt_pk_bf16_f32 %0, %1, %2" : "=v"(r) : "v"(lo), "v"(hi)); return r; }
struct ABDense { const bf16* A; const bf16* Bt; int K;
    __device__ __forceinline__ const char* a_base(const Unit& u) const { return (const char*)(A + (size_t)u.pm * BM * K); }
    __device__ __forceinline__ const char* b_base(const Unit& u) const { return (const char*)(Bt + (size_t)u.pn * BM * K); }
    __device__ __forceinline__ int a_row(int) const { return 0; } };
struct EpiStoreT { bf16* O; int ldo;
    __device__ __forceinline__ void operator()(const f32x4 (&acc)[2][2][4][2], const Unit& u, int wr, int wc, int fr, int fq) const {
        const int row0 = u.pm * BM + wr * 64 + fr, col0 = u.pn * BM + wc * 32 + 8 * fq;
#pragma unroll
        for (int ai = 0; ai < 2; ++ai)
#pragma unroll
            for (int m = 0; m < 4; ++m) { bf16* rowp = O + (size_t)(row0 + ai * HALF + m * 16) * ldo + col0;
#pragma unroll
                for (int bj = 0; bj < 2; ++bj) { const f32x4 v0 = acc[ai][bj][m][0], v1 = acc[ai][bj][m][1];
                    u32x4 w; w.x = cvt_pk_bf16(v0[0], v0[1]); w.y = cvt_pk_bf16(v0[2], v0[3]); w.z = cvt_pk_bf16(v1[0], v1[1]); w.w = cvt_pk_bf16(v1[2], v1[3]);
                    *(u32x4*)(rowp + bj * HALF) = w; } }
    } };
struct ABMoe1 { const unsigned char* X; const unsigned char* W; const int* tile_e;
    __device__ __forceinline__ const char* a_base(const Unit& u) const { return (const char*)(X + (size_t)u.pm * BM * 1024); }
    __device__ __forceinline__ const char* b_base(const Unit& u) const { return (const char*)(W + (size_t)tile_e[u.pm] * 2048 * 1024 + (size_t)u.pn * BM * 1024); }
    __device__ __forceinline__ int a_row(int) const { return 0; } };
struct ABMoe2 { const unsigned char* A; const unsigned char* W; const int* tile_e;
    __device__ __forceinline__ const char* a_base(const Unit& u) const { return (const char*)(A + (size_t)u.pm * BM * 1024); }
    __device__ __forceinline__ const char* b_base(const Unit& u) const { return (const char*)(W + (size_t)tile_e[u.pm] * 1024 * 1024 + (size_t)u.pn * BM * 1024); }
    __device__ __forceinline__ int a_row(int) const { return 0; } };
struct EpiSwigluT { unsigned char* Aout; const float* b1; const int* tile_e;
    __device__ __forceinline__ void operator()(const f32x4 (&acc)[2][2][4][2], const Unit& u, int wr, int wc, int fr, int fq) const {
        const int row0 = u.pm * BM + wr * 64 + fr, j0 = u.pn * HALF + wc * 32 + 8 * fq;
        const float* bp = b1 + (size_t)tile_e[u.pm] * 2048 + 2 * j0;
        f32x4 bb[4];
#pragma unroll
        for (int q = 0; q < 4; ++q) bb[q] = *(const f32x4*)(bp + 4 * q);
#pragma unroll
        for (int ai = 0; ai < 2; ++ai)
#pragma unroll
            for (int m = 0; m < 4; ++m) {
                const f32x4 g0 = acc[ai][0][m][0], g1 = acc[ai][0][m][1], l0 = acc[ai][1][m][0], l1 = acc[ai][1][m][1];
                u32x2 w;
                w.x = pk4_fp8(swiglu(g0[0] + bb[0][0], l0[0] + bb[0][1]) * A8_SCALE, swiglu(g0[1] + bb[0][2], l0[1] + bb[0][3]) * A8_SCALE,
                              swiglu(g0[2] + bb[1][0], l0[2] + bb[1][1]) * A8_SCALE, swiglu(g0[3] + bb[1][2], l0[3] + bb[1][3]) * A8_SCALE);
                w.y = pk4_fp8(swiglu(g1[0] + bb[2][0], l1[0] + bb[2][1]) * A8_SCALE, swiglu(g1[1] + bb[2][2], l1[1] + bb[2][3]) * A8_SCALE,
                              swiglu(g1[2] + bb[3][0], l1[2] + bb[3][1]) * A8_SCALE, swiglu(g1[3] + bb[3][2], l1[3] + bb[3][3]) * A8_SCALE);
                *(u32x2*)(Aout + (size_t)(row0 + ai * HALF + m * 16) * FF + j0) = w; }
    } };
struct EpiMoe2T { bf16* ys; const float* b2; const int* tile_e; const int* slot_assign; const float* slot_gate;
    __device__ __forceinline__ void operator()(const f32x4 (&acc)[2][2][4][2], const Unit& u, int wr, int wc, int fr, int fq) const {
        const int row0 = u.pm * BM + wr * 64 + fr, col0 = u.pn * BM + wc * 32 + 8 * fq;
        const float* bp = b2 + (size_t)tile_e[u.pm] * D + col0;
        f32x4 bv[2][2];
#pragma unroll
        for (int bj = 0; bj < 2; ++bj)
#pragma unroll
            for (int n = 0; n < 2; ++n) bv[bj][n] = *(const f32x4*)(bp + bj * HALF + 4 * n);
#pragma unroll
        for (int ai = 0; ai < 2; ++ai)
#pragma unroll
            for (int m = 0; m < 4; ++m) { const int row = row0 + ai * HALF + m * 16; const int asg = slot_assign[row]; const float g = slot_gate[row];
                if (asg >= 0) { bf16* rowp = ys + (size_t)asg * D + col0;
#pragma unroll
                    for (int bj = 0; bj < 2; ++bj) { const f32x4 v0 = (acc[ai][bj][m][0] + bv[bj][0]) * g, v1 = (acc[ai][bj][m][1] + bv[bj][1]) * g;
                        u32x4 w; w.x = cvt_pk_bf16(v0[0], v0[1]); w.y = cvt_pk_bf16(v0[2], v0[3]); w.z = cvt_pk_bf16(v1[0], v1[1]); w.w = cvt_pk_bf16(v1[2], v1[3]);
                        *(u32x4*)(rowp + bj * HALF) = w; } } }
    } };
}

__device__ __forceinline__ void attn_unit(const Frame& F, int u) {
    const int qblk = u & 127, kvh = (u >> 7) & 1, b = u >> 8;
    LAS unsigned char* Ks = F.lds; LAS unsigned char* Vs = F.lds + 256 * 144;
    const bf16* proj = WSP(bf16, WS_PROJ); bf16* mix = WSP(bf16, WS_MIX);
    const int tok0 = b * S + qblk * 128;
#pragma unroll
    for (int i = 0; i < 4; ++i) {
        const int cid = F.tid + 512 * i, row = cid >> 3, ch = cid & 7;
        u32x4 kv = (u32x4){0u, 0u, 0u, 0u}, vv = (u32x4){0u, 0u, 0u, 0u};
        if (qblk > 0 || row >= 128) {
            const bf16* rp = proj + (size_t)(tok0 - 128 + row) * INP;
            kv = *(const u32x4*)(rp + AK_OFF + kvh * 64 + ch * 8);
            vv = *(const u32x4*)(rp + AV_OFF + kvh * 64 + ch * 8);
        }
        *(LAS u32x4*)(Ks + row * 144 + ch * 16) = kv;
        *(LAS u32x4*)(Vs + row * 144 + ch * 16) = vv;
    }
    __syncthreads();
    const int g = F.wave >> 1, hw = F.wave & 1, hq = kvh * 4 + g;
    const int lane = F.lane, fr = lane & 15, fq = lane >> 4;
    const float sink = F.sinks[hq];
    const float NEG_INF = -__builtin_inff();
    for (int qb = 0; qb < 4; ++qb) {
        const int i = 64 * hw + 16 * qb + fr;
        const bf16* qp = proj + (size_t)(tok0 + i) * INP + AQ_OFF + hq * 64 + 8 * fq;
        const bf16x8 q0 = *(const bf16x8*)qp, q1 = *(const bf16x8*)(qp + 32);
        f32x4 st[12];
#pragma unroll
        for (int kt = 0; kt < 12; ++kt) {
            LAS const unsigned char* kp = Ks + (64 * hw + 16 * kt + fr) * 144 + fq * 16;
            const bf16x8 k0 = *(LAS const bf16x8*)kp, k1 = *(LAS const bf16x8*)(kp + 64);
            f32x4 z = (f32x4){0.f, 0.f, 0.f, 0.f}; z = MFMA(k0, q0, z); z = MFMA(k1, q1, z); st[kt] = z;
        }
        float mx = NEG_INF;
#pragma unroll
        for (int kt = 0; kt < 12; ++kt)
#pragma unroll
            for (int r = 0; r < 4; ++r) {
                const int j = 64 * hw + 16 * kt + 4 * fq + r, rel = i + 128 - j;
                const bool ok = (rel >= 0) && (rel < 128) && (qblk > 0 || j >= 128);
                const float s = ok ? st[kt][r] * 0.125f : NEG_INF;
                st[kt][r] = s; mx = fmaxf(mx, s);
            }
        mx = fmaxf(mx, __shfl_xor(mx, 16)); mx = fmaxf(mx, __shfl_xor(mx, 32)); mx = fmaxf(mx, sink);
        float sum = 0.f;
#pragma unroll
        for (int kt = 0; kt < 12; ++kt)
#pragma unroll
            for (int r = 0; r < 4; ++r) { const float p = __expf(st[kt][r] - mx); st[kt][r] = p; sum += p; }
        sum += __shfl_xor(sum, 16); sum += __shfl_xor(sum, 32); sum += __expf(sink - mx);
        const float inv = 1.f / sum;
        f32x4 o[4];
#pragma unroll
        for (int c = 0; c < 4; ++c) o[c] = (f32x4){0.f, 0.f, 0.f, 0.f};
#pragma unroll
        for (int ks = 0; ks < 6; ++ks) {
            const bf16x8 pf = pack8(st[2 * ks], st[2 * ks + 1]);
            const int rb = 64 * hw + 32 * ks + 4 * fq + (fr >> 2);
#pragma unroll
            for (int c = 0; c < 4; ++c) {
                LAS const unsigned char* vp = Vs + rb * 144 + (16 * c + 4 * (lane & 3)) * 2;
                const bf16x8 vf = cat8(trr(vp), trr(vp + 16 * 144));
                o[c] = MFMA(pf, vf, o[c]);
            }
        }
#pragma unroll
        for (int r = 0; r < 4; ++r) {
            const int qrow = 4 * fq + r; const float iv = __shfl(inv, qrow);
            bf16* op = mix + (size_t)(tok0 + 64 * hw + 16 * qb + qrow) * D + hq * 64 + fr;
#pragma unroll
            for (int c = 0; c < 4; ++c) op[16 * c] = (bf16)f2bf(o[c][r] * iv);
        }
    }
    __syncthreads();
}

__device__ __forceinline__ void gla_gate_prefix(const Frame& F, const bf16* proj, int t0, int h, LAS float* ga_s, LAS float* tot_s, float (&bv)[8], float& b_mid, float& b_last) {
#pragma unroll
    for (int i = 0; i < 2; ++i) { const int idx = F.tid + 512 * i, t = idx >> 4, r = idx & 15; ga_s[idx] = bf2f(proj[(size_t)(t0 + t) * INP + GA_OFF + r]); }
    float wu[16];
#pragma unroll
    for (int r = 0; r < 16; ++r) wu[r] = F.w_gate_up[r * 256 + h * 64 + F.lane];
    const float bg = F.b_gate[h * 64 + F.lane];
    __syncthreads();
    float run = 0.f;
#pragma unroll
    for (int i = 0; i < 8; ++i) {
        const int t = 8 * F.wave + i; float z = bg;
#pragma unroll
        for (int r = 0; r < 16; ++r) z += ga_s[t * 16 + r] * wu[r];
        const float ls = fminf(z, 0.f) - __logf(1.f + __expf(-fabsf(z)));
        run += ls * (1.f / 16.f); bv[i] = run;
    }
    tot_s[F.wave * 64 + F.lane] = run;
    __syncthreads();
    float pre = 0.f, mid = 0.f, all = 0.f;
#pragma unroll
    for (int w = 0; w < 8; ++w) { const float tv = tot_s[w * 64 + F.lane]; pre += (w < F.wave) ? tv : 0.f; mid += (w < 4) ? tv : 0.f; all += tv; }
#pragma unroll
    for (int i = 0; i < 8; ++i) bv[i] += pre;
    b_mid = mid; b_last = all;
}
__device__ __forceinline__ void gla_kv_unit(const Frame& F, int u) {
    const int h = u & 3, n = (u >> 2) & 255, b = u >> 10, t0 = b * S + n * 64;
    const bf16* proj = WSP(bf16, WS_PROJ);
    LAS unsigned char* kd_s = F.lds; LAS unsigned char* v_s = F.lds + 9216;
    LAS float* ga_s = (LAS float*)(F.lds + 26624); LAS float* tot_s = (LAS float*)(F.lds + 30720);
    const int lane = F.lane, fr = lane & 15, fq = lane >> 4;
#pragma unroll
    for (int i = 0; i < 2; ++i) { const int cid = F.tid + 512 * i, row = cid >> 4, ch = cid & 15;
        *(LAS u32x4*)(v_s + row * 272 + ch * 16) = *(const u32x4*)(proj + (size_t)(t0 + row) * INP + GV_OFF + h * 128 + ch * 8); }
    float bv[8], b_mid, b_last;
    gla_gate_prefix(F, proj, t0, h, ga_s, tot_s, bv, b_mid, b_last);
#pragma unroll
    for (int i = 0; i < 8; ++i) { const int t = 8 * F.wave + i;
        const float kx = bf2f(proj[(size_t)(t0 + t) * INP + GK_OFF + h * 64 + lane]);
        *(LAS bf16*)(kd_s + t * 144 + lane * 2) = (bf16)f2bf(kx * __expf(b_last - bv[i])); }
    if (F.wave == 0) WSP(float, WS_DECAY)[((size_t)(b * NCH + n) * 4 + h) * 64 + lane] = __expf(b_last);
    __syncthreads();
    const int c = F.wave;
    f32x4 acc[4];
#pragma unroll
    for (int d = 0; d < 4; ++d) acc[d] = (f32x4){0.f, 0.f, 0.f, 0.f};
#pragma unroll
    for (int ks = 0; ks < 2; ++ks) {
        const int rb = 32 * ks + 8 * fq + (fr >> 2);
        LAS const unsigned char* vp = v_s + rb * 272 + (16 * c + 4 * (lane & 3)) * 2;
        const bf16x8 vf = cat8(trr(vp), trr(vp + 4 * 272));
#pragma unroll
        for (int d = 0; d < 4; ++d) {
            LAS const unsigned char* kp = kd_s + rb * 144 + (16 * d + 4 * (lane & 3)) * 2;
            const bf16x8 kf = cat8(trr(kp), trr(kp + 4 * 144));
            acc[d] = MFMA(kf, vf, acc[d]);
        }
    }
    float* kvp = WSP(float, WS_KV) + (((size_t)(b * NCH + n) * 4 + h) * 128 + 16 * c + fr) * 64;
#pragma unroll
    for (int d = 0; d < 4; ++d) *(f32x4*)(kvp + 16 * d + 4 * fq) = acc[d];
    __syncthreads();
}
__device__ __forceinline__ void gla_scan(const Frame& F) {
    float* kv = WSP(float, WS_KV); const float* decay = WSP(float, WS_DECAY);
    if (F.tid >= 256) return;
    for (int idx = F.bx * 256 + F.tid; idx < 65536; idx += F.G * 256) {
        const int b = idx >> 15, h = (idx >> 13) & 3, dvdk = idx & 8191, dk = idx & 63;
        float* p = kv + ((size_t)(b * NCH) * 4 + h) * 8192 + dvdk;
        const float* dp = decay + ((size_t)(b * NCH) * 4 + h) * 64 + dk;
        float state = 0.f;
        for (int n = 0; n < NCH; n += 8) {
            float tv[8], dv[8];
#pragma unroll
            for (int i = 0; i < 8; ++i) { tv[i] = p[(size_t)(n + i) * 4 * 8192]; dv[i] = dp[(size_t)(n + i) * 4 * 64]; }
#pragma unroll
            for (int i = 0; i < 8; ++i) { p[(size_t)(n + i) * 4 * 8192] = state; state = dv[i] * state + tv[i]; }
        }
    }
}
__device__ __forceinline__ void gla_out_unit(const Frame& F, int u) {
    const int h = u & 3, n = (u >> 2) & 255, b = u >> 10, t0 = b * S + n * 64;
    const bf16* proj = WSP(bf16, WS_PROJ); bf16* mix = WSP(bf16, WS_MIX);
    LAS unsigned char* qd_s = F.lds; LAS unsigned char* kk_s = F.lds + 9216; LAS unsigned char* qe_s = F.lds + 18432;
    LAS unsigned char* v_s = F.lds + 27648; LAS unsigned char* st_s = F.lds + 45056;
    LAS float* ga_s = (LAS float*)(F.lds + 63488); LAS float* tot_s = (LAS float*)(F.lds + 67584); LAS float* ssq_s = (LAS float*)(F.lds + 69632);
    const int lane = F.lane, fr = lane & 15, fq = lane >> 4;
#pragma unroll
    for (int i = 0; i < 2; ++i) { const int cid = F.tid + 512 * i, row = cid >> 4, ch = cid & 15;
        *(LAS u32x4*)(v_s + row * 272 + ch * 16) = *(const u32x4*)(proj + (size_t)(t0 + row) * INP + GV_OFF + h * 128 + ch * 8); }
    const float* stg = WSP(float, WS_KV) + ((size_t)(b * NCH + n) * 4 + h) * 8192;
#pragma unroll
    for (int i = 0; i < 4; ++i) { const int i4 = F.tid + 512 * i, dv = i4 >> 4, dk4 = (i4 & 15) * 4;
        const f32x4 sv = *(const f32x4*)(stg + dv * 64 + dk4);
        u32x2 w; w.x = pk2(sv[0], sv[1]); w.y = pk2(sv[2], sv[3]);
        *(LAS u32x2*)(st_s + dv * 144 + dk4 * 2) = w; }
    float bv[8], b_mid, b_last;
    gla_gate_prefix(F, proj, t0, h, ga_s, tot_s, bv, b_mid, b_last);
#pragma unroll
    for (int i = 0; i < 8; ++i) { const int t = 8 * F.wave + i; const bf16* rp = proj + (size_t)(t0 + t) * INP + h * 64 + lane;
        const float qx = bf2f(rp[GQ_OFF]) * 0.125f, kx = bf2f(rp[GK_OFF]);
        *(LAS bf16*)(qd_s + t * 144 + lane * 2) = (bf16)f2bf(qx * __expf(bv[i] - b_mid));
        *(LAS bf16*)(kk_s + t * 144 + lane * 2) = (bf16)f2bf(kx * __expf(b_mid - bv[i]));
        *(LAS bf16*)(qe_s + t * 144 + lane * 2) = (bf16)f2bf(qx * __expf(bv[i])); }
    __syncthreads();
    const int ib = F.wave >> 1, dvh = F.wave & 1;
    bf16x8 qdf[2], qef[2];
#pragma unroll
    for (int ks = 0; ks < 2; ++ks) { qdf[ks] = *(LAS const bf16x8*)(qd_s + (16 * ib + fr) * 144 + (32 * ks + 8 * fq) * 2);
                                     qef[ks] = *(LAS const bf16x8*)(qe_s + (16 * ib + fr) * 144 + (32 * ks + 8 * fq) * 2); }
    f32x4 at[4];
#pragma unroll
    for (int jt = 0; jt < 4; ++jt) {
        LAS const unsigned char* kp = kk_s + (16 * jt + fr) * 144 + (8 * fq) * 2;
        const bf16x8 k0 = *(LAS const bf16x8*)kp, k1 = *(LAS const bf16x8*)(kp + 64);
        f32x4 z = (f32x4){0.f, 0.f, 0.f, 0.f}; z = MFMA(k0, qdf[0], z); z = MFMA(k1, qdf[1], z);
#pragma unroll
        for (int r = 0; r < 4; ++r) if (16 * jt + 4 * fq + r > 16 * ib + fr) z[r] = 0.f;
        at[jt] = z;
    }
    bf16x8 pf[2];
    pf[0] = pack8(at[0], at[1]); pf[1] = pack8(at[2], at[3]);
    f32x4 o[4];
#pragma unroll
    for (int c = 0; c < 4; ++c) {
        const int dvt = 4 * dvh + c; f32x4 z = (f32x4){0.f, 0.f, 0.f, 0.f};
#pragma unroll
        for (int ks = 0; ks < 2; ++ks) {
            const int rb = 32 * ks + 4 * fq + (fr >> 2);
            LAS const unsigned char* vp = v_s + rb * 272 + (16 * dvt + 4 * (lane & 3)) * 2;
            z = MFMA(pf[ks], cat8(trr(vp), trr(vp + 16 * 272)), z);
        }
#pragma unroll
        for (int ks = 0; ks < 2; ++ks) {
            const bf16x8 sf = *(LAS const bf16x8*)(st_s + (16 * dvt + fr) * 144 + (32 * ks + 8 * fq) * 2);
            z = MFMA(qef[ks], sf, z);
        }
        o[c] = z;
    }
    float ssq[4];
#pragma unroll
    for (int r = 0; r < 4; ++r) { float s = 0.f;
#pragma unroll
        for (int c = 0; c < 4; ++c) s += o[c][r] * o[c][r];
        s += __shfl_xor(s, 1); s += __shfl_xor(s, 2); s += __shfl_xor(s, 4); s += __shfl_xor(s, 8);
        ssq[r] = s; if (fr == 0) ssq_s[F.wave * 16 + 4 * fq + r] = s; }
    __syncthreads();
#pragma unroll
    for (int r = 0; r < 4; ++r) {
        const float tot = ssq[r] + ssq_s[(F.wave ^ 1) * 16 + 4 * fq + r];
        const float rinv = rsqrtf(tot * (1.f / 128.f) + EPS);
        const int t = t0 + 16 * ib + 4 * fq + r;
#pragma unroll
        for (int c = 0; c < 4; ++c) { const int dv = 16 * (4 * dvh + c) + fr;
            const float gg = bf2f(proj[(size_t)t * INP + GG_OFF + h * 128 + dv]);
            const float val = o[c][r] * rinv * F.g_gla_norm[dv] * (gg / (1.f + __expf(-gg)));
            mix[(size_t)t * D + 512 + h * 128 + dv] = (bf16)f2bf(val); }
    }
    __syncthreads();
}

__device__ __forceinline__ void p7_norm_router(const Frame& F) {
    const float* mod = WSP(float, WS_MOD); const bf16* y = WSP(bf16, WS_Y); float* x1 = WSP(float, WS_X1); unsigned char* h2 = WSP(unsigned char, WS_H);
    int* tok_e = WSP(int, WS_TOK_E); int* tok_lpos = WSP(int, WS_TOK_LPOS); float* tok_gate = WSP(float, WS_TOK_GATE);
    LAS float* wr_s = (LAS float*)F.lds; LAS float* lg_s = (LAS float*)(F.lds + SMALL_OFF); LAS int* cnt_s = (LAS int*)(F.lds + SMALL_OFF + 1024);
    const int lane = F.lane;
#pragma unroll
    for (int i = 0; i < 16; ++i) { const int idx = (F.tid + 512 * i) * 4, k = idx >> 5, e0 = idx & 31;
        *(LAS f32x4*)(wr_s + k * 32 + ((((e0 >> 2) ^ ((k >> 2) & 7))) << 2)) = *(const f32x4*)(F.w_router + idx); }
    if (F.tid < 32) cnt_s[F.tid] = 0;
    __syncthreads();
    const float NEG_INF = -__builtin_inff();
    for (int it = 0; it < 16; ++it) {
        const int m = F.bx * 128 + F.wave * 16 + it, b = m >> 14; const float* modb = mod + b * 6144;
        f32x4 xv[4], hv[4]; float ss = 0.f;
#pragma unroll
        for (int j = 0; j < 4; ++j) { hv[j] = unpack4(*(const u32x2*)(y + (size_t)m * D + 4 * lane + 256 * j)); ss += dot4(hv[j]); }
        const float ry = rsqrtf(wave_sum(ss) * (1.f / D) + EPS);
        float s2 = 0.f;
#pragma unroll
        for (int j = 0; j < 4; ++j) { const int idx = 4 * lane + 256 * j;
            const f32x4 g = *(const f32x4*)(F.g_post_mix + idx), gt = *(const f32x4*)(modb + 2048 + idx), xx = *(const f32x4*)(F.x + (size_t)m * D + idx);
            xv[j] = xx + gt * (hv[j] * ry * g); *(f32x4*)(x1 + (size_t)m * D + idx) = xv[j]; s2 += dot4(xv[j]); }
        const float rx = rsqrtf(wave_sum(s2) * (1.f / D) + EPS);
#pragma unroll
        for (int j = 0; j < 4; ++j) { const int idx = 4 * lane + 256 * j;
            const f32x4 g = *(const f32x4*)(F.g_pre_ffn + idx), sc = *(const f32x4*)(modb + 4096 + idx), sh = *(const f32x4*)(modb + 3072 + idx);
            hv[j] = xv[j] * rx * g * (sc + 1.f) + sh;
            *(unsigned*)(h2 + (size_t)m * D + idx) = pk4_fp8(hv[j][0] * H8_SCALE, hv[j][1] * H8_SCALE, hv[j][2] * H8_SCALE, hv[j][3] * H8_SCALE); }
        float acc[32];
#pragma unroll
        for (int e = 0; e < 32; ++e) acc[e] = 0.f;
#pragma unroll
        for (int j = 0; j < 4; ++j)
#pragma unroll
            for (int c = 0; c < 4; ++c) { const int k = 4 * lane + 256 * j + c; const float hvv = hv[j][c]; LAS const float* wp = wr_s + k * 32;
#pragma unroll
                for (int ch = 0; ch < 8; ++ch) { const f32x4 w = *(LAS const f32x4*)(wp + ((ch ^ (lane & 7)) << 2));
                    acc[4 * ch + 0] += hvv * w[0]; acc[4 * ch + 1] += hvv * w[1]; acc[4 * ch + 2] += hvv * w[2]; acc[4 * ch + 3] += hvv * w[3]; } }
#define RED_STEP(HALF, BIT) _Pragma("unroll") for (int i2 = 0; i2 < HALF; ++i2) { const bool hi = (lane & BIT) != 0; \
            const float keep = hi ? acc[i2 + HALF] : acc[i2]; const float send = hi ? acc[i2] : acc[i2 + HALF]; acc[i2] = keep + __shfl_xor(send, BIT); }
        RED_STEP(16, 32) RED_STEP(8, 16) RED_STEP(4, 8) RED_STEP(2, 4) RED_STEP(1, 2)
#undef RED_STEP
        acc[0] += __shfl_xor(acc[0], 1);
        const int my_exp = lane >> 1;
        if ((lane & 1) == 0) lg_s[F.wave * 32 + my_exp] = acc[0] + F.b_router[my_exp];
        float v[32];
#pragma unroll
        for (int ch = 0; ch < 8; ++ch) { const f32x4 w = *(LAS const f32x4*)(lg_s + F.wave * 32 + 4 * ch); v[4 * ch] = w[0]; v[4 * ch + 1] = w[1]; v[4 * ch + 2] = w[2]; v[4 * ch + 3] = w[3]; }
        int se[4]; float sv[4];
#pragma unroll
        for (int r = 0; r < 4; ++r) { float best = v[0]; int bi = 0;
#pragma unroll
            for (int e = 1; e < 32; ++e) if (v[e] > best) { best = v[e]; bi = e; }
            se[r] = bi; sv[r] = best;
#pragma unroll
            for (int e = 0; e < 32; ++e) v[e] = (e == bi) ? NEG_INF : v[e]; }
        const float p1 = __expf(sv[1] - sv[0]), p2 = __expf(sv[2] - sv[0]), p3 = __expf(sv[3] - sv[0]);
        const float rs = 1.f / (1.f + p1 + p2 + p3);
        if (lane < 4) {
            const int my_e = lane == 0 ? se[0] : lane == 1 ? se[1] : lane == 2 ? se[2] : se[3];
            const float my_g = (lane == 0 ? 1.f : lane == 1 ? p1 : lane == 2 ? p2 : p3) * rs;
            const int lpos = __hip_atomic_fetch_add(cnt_s + my_e, 1, __ATOMIC_RELAXED, __HIP_MEMORY_SCOPE_WORKGROUP);
            tok_e[m * 4 + lane] = my_e; tok_lpos[m * 4 + lane] = lpos; tok_gate[m * 4 + lane] = my_g;
        }
    }
    __syncthreads();
    if (F.tid < 32) WSP(int, WS_BLK_CNT)[F.bx * 32 + F.tid] = cnt_s[F.tid];
}

__device__ __forceinline__ void p8_slots(const Frame& F) {
    const int* blk_cnt = WSP(int, WS_BLK_CNT);
    LAS int* tot_p = (LAS int*)F.lds; LAS int* pre_p = tot_p + 512; LAS int* total_s = pre_p + 512; LAS int* pre_s = total_s + 32; LAS int* off_s = pre_s + 32;
    { const int e = F.tid & 31, part = F.tid >> 5; int s = 0, sp = 0;
        for (int bb = part * 16; bb < part * 16 + 16; ++bb) { const int c = blk_cnt[bb * 32 + e]; s += c; sp += (bb < F.bx) ? c : 0; }
        tot_p[part * 32 + e] = s; pre_p[part * 32 + e] = sp; }
    __syncthreads();
    if (F.tid < 32) { int s = 0, sp = 0;
        for (int p = 0; p < 16; ++p) { s += tot_p[p * 32 + F.tid]; sp += pre_p[p * 32 + F.tid]; }
        total_s[F.tid] = s; pre_s[F.tid] = sp; }
    __syncthreads();
    if (F.tid == 0) { int off = 0; for (int e = 0; e < 32; ++e) { off_s[e] = off; off += (total_s[e] + 255) & ~255; } off_s[32] = off; }
    __syncthreads();
    int* slot_assign = WSP(int, WS_SLOT_ASSIGN); float* slot_gate = WSP(float, WS_SLOT_GATE);
    { const int t = F.bx * 128 + (F.tid >> 2), k = F.tid & 3;
        const int e = WSP(int, WS_TOK_E)[t * 4 + k];
        const int slot = off_s[e] + pre_s[e] + WSP(int, WS_TOK_LPOS)[t * 4 + k];
        slot_assign[slot] = t * 4 + k; slot_gate[slot] = WSP(float, WS_TOK_GATE)[t * 4 + k]; }
    if (F.bx < 32) { const int e = F.bx; for (int s = off_s[e] + total_s[e] + F.tid; s < off_s[e + 1]; s += NTHREADS) { slot_assign[s] = -1; slot_gate[s] = 0.f; } }
    if (F.bx == 0) {
        if (F.tid <= 32) WSP(int, WS_MOE_OFF)[F.tid] = off_s[F.tid];
        const int ntile = off_s[32] >> 8;
        for (int rt = F.tid; rt < ntile; rt += NTHREADS) { int e = 0;
            for (int q = 1; q < 32; ++q) e = (off_s[q] <= rt * 256) ? q : e;
            WSP(int, WS_TILE_E)[rt] = e; }
    }
    { const unsigned char* h2 = WSP(unsigned char, WS_H); unsigned char* xs = WSP(unsigned char, WS_XS);
#pragma unroll 4
        for (int i = 0; i < 64; ++i) { const int a = F.wave * 64 + i, t = F.bx * 128 + (a >> 2), k = a & 3;
            const int e = WSP(int, WS_TOK_E)[t * 4 + k];
            const int slot = off_s[e] + pre_s[e] + WSP(int, WS_TOK_LPOS)[t * 4 + k];
            *(u32x4*)(xs + (size_t)slot * 1024 + F.lane * 16) = *(const u32x4*)(h2 + (size_t)t * 1024 + F.lane * 16); } }
}

__device__ __forceinline__ void p11_combine(const Frame& F) {
    const float* mod = WSP(float, WS_MOD); const bf16* ys = WSP(bf16, WS_YS); const float* x1 = WSP(float, WS_X1);
    const int gw = F.bx * NWAVES + F.wave, NGW = F.G * NWAVES, lane = F.lane;
    for (int m = gw; m < T; m += NGW) {
        const int b = m >> 14; const float* modb = mod + b * 6144;
        f32x4 yv[4]; float ss = 0.f;
#pragma unroll
        for (int j = 0; j < 4; ++j) { f32x4 a = (f32x4){0.f, 0.f, 0.f, 0.f};
#pragma unroll
            for (int k4 = 0; k4 < 4; ++k4) a += unpack4(*(const u32x2*)(ys + ((size_t)m * 4 + k4) * D + 4 * lane + 256 * j));
            yv[j] = a; ss += dot4(a); }
        const float ry = rsqrtf(wave_sum(ss) * (1.f / D) + EPS);
#pragma unroll
        for (int j = 0; j < 4; ++j) { const int idx = 4 * lane + 256 * j;
            const f32x4 g = *(const f32x4*)(F.g_post_ffn + idx), gt = *(const f32x4*)(modb + 5120 + idx), xx = *(const f32x4*)(x1 + (size_t)m * D + idx);
            *(f32x4*)(F.out + (size_t)m * D + idx) = xx + gt * (yv[j] * ry * g); }
    }
}

constexpr int NPHASE = 12;
struct Args { const float* in[20]; float* out; unsigned char* ws; int ph_lo, ph_hi; };
__global__ void __launch_bounds__(NTHREADS, 2) fwd(Args args) {
    extern __shared__ __attribute__((aligned(16))) unsigned char lds[];
    Frame F;
    F.lds = (LAS unsigned char*)lds;
    F.tid = threadIdx.x; F.lane = F.tid & 63; F.wave = __builtin_amdgcn_readfirstlane(F.tid >> 6); F.bx = blockIdx.x; F.G = gridDim.x;
    F.x = args.in[0]; F.c = args.in[1]; F.w_ada = args.in[2]; F.b_ada = args.in[3]; F.g_pre_mix = args.in[4]; F.g_post_mix = args.in[5];
    F.g_pre_ffn = args.in[6]; F.g_post_ffn = args.in[7]; F.w_in = args.in[8]; F.w_gate_up = args.in[9]; F.b_gate = args.in[10]; F.g_gla_norm = args.in[11];
    F.sinks = args.in[12]; F.w_out = args.in[13]; F.w_router = args.in[14]; F.b_router = args.in[15]; F.w_mlp1 = args.in[16]; F.b_mlp1 = args.in[17];
    F.w_mlp2 = args.in[18]; F.b_mlp2 = args.in[19]; F.out = args.out; F.ws = args.ws;
    volatile LAS unsigned* MISC = (volatile LAS unsigned*)(F.lds + MISC_OFF);
    if (F.tid < 32) MISC[F.tid] = 0u;
    __syncthreads();
    const int lo = args.ph_lo, hi = args.ph_hi;
    XcdBarrier bar; bar.bar = (unsigned*)(F.ws + WS_CTL) + CW_BAR; bar.x = 0; bar.st = nullptr;
    if (hi - lo > 1) bar = xcd_barrier_post((unsigned*)(F.ws + WS_CTL) + CW_BAR, MISC + 8);
#define IN(k) (lo <= (k) && (k) < hi)
#if DUPMASK
#define REP(k) for (int rep_ = 0; rep_ < 1 + ((DUPMASK >> (k)) & 1); ++rep_, __syncthreads())
#else
#define REP(k)
#endif
#define SEAM(k) do { if (IN(k) && IN((k) + 1)) xcd_barrier(bar); } while (0)

    if (IN(0)) REP(0) { p0_prologue(F); } SEAM(0);
    if (IN(1)) REP(1) { p1_norm(F); } SEAM(1);
    if (IN(2)) REP(2) { pg8::StaticOrder So; So.init(T / 256, INP / 256, F.G, F.bx);
                 pg8::gemm_phase<false, 0, 0, 0>(F.lds, D, So, pg8::ABDense{WSP(bf16, WS_H), WSP(bf16, WS_WIN), D}, pg8::EpiStoreT{WSP(bf16, WS_PROJ), INP}); } SEAM(2);
    if (IN(3)) REP(3) { for (int u = F.bx; u < 512; u += F.G) attn_unit(F, u);
                 for (int u = F.bx; u < 2048; u += F.G) gla_kv_unit(F, u); } SEAM(3);
    if (IN(4)) REP(4) { gla_scan(F); } SEAM(4);
    if (IN(5)) REP(5) { for (int u = F.bx; u < 2048; u += F.G) gla_out_unit(F, u); } SEAM(5);
    if (IN(6)) REP(6) { pg8::StaticOrder So; So.init(T / 256, D / 256, F.G, F.bx);
                 pg8::gemm_phase<false, 0, 0, 0>(F.lds, D, So, pg8::ABDense{WSP(bf16, WS_MIX), WSP(bf16, WS_WOUT), D}, pg8::EpiStoreT{WSP(bf16, WS_Y), D}); } SEAM(6);
    if (IN(7)) REP(7) { p7_norm_router(F); } SEAM(7);
    if (IN(8)) REP(8) { p8_slots(F); } SEAM(8);
    if (IN(9)) REP(9) { const int nM = WSP(int, WS_MOE_OFF)[32] >> 8; pg8::StaticOrder So; So.init(nM, 2048 / 256, F.G, F.bx);
                 pg8::gemm_phase<false, 1, W8_E8M0, H8_E8M0>(F.lds, 512, So, pg8::ABMoe1{WSP(unsigned char, WS_XS), WSP(unsigned char, WS_W1T), WSP(int, WS_TILE_E)},
                                       pg8::EpiSwigluT{WSP(unsigned char, WS_A), F.b_mlp1, WSP(int, WS_TILE_E)}); } SEAM(9);
    if (IN(10)) REP(10) { const int nM = WSP(int, WS_MOE_OFF)[32] >> 8; pg8::StaticOrder So; So.init(nM, D / 256, F.G, F.bx);
                  pg8::gemm_phase<false, 1, W8_E8M0, A8_E8M0>(F.lds, 512, So, pg8::ABMoe2{WSP(unsigned char, WS_A), WSP(unsigned char, WS_W2T), WSP(int, WS_TILE_E)},
                                         pg8::EpiMoe2T{WSP(bf16, WS_YS), F.b_mlp2, WSP(int, WS_TILE_E), WSP(int, WS_SLOT_ASSIGN), WSP(float, WS_SLOT_GATE)}); } SEAM(10);
    if (IN(11)) REP(11) { p11_combine(F); }
#undef IN
#undef SEAM
}

extern "C" void kernel_launch(void* const* d_in, const int* in_sizes, int n_in, void* d_out, int out_size, void* d_ws, size_t ws_size, hipStream_t stream) {
    static int ready = 0;
    if (ready == 0) {
        if (n_in != 20 || out_size != T * D || ws_size < WS_END) { fprintf(stderr, "kernel_launch: unexpected problem (n_in %d, out %d, ws %zu)\n", n_in, out_size, ws_size); ready = -1; return; }
        if (hipFuncSetAttribute((const void*)fwd, hipFuncAttributeMaxDynamicSharedMemorySize, LDS_BYTES) != hipSuccess) { fprintf(stderr, "kernel_launch: hipFuncSetAttribute failed\n"); ready = -1; return; }
        int per_cu = 0;
        if (hipOccupancyMaxActiveBlocksPerMultiprocessor(&per_cu, (const void*)fwd, NTHREADS, LDS_BYTES) != hipSuccess || per_cu < 1) fprintf(stderr, "kernel_launch: occupancy query says %d\n", per_cu);
        (void)hipGetLastError();
        ready = 1;
    }
    if (ready < 0) return;
    (void)hipMemsetAsync((char*)d_ws + WS_CTL, 0, CTL_ZERO_BYTES, stream);
    Args a{};
    for (int i = 0; i < 20; ++i) a.in[i] = (const float*)d_in[i];
    a.out = (float*)d_out; a.ws = (unsigned char*)d_ws;
#if MK_ONE_LAUNCH
    a.ph_lo = 0; a.ph_hi = NPHASE;
    hipLaunchKernelGGL(fwd, dim3(GRID), dim3(NTHREADS), LDS_BYTES, stream, a);
#else
    for (int p = 0; p < NPHASE; ++p) { a.ph_lo = p; a.ph_hi = p + 1; hipLaunchKernelGGL(fwd, dim3(GRID), dim3(NTHREADS), LDS_BYTES, stream, a); }
#endif
}
```

```cpp
#include <hip/hip_runtime.h>
#include <cstdio>
#include <cstdint>

#ifndef MK_ONE_LAUNCH
#define MK_ONE_LAUNCH 1
#endif

#ifndef DUPMASK
#define DUPMASK 0
#endif
#define LAS __attribute__((address_space(3)))
typedef unsigned short bf16;
typedef short bf16x8 __attribute__((ext_vector_type(8)));
typedef short s16x4 __attribute__((ext_vector_type(4)));
typedef float f32x4 __attribute__((ext_vector_type(4)));
typedef unsigned u32x4 __attribute__((ext_vector_type(4)));
typedef unsigned u32x2 __attribute__((ext_vector_type(2)));

constexpr int D = 1024, NB = 2, S = 16384, T = NB * S;
constexpr int INW = 2320, INP = 2560;
constexpr int AQ_OFF = 0, AK_OFF = 512, AV_OFF = 640, GQ_OFF = 768, GK_OFF = 1024, GV_OFF = 1280, GG_OFF = 1792, GA_OFF = 2304;
constexpr int NCH = 256;
constexpr int NE = 32, FF = 1024;
constexpr int NSLOT_MAX = T * 4 + NE * 256;
constexpr float EPS = 1e-6f;
constexpr int NWAVES = 8, NTHREADS = 512, GRID = 256;

constexpr size_t MiB = 1u << 20;
constexpr size_t WS_CTL = 0, CTL_ZERO_BYTES = 1 * MiB;
constexpr size_t WS_MOD = 1 * MiB;
constexpr size_t WS_DECAY = 2 * MiB;
constexpr size_t WS_ROUTE = 3 * MiB;
constexpr size_t WS_TOK_E = WS_ROUTE, WS_TOK_LPOS = WS_ROUTE + 512 * 1024, WS_TOK_GATE = WS_ROUTE + 1024 * 1024;
constexpr size_t WS_BLK_CNT = WS_ROUTE + 1536 * 1024, WS_MOE_OFF = WS_BLK_CNT + 32 * 1024, WS_TILE_E = WS_MOE_OFF + 4096;
constexpr size_t WS_SLOT_ASSIGN = WS_ROUTE + 2 * MiB, WS_SLOT_GATE = WS_ROUTE + 3 * MiB;
constexpr size_t WS_WIN = 8 * MiB, WS_WOUT = 13 * MiB, WS_W2T = 16 * MiB, WS_W1T = 80 * MiB;
constexpr size_t WS_H = 208 * MiB, WS_KV = 272 * MiB, WS_YS = 80 * MiB;
constexpr size_t WS_X1 = 336 * MiB, WS_PROJ = 464 * MiB, WS_MIX = 624 * MiB, WS_Y = 688 * MiB, WS_A = 464 * MiB;
constexpr size_t WS_XS = 608 * MiB;
constexpr size_t WS_END = 752 * MiB;
constexpr int CW_BAR = 4096;

constexpr int LDS_BYTES = 147456, SMALL_OFF = 132096, MISC_OFF = 131072 + 320;

__device__ __forceinline__ float bf2f(unsigned v) { return __uint_as_float(v << 16); }
__device__ __forceinline__ unsigned f2bf(float f) { unsigned u = __float_as_uint(f); return (u + 0x7fffu + ((u >> 16) & 1u)) >> 16; }
__device__ __forceinline__ unsigned pk2(float lo, float hi) { return f2bf(lo) | (f2bf(hi) << 16); }
__device__ __forceinline__ float wave_sum(float v) {
#pragma unroll
    for (int o = 1; o < 64; o <<= 1) v += __shfl_xor(v, o);
    return v;
}
__device__ __forceinline__ f32x4 unpack4(u32x2 r) { return (f32x4){bf2f(r.x & 0xffffu), bf2f(r.x >> 16), bf2f(r.y & 0xffffu), bf2f(r.y >> 16)}; }
__device__ __forceinline__ float dot4(f32x4 a) { return (a[0] * a[0] + a[1] * a[1]) + (a[2] * a[2] + a[3] * a[3]); }
typedef short v4i16_t __attribute__((ext_vector_type(4)));
__device__ __forceinline__ s16x4 trr(LAS const unsigned char* p) { return __builtin_bit_cast(s16x4, __builtin_amdgcn_ds_read_tr16_b64_v4i16((LAS v4i16_t*)p)); }
__device__ __forceinline__ bf16x8 cat8(s16x4 lo, s16x4 hi) { return __builtin_shufflevector(lo, hi, 0, 1, 2, 3, 4, 5, 6, 7); }
__device__ __forceinline__ bf16x8 pack8(f32x4 a, f32x4 b) { u32x4 w; w.x = pk2(a[0], a[1]); w.y = pk2(a[2], a[3]); w.z = pk2(b[0], b[1]); w.w = pk2(b[2], b[3]); return __builtin_bit_cast(bf16x8, w); }
#define MFMA(a, b, c) __builtin_amdgcn_mfma_f32_16x16x32_bf16((a), (b), (c), 0, 0, 0)
typedef int i32x4 __attribute__((ext_vector_type(4)));
typedef int i32x8 __attribute__((ext_vector_type(8)));
__device__ __forceinline__ float clamp8(float v) { return fminf(fmaxf(v, -448.f), 448.f); }
__device__ __forceinline__ unsigned pk4_fp8(float a, float b, float c, float d) {
    int w = 0; w = __builtin_amdgcn_cvt_pk_fp8_f32(clamp8(a), clamp8(b), w, false); w = __builtin_amdgcn_cvt_pk_fp8_f32(clamp8(c), clamp8(d), w, true); return (unsigned)w; }
constexpr float W8_SCALE = 64.f, H8_SCALE = 16.f, A8_SCALE = 4.f;
constexpr int W8_E8M0 = 0x79797979  , H8_E8M0 = 0x7b7b7b7b  , A8_E8M0 = 0x7d7d7d7d  ;

#define XB_TMO      128
#define XB_XCNT(j)  (256  + 64 * (j))
#define XB_XSUB(j)  (1280 + 64 * (j))
#define XB_XGEN(j)  (2304 + 64 * (j))
#define XB_TOP      3328
#define XB_TOPGEN   3392
#define XCD_BAR_WORDS 3456
#define XB_SPIN_CAP (1u << 18)
__device__ __forceinline__ unsigned xb_ld(unsigned* p)              { return __hip_atomic_load(p, __ATOMIC_RELAXED, __HIP_MEMORY_SCOPE_AGENT); }
__device__ __forceinline__ unsigned xb_add(unsigned* p, unsigned v) { return __hip_atomic_fetch_add(p, v, __ATOMIC_RELAXED, __HIP_MEMORY_SCOPE_AGENT); }
__device__ __forceinline__ unsigned xb_xcc_id() { return (unsigned)__builtin_amdgcn_s_getreg((3 << 11) | 20) & 0xFu; }
#define XB_SPIN(cond, bar) do { unsigned _sp = 0; while (cond) { __builtin_amdgcn_s_sleep(1); \
    if ((++_sp & 255u) == 0u) { if (xb_ld(&(bar)[XB_TMO])) break; if (_sp > XB_SPIN_CAP) { atomicAdd(&(bar)[XB_TMO], 1u); break; } } } } while (0)
struct XcdBarrier { unsigned* bar; unsigned x; volatile LAS unsigned* st; };
__device__ __forceinline__ XcdBarrier xcd_barrier_post(unsigned* bar, volatile LAS unsigned* st) {
    XcdBarrier b; b.bar = bar; b.x = xb_xcc_id(); b.st = st;
    if (threadIdx.x == 0) (void)xb_add(&bar[XB_XCNT(b.x)], 1u);
    return b;
}
__device__ __forceinline__ void xcd_barrier_complete(unsigned* bar, unsigned x, unsigned& nloc, unsigned& nx) {
    const unsigned G = gridDim.x * gridDim.y * gridDim.z;
    unsigned sum, cnt, mine, sp = 0u;
    for (;;) {
        sum = 0u; cnt = 0u; mine = 0u;
#pragma unroll
        for (unsigned j = 0; j < 16; ++j) { const unsigned c = xb_ld(&bar[XB_XCNT(j)]); sum += c; cnt += (c > 0u) ? 1u : 0u; mine = (j == x) ? c : mine; }
        if (sum == G) break;
        __builtin_amdgcn_s_sleep(1);
        if ((++sp & 255u) == 0u) { if (xb_ld(&bar[XB_TMO])) break; if (sp > XB_SPIN_CAP) { atomicAdd(&bar[XB_TMO], 1u); break; } }
    }
    nloc = mine > 0u ? mine : 1u; nx = cnt > 0u ? cnt : 1u;
}
__device__ __forceinline__ void xcd_barrier(const XcdBarrier& b) {
    asm volatile("s_waitcnt vmcnt(0)" ::: "memory");
    __syncthreads();
    if (threadIdx.x == 0) {
        unsigned* bar = b.bar;
        __builtin_amdgcn_s_waitcnt(0);
        unsigned nloc = b.st[0], nx = b.st[1];
        if (nloc == 0u) { xcd_barrier_complete(bar, b.x, nloc, nx); b.st[0] = nloc; b.st[1] = nx; }
        const unsigned old = xb_add(&bar[XB_XSUB(b.x)], 1u);
        const unsigned gen = old / nloc;
        if (old + 1u == (gen + 1u) * nloc) {
            __builtin_amdgcn_fence(__ATOMIC_RELEASE, "agent");
            asm volatile("s_waitcnt vmcnt(0)" ::: "memory");
            const unsigned og = xb_add(&bar[XB_TOP], 1u);
            const unsigned tg = og / nx;
            if (og + 1u == (tg + 1u) * nx) xb_add(&bar[XB_TOPGEN], 1u);
            else XB_SPIN(xb_ld(&bar[XB_TOPGEN]) == tg, bar);
            __builtin_amdgcn_fence(__ATOMIC_ACQUIRE, "agent");
            xb_add(&bar[XB_XGEN(b.x)], 1u);
            asm volatile("s_waitcnt vmcnt(0)" ::: "memory");
        } else {
            XB_SPIN(xb_ld(&bar[XB_XGEN(b.x)]) == gen, bar);
            __builtin_amdgcn_fence(__ATOMIC_ACQUIRE, "agent");
            asm volatile("s_waitcnt vmcnt(0)" ::: "memory");
        }
    }
    __syncthreads();
}

struct Frame {
    LAS unsigned char* lds;
    int tid, lane, wave, bx, G;
    const float *x, *c, *w_ada, *b_ada, *g_pre_mix, *g_post_mix, *g_pre_ffn, *g_post_ffn, *w_in, *w_gate_up, *b_gate, *g_gla_norm, *sinks, *w_out,
                *w_router, *b_router, *w_mlp1, *b_mlp1, *w_mlp2, *b_mlp2;
    float* out;
    unsigned char* ws;
};
#define WSP(type, off) ((type*)(F.ws + (off)))

__device__ __forceinline__ void tr_item(const float* W, int N, bf16* WT, int nblk, LAS float* scr, int item, int lane) {
    const int kb = item / nblk, nb = item % nblk, k0 = 64 * kb, n0 = 32 * nb;
    const int n = n0 + (lane & 31);
#pragma unroll 8
    for (int i = 0; i < 32; ++i) { const int kk = 2 * i + (lane >> 5); scr[kk * 33 + (lane & 31)] = (n < N) ? W[(size_t)(k0 + kk) * N + n] : 0.f; }
    asm volatile("s_waitcnt lgkmcnt(0)" ::: "memory");
    const int c = lane & 7;
#pragma unroll
    for (int j = 0; j < 4; ++j) { const int nn = (lane >> 3) + 8 * j; const LAS float* s = scr + (8 * c) * 33 + nn;
        u32x4 o; o.x = pk2(s[0 * 33], s[1 * 33]); o.y = pk2(s[2 * 33], s[3 * 33]); o.z = pk2(s[4 * 33], s[5 * 33]); o.w = pk2(s[6 * 33], s[7 * 33]);
        *(u32x4*)(WT + (size_t)(n0 + nn) * 1024 + k0 + 8 * c) = o; }
    asm volatile("s_waitcnt lgkmcnt(0)" ::: "memory");
}
template <bool DEINT>
__device__ __forceinline__ void tr_item8(const float* W, int N, unsigned char* WT, int nblk, LAS float* scr, int item, int lane) {
    const int kb = item / nblk, nb = item % nblk, k0 = 64 * kb, n0 = 32 * nb;
#pragma unroll 8
    for (int i = 0; i < 32; ++i) { const int kk = 2 * i + (lane >> 5); scr[kk * 33 + (lane & 31)] = W[(size_t)(k0 + kk) * N + n0 + (lane & 31)]; }
    asm volatile("s_waitcnt lgkmcnt(0)" ::: "memory");
    const int c = lane & 7;
#pragma unroll
    for (int j = 0; j < 4; ++j) { const int nn = (lane >> 3) + 8 * j; const LAS float* s = scr + (8 * c) * 33 + nn;
        u32x2 o; o.x = pk4_fp8(s[0 * 33] * W8_SCALE, s[1 * 33] * W8_SCALE, s[2 * 33] * W8_SCALE, s[3 * 33] * W8_SCALE);
                 o.y = pk4_fp8(s[4 * 33] * W8_SCALE, s[5 * 33] * W8_SCALE, s[6 * 33] * W8_SCALE, s[7 * 33] * W8_SCALE);
        const int n = n0 + nn; int row = n;
        if (DEINT) { const int jj = n >> 1; row = 256 * (jj >> 7) + 128 * (n & 1) + (jj & 127); }
        *(u32x2*)(WT + (size_t)row * 1024 + k0 + 8 * c) = o; }
    asm volatile("s_waitcnt lgkmcnt(0)" ::: "memory");
}
__device__ __forceinline__ void p0_prologue(const Frame& F) {
    float* mod = WSP(float, WS_MOD);
    if (F.bx < 192) {
        LAS float* red = (LAS float*)(F.lds + 98304);
        const int cl = F.tid & 31, ks = F.tid >> 5, col = F.bx * 32 + cl;
        float a0 = 0.f, a1 = 0.f;
#pragma unroll 8
        for (int k = ks * 64; k < ks * 64 + 64; ++k) {
            const float w = F.w_ada[(size_t)k * 6144 + col];
            const float c0 = F.c[k], c1 = F.c[1024 + k];
            a0 += c0 / (1.f + __expf(-c0)) * w; a1 += c1 / (1.f + __expf(-c1)) * w;
        }
        red[(0 * 16 + ks) * 32 + cl] = a0; red[(1 * 16 + ks) * 32 + cl] = a1;
        __syncthreads();
        if (F.tid < 64) { const int b = F.tid >> 5; float s = 0.f;
#pragma unroll
            for (int i = 0; i < 16; ++i) s += red[(b * 16 + i) * 32 + cl];
            mod[b * 6144 + col] = s + F.b_ada[col]; }
        __syncthreads();
    }
    LAS float* scr = (LAS float*)(F.lds + F.wave * 8704);
    const int gw = F.bx * NWAVES + F.wave, NGW = F.G * NWAVES;
    constexpr int I_IN = 16 * 80, I_OUT = 16 * 32, I_1 = 16 * 64, I_2 = 16 * 32;
    constexpr int NITEMS = I_IN + I_OUT + NE * I_1 + NE * I_2;
    for (int it = gw; it < NITEMS; it += NGW) {
        int r = it;
        if (r < I_IN) { tr_item(F.w_in, INW, WSP(bf16, WS_WIN), 80, scr, r, F.lane); continue; } r -= I_IN;
        if (r < I_OUT) { tr_item(F.w_out, 1024, WSP(bf16, WS_WOUT), 32, scr, r, F.lane); continue; } r -= I_OUT;
        if (r < NE * I_1) { const int e = r / I_1; tr_item8<true>(F.w_mlp1 + (size_t)e * 1024 * 2048, 2048, WSP(unsigned char, WS_W1T) + (size_t)e * 2048 * 1024, 64, scr, r % I_1, F.lane); continue; } r -= NE * I_1;
        { const int e = r / I_2; tr_item8<false>(F.w_mlp2 + (size_t)e * 1024 * 1024, 1024, WSP(unsigned char, WS_W2T) + (size_t)e * 1024 * 1024, 32, scr, r % I_2, F.lane); }
    }
}

__device__ __forceinline__ void p1_norm(const Frame& F) {
    const float* mod = WSP(float, WS_MOD); bf16* h = WSP(bf16, WS_H);
    const int gw = F.bx * NWAVES + F.wave, NGW = F.G * NWAVES;
    f32x4 v[4], nv[4];
#pragma unroll
    for (int j = 0; j < 4; ++j) v[j] = *(const f32x4*)(F.x + (size_t)gw * D + 4 * F.lane + 256 * j);
    for (int m = gw; m < T; m += NGW) {
        const int b = m >> 14; const float* modb = mod + b * 6144;
        const int mn = (m + NGW < T) ? m + NGW : m;
        f32x4 g[4], sc[4], sh[4];
#pragma unroll
        for (int j = 0; j < 4; ++j) { const int idx = 4 * F.lane + 256 * j;
            nv[j] = *(const f32x4*)(F.x + (size_t)mn * D + idx);
            g[j] = *(const f32x4*)(F.g_pre_mix + idx); sc[j] = *(const f32x4*)(modb + 1024 + idx); sh[j] = *(const f32x4*)(modb + idx); }
        float ss = 0.f;
#pragma unroll
        for (int j = 0; j < 4; ++j) ss += dot4(v[j]);
        const float r = rsqrtf(wave_sum(ss) * (1.f / D) + EPS);
#pragma unroll
        for (int j = 0; j < 4; ++j) { const int idx = 4 * F.lane + 256 * j;
            const f32x4 hv = v[j] * r * g[j] * (sc[j] + 1.f) + sh[j];
            u32x2 o; o.x = pk2(hv[0], hv[1]); o.y = pk2(hv[2], hv[3]);
            *(u32x2*)(h + (size_t)m * D + idx) = o; v[j] = nv[j]; }
    }
}

template <class Epi, class RowMap, class BSel>
__device__ __forceinline__ void simple_gemm(const Frame& F, const bf16* A, int lda, int M, int N, int K, const RowMap& rm, const BSel& bs, const Epi& E) {
    const int fr = F.lane & 15, fq = F.lane >> 4;
    const int ncg = N / 512, nbt = (M / 64) * ncg;
    for (int bt = F.bx; bt < nbt; bt += F.G) {
        const int mt = bt / ncg, cg = bt % ncg, m0 = mt * 64, n0 = cg * 512 + F.wave * 64;
        const bf16* Bt = bs(m0);
        const bf16* ap[4]; const bf16* bp[4];
#pragma unroll
        for (int i = 0; i < 4; ++i) { ap[i] = A + (size_t)rm(m0 + 16 * i + fr) * lda + 8 * fq; bp[i] = Bt + (size_t)(n0 + 16 * i + fr) * K + 8 * fq; }
        f32x4 acc[4][4];
#pragma unroll
        for (int i = 0; i < 4; ++i)
#pragma unroll
            for (int j = 0; j < 4; ++j) acc[i][j] = (f32x4){0.f, 0.f, 0.f, 0.f};
#pragma unroll 2
        for (int k0 = 0; k0 < K; k0 += 32) {
            bf16x8 a[4], b[4];
#pragma unroll
            for (int i = 0; i < 4; ++i) { a[i] = *(const bf16x8*)(ap[i] + k0); b[i] = *(const bf16x8*)(bp[i] + k0); }
#pragma unroll
            for (int i = 0; i < 4; ++i)
#pragma unroll
                for (int j = 0; j < 4; ++j) acc[i][j] = MFMA(b[j], a[i], acc[i][j]);
        }
#pragma unroll
        for (int i = 0; i < 4; ++i)
#pragma unroll
            for (int j = 0; j < 4; ++j) E(m0 + 16 * i + fr, n0 + 16 * j + 4 * fq, acc[i][j]);
    }
}
struct RowId { __device__ __forceinline__ int operator()(int m) const { return m; } };
struct RowGather { const int* slot_assign; __device__ __forceinline__ int operator()(int m) const { const int a = slot_assign[m]; return a < 0 ? 0 : (a >> 2); } };
struct BFixed { const bf16* Bt; __device__ __forceinline__ const bf16* operator()(int) const { return Bt; } };
struct BExpert { const bf16* Bt; const int* tile_e; size_t stride; __device__ __forceinline__ const bf16* operator()(int m0) const { return Bt + (size_t)tile_e[m0 >> 8] * stride; } };
struct EpiStore { bf16* O; int ldo;
    __device__ __forceinline__ void operator()(int m, int n, f32x4 v) const { u32x2 w; w.x = pk2(v[0], v[1]); w.y = pk2(v[2], v[3]); *(u32x2*)(O + (size_t)m * ldo + n) = w; } };
__device__ __forceinline__ float swiglu(float g, float l) {
    const float xg = fminf(g, 7.f), xl = fminf(fmaxf(l, -7.f), 7.f);
    return xg / (1.f + __expf(-1.702f * xg)) * (xl + 1.f);
}
struct EpiSwiglu { bf16* Aout; const float* b1; const int* tile_e;
    __device__ __forceinline__ void operator()(int m, int n, f32x4 v) const {
        const int e = tile_e[m >> 8]; const f32x4 bb = *(const f32x4*)(b1 + (size_t)e * 2048 + n);
        const float a0 = swiglu(v[0] + bb[0], v[1] + bb[1]), a1 = swiglu(v[2] + bb[2], v[3] + bb[3]);
        *(unsigned*)(Aout + (size_t)m * FF + (n >> 1)) = pk2(a0, a1); } };
struct EpiMoe2 { bf16* ys; const float* b2; const int* tile_e; const int* slot_assign; const float* slot_gate;
    __device__ __forceinline__ void operator()(int m, int n, f32x4 v) const {
        const int asg = slot_assign[m]; if (asg < 0) return;
        const int e = tile_e[m >> 8]; const f32x4 bb = *(const f32x4*)(b2 + (size_t)e * D + n); const float g = slot_gate[m];
        u32x2 w; w.x = pk2((v[0] + bb[0]) * g, (v[1] + bb[1]) * g); w.y = pk2((v[2] + bb[2]) * g, (v[3] + bb[3]) * g);
        *(u32x2*)(ys + (size_t)asg * D + n) = w; } };

namespace pg8 {
constexpr int BM = 256, BK = 64, HALF = 128, HTB = HALF * BK * 2, NXCD = 8, WGM = 8;
__device__ __forceinline__ int lds_byte(int r, int c) { const int st = (r >> 4) * 2 + (c >> 5), rr = r & 15, cc = c & 31, ob = rr * 64 + cc * 2; return st * 1024 + (ob ^ (((ob >> 9) & 1) << 5)); }
__device__ __forceinline__ void stage_rc(int b, int& R, int& C) { const int st = b / 1024, sb = b % 1024, swz = sb ^ (((sb >> 9) & 1) << 5); R = (st >> 1) * 16 + swz / 64; C = (st & 1) * 32 + (swz % 64) / 2; }
__device__ __forceinline__ int perm32(int rho) { const int n = rho >> 4, i = rho & 15; return 8 * (i >> 2) + 4 * n + (i & 3); }
struct Unit { int pm, pn; };
struct StaticOrder {
    int nM, nN, nwg, G, c;
    __device__ __forceinline__ void init(int nM_, int nN_, int G_, int c_) { nM = nM_; nN = nN_; nwg = nM * nN; G = G_; c = c_; }
    __device__ __forceinline__ bool next(int i, Unit& u) const {
        const long L = (long)i * G + c; if (L >= nwg) return false;
        int wgid = (int)L; { const int q = nwg / NXCD, r = nwg % NXCD, xcd = wgid % NXCD, off = wgid / NXCD; wgid = (xcd < r ? xcd * (q + 1) : r * (q + 1) + (xcd - r) * q) + off; }
        const int nig = WGM * nN, gid = wgid / nig, fm = gid * WGM, gsz = (nM - fm) < WGM ? (nM - fm) : WGM;
        u.pm = fm + ((wgid % nig) % gsz); u.pn = (wgid % nig) / gsz; return true;
    }
};
template <bool GATHER, int FP8, int SCW, int SCX, class Epi, class Sched, class AB>
__device__ __forceinline__ void gemm_phase(LAS unsigned char* lds, const int K, const Sched& S, const AB& ab, const Epi& E) {
    const int tid = threadIdx.x, wid = __builtin_amdgcn_readfirstlane(tid >> 6), lane = tid & 63, wr = wid >> 2, wc = wid & 3, fr = lane & 15, fq = lane >> 4;
    const int nt = K / BK;
    int sR[2], sC[2]; unsigned voffB[2], vA[2][2], nvA[2][2];
#pragma unroll
    for (int i = 0; i < 2; ++i) { int R, C; stage_rc(tid * 16 + i * 8192, R, C); sR[i] = R; sC[i] = C; const int Rb = (R & ~31) + perm32(R & 31); voffB[i] = (unsigned)(Rb * K + C) * 2u; }
    const size_t kstep = (size_t)(BK * 2);
    const size_t hstep = (size_t)HALF * K * 2;
    const unsigned ldsw = (unsigned)wid * 1024u;
    const int aoff = lds_byte(wr * 64 + fr, fq * 8), boff = lds_byte(wc * 32 + fr, fq * 8);
#define PG8_SA(b, h) (((b) * 2 + (h)) * HTB)
#define PG8_SB(b, h) ((4 + (b) * 2 + (h)) * HTB)
#define PG8_STAGE(bufoff, gbase, voff) do { _Pragma("unroll") for (int _i = 0; _i < 2; ++_i) \
        __builtin_amdgcn_global_load_lds((const unsigned*)((const char*)(gbase) + (voff)[_i]), (LAS unsigned*)(lds + (bufoff) + ldsw + _i * 8192), 16, 0, 0); } while (0)
#define PG8_LDA(dst, b, h) do { _Pragma("unroll") for (int m = 0; m < 4; ++m) _Pragma("unroll") for (int k = 0; k < 2; ++k) dst[m][k] = *(const LAS bf16x8*)(lds + PG8_SA(b, h) + aoff + m * 2048 + k * 1024); } while (0)
#define PG8_LDB(dst, b, h) do { _Pragma("unroll") for (int n = 0; n < 2; ++n) _Pragma("unroll") for (int k = 0; k < 2; ++k) dst[n][k] = *(const LAS bf16x8*)(lds + PG8_SB(b, h) + boff + n * 2048 + k * 1024); } while (0)
#define PG8_C8(x) __builtin_shufflevector(__builtin_bit_cast(i32x4, (x)[0]), __builtin_bit_cast(i32x4, (x)[1]), 0, 1, 2, 3, 4, 5, 6, 7)
#define PG8_MMA(ai, bj, At, Bt) do { __builtin_amdgcn_s_setprio(1); _Pragma("unroll") for (int m = 0; m < 4; ++m) _Pragma("unroll") for (int n = 0; n < 2; ++n) { \
        if (FP8) asm volatile("v_mfma_scale_f32_16x16x128_f8f6f4 %0, %1, %2, %0, %3, %4 op_sel_hi:[0,0,0]" : "+v"(acc[ai][bj][m][n]) : "v"(PG8_C8(Bt[n])), "v"(PG8_C8(At[m])), "v"(scw), "v"(scx)); \
        else { _Pragma("unroll") for (int k = 0; k < 2; ++k) asm volatile("v_mfma_f32_16x16x32_bf16 %0, %1, %2, %0" : "+v"(acc[ai][bj][m][n]) : "v"(Bt[n][k]), "v"(At[m][k])); } } \
        __builtin_amdgcn_s_setprio(0); } while (0)
#define PG8_WAIT_V(n) asm volatile("s_waitcnt vmcnt(" #n ")" ::: "memory")
#define PG8_WAIT_L(n) asm volatile("s_waitcnt lgkmcnt(" #n ")" ::: "memory")
#define PG8_BAR __builtin_amdgcn_s_barrier()
#define PG8_SCHED __builtin_amdgcn_sched_barrier(0)
#define PG8_AOFF(dst, u) do { _Pragma("unroll") for (int _h = 0; _h < 2; ++_h) _Pragma("unroll") for (int _i = 0; _i < 2; ++_i) \
        dst[_h][_i] = GATHER ? (unsigned)(ab.a_row((u).pm * BM + _h * HALF + sR[_i]) * K + sC[_i]) * 2u : (unsigned)((_h * HALF + sR[_i]) * K + sC[_i]) * 2u; } while (0)
    Unit cur, nxt; int ui = 0;
    if (!S.next(0, cur)) return;
    const int scw = SCW, scx = SCX;
    f32x4 acc[2][2][4][2];
#pragma unroll
    for (int a = 0; a < 2; ++a)
#pragma unroll
        for (int b = 0; b < 2; ++b)
#pragma unroll
            for (int m = 0; m < 4; ++m)
#pragma unroll
                for (int n = 0; n < 2; ++n) acc[a][b][m][n] = (f32x4){0.f, 0.f, 0.f, 0.f};
    bf16x8 At[4][2], B0[2][2], B1[2][2];
    const char* cA = ab.a_base(cur); const char* cB = ab.b_base(cur);
    PG8_AOFF(vA, cur);
    PG8_STAGE(PG8_SB(0, 0), cB, voffB); PG8_STAGE(PG8_SB(0, 1), cB + hstep, voffB); PG8_STAGE(PG8_SA(0, 0), cA, vA[0]); PG8_STAGE(PG8_SA(0, 1), cA, vA[1]);
    if (wr == 1) PG8_BAR;
    PG8_WAIT_V(2); PG8_BAR;
    PG8_STAGE(PG8_SB(1, 0), cB + kstep, voffB); PG8_STAGE(PG8_SA(1, 0), cA + kstep, vA[0]); PG8_STAGE(PG8_SB(1, 1), cB + hstep + kstep, voffB);
    PG8_WAIT_V(6); PG8_BAR;
    for (;;) {
        const bool has_next = S.next(ui + 1, nxt);
        const char* nA = has_next ? ab.a_base(nxt) : cA; const char* nB = has_next ? ab.b_base(nxt) : cB;
        if (GATHER) { if (has_next) { PG8_AOFF(nvA, nxt); } else {
#pragma unroll
            for (int h = 0; h < 2; ++h)
#pragma unroll
                for (int i = 0; i < 2; ++i) nvA[h][i] = vA[h][i]; } }
#pragma unroll 1
        for (int t = 0; t < nt; t += 2) {
            const bool last = (t == nt - 2);
            const char* a1 = cA + (size_t)(t + 1) * kstep;
            const char* a2 = last ? nA : cA + (size_t)(t + 2) * kstep; const char* b2 = last ? nB : cB + (size_t)(t + 2) * kstep;
            const char* a3 = a2 + kstep; const char* b3 = b2 + kstep;
            unsigned o2[2][2];
#pragma unroll
            for (int h = 0; h < 2; ++h)
#pragma unroll
                for (int i = 0; i < 2; ++i) o2[h][i] = (GATHER && last) ? nvA[h][i] : vA[h][i];
            PG8_LDB(B0, 0, 0); PG8_LDB(B1, 0, 1); PG8_SCHED; PG8_LDA(At, 0, 0); PG8_STAGE(PG8_SA(1, 1), a1, vA[1]);
            PG8_WAIT_V(8); PG8_WAIT_L(0); PG8_BAR; PG8_MMA(0, 0, At, B0); PG8_MMA(0, 1, At, B1); PG8_BAR; PG8_SCHED;
            PG8_LDA(At, 0, 1); PG8_STAGE(PG8_SB(0, 0), b2, voffB); PG8_STAGE(PG8_SB(0, 1), b2 + hstep, voffB); PG8_STAGE(PG8_SA(0, 0), a2, o2[0]);
            PG8_WAIT_V(8); PG8_WAIT_L(0); PG8_BAR; PG8_MMA(1, 0, At, B0); PG8_MMA(1, 1, At, B1); PG8_BAR; PG8_SCHED;
            PG8_LDB(B0, 1, 0); PG8_LDB(B1, 1, 1); PG8_SCHED; PG8_LDA(At, 1, 0); PG8_STAGE(PG8_SA(0, 1), a2, o2[1]);
            PG8_WAIT_V(8); PG8_WAIT_L(0); PG8_BAR; PG8_MMA(0, 0, At, B0); PG8_MMA(0, 1, At, B1); PG8_BAR; PG8_SCHED;
            PG8_LDA(At, 1, 1); PG8_STAGE(PG8_SB(1, 0), b3, voffB); PG8_STAGE(PG8_SB(1, 1), b3 + hstep, voffB); PG8_STAGE(PG8_SA(1, 0), a3, o2[0]);
            PG8_WAIT_V(8); PG8_WAIT_L(0); PG8_BAR; PG8_MMA(1, 0, At, B0); PG8_MMA(1, 1, At, B1); PG8_BAR; PG8_SCHED;
        }
        if (wr == 0) PG8_BAR;
        asm volatile("s_nop 15\n\ts_nop 15" ::: "memory");
        E(acc, cur, wr, wc, fr, fq);
        if (!has_next) break;
#pragma unroll
        for (int a = 0; a < 2; ++a)
#pragma unroll
            for (int b = 0; b < 2; ++b)
#pragma unroll
                for (int m = 0; m < 4; ++m)
#pragma unroll
                    for (int n = 0; n < 2; ++n) acc[a][b][m][n] = (f32x4){0.f, 0.f, 0.f, 0.f};
        cur = nxt; cA = nA; cB = nB; ++ui;
        if (GATHER) {
#pragma unroll
            for (int h = 0; h < 2; ++h)
#pragma unroll
                for (int i = 0; i < 2; ++i) vA[h][i] = nvA[h][i]; }
        if (wr == 1) PG8_BAR;
    }
    PG8_WAIT_V(0);
    PG8_BAR;
#undef PG8_SA
#undef PG8_SB
#undef PG8_STAGE
#undef PG8_LDA
#undef PG8_LDB
#undef PG8_MMA
#undef PG8_C8
#undef PG8_WAIT_V
#undef PG8_WAIT_L
#undef PG8_BAR
#undef PG8_SCHED
#undef PG8_AOFF
}
__device__ __forceinline__ unsigned cvt_pk_bf16(float lo, float hi) { unsigned r; asm volatile("v_cvt_pk_bf16_f32 %0, %1, %2" : "=v"(r) : "v"(lo), "v"(hi)); return r; }
struct ABDense { const bf16* A; const bf16* Bt; int K;
    __device__ __forceinline__ const char* a_base(const Unit& u) const { return (const char*)(A + (size_t)u.pm * BM * K); }
    __device__ __forceinline__ const char* b_base(const Unit& u) const { return (const char*)(Bt + (size_t)u.pn * BM * K); }
    __device__ __forceinline__ int a_row(int) const { return 0; } };
struct EpiStoreT { bf16* O; int ldo;
    __device__ __forceinline__ void operator()(const f32x4 (&acc)[2][2][4][2], const Unit& u, int wr, int wc, int fr, int fq) const {
        const int row0 = u.pm * BM + wr * 64 + fr, col0 = u.pn * BM + wc * 32 + 8 * fq;
#pragma unroll
        for (int ai = 0; ai < 2; ++ai)
#pragma unroll
            for (int m = 0; m < 4; ++m) { bf16* rowp = O + (size_t)(row0 + ai * HALF + m * 16) * ldo + col0;
#pragma unroll
                for (int bj = 0; bj < 2; ++bj) { const f32x4 v0 = acc[ai][bj][m][0], v1 = acc[ai][bj][m][1];
                    u32x4 w; w.x = cvt_pk_bf16(v0[0], v0[1]); w.y = cvt_pk_bf16(v0[2], v0[3]); w.z = cvt_pk_bf16(v1[0], v1[1]); w.w = cvt_pk_bf16(v1[2], v1[3]);
                    *(u32x4*)(rowp + bj * HALF) = w; } }
    } };
struct ABMoe1 { const unsigned char* X; const unsigned char* W; const int* tile_e;
    __device__ __forceinline__ const char* a_base(const Unit& u) const { return (const char*)(X + (size_t)u.pm * BM * 1024); }
    __device__ __forceinline__ const char* b_base(const Unit& u) const { return (const char*)(W + (size_t)tile_e[u.pm] * 2048 * 1024 + (size_t)u.pn * BM * 1024); }
    __device__ __forceinline__ int a_row(int) const { return 0; } };
struct ABMoe2 { const unsigned char* A; const unsigned char* W; const int* tile_e;
    __device__ __forceinline__ const char* a_base(const Unit& u) const { return (const char*)(A + (size_t)u.pm * BM * 1024); }
    __device__ __forceinline__ const char* b_base(const Unit& u) const { return (const char*)(W + (size_t)tile_e[u.pm] * 1024 * 1024 + (size_t)u.pn * BM * 1024); }
    __device__ __forceinline__ int a_row(int) const { return 0; } };
struct EpiSwigluT { unsigned char* Aout; const float* b1; const int* tile_e;
    __device__ __forceinline__ void operator()(const f32x4 (&acc)[2][2][4][2], const Unit& u, int wr, int wc, int fr, int fq) const {
        const int row0 = u.pm * BM + wr * 64 + fr, j0 = u.pn * HALF + wc * 32 + 8 * fq;
        const float* bp = b1 + (size_t)tile_e[u.pm] * 2048 + 2 * j0;
        f32x4 bb[4];
#pragma unroll
        for (int q = 0; q < 4; ++q) bb[q] = *(const f32x4*)(bp + 4 * q);
#pragma unroll
        for (int ai = 0; ai < 2; ++ai)
#pragma unroll
            for (int m = 0; m < 4; ++m) {
                const f32x4 g0 = acc[ai][0][m][0], g1 = acc[ai][0][m][1], l0 = acc[ai][1][m][0], l1 = acc[ai][1][m][1];
                u32x2 w;
                w.x = pk4_fp8(swiglu(g0[0] + bb[0][0], l0[0] + bb[0][1]) * A8_SCALE, swiglu(g0[1] + bb[0][2], l0[1] + bb[0][3]) * A8_SCALE,
                              swiglu(g0[2] + bb[1][0], l0[2] + bb[1][1]) * A8_SCALE, swiglu(g0[3] + bb[1][2], l0[3] + bb[1][3]) * A8_SCALE);
                w.y = pk4_fp8(swiglu(g1[0] + bb[2][0], l1[0] + bb[2][1]) * A8_SCALE, swiglu(g1[1] + bb[2][2], l1[1] + bb[2][3]) * A8_SCALE,
                              swiglu(g1[2] + bb[3][0], l1[2] + bb[3][1]) * A8_SCALE, swiglu(g1[3] + bb[3][2], l1[3] + bb[3][3]) * A8_SCALE);
                *(u32x2*)(Aout + (size_t)(row0 + ai * HALF + m * 16) * FF + j0) = w; }
    } };
struct EpiMoe2T { bf16* ys; const float* b2; const int* tile_e; const int* slot_assign; const float* slot_gate;
    __device__ __forceinline__ void operator()(const f32x4 (&acc)[2][2][4][2], const Unit& u, int wr, int wc, int fr, int fq) const {
        const int row0 = u.pm * BM + wr * 64 + fr, col0 = u.pn * BM + wc * 32 + 8 * fq;
        const float* bp = b2 + (size_t)tile_e[u.pm] * D + col0;
        f32x4 bv[2][2];
#pragma unroll
        for (int bj = 0; bj < 2; ++bj)
#pragma unroll
            for (int n = 0; n < 2; ++n) bv[bj][n] = *(const f32x4*)(bp + bj * HALF + 4 * n);
#pragma unroll
        for (int ai = 0; ai < 2; ++ai)
#pragma unroll
            for (int m = 0; m < 4; ++m) { const int row = row0 + ai * HALF + m * 16; const int asg = slot_assign[row]; const float g = slot_gate[row];
                if (asg >= 0) { bf16* rowp = ys + (size_t)asg * D + col0;
#pragma unroll
                    for (int bj = 0; bj < 2; ++bj) { const f32x4 v0 = (acc[ai][bj][m][0] + bv[bj][0]) * g, v1 = (acc[ai][bj][m][1] + bv[bj][1]) * g;
                        u32x4 w; w.x = cvt_pk_bf16(v0[0], v0[1]); w.y = cvt_pk_bf16(v0[2], v0[3]); w.z = cvt_pk_bf16(v1[0], v1[1]); w.w = cvt_pk_bf16(v1[2], v1[3]);
                        *(u32x4*)(rowp + bj * HALF) = w; } } }
    } };
}

__device__ __forceinline__ void attn_unit(const Frame& F, int u) {
    const int qblk = u & 127, kvh = (u >> 7) & 1, b = u >> 8;
    LAS unsigned char* Ks = F.lds; LAS unsigned char* Vs = F.lds + 256 * 144;
    const bf16* proj = WSP(bf16, WS_PROJ); bf16* mix = WSP(bf16, WS_MIX);
    const int tok0 = b * S + qblk * 128;
#pragma unroll
    for (int i = 0; i < 4; ++i) {
        const int cid = F.tid + 512 * i, row = cid >> 3, ch = cid & 7;
        u32x4 kv = (u32x4){0u, 0u, 0u, 0u}, vv = (u32x4){0u, 0u, 0u, 0u};
        if (qblk > 0 || row >= 128) {
            const bf16* rp = proj + (size_t)(tok0 - 128 + row) * INP;
            kv = *(const u32x4*)(rp + AK_OFF + kvh * 64 + ch * 8);
            vv = *(const u32x4*)(rp + AV_OFF + kvh * 64 + ch * 8);
        }
        *(LAS u32x4*)(Ks + row * 144 + ch * 16) = kv;
        *(LAS u32x4*)(Vs + row * 144 + ch * 16) = vv;
    }
    __syncthreads();
    const int g = F.wave >> 1, hw = F.wave & 1, hq = kvh * 4 + g;
    const int lane = F.lane, fr = lane & 15, fq = lane >> 4;
    const float sink = F.sinks[hq];
    const float NEG_INF = -__builtin_inff();
    for (int qb = 0; qb < 4; ++qb) {
        const int i = 64 * hw + 16 * qb + fr;
        const bf16* qp = proj + (size_t)(tok0 + i) * INP + AQ_OFF + hq * 64 + 8 * fq;
        const bf16x8 q0 = *(const bf16x8*)qp, q1 = *(const bf16x8*)(qp + 32);
        f32x4 st[12];
#pragma unroll
        for (int kt = 0; kt < 12; ++kt) {
            LAS const unsigned char* kp = Ks + (64 * hw + 16 * kt + fr) * 144 + fq * 16;
            const bf16x8 k0 = *(LAS const bf16x8*)kp, k1 = *(LAS const bf16x8*)(kp + 64);
            f32x4 z = (f32x4){0.f, 0.f, 0.f, 0.f}; z = MFMA(k0, q0, z); z = MFMA(k1, q1, z); st[kt] = z;
        }
        float mx = NEG_INF;
#pragma unroll
        for (int kt = 0; kt < 12; ++kt)
#pragma unroll
            for (int r = 0; r < 4; ++r) {
                const int j = 64 * hw + 16 * kt + 4 * fq + r, rel = i + 128 - j;
                const bool ok = (rel >= 0) && (rel < 128) && (qblk > 0 || j >= 128);
                const float s = ok ? st[kt][r] * 0.125f : NEG_INF;
                st[kt][r] = s; mx = fmaxf(mx, s);
            }
        mx = fmaxf(mx, __shfl_xor(mx, 16)); mx = fmaxf(mx, __shfl_xor(mx, 32)); mx = fmaxf(mx, sink);
        float sum = 0.f;
#pragma unroll
        for (int kt = 0; kt < 12; ++kt)
#pragma unroll
            for (int r = 0; r < 4; ++r) { const float p = __expf(st[kt][r] - mx); st[kt][r] = p; sum += p; }
        sum += __shfl_xor(sum, 16); sum += __shfl_xor(sum, 32); sum += __expf(sink - mx);
        const float inv = 1.f / sum;
        f32x4 o[4];
#pragma unroll
        for (int c = 0; c < 4; ++c) o[c] = (f32x4){0.f, 0.f, 0.f, 0.f};
#pragma unroll
        for (int ks = 0; ks < 6; ++ks) {
            const bf16x8 pf = pack8(st[2 * ks], st[2 * ks + 1]);
            const int rb = 64 * hw + 32 * ks + 4 * fq + (fr >> 2);
#pragma unroll
            for (int c = 0; c < 4; ++c) {
                LAS const unsigned char* vp = Vs + rb * 144 + (16 * c + 4 * (lane & 3)) * 2;
                const bf16x8 vf = cat8(trr(vp), trr(vp + 16 * 144));
                o[c] = MFMA(pf, vf, o[c]);
            }
        }
#pragma unroll
        for (int r = 0; r < 4; ++r) {
            const int qrow = 4 * fq + r; const float iv = __shfl(inv, qrow);
            bf16* op = mix + (size_t)(tok0 + 64 * hw + 16 * qb + qrow) * D + hq * 64 + fr;
#pragma unroll
            for (int c = 0; c < 4; ++c) op[16 * c] = (bf16)f2bf(o[c][r] * iv);
        }
    }
    __syncthreads();
}

__device__ __forceinline__ void gla_gate_prefix(const Frame& F, const bf16* proj, int t0, int h, LAS float* ga_s, LAS float* tot_s, float (&bv)[8], float& b_mid, float& b_last) {
#pragma unroll
    for (int i = 0; i < 2; ++i) { const int idx = F.tid + 512 * i, t = idx >> 4, r = idx & 15; ga_s[idx] = bf2f(proj[(size_t)(t0 + t) * INP + GA_OFF + r]); }
    float wu[16];
#pragma unroll
    for (int r = 0; r < 16; ++r) wu[r] = F.w_gate_up[r * 256 + h * 64 + F.lane];
    const float bg = F.b_gate[h * 64 + F.lane];
    __syncthreads();
    float run = 0.f;
#pragma unroll
    for (int i = 0; i < 8; ++i) {
        const int t = 8 * F.wave + i; float z = bg;
#pragma unroll
        for (int r = 0; r < 16; ++r) z += ga_s[t * 16 + r] * wu[r];
        const float ls = fminf(z, 0.f) - __logf(1.f + __expf(-fabsf(z)));
        run += ls * (1.f / 16.f); bv[i] = run;
    }
    tot_s[F.wave * 64 + F.lane] = run;
    __syncthreads();
    float pre = 0.f, mid = 0.f, all = 0.f;
#pragma unroll
    for (int w = 0; w < 8; ++w) { const float tv = tot_s[w * 64 + F.lane]; pre += (w < F.wave) ? tv : 0.f; mid += (w < 4) ? tv : 0.f; all += tv; }
#pragma unroll
    for (int i = 0; i < 8; ++i) bv[i] += pre;
    b_mid = mid; b_last = all;
}
__device__ __forceinline__ void gla_kv_unit(const Frame& F, int u) {
    const int h = u & 3, n = (u >> 2) & 255, b = u >> 10, t0 = b * S + n * 64;
    const bf16* proj = WSP(bf16, WS_PROJ);
    LAS unsigned char* kd_s = F.lds; LAS unsigned char* v_s = F.lds + 9216;
    LAS float* ga_s = (LAS float*)(F.lds + 26624); LAS float* tot_s = (LAS float*)(F.lds + 30720);
    const int lane = F.lane, fr = lane & 15, fq = lane >> 4;
#pragma unroll
    for (int i = 0; i < 2; ++i) { const int cid = F.tid + 512 * i, row = cid >> 4, ch = cid & 15;
        *(LAS u32x4*)(v_s + row * 272 + ch * 16) = *(const u32x4*)(proj + (size_t)(t0 + row) * INP + GV_OFF + h * 128 + ch * 8); }
    float bv[8], b_mid, b_last;
    gla_gate_prefix(F, proj, t0, h, ga_s, tot_s, bv, b_mid, b_last);
#pragma unroll
    for (int i = 0; i < 8; ++i) { const int t = 8 * F.wave + i;
        const float kx = bf2f(proj[(size_t)(t0 + t) * INP + GK_OFF + h * 64 + lane]);
        *(LAS bf16*)(kd_s + t * 144 + lane * 2) = (bf16)f2bf(kx * __expf(b_last - bv[i])); }
    if (F.wave == 0) WSP(float, WS_DECAY)[((size_t)(b * NCH + n) * 4 + h) * 64 + lane] = __expf(b_last);
    __syncthreads();
    const int c = F.wave;
    f32x4 acc[4];
#pragma unroll
    for (int d = 0; d < 4; ++d) acc[d] = (f32x4){0.f, 0.f, 0.f, 0.f};
#pragma unroll
    for (int ks = 0; ks < 2; ++ks) {
        const int rb = 32 * ks + 8 * fq + (fr >> 2);
        LAS const unsigned char* vp = v_s + rb * 272 + (16 * c + 4 * (lane & 3)) * 2;
        const bf16x8 vf = cat8(trr(vp), trr(vp + 4 * 272));
#pragma unroll
        for (int d = 0; d < 4; ++d) {
            LAS const unsigned char* kp = kd_s + rb * 144 + (16 * d + 4 * (lane & 3)) * 2;
            const bf16x8 kf = cat8(trr(kp), trr(kp + 4 * 144));
            acc[d] = MFMA(kf, vf, acc[d]);
        }
    }
    float* kvp = WSP(float, WS_KV) + (((size_t)(b * NCH + n) * 4 + h) * 128 + 16 * c + fr) * 64;
#pragma unroll
    for (int d = 0; d < 4; ++d) *(f32x4*)(kvp + 16 * d + 4 * fq) = acc[d];
    __syncthreads();
}
__device__ __forceinline__ void gla_scan(const Frame& F) {
    float* kv = WSP(float, WS_KV); const float* decay = WSP(float, WS_DECAY);
    if (F.tid >= 256) return;
    for (int idx = F.bx * 256 + F.tid; idx < 65536; idx += F.G * 256) {
        const int b = idx >> 15, h = (idx >> 13) & 3, dvdk = idx & 8191, dk = idx & 63;
        float* p = kv + ((size_t)(b * NCH) * 4 + h) * 8192 + dvdk;
        const float* dp = decay + ((size_t)(b * NCH) * 4 + h) * 64 + dk;
        float state = 0.f;
        for (int n = 0; n < NCH; n += 8) {
            float tv[8], dv[8];
#pragma unroll
            for (int i = 0; i < 8; ++i) { tv[i] = p[(size_t)(n + i) * 4 * 8192]; dv[i] = dp[(size_t)(n + i) * 4 * 64]; }
#pragma unroll
            for (int i = 0; i < 8; ++i) { p[(size_t)(n + i) * 4 * 8192] = state; state = dv[i] * state + tv[i]; }
        }
    }
}
__device__ __forceinline__ void gla_out_unit(const Frame& F, int u) {
    const int h = u & 3, n = (u >> 2) & 255, b = u >> 10, t0 = b * S + n * 64;
    const bf16* proj = WSP(bf16, WS_PROJ); bf16* mix = WSP(bf16, WS_MIX);
    LAS unsigned char* qd_s = F.lds; LAS unsigned char* kk_s = F.lds + 9216; LAS unsigned char* qe_s = F.lds + 18432;
    LAS unsigned char* v_s = F.lds + 27648; LAS unsigned char* st_s = F.lds + 45056;
    LAS float* ga_s = (LAS float*)(F.lds + 63488); LAS float* tot_s = (LAS float*)(F.lds + 67584); LAS float* ssq_s = (LAS float*)(F.lds + 69632);
    const int lane = F.lane, fr = lane & 15, fq = lane >> 4;
#pragma unroll
    for (int i = 0; i < 2; ++i) { const int cid = F.tid + 512 * i, row = cid >> 4, ch = cid & 15;
        *(LAS u32x4*)(v_s + row * 272 + ch * 16) = *(const u32x4*)(proj + (size_t)(t0 + row) * INP + GV_OFF + h * 128 + ch * 8); }
    const float* stg = WSP(float, WS_KV) + ((size_t)(b * NCH + n) * 4 + h) * 8192;
#pragma unroll
    for (int i = 0; i < 4; ++i) { const int i4 = F.tid + 512 * i, dv = i4 >> 4, dk4 = (i4 & 15) * 4;
        const f32x4 sv = *(const f32x4*)(stg + dv * 64 + dk4);
        u32x2 w; w.x = pk2(sv[0], sv[1]); w.y = pk2(sv[2], sv[3]);
        *(LAS u32x2*)(st_s + dv * 144 + dk4 * 2) = w; }
    float bv[8], b_mid, b_last;
    gla_gate_prefix(F, proj, t0, h, ga_s, tot_s, bv, b_mid, b_last);
#pragma unroll
    for (int i = 0; i < 8; ++i) { const int t = 8 * F.wave + i; const bf16* rp = proj + (size_t)(t0 + t) * INP + h * 64 + lane;
        const float qx = bf2f(rp[GQ_OFF]) * 0.125f, kx = bf2f(rp[GK_OFF]);
        *(LAS bf16*)(qd_s + t * 144 + lane * 2) = (bf16)f2bf(qx * __expf(bv[i] - b_mid));
        *(LAS bf16*)(kk_s + t * 144 + lane * 2) = (bf16)f2bf(kx * __expf(b_mid - bv[i]));
        *(LAS bf16*)(qe_s + t * 144 + lane * 2) = (bf16)f2bf(qx * __expf(bv[i])); }
    __syncthreads();
    const int ib = F.wave >> 1, dvh = F.wave & 1;
    bf16x8 qdf[2], qef[2];
#pragma unroll
    for (int ks = 0; ks < 2; ++ks) { qdf[ks] = *(LAS const bf16x8*)(qd_s + (16 * ib + fr) * 144 + (32 * ks + 8 * fq) * 2);
                                     qef[ks] = *(LAS const bf16x8*)(qe_s + (16 * ib + fr) * 144 + (32 * ks + 8 * fq) * 2); }
    f32x4 at[4];
#pragma unroll
    for (int jt = 0; jt < 4; ++jt) {
        LAS const unsigned char* kp = kk_s + (16 * jt + fr) * 144 + (8 * fq) * 2;
        const bf16x8 k0 = *(LAS const bf16x8*)kp, k1 = *(LAS const bf16x8*)(kp + 64);
        f32x4 z = (f32x4){0.f, 0.f, 0.f, 0.f}; z = MFMA(k0, qdf[0], z); z = MFMA(k1, qdf[1], z);
#pragma unroll
        for (int r = 0; r < 4; ++r) if (16 * jt + 4 * fq + r > 16 * ib + fr) z[r] = 0.f;
        at[jt] = z;
    }
    bf16x8 pf[2];
    pf[0] = pack8(at[0], at[1]); pf[1] = pack8(at[2], at[3]);
    f32x4 o[4];
#pragma unroll
    for (int c = 0; c < 4; ++c) {
        const int dvt = 4 * dvh + c; f32x4 z = (f32x4){0.f, 0.f, 0.f, 0.f};
#pragma unroll
        for (int ks = 0; ks < 2; ++ks) {
            const int rb = 32 * ks + 4 * fq + (fr >> 2);
            LAS const unsigned char* vp = v_s + rb * 272 + (16 * dvt + 4 * (lane & 3)) * 2;
            z = MFMA(pf[ks], cat8(trr(vp), trr(vp + 16 * 272)), z);
        }
#pragma unroll
        for (int ks = 0; ks < 2; ++ks) {
            const bf16x8 sf = *(LAS const bf16x8*)(st_s + (16 * dvt + fr) * 144 + (32 * ks + 8 * fq) * 2);
            z = MFMA(qef[ks], sf, z);
        }
        o[c] = z;
    }
    float ssq[4];
#pragma unroll
    for (int r = 0; r < 4; ++r) { float s = 0.f;
#pragma unroll
        for (int c = 0; c < 4; ++c) s += o[c][r] * o[c][r];
        s += __shfl_xor(s, 1); s += __shfl_xor(s, 2); s += __shfl_xor(s, 4); s += __shfl_xor(s, 8);
        ssq[r] = s; if (fr == 0) ssq_s[F.wave * 16 + 4 * fq + r] = s; }
    __syncthreads();
#pragma unroll
    for (int r = 0; r < 4; ++r) {
        const float tot = ssq[r] + ssq_s[(F.wave ^ 1) * 16 + 4 * fq + r];
        const float rinv = rsqrtf(tot * (1.f / 128.f) + EPS);
        const int t = t0 + 16 * ib + 4 * fq + r;
#pragma unroll
        for (int c = 0; c < 4; ++c) { const int dv = 16 * (4 * dvh + c) + fr;
            const float gg = bf2f(proj[(size_t)t * INP + GG_OFF + h * 128 + dv]);
            const float val = o[c][r] * rinv * F.g_gla_norm[dv] * (gg / (1.f + __expf(-gg)));
            mix[(size_t)t * D + 512 + h * 128 + dv] = (bf16)f2bf(val); }
    }
    __syncthreads();
}

template <bool OUT>
__device__ __forceinline__ void gla_super_unit(const Frame& F, int u) {
    const int sc = u & 31, h = (u >> 5) & 3, b = u >> 7;
    const bf16* proj = WSP(bf16, WS_PROJ); bf16* mix = WSP(bf16, WS_MIX);
    LAS unsigned char* qd_s = F.lds; LAS unsigned char* kk_s = F.lds + 9216; LAS unsigned char* qe_s = F.lds + 18432;
    LAS unsigned char* v_s = F.lds + 27648; LAS unsigned char* st_s = F.lds + 45056; LAS unsigned char* kd_s = F.lds + 63488;
    LAS float* ga_s = (LAS float*)(F.lds + 72704); LAS float* tot_s = (LAS float*)(F.lds + 76800); LAS float* ssq_s = (LAS float*)(F.lds + 78848); LAS float* dec_s = (LAS float*)(F.lds + 79360);
    const int lane = F.lane, fr = lane & 15, fq = lane >> 4;
    const int ib = F.wave >> 1, dvh = F.wave & 1;
    float wu[16];
#pragma unroll
    for (int r = 0; r < 16; ++r) wu[r] = F.w_gate_up[r * 256 + h * 64 + lane];
    const float bg = F.b_gate[h * 64 + lane];
    float gn[4];
#pragma unroll
    for (int cc = 0; cc < 4; ++cc) gn[cc] = OUT ? F.g_gla_norm[16 * (4 * dvh + cc) + fr] : 0.f;
    float* Sg = WSP(float, WS_KV) + (size_t)u * 8192 + (16 * F.wave + fr) * 64 + 4 * fq;
    f32x4 St[4];
#pragma unroll
    for (int d = 0; d < 4; ++d) St[d] = OUT ? *(const f32x4*)(Sg + 16 * d) : (f32x4){0.f, 0.f, 0.f, 0.f};
    float ltot = 0.f;
    u32x4 v_r[2]; unsigned ga_r[2], k_r[8], q_r[8], gg_r[16];
#define GLA_LOAD_CHUNK(tc0) do { \
        _Pragma("unroll") for (int i = 0; i < 2; ++i) { const int cid = F.tid + 512 * i, row = cid >> 4, ch = cid & 15; v_r[i] = *(const u32x4*)(proj + (size_t)((tc0) + row) * INP + GV_OFF + h * 128 + ch * 8); } \
        _Pragma("unroll") for (int i = 0; i < 2; ++i) { const int idx = F.tid + 512 * i, t = idx >> 4, r = idx & 15; ga_r[i] = proj[(size_t)((tc0) + t) * INP + GA_OFF + r]; } \
        _Pragma("unroll") for (int i = 0; i < 8; ++i) { const bf16* rp = proj + (size_t)((tc0) + 8 * F.wave + i) * INP + h * 64 + lane; k_r[i] = rp[GK_OFF]; if (OUT) q_r[i] = rp[GQ_OFF]; } \
        if (OUT) { _Pragma("unroll") for (int r = 0; r < 4; ++r) _Pragma("unroll") for (int cc = 0; cc < 4; ++cc) \
            gg_r[r * 4 + cc] = proj[(size_t)((tc0) + 16 * ib + 4 * fq + r) * INP + GG_OFF + h * 128 + 16 * (4 * dvh + cc) + fr]; } } while (0)
    const int tu0 = b * S + sc * 512;
    GLA_LOAD_CHUNK(tu0);
    for (int c = 0; c < 8; ++c) {
        const int t0 = tu0 + c * 64;
#pragma unroll
        for (int i = 0; i < 2; ++i) { const int cid = F.tid + 512 * i, row = cid >> 4, ch = cid & 15; *(LAS u32x4*)(v_s + row * 272 + ch * 16) = v_r[i]; }
#pragma unroll
        for (int i = 0; i < 2; ++i) ga_s[F.tid + 512 * i] = bf2f(ga_r[i]);
        float kx[8], qx[8], ggf[16];
#pragma unroll
        for (int i = 0; i < 8; ++i) { kx[i] = bf2f(k_r[i]); qx[i] = OUT ? bf2f(q_r[i]) * 0.125f : 0.f; }
#pragma unroll
        for (int i = 0; i < 16; ++i) ggf[i] = OUT ? bf2f(gg_r[i]) : 0.f;
        if (c < 7) GLA_LOAD_CHUNK(t0 + 64);
        __syncthreads();
        float bv[8]; float run = 0.f;
#pragma unroll
        for (int i = 0; i < 8; ++i) {
            const int t = 8 * F.wave + i; float z = bg;
#pragma unroll
            for (int r = 0; r < 16; ++r) z += ga_s[t * 16 + r] * wu[r];
            const float ls = fminf(z, 0.f) - __logf(1.f + __expf(-fabsf(z)));
            run += ls * (1.f / 16.f); bv[i] = run;
        }
        tot_s[F.wave * 64 + lane] = run;
        if (OUT) {
#pragma unroll
            for (int d = 0; d < 4; ++d) { u32x2 w; w.x = pk2(St[d][0], St[d][1]); w.y = pk2(St[d][2], St[d][3]);
                *(LAS u32x2*)(st_s + (16 * F.wave + fr) * 144 + (16 * d + 4 * fq) * 2) = w; }
        }
        __syncthreads();
        float pre = 0.f, b_mid = 0.f, b_last = 0.f;
#pragma unroll
        for (int w = 0; w < 8; ++w) { const float tv = tot_s[w * 64 + lane]; pre += (w < F.wave) ? tv : 0.f; b_mid += (w < 4) ? tv : 0.f; b_last += tv; }
        ltot += b_last;
#pragma unroll
        for (int i = 0; i < 8; ++i) { const int t = 8 * F.wave + i; const float bb = bv[i] + pre;
            *(LAS bf16*)(kd_s + t * 144 + lane * 2) = (bf16)f2bf(kx[i] * __expf(b_last - bb));
            if (OUT) {
                *(LAS bf16*)(qd_s + t * 144 + lane * 2) = (bf16)f2bf(qx[i] * __expf(bb - b_mid));
                *(LAS bf16*)(kk_s + t * 144 + lane * 2) = (bf16)f2bf(kx[i] * __expf(b_mid - bb));
                *(LAS bf16*)(qe_s + t * 144 + lane * 2) = (bf16)f2bf(qx[i] * __expf(bb)); } }
        if (F.wave == 0) dec_s[lane] = __expf(b_last);
        __syncthreads();
        if (OUT) {
            bf16x8 qdf[2], qef[2];
#pragma unroll
            for (int ks = 0; ks < 2; ++ks) { qdf[ks] = *(LAS const bf16x8*)(qd_s + (16 * ib + fr) * 144 + (32 * ks + 8 * fq) * 2);
                                             qef[ks] = *(LAS const bf16x8*)(qe_s + (16 * ib + fr) * 144 + (32 * ks + 8 * fq) * 2); }
            f32x4 at[4];
#pragma unroll
            for (int jt = 0; jt < 4; ++jt) {
                LAS const unsigned char* kp = kk_s + (16 * jt + fr) * 144 + (8 * fq) * 2;
                const bf16x8 k0 = *(LAS const bf16x8*)kp, k1 = *(LAS const bf16x8*)(kp + 64);
                f32x4 z = (f32x4){0.f, 0.f, 0.f, 0.f}; z = MFMA(k0, qdf[0], z); z = MFMA(k1, qdf[1], z);
#pragma unroll
                for (int r = 0; r < 4; ++r) if (16 * jt + 4 * fq + r > 16 * ib + fr) z[r] = 0.f;
                at[jt] = z;
            }
            bf16x8 pf[2];
            pf[0] = pack8(at[0], at[1]); pf[1] = pack8(at[2], at[3]);
            f32x4 o[4];
#pragma unroll
            for (int cc = 0; cc < 4; ++cc) {
                const int dvt = 4 * dvh + cc; f32x4 z = (f32x4){0.f, 0.f, 0.f, 0.f};
#pragma unroll
                for (int ks = 0; ks < 2; ++ks) {
                    const int rb = 32 * ks + 4 * fq + (fr >> 2);
                    LAS const unsigned char* vp = v_s + rb * 272 + (16 * dvt + 4 * (lane & 3)) * 2;
                    z = MFMA(pf[ks], cat8(trr(vp), trr(vp + 16 * 272)), z);
                }
#pragma unroll
                for (int ks = 0; ks < 2; ++ks) {
                    const bf16x8 sf = *(LAS const bf16x8*)(st_s + (16 * dvt + fr) * 144 + (32 * ks + 8 * fq) * 2);
                    z = MFMA(qef[ks], sf, z);
                }
                o[cc] = z;
            }
            float ssq[4];
#pragma unroll
            for (int r = 0; r < 4; ++r) { float sq = 0.f;
#pragma unroll
                for (int cc = 0; cc < 4; ++cc) sq += o[cc][r] * o[cc][r];
                sq += __shfl_xor(sq, 1); sq += __shfl_xor(sq, 2); sq += __shfl_xor(sq, 4); sq += __shfl_xor(sq, 8);
                ssq[r] = sq; if (fr == 0) ssq_s[F.wave * 16 + 4 * fq + r] = sq; }
            __syncthreads();
#pragma unroll
            for (int r = 0; r < 4; ++r) {
                const float tot = ssq[r] + ssq_s[(F.wave ^ 1) * 16 + 4 * fq + r];
                const float rinv = rsqrtf(tot * (1.f / 128.f) + EPS);
                const int t = t0 + 16 * ib + 4 * fq + r;
#pragma unroll
                for (int cc = 0; cc < 4; ++cc) { const int dv = 16 * (4 * dvh + cc) + fr;
                    const float gg = ggf[r * 4 + cc];
                    const float val = o[cc][r] * rinv * gn[cc] * (gg / (1.f + __expf(-gg)));
                    mix[(size_t)t * D + 512 + h * 128 + dv] = (bf16)f2bf(val); }
            }
        }
#pragma unroll
        for (int d = 0; d < 4; ++d) { const f32x4 dc = *(LAS const f32x4*)(dec_s + 16 * d + 4 * fq); St[d] = St[d] * dc; }
#pragma unroll
        for (int ks = 0; ks < 2; ++ks) {
            const int rb = 32 * ks + 8 * fq + (fr >> 2);
            LAS const unsigned char* vp = v_s + rb * 272 + (16 * F.wave + 4 * (lane & 3)) * 2;
            const bf16x8 vf = cat8(trr(vp), trr(vp + 4 * 272));
#pragma unroll
            for (int d = 0; d < 4; ++d) {
                LAS const unsigned char* kp = kd_s + rb * 144 + (16 * d + 4 * (lane & 3)) * 2;
                St[d] = MFMA(cat8(trr(kp), trr(kp + 4 * 144)), vf, St[d]);
            }
        }
        __syncthreads();
    }
#undef GLA_LOAD_CHUNK
    if (!OUT) {
#pragma unroll
        for (int d = 0; d < 4; ++d) *(f32x4*)(Sg + 16 * d) = St[d];
        if (F.wave == 0) WSP(float, WS_DECAY)[u * 64 + lane] = __expf(ltot);
    }
}
__device__ __forceinline__ void gla_super_scan(const Frame& F) {
    float* kv = WSP(float, WS_KV); const float* decay = WSP(float, WS_DECAY);
    if (F.tid >= 256) return;
    for (int idx = F.bx * 256 + F.tid; idx < 65536; idx += F.G * 256) {
        const int bh = idx >> 13, dvdk = idx & 8191, dk = idx & 63;
        float* p = kv + (size_t)(bh * 32) * 8192 + dvdk; const float* dp = decay + (bh * 32) * 64 + dk;
        float tv[32], dv[32];
#pragma unroll
        for (int i = 0; i < 32; ++i) { tv[i] = p[(size_t)i * 8192]; dv[i] = dp[i * 64]; }
        float state = 0.f;
#pragma unroll
        for (int i = 0; i < 32; ++i) { p[(size_t)i * 8192] = state; state = dv[i] * state + tv[i]; }
    }
}

__device__ __forceinline__ void p7_norm_router(const Frame& F) {
    const float* mod = WSP(float, WS_MOD); const bf16* y = WSP(bf16, WS_Y); float* x1 = WSP(float, WS_X1); unsigned char* h2 = WSP(unsigned char, WS_H);
    int* tok_e = WSP(int, WS_TOK_E); int* tok_lpos = WSP(int, WS_TOK_LPOS); float* tok_gate = WSP(float, WS_TOK_GATE);
    LAS float* wr_s = (LAS float*)F.lds; LAS float* lg_s = (LAS float*)(F.lds + SMALL_OFF); LAS int* cnt_s = (LAS int*)(F.lds + SMALL_OFF + 1024);
    const int lane = F.lane;
#pragma unroll
    for (int i = 0; i < 16; ++i) { const int idx = (F.tid + 512 * i) * 4, k = idx >> 5, e0 = idx & 31;
        *(LAS f32x4*)(wr_s + k * 32 + ((((e0 >> 2) ^ ((k >> 2) & 7))) << 2)) = *(const f32x4*)(F.w_router + idx); }
    if (F.tid < 32) cnt_s[F.tid] = 0;
    __syncthreads();
    const float NEG_INF = -__builtin_inff();
    const int mb0 = F.bx * 128 + F.wave * 16;
    const float* modb = mod + (mb0 >> 14) * 6144;
    u32x2 yr[4], nyr[4]; f32x4 xr[4], nxr[4];
#pragma unroll
    for (int j = 0; j < 4; ++j) { yr[j] = *(const u32x2*)(y + (size_t)mb0 * D + 4 * lane + 256 * j); xr[j] = *(const f32x4*)(F.x + (size_t)mb0 * D + 4 * lane + 256 * j); }
    for (int it = 0; it < 16; ++it) {
        const int m = mb0 + it, mn = mb0 + (it < 15 ? it + 1 : it);
        f32x4 xv[4], hv[4], pg[4], pgt[4], pg2[4], psc[4], psh[4];
#pragma unroll
        for (int j = 0; j < 4; ++j) { const int idx = 4 * lane + 256 * j;
            nyr[j] = *(const u32x2*)(y + (size_t)mn * D + idx); nxr[j] = *(const f32x4*)(F.x + (size_t)mn * D + idx);
            pg[j] = *(const f32x4*)(F.g_post_mix + idx); pgt[j] = *(const f32x4*)(modb + 2048 + idx); pg2[j] = *(const f32x4*)(F.g_pre_ffn + idx);
            psc[j] = *(const f32x4*)(modb + 4096 + idx); psh[j] = *(const f32x4*)(modb + 3072 + idx); }
        float ss = 0.f;
#pragma unroll
        for (int j = 0; j < 4; ++j) { hv[j] = unpack4(yr[j]); ss += dot4(hv[j]); }
        const float ry = rsqrtf(wave_sum(ss) * (1.f / D) + EPS);
        float s2 = 0.f;
#pragma unroll
        for (int j = 0; j < 4; ++j) { xv[j] = xr[j] + pgt[j] * (hv[j] * ry * pg[j]); s2 += dot4(xv[j]); }
        const float rx = rsqrtf(wave_sum(s2) * (1.f / D) + EPS);
#pragma unroll
        for (int j = 0; j < 4; ++j) { const int idx = 4 * lane + 256 * j;
            hv[j] = xv[j] * rx * pg2[j] * (psc[j] + 1.f) + psh[j];
            *(f32x4*)(x1 + (size_t)m * D + idx) = xv[j];
            *(unsigned*)(h2 + (size_t)m * D + idx) = pk4_fp8(hv[j][0] * H8_SCALE, hv[j][1] * H8_SCALE, hv[j][2] * H8_SCALE, hv[j][3] * H8_SCALE);
            yr[j] = nyr[j]; xr[j] = nxr[j]; }
        float acc[32];
#pragma unroll
        for (int e = 0; e < 32; ++e) acc[e] = 0.f;
#pragma unroll
        for (int j = 0; j < 4; ++j)
#pragma unroll
            for (int c = 0; c < 4; ++c) { const int k = 4 * lane + 256 * j + c; const float hvv = hv[j][c]; LAS const float* wp = wr_s + k * 32;
#pragma unroll
                for (int ch = 0; ch < 8; ++ch) { const f32x4 w = *(LAS const f32x4*)(wp + ((ch ^ (lane & 7)) << 2));
                    acc[4 * ch + 0] += hvv * w[0]; acc[4 * ch + 1] += hvv * w[1]; acc[4 * ch + 2] += hvv * w[2]; acc[4 * ch + 3] += hvv * w[3]; } }
#define RED_STEP(HALF, BIT) _Pragma("unroll") for (int i2 = 0; i2 < HALF; ++i2) { const bool hi = (lane & BIT) != 0; \
            const float keep = hi ? acc[i2 + HALF] : acc[i2]; const float send = hi ? acc[i2] : acc[i2 + HALF]; acc[i2] = keep + __shfl_xor(send, BIT); }
        RED_STEP(16, 32) RED_STEP(8, 16) RED_STEP(4, 8) RED_STEP(2, 4) RED_STEP(1, 2)
#undef RED_STEP
        acc[0] += __shfl_xor(acc[0], 1);
        const int my_exp = lane >> 1;
        if ((lane & 1) == 0) lg_s[F.wave * 32 + my_exp] = acc[0] + F.b_router[my_exp];
        float v[32];
#pragma unroll
        for (int ch = 0; ch < 8; ++ch) { const f32x4 w = *(LAS const f32x4*)(lg_s + F.wave * 32 + 4 * ch); v[4 * ch] = w[0]; v[4 * ch + 1] = w[1]; v[4 * ch + 2] = w[2]; v[4 * ch + 3] = w[3]; }
        int se[4]; float sv[4];
#pragma unroll
        for (int r = 0; r < 4; ++r) { float best = v[0]; int bi = 0;
#pragma unroll
            for (int e = 1; e < 32; ++e) if (v[e] > best) { best = v[e]; bi = e; }
            se[r] = bi; sv[r] = best;
#pragma unroll
            for (int e = 0; e < 32; ++e) v[e] = (e == bi) ? NEG_INF : v[e]; }
        const float p1 = __expf(sv[1] - sv[0]), p2 = __expf(sv[2] - sv[0]), p3 = __expf(sv[3] - sv[0]);
        const float rs = 1.f / (1.f + p1 + p2 + p3);
        if (lane < 4) {
            const int my_e = lane == 0 ? se[0] : lane == 1 ? se[1] : lane == 2 ? se[2] : se[3];
            const float my_g = (lane == 0 ? 1.f : lane == 1 ? p1 : lane == 2 ? p2 : p3) * rs;
            const int lpos = __hip_atomic_fetch_add(cnt_s + my_e, 1, __ATOMIC_RELAXED, __HIP_MEMORY_SCOPE_WORKGROUP);
            tok_e[m * 4 + lane] = my_e; tok_lpos[m * 4 + lane] = lpos; tok_gate[m * 4 + lane] = my_g;
        }
    }
    __syncthreads();
    if (F.tid < 32) WSP(int, WS_BLK_CNT)[F.bx * 32 + F.tid] = cnt_s[F.tid];
}

__device__ __forceinline__ void p8_slots(const Frame& F) {
    const int* blk_cnt = WSP(int, WS_BLK_CNT);
    LAS int* tot_p = (LAS int*)F.lds; LAS int* pre_p = tot_p + 512; LAS int* total_s = pre_p + 512; LAS int* pre_s = total_s + 32; LAS int* off_s = pre_s + 32;
    { const int e = F.tid & 31, part = F.tid >> 5; int s = 0, sp = 0;
        for (int bb = part * 16; bb < part * 16 + 16; ++bb) { const int c = blk_cnt[bb * 32 + e]; s += c; sp += (bb < F.bx) ? c : 0; }
        tot_p[part * 32 + e] = s; pre_p[part * 32 + e] = sp; }
    __syncthreads();
    if (F.tid < 32) { int s = 0, sp = 0;
        for (int p = 0; p < 16; ++p) { s += tot_p[p * 32 + F.tid]; sp += pre_p[p * 32 + F.tid]; }
        total_s[F.tid] = s; pre_s[F.tid] = sp; }
    __syncthreads();
    if (F.tid == 0) { int off = 0; for (int e = 0; e < 32; ++e) { off_s[e] = off; off += (total_s[e] + 255) & ~255; } off_s[32] = off; }
    __syncthreads();
    int* slot_assign = WSP(int, WS_SLOT_ASSIGN); float* slot_gate = WSP(float, WS_SLOT_GATE);
    { const int t = F.bx * 128 + (F.tid >> 2), k = F.tid & 3;
        const int e = WSP(int, WS_TOK_E)[t * 4 + k];
        const int slot = off_s[e] + pre_s[e] + WSP(int, WS_TOK_LPOS)[t * 4 + k];
        slot_assign[slot] = t * 4 + k; slot_gate[slot] = WSP(float, WS_TOK_GATE)[t * 4 + k]; }
    if (F.bx < 32) { const int e = F.bx; for (int s = off_s[e] + total_s[e] + F.tid; s < off_s[e + 1]; s += NTHREADS) { slot_assign[s] = -1; slot_gate[s] = 0.f; } }
    if (F.bx == 0) {
        if (F.tid <= 32) WSP(int, WS_MOE_OFF)[F.tid] = off_s[F.tid];
        const int ntile = off_s[32] >> 8;
        for (int rt = F.tid; rt < ntile; rt += NTHREADS) { int e = 0;
            for (int q = 1; q < 32; ++q) e = (off_s[q] <= rt * 256) ? q : e;
            WSP(int, WS_TILE_E)[rt] = e; }
    }
    { const unsigned char* h2 = WSP(unsigned char, WS_H); unsigned char* xs = WSP(unsigned char, WS_XS);
#pragma unroll 4
        for (int i = 0; i < 64; ++i) { const int a = F.wave * 64 + i, t = F.bx * 128 + (a >> 2), k = a & 3;
            const int e = WSP(int, WS_TOK_E)[t * 4 + k];
            const int slot = off_s[e] + pre_s[e] + WSP(int, WS_TOK_LPOS)[t * 4 + k];
            *(u32x4*)(xs + (size_t)slot * 1024 + F.lane * 16) = *(const u32x4*)(h2 + (size_t)t * 1024 + F.lane * 16); } }
}

__device__ __forceinline__ void p11_combine(const Frame& F) {
    const float* mod = WSP(float, WS_MOD); const bf16* ys = WSP(bf16, WS_YS); const float* x1 = WSP(float, WS_X1);
    const int gw = F.bx * NWAVES + F.wave, NGW = F.G * NWAVES, lane = F.lane;
    u32x2 yr[4][4], nyr[4][4]; f32x4 xr[4], nxr[4];
#pragma unroll
    for (int j = 0; j < 4; ++j) { xr[j] = *(const f32x4*)(x1 + (size_t)gw * D + 4 * lane + 256 * j);
#pragma unroll
        for (int k4 = 0; k4 < 4; ++k4) yr[j][k4] = *(const u32x2*)(ys + ((size_t)gw * 4 + k4) * D + 4 * lane + 256 * j); }
    for (int m = gw; m < T; m += NGW) {
        const int b = m >> 14; const float* modb = mod + b * 6144;
        const int mn = (m + NGW < T) ? m + NGW : m;
        f32x4 g[4], gt[4];
#pragma unroll
        for (int j = 0; j < 4; ++j) { const int idx = 4 * lane + 256 * j;
            nxr[j] = *(const f32x4*)(x1 + (size_t)mn * D + idx);
#pragma unroll
            for (int k4 = 0; k4 < 4; ++k4) nyr[j][k4] = *(const u32x2*)(ys + ((size_t)mn * 4 + k4) * D + idx);
            g[j] = *(const f32x4*)(F.g_post_ffn + idx); gt[j] = *(const f32x4*)(modb + 5120 + idx); }
        f32x4 yv[4]; float ss = 0.f;
#pragma unroll
        for (int j = 0; j < 4; ++j) { f32x4 a = (f32x4){0.f, 0.f, 0.f, 0.f};
#pragma unroll
            for (int k4 = 0; k4 < 4; ++k4) a += unpack4(yr[j][k4]);
            yv[j] = a; ss += dot4(a); }
        const float ry = rsqrtf(wave_sum(ss) * (1.f / D) + EPS);
#pragma unroll
        for (int j = 0; j < 4; ++j) { const int idx = 4 * lane + 256 * j;
            *(f32x4*)(F.out + (size_t)m * D + idx) = xr[j] + gt[j] * (yv[j] * ry * g[j]);
            xr[j] = nxr[j];
#pragma unroll
            for (int k4 = 0; k4 < 4; ++k4) yr[j][k4] = nyr[j][k4]; }
    }
}

constexpr int NPHASE = 12;
struct Args { const float* in[20]; float* out; unsigned char* ws; int ph_lo, ph_hi; };
__global__ void __launch_bounds__(NTHREADS, 2) fwd(Args args) {
    extern __shared__ __attribute__((aligned(16))) unsigned char lds[];
    Frame F;
    F.lds = (LAS unsigned char*)lds;
    F.tid = threadIdx.x; F.lane = F.tid & 63; F.wave = __builtin_amdgcn_readfirstlane(F.tid >> 6); F.bx = blockIdx.x; F.G = gridDim.x;
    F.x = args.in[0]; F.c = args.in[1]; F.w_ada = args.in[2]; F.b_ada = args.in[3]; F.g_pre_mix = args.in[4]; F.g_post_mix = args.in[5];
    F.g_pre_ffn = args.in[6]; F.g_post_ffn = args.in[7]; F.w_in = args.in[8]; F.w_gate_up = args.in[9]; F.b_gate = args.in[10]; F.g_gla_norm = args.in[11];
    F.sinks = args.in[12]; F.w_out = args.in[13]; F.w_router = args.in[14]; F.b_router = args.in[15]; F.w_mlp1 = args.in[16]; F.b_mlp1 = args.in[17];
    F.w_mlp2 = args.in[18]; F.b_mlp2 = args.in[19]; F.out = args.out; F.ws = args.ws;
    volatile LAS unsigned* MISC = (volatile LAS unsigned*)(F.lds + MISC_OFF);
    if (F.tid < 32) MISC[F.tid] = 0u;
    __syncthreads();
    const int lo = args.ph_lo, hi = args.ph_hi;
    XcdBarrier bar; bar.bar = (unsigned*)(F.ws + WS_CTL) + CW_BAR; bar.x = 0; bar.st = nullptr;
    if (hi - lo > 1) bar = xcd_barrier_post((unsigned*)(F.ws + WS_CTL) + CW_BAR, MISC + 8);
#define IN(k) (lo <= (k) && (k) < hi)
#if DUPMASK
#define REP(k) for (int rep_ = 0; rep_ < 1 + ((DUPMASK >> (k)) & 1); ++rep_, __syncthreads())
#else
#define REP(k)
#endif
#define SEAM(k) do { if (IN(k) && IN((k) + 1)) xcd_barrier(bar); } while (0)

    if (IN(0)) REP(0) { p0_prologue(F); } SEAM(0);
    if (IN(1)) REP(1) { p1_norm(F); } SEAM(1);
    if (IN(2)) REP(2) { pg8::StaticOrder So; So.init(T / 256, INP / 256, F.G, F.bx);
                 pg8::gemm_phase<false, 0, 0, 0>(F.lds, D, So, pg8::ABDense{WSP(bf16, WS_H), WSP(bf16, WS_WIN), D}, pg8::EpiStoreT{WSP(bf16, WS_PROJ), INP}); } SEAM(2);
    if (IN(3)) REP(3) { for (int u = F.bx; u < 512; u += F.G) attn_unit(F, u);
                 for (int u = F.bx; u < 256; u += F.G) gla_super_unit<false>(F, u); } SEAM(3);
    if (IN(4)) REP(4) { gla_super_scan(F); } SEAM(4);
    if (IN(5)) REP(5) { for (int u = F.bx; u < 256; u += F.G) gla_super_unit<true>(F, u); } SEAM(5);
    if (IN(6)) REP(6) { pg8::StaticOrder So; So.init(T / 256, D / 256, F.G, F.bx);
                 pg8::gemm_phase<false, 0, 0, 0>(F.lds, D, So, pg8::ABDense{WSP(bf16, WS_MIX), WSP(bf16, WS_WOUT), D}, pg8::EpiStoreT{WSP(bf16, WS_Y), D}); } SEAM(6);
    if (IN(7)) REP(7) { p7_norm_router(F); } SEAM(7);
    if (IN(8)) REP(8) { p8_slots(F); } SEAM(8);
    if (IN(9)) REP(9) { const int nM = WSP(int, WS_MOE_OFF)[32] >> 8; pg8::StaticOrder So; So.init(nM, 2048 / 256, F.G, F.bx);
                 pg8::gemm_phase<false, 1, W8_E8M0, H8_E8M0>(F.lds, 512, So, pg8::ABMoe1{WSP(unsigned char, WS_XS), WSP(unsigned char, WS_W1T), WSP(int, WS_TILE_E)},
                                       pg8::EpiSwigluT{WSP(unsigned char, WS_A), F.b_mlp1, WSP(int, WS_TILE_E)}); } SEAM(9);
    if (IN(10)) REP(10) { const int nM = WSP(int, WS_MOE_OFF)[32] >> 8; pg8::StaticOrder So; So.init(nM, D / 256, F.G, F.bx);
                  pg8::gemm_phase<false, 1, W8_E8M0, A8_E8M0>(F.lds, 512, So, pg8::ABMoe2{WSP(unsigned char, WS_A), WSP(unsigned char, WS_W2T), WSP(int, WS_TILE_E)},
                                         pg8::EpiMoe2T{WSP(bf16, WS_YS), F.b_mlp2, WSP(int, WS_TILE_E), WSP(int, WS_SLOT_ASSIGN), WSP(float, WS_SLOT_GATE)}); } SEAM(10);
    if (IN(11)) REP(11) { p11_combine(F); }
#undef IN
#undef SEAM
}

extern "C" void kernel_launch(void* const* d_in, const int* in_sizes, int n_in, void* d_out, int out_size, void* d_ws, size_t ws_size, hipStream_t stream) {
    static int ready = 0;
    if (ready == 0) {
        if (n_in != 20 || out_size != T * D || ws_size < WS_END) { fprintf(stderr, "kernel_launch: unexpected problem (n_in %d, out %d, ws %zu)\n", n_in, out_size, ws_size); ready = -1; return; }
        if (hipFuncSetAttribute((const void*)fwd, hipFuncAttributeMaxDynamicSharedMemorySize, LDS_BYTES) != hipSuccess) { fprintf(stderr, "kernel_launch: hipFuncSetAttribute failed\n"); ready = -1; return; }
        int per_cu = 0;
        if (hipOccupancyMaxActiveBlocksPerMultiprocessor(&per_cu, (const void*)fwd, NTHREADS, LDS_BYTES) != hipSuccess || per_cu < 1) fprintf(stderr, "kernel_launch: occupancy query says %d\n", per_cu);
        (void)hipGetLastError();
        ready = 1;
    }
    if (ready < 0) return;
    (void)hipMemsetAsync((char*)d_ws + WS_CTL, 0, CTL_ZERO_BYTES, stream);
    Args a{};
    for (int i = 0; i < 20; ++i) a.in[i] = (const float*)d_in[i];
    a.out = (float*)d_out; a.ws = (unsigned char*)d_ws;
#if MK_ONE_LAUNCH
    a.ph_lo = 0; a.ph_hi = NPHASE;
    hipLaunchKernelGGL(fwd, dim3(GRID), dim3(NTHREADS), LDS_BYTES, stream, a);
#else
    for (int p = 0; p < NPHASE; ++p) { a.ph_lo = p; a.ph_hi = p + 1; hipLaunchKernelGGL(fwd, dim3(GRID), dim3(NTHREADS), LDS_BYTES, stream, a); }
#endif
}
```

```cpp
#include <hip/hip_runtime.h>
#include <cstdio>
#include <cstdint>

#ifndef MK_ONE_LAUNCH
#define MK_ONE_LAUNCH 1
#endif

#ifndef DUPMASK
#define DUPMASK 0
#endif
#define LAS __attribute__((address_space(3)))
typedef unsigned short bf16;
typedef short bf16x8 __attribute__((ext_vector_type(8)));
typedef short s16x4 __attribute__((ext_vector_type(4)));
typedef float f32x4 __attribute__((ext_vector_type(4)));
typedef unsigned u32x4 __attribute__((ext_vector_type(4)));
typedef unsigned u32x2 __attribute__((ext_vector_type(2)));

constexpr int D = 1024, NB = 2, S = 16384, T = NB * S;
constexpr int INW = 2320, INP = 2560;
constexpr int AQ_OFF = 0, AK_OFF = 512, AV_OFF = 640, GQ_OFF = 768, GK_OFF = 1024, GV_OFF = 1280, GG_OFF = 1792, GA_OFF = 2304;
constexpr int NCH = 256;
constexpr int NE = 32, FF = 1024;
constexpr int NSLOT_MAX = T * 4 + NE * 256;
constexpr float EPS = 1e-6f;
constexpr int NWAVES = 8, NTHREADS = 512, GRID = 256;

constexpr size_t MiB = 1u << 20;
constexpr size_t WS_CTL = 0, CTL_ZERO_BYTES = 1 * MiB;
constexpr size_t WS_MOD = 1 * MiB;
constexpr size_t WS_DECAY = 2 * MiB;
constexpr size_t WS_ROUTE = 3 * MiB;
constexpr size_t WS_TOK_E = WS_ROUTE, WS_TOK_LPOS = WS_ROUTE + 512 * 1024, WS_TOK_GATE = WS_ROUTE + 1024 * 1024;
constexpr size_t WS_BLK_CNT = WS_ROUTE + 1536 * 1024, WS_MOE_OFF = WS_BLK_CNT + 32 * 1024, WS_TILE_E = WS_MOE_OFF + 4096;
constexpr size_t WS_SLOT_ASSIGN = WS_ROUTE + 2 * MiB, WS_SLOT_GATE = WS_ROUTE + 3 * MiB;
constexpr size_t WS_WIN = 8 * MiB, WS_WOUT = 13 * MiB, WS_W2T = 16 * MiB, WS_W1T = 80 * MiB;
constexpr size_t WS_H = 208 * MiB, WS_KV = 272 * MiB, WS_YS = 80 * MiB;
constexpr size_t WS_X1 = 336 * MiB, WS_PROJ = 464 * MiB, WS_MIX = 624 * MiB, WS_Y = 688 * MiB, WS_A = 464 * MiB;
constexpr size_t WS_XS = 608 * MiB;
constexpr size_t WS_END = 752 * MiB;
constexpr int CW_BAR = 4096;

constexpr int LDS_BYTES = 147456, SMALL_OFF = 132096, MISC_OFF = 131072 + 320;

__device__ __forceinline__ float bf2f(unsigned v) { return __uint_as_float(v << 16); }
__device__ __forceinline__ unsigned f2bf(float f) { unsigned u = __float_as_uint(f); return (u + 0x7fffu + ((u >> 16) & 1u)) >> 16; }
__device__ __forceinline__ unsigned pk2(float lo, float hi) { return f2bf(lo) | (f2bf(hi) << 16); }
__device__ __forceinline__ float wave_sum(float v) {
#pragma unroll
    for (int o = 1; o < 64; o <<= 1) v += __shfl_xor(v, o);
    return v;
}
__device__ __forceinline__ f32x4 unpack4(u32x2 r) { return (f32x4){bf2f(r.x & 0xffffu), bf2f(r.x >> 16), bf2f(r.y & 0xffffu), bf2f(r.y >> 16)}; }
__device__ __forceinline__ float dot4(f32x4 a) { return (a[0] * a[0] + a[1] * a[1]) + (a[2] * a[2] + a[3] * a[3]); }
typedef short v4i16_t __attribute__((ext_vector_type(4)));
__device__ __forceinline__ s16x4 trr(LAS const unsigned char* p) { return __builtin_bit_cast(s16x4, __builtin_amdgcn_ds_read_tr16_b64_v4i16((LAS v4i16_t*)p)); }
__device__ __forceinline__ bf16x8 cat8(s16x4 lo, s16x4 hi) { return __builtin_shufflevector(lo, hi, 0, 1, 2, 3, 4, 5, 6, 7); }
__device__ __forceinline__ bf16x8 pack8(f32x4 a, f32x4 b) { u32x4 w; w.x = pk2(a[0], a[1]); w.y = pk2(a[2], a[3]); w.z = pk2(b[0], b[1]); w.w = pk2(b[2], b[3]); return __builtin_bit_cast(bf16x8, w); }
#define MFMA(a, b, c) __builtin_amdgcn_mfma_f32_16x16x32_bf16((a), (b), (c), 0, 0, 0)
typedef int i32x4 __attribute__((ext_vector_type(4)));
typedef int i32x8 __attribute__((ext_vector_type(8)));
__device__ __forceinline__ float clamp8(float v) { return fminf(fmaxf(v, -448.f), 448.f); }
__device__ __forceinline__ unsigned pk4_fp8(float a, float b, float c, float d) {
    int w = 0; w = __builtin_amdgcn_cvt_pk_fp8_f32(clamp8(a), clamp8(b), w, false); w = __builtin_amdgcn_cvt_pk_fp8_f32(clamp8(c), clamp8(d), w, true); return (unsigned)w; }
constexpr float W8_SCALE = 64.f, H8_SCALE = 16.f, A8_SCALE = 4.f;
constexpr int W8_E8M0 = 0x79797979  , H8_E8M0 = 0x7b7b7b7b  , A8_E8M0 = 0x7d7d7d7d  ;

#define XB_TMO      128
#define XB_XCNT(j)  (256  + 64 * (j))
#define XB_XSUB(j)  (1280 + 64 * (j))
#define XB_XGEN(j)  (2304 + 64 * (j))
#define XB_TOP      3328
#define XB_TOPGEN   3392
#define XCD_BAR_WORDS 3456
#define XB_SPIN_CAP (1u << 18)
__device__ __forceinline__ unsigned xb_ld(unsigned* p)              { return __hip_atomic_load(p, __ATOMIC_RELAXED, __HIP_MEMORY_SCOPE_AGENT); }
__device__ __forceinline__ unsigned xb_add(unsigned* p, unsigned v) { return __hip_atomic_fetch_add(p, v, __ATOMIC_RELAXED, __HIP_MEMORY_SCOPE_AGENT); }
__device__ __forceinline__ unsigned xb_xcc_id() { return (unsigned)__builtin_amdgcn_s_getreg((3 << 11) | 20) & 0xFu; }
#define XB_SPIN(cond, bar) do { unsigned _sp = 0; while (cond) { __builtin_amdgcn_s_sleep(1); \
    if ((++_sp & 255u) == 0u) { if (xb_ld(&(bar)[XB_TMO])) break; if (_sp > XB_SPIN_CAP) { atomicAdd(&(bar)[XB_TMO], 1u); break; } } } } while (0)
struct XcdBarrier { unsigned* bar; unsigned x; volatile LAS unsigned* st; };
__device__ __forceinline__ XcdBarrier xcd_barrier_post(unsigned* bar, volatile LAS unsigned* st) {
    XcdBarrier b; b.bar = bar; b.x = xb_xcc_id(); b.st = st;
    if (threadIdx.x == 0) (void)xb_add(&bar[XB_XCNT(b.x)], 1u);
    return b;
}
__device__ __forceinline__ void xcd_barrier_complete(unsigned* bar, unsigned x, unsigned& nloc, unsigned& nx) {
    const unsigned G = gridDim.x * gridDim.y * gridDim.z;
    unsigned sum, cnt, mine, sp = 0u;
    for (;;) {
        sum = 0u; cnt = 0u; mine = 0u;
#pragma unroll
        for (unsigned j = 0; j < 16; ++j) { const unsigned c = xb_ld(&bar[XB_XCNT(j)]); sum += c; cnt += (c > 0u) ? 1u : 0u; mine = (j == x) ? c : mine; }
        if (sum == G) break;
        __builtin_amdgcn_s_sleep(1);
        if ((++sp & 255u) == 0u) { if (xb_ld(&bar[XB_TMO])) break; if (sp > XB_SPIN_CAP) { atomicAdd(&bar[XB_TMO], 1u); break; } }
    }
    nloc = mine > 0u ? mine : 1u; nx = cnt > 0u ? cnt : 1u;
}
__device__ __forceinline__ void xcd_barrier(const XcdBarrier& b) {
    asm volatile("s_waitcnt vmcnt(0)" ::: "memory");
    __syncthreads();
    if (threadIdx.x == 0) {
        unsigned* bar = b.bar;
        __builtin_amdgcn_s_waitcnt(0);
        unsigned nloc = b.st[0], nx = b.st[1];
        if (nloc == 0u) { xcd_barrier_complete(bar, b.x, nloc, nx); b.st[0] = nloc; b.st[1] = nx; }
        const unsigned old = xb_add(&bar[XB_XSUB(b.x)], 1u);
        const unsigned gen = old / nloc;
        if (old + 1u == (gen + 1u) * nloc) {
            __builtin_amdgcn_fence(__ATOMIC_RELEASE, "agent");
            asm volatile("s_waitcnt vmcnt(0)" ::: "memory");
            const unsigned og = xb_add(&bar[XB_TOP], 1u);
            const unsigned tg = og / nx;
            if (og + 1u == (tg + 1u) * nx) xb_add(&bar[XB_TOPGEN], 1u);
            else XB_SPIN(xb_ld(&bar[XB_TOPGEN]) == tg, bar);
            __builtin_amdgcn_fence(__ATOMIC_ACQUIRE, "agent");
            xb_add(&bar[XB_XGEN(b.x)], 1u);
            asm volatile("s_waitcnt vmcnt(0)" ::: "memory");
        } else {
            XB_SPIN(xb_ld(&bar[XB_XGEN(b.x)]) == gen, bar);
            __builtin_amdgcn_fence(__ATOMIC_ACQUIRE, "agent");
            asm volatile("s_waitcnt vmcnt(0)" ::: "memory");
        }
    }
    __syncthreads();
}

struct Frame {
    LAS unsigned char* lds;
    int tid, lane, wave, bx, G;
    const float *x, *c, *w_ada, *b_ada, *g_pre_mix, *g_post_mix, *g_pre_ffn, *g_post_ffn, *w_in, *w_gate_up, *b_gate, *g_gla_norm, *sinks, *w_out,
                *w_router, *b_router, *w_mlp1, *b_mlp1, *w_mlp2, *b_mlp2;
    float* out;
    unsigned char* ws;
};
#define WSP(type, off) ((type*)(F.ws + (off)))

struct TrItem { const float* W; int N; int k0, n0; unsigned char* WT; int kind; };
__device__ __forceinline__ bool tr_decode(const Frame& F, int it, TrItem& t) {
    constexpr int I_IN = 16 * 80, I_OUT = 16 * 32, I_1 = 16 * 64, I_2 = 16 * 32;
    constexpr int NITEMS = I_IN + I_OUT + NE * I_1 + NE * I_2;
    if (it >= NITEMS) return false;
    int r = it, nblk, item;
    if (r < I_IN) { t.W = F.w_in; t.N = INW; t.WT = F.ws + WS_WIN; t.kind = 0; nblk = 80; item = r; }
    else if ((r -= I_IN) < I_OUT) { t.W = F.w_out; t.N = 1024; t.WT = F.ws + WS_WOUT; t.kind = 0; nblk = 32; item = r; }
    else if ((r -= I_OUT) < NE * I_1) { const int e = r / I_1; t.W = F.w_mlp1 + (size_t)e * 1024 * 2048; t.N = 2048; t.WT = F.ws + WS_W1T + (size_t)e * 2048 * 1024; t.kind = 1; nblk = 64; item = r % I_1; }
    else { r -= NE * I_1; const int e = r / I_2; t.W = F.w_mlp2 + (size_t)e * 1024 * 1024; t.N = 1024; t.WT = F.ws + WS_W2T + (size_t)e * 1024 * 1024; t.kind = 2; nblk = 32; item = r % I_2; }
    t.k0 = 64 * (item / nblk); t.n0 = 32 * (item % nblk);
    return true;
}
__device__ __forceinline__ void tr_load(const TrItem& t, int lane, float (&v)[32]) {
    const int n = t.n0 + (lane & 31); const bool ok = n < t.N; const int nc = ok ? n : t.N - 1;
    const float* wp = t.W + (size_t)(t.k0 + (lane >> 5)) * t.N + nc; const size_t st = (size_t)2 * t.N;
#pragma unroll
    for (int i = 0; i < 32; ++i) v[i] = wp[i * st];
#pragma unroll
    for (int i = 0; i < 32; ++i) v[i] = ok ? v[i] : 0.f;
}
__device__ __forceinline__ void tr_store(const TrItem& t, int lane, const float (&v)[32], LAS float* scr) {
#pragma unroll
    for (int i = 0; i < 32; ++i) scr[(2 * i + (lane >> 5)) * 33 + (lane & 31)] = v[i];
    asm volatile("s_waitcnt lgkmcnt(0)" ::: "memory");
    const int c = lane & 7;
#pragma unroll
    for (int j = 0; j < 4; ++j) { const int nn = (lane >> 3) + 8 * j; const LAS float* s = scr + (8 * c) * 33 + nn;
        float e[8];
#pragma unroll
        for (int q = 0; q < 8; ++q) e[q] = s[q * 33];
        const int n = t.n0 + nn;
        if (t.kind == 0) { u32x4 o; o.x = pk2(e[0], e[1]); o.y = pk2(e[2], e[3]); o.z = pk2(e[4], e[5]); o.w = pk2(e[6], e[7]);
            *(u32x4*)((bf16*)t.WT + (size_t)n * 1024 + t.k0 + 8 * c) = o; }
        else { u32x2 o; o.x = pk4_fp8(e[0] * W8_SCALE, e[1] * W8_SCALE, e[2] * W8_SCALE, e[3] * W8_SCALE); o.y = pk4_fp8(e[4] * W8_SCALE, e[5] * W8_SCALE, e[6] * W8_SCALE, e[7] * W8_SCALE);
            int row = n; if (t.kind == 1) { const int jj = n >> 1; row = 256 * (jj >> 7) + 128 * (n & 1) + (jj & 127); }
            *(u32x2*)(t.WT + (size_t)row * 1024 + t.k0 + 8 * c) = o; } }
    asm volatile("s_waitcnt lgkmcnt(0)" ::: "memory");
}
__device__ __forceinline__ void p0_prologue(const Frame& F) {
    float* mod = WSP(float, WS_MOD);
    if (F.bx < 192) {
        LAS float* red = (LAS float*)(F.lds + 98304);
        const int cl = F.tid & 31, ks = F.tid >> 5, col = F.bx * 32 + cl;
        float a0 = 0.f, a1 = 0.f;
#pragma unroll 8
        for (int k = ks * 64; k < ks * 64 + 64; ++k) {
            const float w = F.w_ada[(size_t)k * 6144 + col];
            const float c0 = F.c[k], c1 = F.c[1024 + k];
            a0 += c0 / (1.f + __expf(-c0)) * w; a1 += c1 / (1.f + __expf(-c1)) * w;
        }
        red[(0 * 16 + ks) * 32 + cl] = a0; red[(1 * 16 + ks) * 32 + cl] = a1;
        __syncthreads();
        if (F.tid < 64) { const int b = F.tid >> 5; float s = 0.f;
#pragma unroll
            for (int i = 0; i < 16; ++i) s += red[(b * 16 + i) * 32 + cl];
            mod[b * 6144 + col] = s + F.b_ada[col]; }
        __syncthreads();
    }
    LAS float* scr = (LAS float*)(F.lds + F.wave * 8704);
    const int gw = F.bx * NWAVES + F.wave, NGW = F.G * NWAVES;
    TrItem cur, nxt; float v[32], nv[32];
    bool have = tr_decode(F, gw, cur);
    if (have) tr_load(cur, F.lane, v);
    for (int it = gw; have; it += NGW) {
        const bool hn = tr_decode(F, it + NGW, nxt);
        if (hn) tr_load(nxt, F.lane, nv);
        tr_store(cur, F.lane, v, scr);
        cur = nxt; have = hn;
#pragma unroll
        for (int i = 0; i < 32; ++i) v[i] = nv[i];
    }
}

__device__ __forceinline__ void p1_norm(const Frame& F) {
    const float* mod = WSP(float, WS_MOD); bf16* h = WSP(bf16, WS_H);
    const int gw = F.bx * NWAVES + F.wave, NGW = F.G * NWAVES;
    f32x4 v[4], nv[4];
#pragma unroll
    for (int j = 0; j < 4; ++j) v[j] = *(const f32x4*)(F.x + (size_t)gw * D + 4 * F.lane + 256 * j);
    for (int m = gw; m < T; m += NGW) {
        const int b = m >> 14; const float* modb = mod + b * 6144;
        const int mn = (m + NGW < T) ? m + NGW : m;
        f32x4 g[4], sc[4], sh[4];
#pragma unroll
        for (int j = 0; j < 4; ++j) { const int idx = 4 * F.lane + 256 * j;
            nv[j] = *(const f32x4*)(F.x + (size_t)mn * D + idx);
            g[j] = *(const f32x4*)(F.g_pre_mix + idx); sc[j] = *(const f32x4*)(modb + 1024 + idx); sh[j] = *(const f32x4*)(modb + idx); }
        float ss = 0.f;
#pragma unroll
        for (int j = 0; j < 4; ++j) ss += dot4(v[j]);
        const float r = rsqrtf(wave_sum(ss) * (1.f / D) + EPS);
#pragma unroll
        for (int j = 0; j < 4; ++j) { const int idx = 4 * F.lane + 256 * j;
            const f32x4 hv = v[j] * r * g[j] * (sc[j] + 1.f) + sh[j];
            u32x2 o; o.x = pk2(hv[0], hv[1]); o.y = pk2(hv[2], hv[3]);
            *(u32x2*)(h + (size_t)m * D + idx) = o; v[j] = nv[j]; }
    }
}

template <class Epi, class RowMap, class BSel>
__device__ __forceinline__ void simple_gemm(const Frame& F, const bf16* A, int lda, int M, int N, int K, const RowMap& rm, const BSel& bs, const Epi& E) {
    const int fr = F.lane & 15, fq = F.lane >> 4;
    const int ncg = N / 512, nbt = (M / 64) * ncg;
    for (int bt = F.bx; bt < nbt; bt += F.G) {
        const int mt = bt / ncg, cg = bt % ncg, m0 = mt * 64, n0 = cg * 512 + F.wave * 64;
        const bf16* Bt = bs(m0);
        const bf16* ap[4]; const bf16* bp[4];
#pragma unroll
        for (int i = 0; i < 4; ++i) { ap[i] = A + (size_t)rm(m0 + 16 * i + fr) * lda + 8 * fq; bp[i] = Bt + (size_t)(n0 + 16 * i + fr) * K + 8 * fq; }
        f32x4 acc[4][4];
#pragma unroll
        for (int i = 0; i < 4; ++i)
#pragma unroll
            for (int j = 0; j < 4; ++j) acc[i][j] = (f32x4){0.f, 0.f, 0.f, 0.f};
#pragma unroll 2
        for (int k0 = 0; k0 < K; k0 += 32) {
            bf16x8 a[4], b[4];
#pragma unroll
            for (int i = 0; i < 4; ++i) { a[i] = *(const bf16x8*)(ap[i] + k0); b[i] = *(const bf16x8*)(bp[i] + k0); }
#pragma unroll
            for (int i = 0; i < 4; ++i)
#pragma unroll
                for (int j = 0; j < 4; ++j) acc[i][j] = MFMA(b[j], a[i], acc[i][j]);
        }
#pragma unroll
        for (int i = 0; i < 4; ++i)
#pragma unroll
            for (int j = 0; j < 4; ++j) E(m0 + 16 * i + fr, n0 + 16 * j + 4 * fq, acc[i][j]);
    }
}
struct RowId { __device__ __forceinline__ int operator()(int m) const { return m; } };
struct RowGather { const int* slot_assign; __device__ __forceinline__ int operator()(int m) const { const int a = slot_assign[m]; return a < 0 ? 0 : (a >> 2); } };
struct BFixed { const bf16* Bt; __device__ __forceinline__ const bf16* operator()(int) const { return Bt; } };
struct BExpert { const bf16* Bt; const int* tile_e; size_t stride; __device__ __forceinline__ const bf16* operator()(int m0) const { return Bt + (size_t)tile_e[m0 >> 8] * stride; } };
struct EpiStore { bf16* O; int ldo;
    __device__ __forceinline__ void operator()(int m, int n, f32x4 v) const { u32x2 w; w.x = pk2(v[0], v[1]); w.y = pk2(v[2], v[3]); *(u32x2*)(O + (size_t)m * ldo + n) = w; } };
__device__ __forceinline__ float swiglu(float g, float l) {
    const float xg = fminf(g, 7.f), xl = fminf(fmaxf(l, -7.f), 7.f);
    return xg / (1.f + __expf(-1.702f * xg)) * (xl + 1.f);
}
struct EpiSwiglu { bf16* Aout; const float* b1; const int* tile_e;
    __device__ __forceinline__ void operator()(int m, int n, f32x4 v) const {
        const int e = tile_e[m >> 8]; const f32x4 bb = *(const f32x4*)(b1 + (size_t)e * 2048 + n);
        const float a0 = swiglu(v[0] + bb[0], v[1] + bb[1]), a1 = swiglu(v[2] + bb[2], v[3] + bb[3]);
        *(unsigned*)(Aout + (size_t)m * FF + (n >> 1)) = pk2(a0, a1); } };
struct EpiMoe2 { bf16* ys; const float* b2; const int* tile_e; const int* slot_assign; const float* slot_gate;
    __device__ __forceinline__ void operator()(int m, int n, f32x4 v) const {
        const int asg = slot_assign[m]; if (asg < 0) return;
        const int e = tile_e[m >> 8]; const f32x4 bb = *(const f32x4*)(b2 + (size_t)e * D + n); const float g = slot_gate[m];
        u32x2 w; w.x = pk2((v[0] + bb[0]) * g, (v[1] + bb[1]) * g); w.y = pk2((v[2] + bb[2]) * g, (v[3] + bb[3]) * g);
        *(u32x2*)(ys + (size_t)asg * D + n) = w; } };

namespace pg8 {
constexpr int BM = 256, BK = 64, HALF = 128, HTB = HALF * BK * 2, NXCD = 8, WGM = 8;
__device__ __forceinline__ int lds_byte(int r, int c) { const int st = (r >> 4) * 2 + (c >> 5), rr = r & 15, cc = c & 31, ob = rr * 64 + cc * 2; return st * 1024 + (ob ^ (((ob >> 9) & 1) << 5)); }
__device__ __forceinline__ void stage_rc(int b, int& R, int& C) { const int st = b / 1024, sb = b % 1024, swz = sb ^ (((sb >> 9) & 1) << 5); R = (st >> 1) * 16 + swz / 64; C = (st & 1) * 32 + (swz % 64) / 2; }
__device__ __forceinline__ int perm32(int rho) { const int n = rho >> 4, i = rho & 15; return 8 * (i >> 2) + 4 * n + (i & 3); }
struct Unit { int pm, pn; };
struct StaticOrder {
    int nM, nN, nwg, G, c;
    __device__ __forceinline__ void init(int nM_, int nN_, int G_, int c_) { nM = nM_; nN = nN_; nwg = nM * nN; G = G_; c = c_; }
    __device__ __forceinline__ bool next(int i, Unit& u) const {
        const long L = (long)i * G + c; if (L >= nwg) return false;
        int wgid = (int)L; { const int q = nwg / NXCD, r = nwg % NXCD, xcd = wgid % NXCD, off = wgid / NXCD; wgid = (xcd < r ? xcd * (q + 1) : r * (q + 1) + (xcd - r) * q) + off; }
        const int nig = WGM * nN, gid = wgid / nig, fm = gid * WGM, gsz = (nM - fm) < WGM ? (nM - fm) : WGM;
        u.pm = fm + ((wgid % nig) % gsz); u.pn = (wgid % nig) / gsz; return true;
    }
};
template <bool GATHER, int FP8, int SCW, int SCX, class Epi, class Sched, class AB>
__device__ __forceinline__ void gemm_phase(LAS unsigned char* lds, const int K, const Sched& S, const AB& ab, const Epi& E) {
    const int tid = threadIdx.x, wid = __builtin_amdgcn_readfirstlane(tid >> 6), lane = tid & 63, wr = wid >> 2, wc = wid & 3, fr = lane & 15, fq = lane >> 4;
    const int nt = K / BK;
    int sR[2], sC[2]; unsigned voffB[2], vA[2][2], nvA[2][2];
#pragma unroll
    for (int i = 0; i < 2; ++i) { int R, C; stage_rc(tid * 16 + i * 8192, R, C); sR[i] = R; sC[i] = C; const int Rb = (R & ~31) + perm32(R & 31); voffB[i] = (unsigned)(Rb * K + C) * 2u; }
    const size_t kstep = (size_t)(BK * 2);
    const size_t hstep = (size_t)HALF * K * 2;
    const unsigned ldsw = (unsigned)wid * 1024u;
    const int aoff = lds_byte(wr * 64 + fr, fq * 8), boff = lds_byte(wc * 32 + fr, fq * 8);
#define PG8_SA(b, h) (((b) * 2 + (h)) * HTB)
#define PG8_SB(b, h) ((4 + (b) * 2 + (h)) * HTB)
#define PG8_STAGE(bufoff, gbase, voff) do { _Pragma("unroll") for (int _i = 0; _i < 2; ++_i) \
        __builtin_amdgcn_global_load_lds((const unsigned*)((const char*)(gbase) + (voff)[_i]), (LAS unsigned*)(lds + (bufoff) + ldsw + _i * 8192), 16, 0, 0); } while (0)
#define PG8_LDA(dst, b, h) do { _Pragma("unroll") for (int m = 0; m < 4; ++m) _Pragma("unroll") for (int k = 0; k < 2; ++k) dst[m][k] = *(const LAS bf16x8*)(lds + PG8_SA(b, h) + aoff + m * 2048 + k * 1024); } while (0)
#define PG8_LDB(dst, b, h) do { _Pragma("unroll") for (int n = 0; n < 2; ++n) _Pragma("unroll") for (int k = 0; k < 2; ++k) dst[n][k] = *(const LAS bf16x8*)(lds + PG8_SB(b, h) + boff + n * 2048 + k * 1024); } while (0)
#define PG8_C8(x) __builtin_shufflevector(__builtin_bit_cast(i32x4, (x)[0]), __builtin_bit_cast(i32x4, (x)[1]), 0, 1, 2, 3, 4, 5, 6, 7)
#define PG8_MMA(ai, bj, At, Bt) do { __builtin_amdgcn_s_setprio(1); _Pragma("unroll") for (int m = 0; m < 4; ++m) _Pragma("unroll") for (int n = 0; n < 2; ++n) { \
        if (FP8) asm volatile("v_mfma_scale_f32_16x16x128_f8f6f4 %0, %1, %2, %0, %3, %4 op_sel_hi:[0,0,0]" : "+v"(acc[ai][bj][m][n]) : "v"(PG8_C8(Bt[n])), "v"(PG8_C8(At[m])), "v"(scw), "v"(scx)); \
        else { _Pragma("unroll") for (int k = 0; k < 2; ++k) asm volatile("v_mfma_f32_16x16x32_bf16 %0, %1, %2, %0" : "+v"(acc[ai][bj][m][n]) : "v"(Bt[n][k]), "v"(At[m][k])); } } \
        __builtin_amdgcn_s_setprio(0); } while (0)
#define PG8_WAIT_V(n) asm volatile("s_waitcnt vmcnt(" #n ")" ::: "memory")
#define PG8_WAIT_L(n) asm volatile("s_waitcnt lgkmcnt(" #n ")" ::: "memory")
#define PG8_BAR __builtin_amdgcn_s_barrier()
#define PG8_SCHED __builtin_amdgcn_sched_barrier(0)
#define PG8_AOFF(dst, u) do { _Pragma("unroll") for (int _h = 0; _h < 2; ++_h) _Pragma("unroll") for (int _i = 0; _i < 2; ++_i) \
        dst[_h][_i] = GATHER ? (unsigned)(ab.a_row((u).pm * BM + _h * HALF + sR[_i]) * K + sC[_i]) * 2u : (unsigned)((_h * HALF + sR[_i]) * K + sC[_i]) * 2u; } while (0)
    Unit cur, nxt; int ui = 0;
    if (!S.next(0, cur)) return;
    const int scw = SCW, scx = SCX;
    f32x4 acc[2][2][4][2];
#pragma unroll
    for (int a = 0; a < 2; ++a)
#pragma unroll
        for (int b = 0; b < 2; ++b)
#pragma unroll
            for (int m = 0; m < 4; ++m)
#pragma unroll
                for (int n = 0; n < 2; ++n) acc[a][b][m][n] = (f32x4){0.f, 0.f, 0.f, 0.f};
    bf16x8 At[4][2], B0[2][2], B1[2][2];
    const char* cA = ab.a_base(cur); const char* cB = ab.b_base(cur);
    PG8_AOFF(vA, cur);
    PG8_STAGE(PG8_SB(0, 0), cB, voffB); PG8_STAGE(PG8_SB(0, 1), cB + hstep, voffB); PG8_STAGE(PG8_SA(0, 0), cA, vA[0]); PG8_STAGE(PG8_SA(0, 1), cA, vA[1]);
    if (wr == 1) PG8_BAR;
    PG8_WAIT_V(2); PG8_BAR;
    PG8_STAGE(PG8_SB(1, 0), cB + kstep, voffB); PG8_STAGE(PG8_SA(1, 0), cA + kstep, vA[0]); PG8_STAGE(PG8_SB(1, 1), cB + hstep + kstep, voffB);
    PG8_WAIT_V(6); PG8_BAR;
    for (;;) {
        const bool has_next = S.next(ui + 1, nxt);
        const char* nA = has_next ? ab.a_base(nxt) : cA; const char* nB = has_next ? ab.b_base(nxt) : cB;
        if (GATHER) { if (has_next) { PG8_AOFF(nvA, nxt); } else {
#pragma unroll
            for (int h = 0; h < 2; ++h)
#pragma unroll
                for (int i = 0; i < 2; ++i) nvA[h][i] = vA[h][i]; } }
#pragma unroll 1
        for (int t = 0; t < nt; t += 2) {
            const bool last = (t == nt - 2);
            const char* a1 = cA + (size_t)(t + 1) * kstep;
            const char* a2 = last ? nA : cA + (size_t)(t + 2) * kstep; const char* b2 = last ? nB : cB + (size_t)(t + 2) * kstep;
            const char* a3 = a2 + kstep; const char* b3 = b2 + kstep;
            unsigned o2[2][2];
#pragma unroll
            for (int h = 0; h < 2; ++h)
#pragma unroll
                for (int i = 0; i < 2; ++i) o2[h][i] = (GATHER && last) ? nvA[h][i] : vA[h][i];
            PG8_LDB(B0, 0, 0); PG8_LDB(B1, 0, 1); PG8_SCHED; PG8_LDA(At, 0, 0); PG8_STAGE(PG8_SA(1, 1), a1, vA[1]);
            PG8_WAIT_V(8); PG8_WAIT_L(0); PG8_BAR; PG8_MMA(0, 0, At, B0); PG8_MMA(0, 1, At, B1); PG8_BAR; PG8_SCHED;
            PG8_LDA(At, 0, 1); PG8_STAGE(PG8_SB(0, 0), b2, voffB); PG8_STAGE(PG8_SB(0, 1), b2 + hstep, voffB); PG8_STAGE(PG8_SA(0, 0), a2, o2[0]);
            PG8_WAIT_V(8); PG8_WAIT_L(0); PG8_BAR; PG8_MMA(1, 0, At, B0); PG8_MMA(1, 1, At, B1); PG8_BAR; PG8_SCHED;
            PG8_LDB(B0, 1, 0); PG8_LDB(B1, 1, 1); PG8_SCHED; PG8_LDA(At, 1, 0); PG8_STAGE(PG8_SA(0, 1), a2, o2[1]);
            PG8_WAIT_V(8); PG8_WAIT_L(0); PG8_BAR; PG8_MMA(0, 0, At, B0); PG8_MMA(0, 1, At, B1); PG8_BAR; PG8_SCHED;
            PG8_LDA(At, 1, 1); PG8_STAGE(PG8_SB(1, 0), b3, voffB); PG8_STAGE(PG8_SB(1, 1), b3 + hstep, voffB); PG8_STAGE(PG8_SA(1, 0), a3, o2[0]);
            PG8_WAIT_V(8); PG8_WAIT_L(0); PG8_BAR; PG8_MMA(1, 0, At, B0); PG8_MMA(1, 1, At, B1); PG8_BAR; PG8_SCHED;
        }
        if (wr == 0) PG8_BAR;
        asm volatile("s_nop 15\n\ts_nop 15" ::: "memory");
        E(acc, cur, wr, wc, fr, fq);
        if (!has_next) break;
#pragma unroll
        for (int a = 0; a < 2; ++a)
#pragma unroll
            for (int b = 0; b < 2; ++b)
#pragma unroll
                for (int m = 0; m < 4; ++m)
#pragma unroll
                    for (int n = 0; n < 2; ++n) acc[a][b][m][n] = (f32x4){0.f, 0.f, 0.f, 0.f};
        cur = nxt; cA = nA; cB = nB; ++ui;
        if (GATHER) {
#pragma unroll
            for (int h = 0; h < 2; ++h)
#pragma unroll
                for (int i = 0; i < 2; ++i) vA[h][i] = nvA[h][i]; }
        if (wr == 1) PG8_BAR;
    }
    PG8_WAIT_V(0);
    PG8_BAR;
#undef PG8_SA
#undef PG8_SB
#undef PG8_STAGE
#undef PG8_LDA
#undef PG8_LDB
#undef PG8_MMA
#undef PG8_C8
#undef PG8_WAIT_V
#undef PG8_WAIT_L
#undef PG8_BAR
#undef PG8_SCHED
#undef PG8_AOFF
}
__device__ __forceinline__ unsigned cvt_pk_bf16(float lo, float hi) { unsigned r; asm volatile("v_cvt_pk_bf16_f32 %0, %1, %2" : "=v"(r) : "v"(lo), "v"(hi)); return r; }
struct ABDense { const bf16* A; const bf16* Bt; int K;
    __device__ __forceinline__ const char* a_base(const Unit& u) const { return (const char*)(A + (size_t)u.pm * BM * K); }
    __device__ __forceinline__ const char* b_base(const Unit& u) const { return (const char*)(Bt + (size_t)u.pn * BM * K); }
    __device__ __forceinline__ int a_row(int) const { return 0; } };
struct EpiStoreT { bf16* O; int ldo;
    __device__ __forceinline__ void operator()(const f32x4 (&acc)[2][2][4][2], const Unit& u, int wr, int wc, int fr, int fq) const {
        const int row0 = u.pm * BM + wr * 64 + fr, col0 = u.pn * BM + wc * 32 + 8 * fq;
#pragma unroll
        for (int ai = 0; ai < 2; ++ai)
#pragma unroll
            for (int m = 0; m < 4; ++m) { bf16* rowp = O + (size_t)(row0 + ai * HALF + m * 16) * ldo + col0;
#pragma unroll
                for (int bj = 0; bj < 2; ++bj) { const f32x4 v0 = acc[ai][bj][m][0], v1 = acc[ai][bj][m][1];
                    u32x4 w; w.x = cvt_pk_bf16(v0[0], v0[1]); w.y = cvt_pk_bf16(v0[2], v0[3]); w.z = cvt_pk_bf16(v1[0], v1[1]); w.w = cvt_pk_bf16(v1[2], v1[3]);
                    *(u32x4*)(rowp + bj * HALF) = w; } }
    } };
struct ABMoe1 { const unsigned char* X; const unsigned char* W; const int* tile_e;
    __device__ __forceinline__ const char* a_base(const Unit& u) const { return (const char*)(X + (size_t)u.pm * BM * 1024); }
    __device__ __forceinline__ const char* b_base(const Unit& u) const { return (const char*)(W + (size_t)tile_e[u.pm] * 2048 * 1024 + (size_t)u.pn * BM * 1024); }
    __device__ __forceinline__ int a_row(int) const { return 0; } };
struct ABMoe2 { const unsigned char* A; const unsigned char* W; const int* tile_e;
    __device__ __forceinline__ const char* a_base(const Unit& u) const { return (const char*)(A + (size_t)u.pm * BM * 1024); }
    __device__ __forceinline__ const char* b_base(const Unit& u) const { return (const char*)(W + (size_t)tile_e[u.pm] * 1024 * 1024 + (size_t)u.pn * BM * 1024); }
    __device__ __forceinline__ int a_row(int) const { return 0; } };
struct EpiSwigluT { unsigned char* Aout; const float* b1; const int* tile_e;
    __device__ __forceinline__ void operator()(const f32x4 (&acc)[2][2][4][2], const Unit& u, int wr, int wc, int fr, int fq) const {
        const int row0 = u.pm * BM + wr * 64 + fr, j0 = u.pn * HALF + wc * 32 + 8 * fq;
        const float* bp = b1 + (size_t)tile_e[u.pm] * 2048 + 2 * j0;
        f32x4 bb[4];
#pragma unroll
        for (int q = 0; q < 4; ++q) bb[q] = *(const f32x4*)(bp + 4 * q);
#pragma unroll
        for (int ai = 0; ai < 2; ++ai)
#pragma unroll
            for (int m = 0; m < 4; ++m) {
                const f32x4 g0 = acc[ai][0][m][0], g1 = acc[ai][0][m][1], l0 = acc[ai][1][m][0], l1 = acc[ai][1][m][1];
                u32x2 w;
                w.x = pk4_fp8(swiglu(g0[0] + bb[0][0], l0[0] + bb[0][1]) * A8_SCALE, swiglu(g0[1] + bb[0][2], l0[1] + bb[0][3]) * A8_SCALE,
                              swiglu(g0[2] + bb[1][0], l0[2] + bb[1][1]) * A8_SCALE, swiglu(g0[3] + bb[1][2], l0[3] + bb[1][3]) * A8_SCALE);
                w.y = pk4_fp8(swiglu(g1[0] + bb[2][0], l1[0] + bb[2][1]) * A8_SCALE, swiglu(g1[1] + bb[2][2], l1[1] + bb[2][3]) * A8_SCALE,
                              swiglu(g1[2] + bb[3][0], l1[2] + bb[3][1]) * A8_SCALE, swiglu(g1[3] + bb[3][2], l1[3] + bb[3][3]) * A8_SCALE);
                *(u32x2*)(Aout + (size_t)(row0 + ai * HALF + m * 16) * FF + j0) = w; }
    } };
struct EpiMoe2T { bf16* ys; const float* b2; const int* tile_e; const int* slot_assign; const float* slot_gate;
    __device__ __forceinline__ void operator()(const f32x4 (&acc)[2][2][4][2], const Unit& u, int wr, int wc, int fr, int fq) const {
        const int row0 = u.pm * BM + wr * 64 + fr, col0 = u.pn * BM + wc * 32 + 8 * fq;
        const float* bp = b2 + (size_t)tile_e[u.pm] * D + col0;
        f32x4 bv[2][2];
#pragma unroll
        for (int bj = 0; bj < 2; ++bj)
#pragma unroll
            for (int n = 0; n < 2; ++n) bv[bj][n] = *(const f32x4*)(bp + bj * HALF + 4 * n);
        int asgv[2][4]; float gv[2][4];
#pragma unroll
        for (int ai = 0; ai < 2; ++ai)
#pragma unroll
            for (int m = 0; m < 4; ++m) { const int row = row0 + ai * HALF + m * 16; asgv[ai][m] = slot_assign[row]; gv[ai][m] = slot_gate[row]; }
#pragma unroll
        for (int ai = 0; ai < 2; ++ai)
#pragma unroll
            for (int m = 0; m < 4; ++m) { const int asg = asgv[ai][m]; const float g = gv[ai][m];
                if (asg >= 0) { bf16* rowp = ys + (size_t)asg * D + col0;
#pragma unroll
                    for (int bj = 0; bj < 2; ++bj) { const f32x4 v0 = (acc[ai][bj][m][0] + bv[bj][0]) * g, v1 = (acc[ai][bj][m][1] + bv[bj][1]) * g;
                        u32x4 w; w.x = cvt_pk_bf16(v0[0], v0[1]); w.y = cvt_pk_bf16(v0[2], v0[3]); w.z = cvt_pk_bf16(v1[0], v1[1]); w.w = cvt_pk_bf16(v1[2], v1[3]);
                        *(u32x4*)(rowp + bj * HALF) = w; } } }
    } };
}

__device__ __forceinline__ void attn_unit(const Frame& F, int u) {
    const int qblk = u & 127, kvh = (u >> 7) & 1, b = u >> 8;
    LAS unsigned char* Ks = F.lds; LAS unsigned char* Vs = F.lds + 256 * 144;
    const bf16* proj = WSP(bf16, WS_PROJ); bf16* mix = WSP(bf16, WS_MIX);
    const int tok0 = b * S + qblk * 128;
#pragma unroll
    for (int i = 0; i < 4; ++i) {
        const int cid = F.tid + 512 * i, row = cid >> 3, ch = cid & 7;
        u32x4 kv = (u32x4){0u, 0u, 0u, 0u}, vv = (u32x4){0u, 0u, 0u, 0u};
        if (qblk > 0 || row >= 128) {
            const bf16* rp = proj + (size_t)(tok0 - 128 + row) * INP;
            kv = *(const u32x4*)(rp + AK_OFF + kvh * 64 + ch * 8);
            vv = *(const u32x4*)(rp + AV_OFF + kvh * 64 + ch * 8);
        }
        *(LAS u32x4*)(Ks + row * 144 + ch * 16) = kv;
        *(LAS u32x4*)(Vs + row * 144 + ch * 16) = vv;
    }
    __syncthreads();
    const int g = F.wave >> 1, hw = F.wave & 1, hq = kvh * 4 + g;
    const int lane = F.lane, fr = lane & 15, fq = lane >> 4;
    const float sink = F.sinks[hq];
    const float NEG_INF = -__builtin_inff();
    const bf16* qbase = proj + (size_t)(tok0 + 64 * hw + fr) * INP + AQ_OFF + hq * 64 + 8 * fq;
    bf16x8 nq0 = *(const bf16x8*)qbase, nq1 = *(const bf16x8*)(qbase + 32);
    for (int qb = 0; qb < 4; ++qb) {
        const int i = 64 * hw + 16 * qb + fr;
        const bf16x8 q0 = nq0, q1 = nq1;
        { const bf16* qn = qbase + (size_t)(16 * (qb < 3 ? qb + 1 : qb)) * INP; nq0 = *(const bf16x8*)qn; nq1 = *(const bf16x8*)(qn + 32); }
        f32x4 st[12];
#pragma unroll
        for (int kt = 0; kt < 12; ++kt) {
            LAS const unsigned char* kp = Ks + (64 * hw + 16 * kt + fr) * 144 + fq * 16;
            const bf16x8 k0 = *(LAS const bf16x8*)kp, k1 = *(LAS const bf16x8*)(kp + 64);
            f32x4 z = (f32x4){0.f, 0.f, 0.f, 0.f}; z = MFMA(k0, q0, z); z = MFMA(k1, q1, z); st[kt] = z;
        }
        float mx = NEG_INF;
#pragma unroll
        for (int kt = 0; kt < 12; ++kt)
#pragma unroll
            for (int r = 0; r < 4; ++r) {
                const int j = 64 * hw + 16 * kt + 4 * fq + r, rel = i + 128 - j;
                const bool ok = (rel >= 0) && (rel < 128) && (qblk > 0 || j >= 128);
                const float s = ok ? st[kt][r] * 0.125f : NEG_INF;
                st[kt][r] = s; mx = fmaxf(mx, s);
            }
        mx = fmaxf(mx, __shfl_xor(mx, 16)); mx = fmaxf(mx, __shfl_xor(mx, 32)); mx = fmaxf(mx, sink);
        float sum = 0.f;
#pragma unroll
        for (int kt = 0; kt < 12; ++kt)
#pragma unroll
            for (int r = 0; r < 4; ++r) { const float p = __expf(st[kt][r] - mx); st[kt][r] = p; sum += p; }
        sum += __shfl_xor(sum, 16); sum += __shfl_xor(sum, 32); sum += __expf(sink - mx);
        const float inv = 1.f / sum;
        f32x4 o[4];
#pragma unroll
        for (int c = 0; c < 4; ++c) o[c] = (f32x4){0.f, 0.f, 0.f, 0.f};
#pragma unroll
        for (int ks = 0; ks < 6; ++ks) {
            const bf16x8 pf = pack8(st[2 * ks], st[2 * ks + 1]);
            const int rb = 64 * hw + 32 * ks + 4 * fq + (fr >> 2);
#pragma unroll
            for (int c = 0; c < 4; ++c) {
                LAS const unsigned char* vp = Vs + rb * 144 + (16 * c + 4 * (lane & 3)) * 2;
                const bf16x8 vf = cat8(trr(vp), trr(vp + 16 * 144));
                o[c] = MFMA(pf, vf, o[c]);
            }
        }
#pragma unroll
        for (int r = 0; r < 4; ++r) {
            const int qrow = 4 * fq + r; const float iv = __shfl(inv, qrow);
            bf16* op = mix + (size_t)(tok0 + 64 * hw + 16 * qb + qrow) * D + hq * 64 + fr;
#pragma unroll
            for (int c = 0; c < 4; ++c) op[16 * c] = (bf16)f2bf(o[c][r] * iv);
        }
    }
    __syncthreads();
}

__device__ __forceinline__ void gla_gate_prefix(const Frame& F, const bf16* proj, int t0, int h, LAS float* ga_s, LAS float* tot_s, float (&bv)[8], float& b_mid, float& b_last) {
#pragma unroll
    for (int i = 0; i < 2; ++i) { const int idx = F.tid + 512 * i, t = idx >> 4, r = idx & 15; ga_s[idx] = bf2f(proj[(size_t)(t0 + t) * INP + GA_OFF + r]); }
    float wu[16];
#pragma unroll
    for (int r = 0; r < 16; ++r) wu[r] = F.w_gate_up[r * 256 + h * 64 + F.lane];
    const float bg = F.b_gate[h * 64 + F.lane];
    __syncthreads();
    float run = 0.f;
#pragma unroll
    for (int i = 0; i < 8; ++i) {
        const int t = 8 * F.wave + i; float z = bg;
#pragma unroll
        for (int r = 0; r < 16; ++r) z += ga_s[t * 16 + r] * wu[r];
        const float ls = fminf(z, 0.f) - __logf(1.f + __expf(-fabsf(z)));
        run += ls * (1.f / 16.f); bv[i] = run;
    }
    tot_s[F.wave * 64 + F.lane] = run;
    __syncthreads();
    float pre = 0.f, mid = 0.f, all = 0.f;
#pragma unroll
    for (int w = 0; w < 8; ++w) { const float tv = tot_s[w * 64 + F.lane]; pre += (w < F.wave) ? tv : 0.f; mid += (w < 4) ? tv : 0.f; all += tv; }
#pragma unroll
    for (int i = 0; i < 8; ++i) bv[i] += pre;
    b_mid = mid; b_last = all;
}
__device__ __forceinline__ void gla_kv_unit(const Frame& F, int u) {
    const int h = u & 3, n = (u >> 2) & 255, b = u >> 10, t0 = b * S + n * 64;
    const bf16* proj = WSP(bf16, WS_PROJ);
    LAS unsigned char* kd_s = F.lds; LAS unsigned char* v_s = F.lds + 9216;
    LAS float* ga_s = (LAS float*)(F.lds + 26624); LAS float* tot_s = (LAS float*)(F.lds + 30720);
    const int lane = F.lane, fr = lane & 15, fq = lane >> 4;
#pragma unroll
    for (int i = 0; i < 2; ++i) { const int cid = F.tid + 512 * i, row = cid >> 4, ch = cid & 15;
        *(LAS u32x4*)(v_s + row * 272 + ch * 16) = *(const u32x4*)(proj + (size_t)(t0 + row) * INP + GV_OFF + h * 128 + ch * 8); }
    float bv[8], b_mid, b_last;
    gla_gate_prefix(F, proj, t0, h, ga_s, tot_s, bv, b_mid, b_last);
#pragma unroll
    for (int i = 0; i < 8; ++i) { const int t = 8 * F.wave + i;
        const float kx = bf2f(proj[(size_t)(t0 + t) * INP + GK_OFF + h * 64 + lane]);
        *(LAS bf16*)(kd_s + t * 144 + lane * 2) = (bf16)f2bf(kx * __expf(b_last - bv[i])); }
    if (F.wave == 0) WSP(float, WS_DECAY)[((size_t)(b * NCH + n) * 4 + h) * 64 + lane] = __expf(b_last);
    __syncthreads();
    const int c = F.wave;
    f32x4 acc[4];
#pragma unroll
    for (int d = 0; d < 4; ++d) acc[d] = (f32x4){0.f, 0.f, 0.f, 0.f};
#pragma unroll
    for (int ks = 0; ks < 2; ++ks) {
        const int rb = 32 * ks + 8 * fq + (fr >> 2);
        LAS const unsigned char* vp = v_s + rb * 272 + (16 * c + 4 * (lane & 3)) * 2;
        const bf16x8 vf = cat8(trr(vp), trr(vp + 4 * 272));
#pragma unroll
        for (int d = 0; d < 4; ++d) {
            LAS const unsigned char* kp = kd_s + rb * 144 + (16 * d + 4 * (lane & 3)) * 2;
            const bf16x8 kf = cat8(trr(kp), trr(kp + 4 * 144));
            acc[d] = MFMA(kf, vf, acc[d]);
        }
    }
    float* kvp = WSP(float, WS_KV) + (((size_t)(b * NCH + n) * 4 + h) * 128 + 16 * c + fr) * 64;
#pragma unroll
    for (int d = 0; d < 4; ++d) *(f32x4*)(kvp + 16 * d + 4 * fq) = acc[d];
    __syncthreads();
}
__device__ __forceinline__ void gla_scan(const Frame& F) {
    float* kv = WSP(float, WS_KV); const float* decay = WSP(float, WS_DECAY);
    if (F.tid >= 256) return;
    for (int idx = F.bx * 256 + F.tid; idx < 65536; idx += F.G * 256) {
        const int b = idx >> 15, h = (idx >> 13) & 3, dvdk = idx & 8191, dk = idx & 63;
        float* p = kv + ((size_t)(b * NCH) * 4 + h) * 8192 + dvdk;
        const float* dp = decay + ((size_t)(b * NCH) * 4 + h) * 64 + dk;
        float state = 0.f;
        for (int n = 0; n < NCH; n += 8) {
            float tv[8], dv[8];
#pragma unroll
            for (int i = 0; i < 8; ++i) { tv[i] = p[(size_t)(n + i) * 4 * 8192]; dv[i] = dp[(size_t)(n + i) * 4 * 64]; }
#pragma unroll
            for (int i = 0; i < 8; ++i) { p[(size_t)(n + i) * 4 * 8192] = state; state = dv[i] * state + tv[i]; }
        }
    }
}
__device__ __forceinline__ void gla_out_unit(const Frame& F, int u) {
    const int h = u & 3, n = (u >> 2) & 255, b = u >> 10, t0 = b * S + n * 64;
    const bf16* proj = WSP(bf16, WS_PROJ); bf16* mix = WSP(bf16, WS_MIX);
    LAS unsigned char* qd_s = F.lds; LAS unsigned char* kk_s = F.lds + 9216; LAS unsigned char* qe_s = F.lds + 18432;
    LAS unsigned char* v_s = F.lds + 27648; LAS unsigned char* st_s = F.lds + 45056;
    LAS float* ga_s = (LAS float*)(F.lds + 63488); LAS float* tot_s = (LAS float*)(F.lds + 67584); LAS float* ssq_s = (LAS float*)(F.lds + 69632);
    const int lane = F.lane, fr = lane & 15, fq = lane >> 4;
#pragma unroll
    for (int i = 0; i < 2; ++i) { const int cid = F.tid + 512 * i, row = cid >> 4, ch = cid & 15;
        *(LAS u32x4*)(v_s + row * 272 + ch * 16) = *(const u32x4*)(proj + (size_t)(t0 + row) * INP + GV_OFF + h * 128 + ch * 8); }
    const float* stg = WSP(float, WS_KV) + ((size_t)(b * NCH + n) * 4 + h) * 8192;
#pragma unroll
    for (int i = 0; i < 4; ++i) { const int i4 = F.tid + 512 * i, dv = i4 >> 4, dk4 = (i4 & 15) * 4;
        const f32x4 sv = *(const f32x4*)(stg + dv * 64 + dk4);
        u32x2 w; w.x = pk2(sv[0], sv[1]); w.y = pk2(sv[2], sv[3]);
        *(LAS u32x2*)(st_s + dv * 144 + dk4 * 2) = w; }
    float bv[8], b_mid, b_last;
    gla_gate_prefix(F, proj, t0, h, ga_s, tot_s, bv, b_mid, b_last);
#pragma unroll
    for (int i = 0; i < 8; ++i) { const int t = 8 * F.wave + i; const bf16* rp = proj + (size_t)(t0 + t) * INP + h * 64 + lane;
        const float qx = bf2f(rp[GQ_OFF]) * 0.125f, kx = bf2f(rp[GK_OFF]);
        *(LAS bf16*)(qd_s + t * 144 + lane * 2) = (bf16)f2bf(qx * __expf(bv[i] - b_mid));
        *(LAS bf16*)(kk_s + t * 144 + lane * 2) = (bf16)f2bf(kx * __expf(b_mid - bv[i]));
        *(LAS bf16*)(qe_s + t * 144 + lane * 2) = (bf16)f2bf(qx * __expf(bv[i])); }
    __syncthreads();
    const int ib = F.wave >> 1, dvh = F.wave & 1;
    bf16x8 qdf[2], qef[2];
#pragma unroll
    for (int ks = 0; ks < 2; ++ks) { qdf[ks] = *(LAS const bf16x8*)(qd_s + (16 * ib + fr) * 144 + (32 * ks + 8 * fq) * 2);
                                     qef[ks] = *(LAS const bf16x8*)(qe_s + (16 * ib + fr) * 144 + (32 * ks + 8 * fq) * 2); }
    f32x4 at[4];
#pragma unroll
    for (int jt = 0; jt < 4; ++jt) {
        LAS const unsigned char* kp = kk_s + (16 * jt + fr) * 144 + (8 * fq) * 2;
        const bf16x8 k0 = *(LAS const bf16x8*)kp, k1 = *(LAS const bf16x8*)(kp + 64);
        f32x4 z = (f32x4){0.f, 0.f, 0.f, 0.f}; z = MFMA(k0, qdf[0], z); z = MFMA(k1, qdf[1], z);
#pragma unroll
        for (int r = 0; r < 4; ++r) if (16 * jt + 4 * fq + r > 16 * ib + fr) z[r] = 0.f;
        at[jt] = z;
    }
    bf16x8 pf[2];
    pf[0] = pack8(at[0], at[1]); pf[1] = pack8(at[2], at[3]);
    f32x4 o[4];
#pragma unroll
    for (int c = 0; c < 4; ++c) {
        const int dvt = 4 * dvh + c; f32x4 z = (f32x4){0.f, 0.f, 0.f, 0.f};
#pragma unroll
        for (int ks = 0; ks < 2; ++ks) {
            const int rb = 32 * ks + 4 * fq + (fr >> 2);
            LAS const unsigned char* vp = v_s + rb * 272 + (16 * dvt + 4 * (lane & 3)) * 2;
            z = MFMA(pf[ks], cat8(trr(vp), trr(vp + 16 * 272)), z);
        }
#pragma unroll
        for (int ks = 0; ks < 2; ++ks) {
            const bf16x8 sf = *(LAS const bf16x8*)(st_s + (16 * dvt + fr) * 144 + (32 * ks + 8 * fq) * 2);
            z = MFMA(qef[ks], sf, z);
        }
        o[c] = z;
    }
    float ssq[4];
#pragma unroll
    for (int r = 0; r < 4; ++r) { float s = 0.f;
#pragma unroll
        for (int c = 0; c < 4; ++c) s += o[c][r] * o[c][r];
        s += __shfl_xor(s, 1); s += __shfl_xor(s, 2); s += __shfl_xor(s, 4); s += __shfl_xor(s, 8);
        ssq[r] = s; if (fr == 0) ssq_s[F.wave * 16 + 4 * fq + r] = s; }
    __syncthreads();
#pragma unroll
    for (int r = 0; r < 4; ++r) {
        const float tot = ssq[r] + ssq_s[(F.wave ^ 1) * 16 + 4 * fq + r];
        const float rinv = rsqrtf(tot * (1.f / 128.f) + EPS);
        const int t = t0 + 16 * ib + 4 * fq + r;
#pragma unroll
        for (int c = 0; c < 4; ++c) { const int dv = 16 * (4 * dvh + c) + fr;
            const float gg = bf2f(proj[(size_t)t * INP + GG_OFF + h * 128 + dv]);
            const float val = o[c][r] * rinv * F.g_gla_norm[dv] * (gg / (1.f + __expf(-gg)));
            mix[(size_t)t * D + 512 + h * 128 + dv] = (bf16)f2bf(val); }
    }
    __syncthreads();
}

template <bool OUT>
__device__ __forceinline__ void gla_super_unit(const Frame& F, int u) {
    const int sc = u & 31, h = (u >> 5) & 3, b = u >> 7;
    const bf16* proj = WSP(bf16, WS_PROJ); bf16* mix = WSP(bf16, WS_MIX);
    LAS unsigned char* qd_s = F.lds; LAS unsigned char* kk_s = F.lds + 9216; LAS unsigned char* qe_s = F.lds + 18432;
    LAS unsigned char* v_s = F.lds + 27648; LAS unsigned char* st_s = F.lds + 45056; LAS unsigned char* kd_s = F.lds + 63488;
    LAS float* ga_s = (LAS float*)(F.lds + 72704); LAS float* tot_s = (LAS float*)(F.lds + 76800); LAS float* ssq_s = (LAS float*)(F.lds + 78848); LAS float* dec_s = (LAS float*)(F.lds + 79360);
    const int lane = F.lane, fr = lane & 15, fq = lane >> 4;
    const int ib = F.wave >> 1, dvh = F.wave & 1;
    float wu[16];
#pragma unroll
    for (int r = 0; r < 16; ++r) wu[r] = F.w_gate_up[r * 256 + h * 64 + lane];
    const float bg = F.b_gate[h * 64 + lane];
    float gn[4];
#pragma unroll
    for (int cc = 0; cc < 4; ++cc) gn[cc] = OUT ? F.g_gla_norm[16 * (4 * dvh + cc) + fr] : 0.f;
    float* Sg = WSP(float, WS_KV) + (size_t)u * 8192 + (16 * F.wave + fr) * 64 + 4 * fq;
    f32x4 St[4];
#pragma unroll
    for (int d = 0; d < 4; ++d) St[d] = OUT ? *(const f32x4*)(Sg + 16 * d) : (f32x4){0.f, 0.f, 0.f, 0.f};
    float ltot = 0.f;
    u32x4 v_r[2]; unsigned ga_r[2], k_r[8], q_r[8], gg_r[16];
#define GLA_LOAD_CHUNK(tc0) do { \
        _Pragma("unroll") for (int i = 0; i < 2; ++i) { const int cid = F.tid + 512 * i, row = cid >> 4, ch = cid & 15; v_r[i] = *(const u32x4*)(proj + (size_t)((tc0) + row) * INP + GV_OFF + h * 128 + ch * 8); } \
        _Pragma("unroll") for (int i = 0; i < 2; ++i) { const int idx = F.tid + 512 * i, t = idx >> 4, r = idx & 15; ga_r[i] = proj[(size_t)((tc0) + t) * INP + GA_OFF + r]; } \
        _Pragma("unroll") for (int i = 0; i < 8; ++i) { const bf16* rp = proj + (size_t)((tc0) + 8 * F.wave + i) * INP + h * 64 + lane; k_r[i] = rp[GK_OFF]; if (OUT) q_r[i] = rp[GQ_OFF]; } \
        if (OUT) { _Pragma("unroll") for (int r = 0; r < 4; ++r) _Pragma("unroll") for (int cc = 0; cc < 4; ++cc) \
            gg_r[r * 4 + cc] = proj[(size_t)((tc0) + 16 * ib + 4 * fq + r) * INP + GG_OFF + h * 128 + 16 * (4 * dvh + cc) + fr]; } } while (0)
    const int tu0 = b * S + sc * 512;
    GLA_LOAD_CHUNK(tu0);
    for (int c = 0; c < 8; ++c) {
        const int t0 = tu0 + c * 64;
#pragma unroll
        for (int i = 0; i < 2; ++i) { const int cid = F.tid + 512 * i, row = cid >> 4, ch = cid & 15; *(LAS u32x4*)(v_s + row * 272 + ch * 16) = v_r[i]; }
#pragma unroll
        for (int i = 0; i < 2; ++i) ga_s[F.tid + 512 * i] = bf2f(ga_r[i]);
        float kx[8], qx[8], ggf[16];
#pragma unroll
        for (int i = 0; i < 8; ++i) { kx[i] = bf2f(k_r[i]); qx[i] = OUT ? bf2f(q_r[i]) * 0.125f : 0.f; }
#pragma unroll
        for (int i = 0; i < 16; ++i) ggf[i] = OUT ? bf2f(gg_r[i]) : 0.f;
        if (c < 7) GLA_LOAD_CHUNK(t0 + 64);
        __syncthreads();
        float bv[8]; float run = 0.f;
#pragma unroll
        for (int i = 0; i < 8; ++i) {
            const int t = 8 * F.wave + i; float z = bg;
#pragma unroll
            for (int r = 0; r < 16; ++r) z += ga_s[t * 16 + r] * wu[r];
            const float ls = fminf(z, 0.f) - __logf(1.f + __expf(-fabsf(z)));
            run += ls * (1.f / 16.f); bv[i] = run;
        }
        tot_s[F.wave * 64 + lane] = run;
        if (OUT) {
#pragma unroll
            for (int d = 0; d < 4; ++d) { u32x2 w; w.x = pk2(St[d][0], St[d][1]); w.y = pk2(St[d][2], St[d][3]);
                *(LAS u32x2*)(st_s + (16 * F.wave + fr) * 144 + (16 * d + 4 * fq) * 2) = w; }
        }
        __syncthreads();
        float pre = 0.f, b_mid = 0.f, b_last = 0.f;
#pragma unroll
        for (int w = 0; w < 8; ++w) { const float tv = tot_s[w * 64 + lane]; pre += (w < F.wave) ? tv : 0.f; b_mid += (w < 4) ? tv : 0.f; b_last += tv; }
        ltot += b_last;
#pragma unroll
        for (int i = 0; i < 8; ++i) { const int t = 8 * F.wave + i; const float bb = bv[i] + pre;
            *(LAS bf16*)(kd_s + t * 144 + lane * 2) = (bf16)f2bf(kx[i] * __expf(b_last - bb));
            if (OUT) {
                *(LAS bf16*)(qd_s + t * 144 + lane * 2) = (bf16)f2bf(qx[i] * __expf(bb - b_mid));
                *(LAS bf16*)(kk_s + t * 144 + lane * 2) = (bf16)f2bf(kx[i] * __expf(b_mid - bb));
                *(LAS bf16*)(qe_s + t * 144 + lane * 2) = (bf16)f2bf(qx[i] * __expf(bb)); } }
        if (F.wave == 0) dec_s[lane] = __expf(b_last);
        __syncthreads();
        if (OUT) {
            bf16x8 qdf[2], qef[2];
#pragma unroll
            for (int ks = 0; ks < 2; ++ks) { qdf[ks] = *(LAS const bf16x8*)(qd_s + (16 * ib + fr) * 144 + (32 * ks + 8 * fq) * 2);
                                             qef[ks] = *(LAS const bf16x8*)(qe_s + (16 * ib + fr) * 144 + (32 * ks + 8 * fq) * 2); }
            f32x4 at[4];
#pragma unroll
            for (int jt = 0; jt < 4; ++jt) {
                LAS const unsigned char* kp = kk_s + (16 * jt + fr) * 144 + (8 * fq) * 2;
                const bf16x8 k0 = *(LAS const bf16x8*)kp, k1 = *(LAS const bf16x8*)(kp + 64);
                f32x4 z = (f32x4){0.f, 0.f, 0.f, 0.f}; z = MFMA(k0, qdf[0], z); z = MFMA(k1, qdf[1], z);
#pragma unroll
                for (int r = 0; r < 4; ++r) if (16 * jt + 4 * fq + r > 16 * ib + fr) z[r] = 0.f;
                at[jt] = z;
            }
            bf16x8 pf[2];
            pf[0] = pack8(at[0], at[1]); pf[1] = pack8(at[2], at[3]);
            f32x4 o[4];
#pragma unroll
            for (int cc = 0; cc < 4; ++cc) {
                const int dvt = 4 * dvh + cc; f32x4 z = (f32x4){0.f, 0.f, 0.f, 0.f};
#pragma unroll
                for (int ks = 0; ks < 2; ++ks) {
                    const int rb = 32 * ks + 4 * fq + (fr >> 2);
                    LAS const unsigned char* vp = v_s + rb * 272 + (16 * dvt + 4 * (lane & 3)) * 2;
                    z = MFMA(pf[ks], cat8(trr(vp), trr(vp + 16 * 272)), z);
                }
#pragma unroll
                for (int ks = 0; ks < 2; ++ks) {
                    const bf16x8 sf = *(LAS const bf16x8*)(st_s + (16 * dvt + fr) * 144 + (32 * ks + 8 * fq) * 2);
                    z = MFMA(qef[ks], sf, z);
                }
                o[cc] = z;
            }
            float ssq[4];
#pragma unroll
            for (int r = 0; r < 4; ++r) { float sq = 0.f;
#pragma unroll
                for (int cc = 0; cc < 4; ++cc) sq += o[cc][r] * o[cc][r];
                sq += __shfl_xor(sq, 1); sq += __shfl_xor(sq, 2); sq += __shfl_xor(sq, 4); sq += __shfl_xor(sq, 8);
                ssq[r] = sq; if (fr == 0) ssq_s[F.wave * 16 + 4 * fq + r] = sq; }
            __syncthreads();
#pragma unroll
            for (int r = 0; r < 4; ++r) {
                const float tot = ssq[r] + ssq_s[(F.wave ^ 1) * 16 + 4 * fq + r];
                const float rinv = rsqrtf(tot * (1.f / 128.f) + EPS);
                const int t = t0 + 16 * ib + 4 * fq + r;
#pragma unroll
                for (int cc = 0; cc < 4; ++cc) { const int dv = 16 * (4 * dvh + cc) + fr;
                    const float gg = ggf[r * 4 + cc];
                    const float val = o[cc][r] * rinv * gn[cc] * (gg / (1.f + __expf(-gg)));
                    mix[(size_t)t * D + 512 + h * 128 + dv] = (bf16)f2bf(val); }
            }
        }
#pragma unroll
        for (int d = 0; d < 4; ++d) { const f32x4 dc = *(LAS const f32x4*)(dec_s + 16 * d + 4 * fq); St[d] = St[d] * dc; }
#pragma unroll
        for (int ks = 0; ks < 2; ++ks) {
            const int rb = 32 * ks + 8 * fq + (fr >> 2);
            LAS const unsigned char* vp = v_s + rb * 272 + (16 * F.wave + 4 * (lane & 3)) * 2;
            const bf16x8 vf = cat8(trr(vp), trr(vp + 4 * 272));
#pragma unroll
            for (int d = 0; d < 4; ++d) {
                LAS const unsigned char* kp = kd_s + rb * 144 + (16 * d + 4 * (lane & 3)) * 2;
                St[d] = MFMA(cat8(trr(kp), trr(kp + 4 * 144)), vf, St[d]);
            }
        }
        __syncthreads();
    }
#undef GLA_LOAD_CHUNK
    if (!OUT) {
#pragma unroll
        for (int d = 0; d < 4; ++d) *(f32x4*)(Sg + 16 * d) = St[d];
        if (F.wave == 0) WSP(float, WS_DECAY)[u * 64 + lane] = __expf(ltot);
    }
}
__device__ __forceinline__ void gla_super_scan(const Frame& F) {
    float* kv = WSP(float, WS_KV); const float* decay = WSP(float, WS_DECAY);
    if (F.tid >= 256) return;
    for (int idx = F.bx * 256 + F.tid; idx < 65536; idx += F.G * 256) {
        const int bh = idx >> 13, dvdk = idx & 8191, dk = idx & 63;
        float* p = kv + (size_t)(bh * 32) * 8192 + dvdk; const float* dp = decay + (bh * 32) * 64 + dk;
        float tv[32], dv[32];
#pragma unroll
        for (int i = 0; i < 32; ++i) { tv[i] = p[(size_t)i * 8192]; dv[i] = dp[i * 64]; }
        float state = 0.f;
#pragma unroll
        for (int i = 0; i < 32; ++i) { p[(size_t)i * 8192] = state; state = dv[i] * state + tv[i]; }
    }
}

__device__ __forceinline__ void p7_norm_router(const Frame& F) {
    const float* mod = WSP(float, WS_MOD); const bf16* y = WSP(bf16, WS_Y); float* x1 = WSP(float, WS_X1); unsigned char* h2 = WSP(unsigned char, WS_H);
    int* tok_e = WSP(int, WS_TOK_E); int* tok_lpos = WSP(int, WS_TOK_LPOS); float* tok_gate = WSP(float, WS_TOK_GATE);
    LAS float* wr_s = (LAS float*)F.lds; LAS float* lg_s = (LAS float*)(F.lds + SMALL_OFF); LAS int* cnt_s = (LAS int*)(F.lds + SMALL_OFF + 1024);
    const int lane = F.lane;
#pragma unroll
    for (int i = 0; i < 16; ++i) { const int idx = (F.tid + 512 * i) * 4, k = idx >> 5, e0 = idx & 31;
        *(LAS f32x4*)(wr_s + k * 32 + ((((e0 >> 2) ^ ((k >> 2) & 7))) << 2)) = *(const f32x4*)(F.w_router + idx); }
    if (F.tid < 32) cnt_s[F.tid] = 0;
    __syncthreads();
    const float NEG_INF = -__builtin_inff();
    const int mb0 = F.bx * 128 + F.wave * 16;
    const float* modb = mod + (mb0 >> 14) * 6144;
    u32x2 yr[4], nyr[4]; f32x4 xr[4], nxr[4];
#pragma unroll
    for (int j = 0; j < 4; ++j) { yr[j] = *(const u32x2*)(y + (size_t)mb0 * D + 4 * lane + 256 * j); xr[j] = *(const f32x4*)(F.x + (size_t)mb0 * D + 4 * lane + 256 * j); }
    for (int it = 0; it < 16; ++it) {
        const int m = mb0 + it, mn = mb0 + (it < 15 ? it + 1 : it);
        f32x4 xv[4], hv[4], pg[4], pgt[4], pg2[4], psc[4], psh[4];
#pragma unroll
        for (int j = 0; j < 4; ++j) { const int idx = 4 * lane + 256 * j;
            nyr[j] = *(const u32x2*)(y + (size_t)mn * D + idx); nxr[j] = *(const f32x4*)(F.x + (size_t)mn * D + idx);
            pg[j] = *(const f32x4*)(F.g_post_mix + idx); pgt[j] = *(const f32x4*)(modb + 2048 + idx); pg2[j] = *(const f32x4*)(F.g_pre_ffn + idx);
            psc[j] = *(const f32x4*)(modb + 4096 + idx); psh[j] = *(const f32x4*)(modb + 3072 + idx); }
        float ss = 0.f;
#pragma unroll
        for (int j = 0; j < 4; ++j) { hv[j] = unpack4(yr[j]); ss += dot4(hv[j]); }
        const float ry = rsqrtf(wave_sum(ss) * (1.f / D) + EPS);
        float s2 = 0.f;
#pragma unroll
        for (int j = 0; j < 4; ++j) { xv[j] = xr[j] + pgt[j] * (hv[j] * ry * pg[j]); s2 += dot4(xv[j]); }
        const float rx = rsqrtf(wave_sum(s2) * (1.f / D) + EPS);
#pragma unroll
        for (int j = 0; j < 4; ++j) { const int idx = 4 * lane + 256 * j;
            hv[j] = xv[j] * rx * pg2[j] * (psc[j] + 1.f) + psh[j];
            *(f32x4*)(x1 + (size_t)m * D + idx) = xv[j];
            *(unsigned*)(h2 + (size_t)m * D + idx) = pk4_fp8(hv[j][0] * H8_SCALE, hv[j][1] * H8_SCALE, hv[j][2] * H8_SCALE, hv[j][3] * H8_SCALE);
            yr[j] = nyr[j]; xr[j] = nxr[j]; }
        float acc[32];
#pragma unroll
        for (int e = 0; e < 32; ++e) acc[e] = 0.f;
#pragma unroll
        for (int j = 0; j < 4; ++j)
#pragma unroll
            for (int c = 0; c < 4; ++c) { const int k = 4 * lane + 256 * j + c; const float hvv = hv[j][c]; LAS const float* wp = wr_s + k * 32;
#pragma unroll
                for (int ch = 0; ch < 8; ++ch) { const f32x4 w = *(LAS const f32x4*)(wp + ((ch ^ (lane & 7)) << 2));
                    acc[4 * ch + 0] += hvv * w[0]; acc[4 * ch + 1] += hvv * w[1]; acc[4 * ch + 2] += hvv * w[2]; acc[4 * ch + 3] += hvv * w[3]; } }
#define RED_STEP(HALF, BIT) _Pragma("unroll") for (int i2 = 0; i2 < HALF; ++i2) { const bool hi = (lane & BIT) != 0; \
            const float keep = hi ? acc[i2 + HALF] : acc[i2]; const float send = hi ? acc[i2] : acc[i2 + HALF]; acc[i2] = keep + __shfl_xor(send, BIT); }
        RED_STEP(16, 32) RED_STEP(8, 16) RED_STEP(4, 8) RED_STEP(2, 4) RED_STEP(1, 2)
#undef RED_STEP
        acc[0] += __shfl_xor(acc[0], 1);
        const int my_exp = lane >> 1;
        if ((lane & 1) == 0) lg_s[F.wave * 32 + my_exp] = acc[0] + F.b_router[my_exp];
        float v[32];
#pragma unroll
        for (int ch = 0; ch < 8; ++ch) { const f32x4 w = *(LAS const f32x4*)(lg_s + F.wave * 32 + 4 * ch); v[4 * ch] = w[0]; v[4 * ch + 1] = w[1]; v[4 * ch + 2] = w[2]; v[4 * ch + 3] = w[3]; }
        int se[4]; float sv[4];
#pragma unroll
        for (int r = 0; r < 4; ++r) { float best = v[0]; int bi = 0;
#pragma unroll
            for (int e = 1; e < 32; ++e) if (v[e] > best) { best = v[e]; bi = e; }
            se[r] = bi; sv[r] = best;
#pragma unroll
            for (int e = 0; e < 32; ++e) v[e] = (e == bi) ? NEG_INF : v[e]; }
        const float p1 = __expf(sv[1] - sv[0]), p2 = __expf(sv[2] - sv[0]), p3 = __expf(sv[3] - sv[0]);
        const float rs = 1.f / (1.f + p1 + p2 + p3);
        if (lane < 4) {
            const int my_e = lane == 0 ? se[0] : lane == 1 ? se[1] : lane == 2 ? se[2] : se[3];
            const float my_g = (lane == 0 ? 1.f : lane == 1 ? p1 : lane == 2 ? p2 : p3) * rs;
            const int lpos = __hip_atomic_fetch_add(cnt_s + my_e, 1, __ATOMIC_RELAXED, __HIP_MEMORY_SCOPE_WORKGROUP);
            tok_e[m * 4 + lane] = my_e; tok_lpos[m * 4 + lane] = lpos; tok_gate[m * 4 + lane] = my_g;
        }
    }
    __syncthreads();
    if (F.tid < 32) WSP(int, WS_BLK_CNT)[F.bx * 32 + F.tid] = cnt_s[F.tid];
}

__device__ __forceinline__ void p8_slots(const Frame& F) {
    const int* blk_cnt = WSP(int, WS_BLK_CNT);
    LAS int* tot_p = (LAS int*)F.lds; LAS int* pre_p = tot_p + 512; LAS int* total_s = pre_p + 512; LAS int* pre_s = total_s + 32; LAS int* off_s = pre_s + 32;
    { const int e = F.tid & 31, part = F.tid >> 5; int s = 0, sp = 0;
        for (int bb = part * 16; bb < part * 16 + 16; ++bb) { const int c = blk_cnt[bb * 32 + e]; s += c; sp += (bb < F.bx) ? c : 0; }
        tot_p[part * 32 + e] = s; pre_p[part * 32 + e] = sp; }
    __syncthreads();
    if (F.tid < 32) { int s = 0, sp = 0;
        for (int p = 0; p < 16; ++p) { s += tot_p[p * 32 + F.tid]; sp += pre_p[p * 32 + F.tid]; }
        total_s[F.tid] = s; pre_s[F.tid] = sp; }
    __syncthreads();
    if (F.tid == 0) { int off = 0; for (int e = 0; e < 32; ++e) { off_s[e] = off; off += (total_s[e] + 255) & ~255; } off_s[32] = off; }
    __syncthreads();
    int* slot_assign = WSP(int, WS_SLOT_ASSIGN); float* slot_gate = WSP(float, WS_SLOT_GATE);
    { const int t = F.bx * 128 + (F.tid >> 2), k = F.tid & 3;
        const int e = WSP(int, WS_TOK_E)[t * 4 + k];
        const int slot = off_s[e] + pre_s[e] + WSP(int, WS_TOK_LPOS)[t * 4 + k];
        slot_assign[slot] = t * 4 + k; slot_gate[slot] = WSP(float, WS_TOK_GATE)[t * 4 + k]; }
    if (F.bx < 32) { const int e = F.bx; for (int s = off_s[e] + total_s[e] + F.tid; s < off_s[e + 1]; s += NTHREADS) { slot_assign[s] = -1; slot_gate[s] = 0.f; } }
    if (F.bx == 0) {
        if (F.tid <= 32) WSP(int, WS_MOE_OFF)[F.tid] = off_s[F.tid];
        const int ntile = off_s[32] >> 8;
        for (int rt = F.tid; rt < ntile; rt += NTHREADS) { int e = 0;
            for (int q = 1; q < 32; ++q) e = (off_s[q] <= rt * 256) ? q : e;
            WSP(int, WS_TILE_E)[rt] = e; }
    }
    { const unsigned char* h2 = WSP(unsigned char, WS_H); unsigned char* xs = WSP(unsigned char, WS_XS);
        for (int i0 = 0; i0 < 64; i0 += 16) {
            u32x4 rowv[16]; int slot[16];
#pragma unroll
            for (int i = 0; i < 16; ++i) { const int a = F.wave * 64 + i0 + i, t = F.bx * 128 + (a >> 2), k = a & 3;
                const int e = WSP(int, WS_TOK_E)[t * 4 + k];
                slot[i] = off_s[e] + pre_s[e] + WSP(int, WS_TOK_LPOS)[t * 4 + k];
                rowv[i] = *(const u32x4*)(h2 + (size_t)t * 1024 + F.lane * 16); }
#pragma unroll
            for (int i = 0; i < 16; ++i) *(u32x4*)(xs + (size_t)slot[i] * 1024 + F.lane * 16) = rowv[i];
        } }
}

__device__ __forceinline__ void p11_combine(const Frame& F) {
    const float* mod = WSP(float, WS_MOD); const bf16* ys = WSP(bf16, WS_YS); const float* x1 = WSP(float, WS_X1);
    const int gw = F.bx * NWAVES + F.wave, NGW = F.G * NWAVES, lane = F.lane;
    u32x2 yr[4][4], nyr[4][4]; f32x4 xr[4], nxr[4];
#pragma unroll
    for (int j = 0; j < 4; ++j) { xr[j] = *(const f32x4*)(x1 + (size_t)gw * D + 4 * lane + 256 * j);
#pragma unroll
        for (int k4 = 0; k4 < 4; ++k4) yr[j][k4] = *(const u32x2*)(ys + ((size_t)gw * 4 + k4) * D + 4 * lane + 256 * j); }
    for (int m = gw; m < T; m += NGW) {
        const int b = m >> 14; const float* modb = mod + b * 6144;
        const int mn = (m + NGW < T) ? m + NGW : m;
        f32x4 g[4], gt[4];
#pragma unroll
        for (int j = 0; j < 4; ++j) { const int idx = 4 * lane + 256 * j;
            nxr[j] = *(const f32x4*)(x1 + (size_t)mn * D + idx);
#pragma unroll
            for (int k4 = 0; k4 < 4; ++k4) nyr[j][k4] = *(const u32x2*)(ys + ((size_t)mn * 4 + k4) * D + idx);
            g[j] = *(const f32x4*)(F.g_post_ffn + idx); gt[j] = *(const f32x4*)(modb + 5120 + idx); }
        f32x4 yv[4]; float ss = 0.f;
#pragma unroll
        for (int j = 0; j < 4; ++j) { f32x4 a = (f32x4){0.f, 0.f, 0.f, 0.f};
#pragma unroll
            for (int k4 = 0; k4 < 4; ++k4) a += unpack4(yr[j][k4]);
            yv[j] = a; ss += dot4(a); }
        const float ry = rsqrtf(wave_sum(ss) * (1.f / D) + EPS);
#pragma unroll
        for (int j = 0; j < 4; ++j) { const int idx = 4 * lane + 256 * j;
            *(f32x4*)(F.out + (size_t)m * D + idx) = xr[j] + gt[j] * (yv[j] * ry * g[j]);
            xr[j] = nxr[j];
#pragma unroll
            for (int k4 = 0; k4 < 4; ++k4) yr[j][k4] = nyr[j][k4]; }
    }
}

constexpr int NPHASE = 12;
struct Args { const float* in[20]; float* out; unsigned char* ws; int ph_lo, ph_hi; };
__global__ void __launch_bounds__(NTHREADS, 2) fwd(Args args) {
    extern __shared__ __attribute__((aligned(16))) unsigned char lds[];
    Frame F;
    F.lds = (LAS unsigned char*)lds;
    F.tid = threadIdx.x; F.lane = F.tid & 63; F.wave = __builtin_amdgcn_readfirstlane(F.tid >> 6); F.bx = blockIdx.x; F.G = gridDim.x;
    F.x = args.in[0]; F.c = args.in[1]; F.w_ada = args.in[2]; F.b_ada = args.in[3]; F.g_pre_mix = args.in[4]; F.g_post_mix = args.in[5];
    F.g_pre_ffn = args.in[6]; F.g_post_ffn = args.in[7]; F.w_in = args.in[8]; F.w_gate_up = args.in[9]; F.b_gate = args.in[10]; F.g_gla_norm = args.in[11];
    F.sinks = args.in[12]; F.w_out = args.in[13]; F.w_router = args.in[14]; F.b_router = args.in[15]; F.w_mlp1 = args.in[16]; F.b_mlp1 = args.in[17];
    F.w_mlp2 = args.in[18]; F.b_mlp2 = args.in[19]; F.out = args.out; F.ws = args.ws;
    volatile LAS unsigned* MISC = (volatile LAS unsigned*)(F.lds + MISC_OFF);
    if (F.tid < 32) MISC[F.tid] = 0u;
    __syncthreads();
    const int lo = args.ph_lo, hi = args.ph_hi;
    XcdBarrier bar; bar.bar = (unsigned*)(F.ws + WS_CTL) + CW_BAR; bar.x = 0; bar.st = nullptr;
    if (hi - lo > 1) bar = xcd_barrier_post((unsigned*)(F.ws + WS_CTL) + CW_BAR, MISC + 8);
#define IN(k) (lo <= (k) && (k) < hi)
#if DUPMASK
#define REP(k) for (int rep_ = 0; rep_ < 1 + ((DUPMASK >> (k)) & 1); ++rep_, __syncthreads())
#else
#define REP(k)
#endif
#define SEAM(k) do { if (IN(k) && IN((k) + 1)) xcd_barrier(bar); } while (0)

    if (IN(0)) REP(0) { p0_prologue(F); } SEAM(0);
    if (IN(1)) REP(1) { p1_norm(F); } SEAM(1);
    if (IN(2)) REP(2) { pg8::StaticOrder So; So.init(T / 256, INP / 256, F.G, F.bx);
                 pg8::gemm_phase<false, 0, 0, 0>(F.lds, D, So, pg8::ABDense{WSP(bf16, WS_H), WSP(bf16, WS_WIN), D}, pg8::EpiStoreT{WSP(bf16, WS_PROJ), INP}); } SEAM(2);
    if (IN(3)) REP(3) { for (int u = F.bx; u < 512; u += F.G) attn_unit(F, u);
                 for (int u = F.bx; u < 256; u += F.G) gla_super_unit<false>(F, u); } SEAM(3);
    if (IN(4)) REP(4) { gla_super_scan(F); } SEAM(4);
    if (IN(5)) REP(5) { for (int u = F.bx; u < 256; u += F.G) gla_super_unit<true>(F, u); } SEAM(5);
    if (IN(6)) REP(6) { pg8::StaticOrder So; So.init(T / 256, D / 256, F.G, F.bx);
                 pg8::gemm_phase<false, 0, 0, 0>(F.lds, D, So, pg8::ABDense{WSP(bf16, WS_MIX), WSP(bf16, WS_WOUT), D}, pg8::EpiStoreT{WSP(bf16, WS_Y), D}); } SEAM(6);
    if (IN(7)) REP(7) { p7_norm_router(F); } SEAM(7);
    if (IN(8)) REP(8) { p8_slots(F); } SEAM(8);
    if (IN(9)) REP(9) { const int nM = WSP(int, WS_MOE_OFF)[32] >> 8; pg8::StaticOrder So; So.init(nM, 2048 / 256, F.G, F.bx);
                 pg8::gemm_phase<false, 1, W8_E8M0, H8_E8M0>(F.lds, 512, So, pg8::ABMoe1{WSP(unsigned char, WS_XS), WSP(unsigned char, WS_W1T), WSP(int, WS_TILE_E)},
                                       pg8::EpiSwigluT{WSP(unsigned char, WS_A), F.b_mlp1, WSP(int, WS_TILE_E)}); } SEAM(9);
    if (IN(10)) REP(10) { const int nM = WSP(int, WS_MOE_OFF)[32] >> 8; pg8::StaticOrder So; So.init(nM, D / 256, F.G, F.bx);
                  pg8::gemm_phase<false, 1, W8_E8M0, A8_E8M0>(F.lds, 512, So, pg8::ABMoe2{WSP(unsigned char, WS_A), WSP(unsigned char, WS_W2T), WSP(int, WS_TILE_E)},
                                         pg8::EpiMoe2T{WSP(bf16, WS_YS), F.b_mlp2, WSP(int, WS_TILE_E), WSP(int, WS_SLOT_ASSIGN), WSP(float, WS_SLOT_GATE)}); } SEAM(10);
    if (IN(11)) REP(11) { p11_combine(F); }
#undef IN
#undef SEAM
}

extern "C" void kernel_launch(void* const* d_in, const int* in_sizes, int n_in, void* d_out, int out_size, void* d_ws, size_t ws_size, hipStream_t stream) {
    static int ready = 0;
    if (ready == 0) {
        if (n_in != 20 || out_size != T * D || ws_size < WS_END) { fprintf(stderr, "kernel_launch: unexpected problem (n_in %d, out %d, ws %zu)\n", n_in, out_size, ws_size); ready = -1; return; }
        if (hipFuncSetAttribute((const void*)fwd, hipFuncAttributeMaxDynamicSharedMemorySize, LDS_BYTES) != hipSuccess) { fprintf(stderr, "kernel_launch: hipFuncSetAttribute failed\n"); ready = -1; return; }
        int per_cu = 0;
        if (hipOccupancyMaxActiveBlocksPerMultiprocessor(&per_cu, (const void*)fwd, NTHREADS, LDS_BYTES) != hipSuccess || per_cu < 1) fprintf(stderr, "kernel_launch: occupancy query says %d\n", per_cu);
        (void)hipGetLastError();
        ready = 1;
    }
    if (ready < 0) return;
    (void)hipMemsetAsync((char*)d_ws + WS_CTL, 0, CTL_ZERO_BYTES, stream);
    Args a{};
    for (int i = 0; i < 20; ++i) a.in[i] = (const float*)d_in[i];
    a.out = (float*)d_out; a.ws = (unsigned char*)d_ws;
#if MK_ONE_LAUNCH
    a.ph_lo = 0; a.ph_hi = NPHASE;
    hipLaunchKernelGGL(fwd, dim3(GRID), dim3(NTHREADS), LDS_BYTES, stream, a);
#else
    for (int p = 0; p < NPHASE; ++p) { a.ph_lo = p; a.ph_hi = p + 1; hipLaunchKernelGGL(fwd, dim3(GRID), dim3(NTHREADS), LDS_BYTES, stream, a); }
#endif
}
```

```cpp
#include <hip/hip_runtime.h>
#include <cstdio>
#include <cstdint>

#ifndef MK_ONE_LAUNCH
#define MK_ONE_LAUNCH 1
#endif

#ifndef PROBE_PHASE
#define PROBE_PHASE -1
#endif
#ifndef DUPMASK
#define DUPMASK 0
#endif
#define LAS __attribute__((address_space(3)))
typedef unsigned short bf16;
typedef short bf16x8 __attribute__((ext_vector_type(8)));
typedef short s16x4 __attribute__((ext_vector_type(4)));
typedef float f32x4 __attribute__((ext_vector_type(4)));
typedef unsigned u32x4 __attribute__((ext_vector_type(4)));
typedef unsigned u32x2 __attribute__((ext_vector_type(2)));

constexpr int D = 1024, NB = 2, S = 16384, T = NB * S;
constexpr int INW = 2320, INP = 2560;
constexpr int AQ_OFF = 0, AK_OFF = 512, AV_OFF = 640, GQ_OFF = 768, GK_OFF = 1024, GV_OFF = 1280, GG_OFF = 1792, GA_OFF = 2304;
constexpr int NCH = 256;
constexpr int NE = 32, FF = 1024;
constexpr int NSLOT_MAX = T * 4 + NE * 256;
constexpr float EPS = 1e-6f;
constexpr int NWAVES = 8, NTHREADS = 512, GRID = 256;

constexpr size_t MiB = 1u << 20;
constexpr size_t WS_CTL = 0, CTL_ZERO_BYTES = 1 * MiB;
constexpr size_t WS_MOD = 1 * MiB;
constexpr size_t WS_DECAY = 2 * MiB;
constexpr size_t WS_ROUTE = 3 * MiB;
constexpr size_t WS_TOK_E = WS_ROUTE, WS_TOK_LPOS = WS_ROUTE + 512 * 1024, WS_TOK_GATE = WS_ROUTE + 1024 * 1024;
constexpr size_t WS_BLK_CNT = WS_ROUTE + 1536 * 1024, WS_MOE_OFF = WS_BLK_CNT + 32 * 1024, WS_TILE_E = WS_MOE_OFF + 4096;
constexpr size_t WS_SLOT_ASSIGN = WS_ROUTE + 2 * MiB, WS_SLOT_GATE = WS_ROUTE + 3 * MiB;
constexpr size_t WS_WIN = 8 * MiB, WS_WOUT = 13 * MiB, WS_W2T = 16 * MiB, WS_W1T = 80 * MiB;
constexpr size_t WS_H = 208 * MiB, WS_KV = 272 * MiB, WS_YS = 80 * MiB;
constexpr size_t WS_X1 = 336 * MiB, WS_PROJ = 464 * MiB, WS_MIX = 624 * MiB, WS_Y = 688 * MiB, WS_A = 464 * MiB;
constexpr size_t WS_LIST_A = 752 * MiB, WS_LIST_G = 756 * MiB;
constexpr size_t WS_XS = 608 * MiB;
constexpr size_t WS_END = 760 * MiB;
constexpr int CW_BAR = 4096, CW_GCNT = 8192  , CW_DONE = 8192 + 64 * 32, CW_MOE_CNT = 16384  ;

constexpr int LDS_BYTES = 163840, SMALL_OFF = 132096, MISC_OFF = 131072 + 320;

__device__ __forceinline__ float bf2f(unsigned v) { return __uint_as_float(v << 16); }
__device__ __forceinline__ unsigned f2bf(float f) { unsigned u = __float_as_uint(f); return (u + 0x7fffu + ((u >> 16) & 1u)) >> 16; }
__device__ __forceinline__ unsigned pk2(float lo, float hi) { return f2bf(lo) | (f2bf(hi) << 16); }
__device__ __forceinline__ float wave_sum(float v) {
#pragma unroll
    for (int o = 1; o < 64; o <<= 1) v += __shfl_xor(v, o);
    return v;
}
__device__ __forceinline__ f32x4 unpack4(u32x2 r) { return (f32x4){bf2f(r.x & 0xffffu), bf2f(r.x >> 16), bf2f(r.y & 0xffffu), bf2f(r.y >> 16)}; }
__device__ __forceinline__ float dot4(f32x4 a) { return (a[0] * a[0] + a[1] * a[1]) + (a[2] * a[2] + a[3] * a[3]); }
typedef short v4i16_t __attribute__((ext_vector_type(4)));
__device__ __forceinline__ s16x4 trr(LAS const unsigned char* p) { return __builtin_bit_cast(s16x4, __builtin_amdgcn_ds_read_tr16_b64_v4i16((LAS v4i16_t*)p)); }
__device__ __forceinline__ bf16x8 cat8(s16x4 lo, s16x4 hi) { return __builtin_shufflevector(lo, hi, 0, 1, 2, 3, 4, 5, 6, 7); }
__device__ __forceinline__ bf16x8 pack8(f32x4 a, f32x4 b) { u32x4 w; w.x = pk2(a[0], a[1]); w.y = pk2(a[2], a[3]); w.z = pk2(b[0], b[1]); w.w = pk2(b[2], b[3]); return __builtin_bit_cast(bf16x8, w); }
#define MFMA(a, b, c) __builtin_amdgcn_mfma_f32_16x16x32_bf16((a), (b), (c), 0, 0, 0)
typedef int i32x4 __attribute__((ext_vector_type(4)));
typedef int i32x8 __attribute__((ext_vector_type(8)));
__device__ __forceinline__ float clamp8(float v) { return fminf(fmaxf(v, -448.f), 448.f); }
__device__ __forceinline__ unsigned pk4_fp8(float a, float b, float c, float d) {
    int w = 0; w = __builtin_amdgcn_cvt_pk_fp8_f32(clamp8(a), clamp8(b), w, false); w = __builtin_amdgcn_cvt_pk_fp8_f32(clamp8(c), clamp8(d), w, true); return (unsigned)w; }
constexpr float W8_SCALE = 64.f, H8_SCALE = 16.f, A8_SCALE = 4.f;
constexpr int W8_E8M0 = 0x79797979  , H8_E8M0 = 0x7b7b7b7b  , A8_E8M0 = 0x7d7d7d7d  ;

#define XB_TMO      128
#define XB_XCNT(j)  (256  + 64 * (j))
#define XB_XSUB(j)  (1280 + 64 * (j))
#define XB_XGEN(j)  (2304 + 64 * (j))
#define XB_TOP      3328
#define XB_TOPGEN   3392
#define XCD_BAR_WORDS 3456
#define XB_SPIN_CAP (1u << 18)
__device__ __forceinline__ unsigned xb_ld(unsigned* p)              { return __hip_atomic_load(p, __ATOMIC_RELAXED, __HIP_MEMORY_SCOPE_AGENT); }
__device__ __forceinline__ unsigned xb_add(unsigned* p, unsigned v) { return __hip_atomic_fetch_add(p, v, __ATOMIC_RELAXED, __HIP_MEMORY_SCOPE_AGENT); }
__device__ __forceinline__ unsigned xb_xcc_id() { return (unsigned)__builtin_amdgcn_s_getreg((3 << 11) | 20) & 0xFu; }
#define XB_SPIN(cond, bar) do { unsigned _sp = 0; while (cond) { __builtin_amdgcn_s_sleep(1); \
    if ((++_sp & 255u) == 0u) { if (xb_ld(&(bar)[XB_TMO])) break; if (_sp > XB_SPIN_CAP) { atomicAdd(&(bar)[XB_TMO], 1u); break; } } } } while (0)
struct XcdBarrier { unsigned* bar; unsigned x; volatile LAS unsigned* st; };
__device__ __forceinline__ XcdBarrier xcd_barrier_post(unsigned* bar, volatile LAS unsigned* st) {
    XcdBarrier b; b.bar = bar; b.x = xb_xcc_id(); b.st = st;
    if (threadIdx.x == 0) (void)xb_add(&bar[XB_XCNT(b.x)], 1u);
    return b;
}
__device__ __forceinline__ void xcd_barrier_complete(unsigned* bar, unsigned x, unsigned& nloc, unsigned& nx) {
    const unsigned G = gridDim.x * gridDim.y * gridDim.z;
    unsigned sum, cnt, mine, sp = 0u;
    for (;;) {
        sum = 0u; cnt = 0u; mine = 0u;
#pragma unroll
        for (unsigned j = 0; j < 16; ++j) { const unsigned c = xb_ld(&bar[XB_XCNT(j)]); sum += c; cnt += (c > 0u) ? 1u : 0u; mine = (j == x) ? c : mine; }
        if (sum == G) break;
        __builtin_amdgcn_s_sleep(1);
        if ((++sp & 255u) == 0u) { if (xb_ld(&bar[XB_TMO])) break; if (sp > XB_SPIN_CAP) { atomicAdd(&bar[XB_TMO], 1u); break; } }
    }
    nloc = mine > 0u ? mine : 1u; nx = cnt > 0u ? cnt : 1u;
}
__device__ __forceinline__ void xcd_barrier(const XcdBarrier& b) {
    asm volatile("s_waitcnt vmcnt(0)" ::: "memory");
    __syncthreads();
    if (threadIdx.x == 0) {
        unsigned* bar = b.bar;
        __builtin_amdgcn_s_waitcnt(0);
        unsigned nloc = b.st[0], nx = b.st[1];
        if (nloc == 0u) { xcd_barrier_complete(bar, b.x, nloc, nx); b.st[0] = nloc; b.st[1] = nx; }
        const unsigned old = xb_add(&bar[XB_XSUB(b.x)], 1u);
        const unsigned gen = old / nloc;
        if (old + 1u == (gen + 1u) * nloc) {
            __builtin_amdgcn_fence(__ATOMIC_RELEASE, "agent");
            asm volatile("s_waitcnt vmcnt(0)" ::: "memory");
            const unsigned og = xb_add(&bar[XB_TOP], 1u);
            const unsigned tg = og / nx;
            if (og + 1u == (tg + 1u) * nx) xb_add(&bar[XB_TOPGEN], 1u);
            else XB_SPIN(xb_ld(&bar[XB_TOPGEN]) == tg, bar);
            __builtin_amdgcn_fence(__ATOMIC_ACQUIRE, "agent");
            xb_add(&bar[XB_XGEN(b.x)], 1u);
            asm volatile("s_waitcnt vmcnt(0)" ::: "memory");
        } else {
            XB_SPIN(xb_ld(&bar[XB_XGEN(b.x)]) == gen, bar);
            __builtin_amdgcn_fence(__ATOMIC_ACQUIRE, "agent");
            asm volatile("s_waitcnt vmcnt(0)" ::: "memory");
        }
    }
    __syncthreads();
}

struct Frame {
    LAS unsigned char* lds;
    int tid, lane, wave, bx, G;
    const float *x, *c, *w_ada, *b_ada, *g_pre_mix, *g_post_mix, *g_pre_ffn, *g_post_ffn, *w_in, *w_gate_up, *b_gate, *g_gla_norm, *sinks, *w_out,
                *w_router, *b_router, *w_mlp1, *b_mlp1, *w_mlp2, *b_mlp2;
    float* out;
    unsigned char* ws;
};
#define WSP(type, off) ((type*)(F.ws + (off)))

struct TrItem { const float* W; int N; int k0, n0; unsigned char* WT; int kind; };
__device__ __forceinline__ bool tr_decode(const Frame& F, int it, TrItem& t) {
    constexpr int I_IN = 16 * 80, I_OUT = 16 * 32, I_1 = 16 * 64, I_2 = 16 * 32;
    constexpr int NITEMS = I_IN + I_OUT + NE * I_1 + NE * I_2;
    if (it >= NITEMS) return false;
    int r = it, nblk, item;
    if (r < I_IN) { t.W = F.w_in; t.N = INW; t.WT = F.ws + WS_WIN; t.kind = 0; nblk = 80; item = r; }
    else if ((r -= I_IN) < I_OUT) { t.W = F.w_out; t.N = 1024; t.WT = F.ws + WS_WOUT; t.kind = 0; nblk = 32; item = r; }
    else if ((r -= I_OUT) < NE * I_1) { const int e = r / I_1; t.W = F.w_mlp1 + (size_t)e * 1024 * 2048; t.N = 2048; t.WT = F.ws + WS_W1T + (size_t)e * 2048 * 1024; t.kind = 1; nblk = 64; item = r % I_1; }
    else { r -= NE * I_1; const int e = r / I_2; t.W = F.w_mlp2 + (size_t)e * 1024 * 1024; t.N = 1024; t.WT = F.ws + WS_W2T + (size_t)e * 1024 * 1024; t.kind = 2; nblk = 32; item = r % I_2; }
    t.k0 = 64 * (item / nblk); t.n0 = 32 * (item % nblk);
    return true;
}
__device__ __forceinline__ void tr_load(const TrItem& t, int lane, float (&v)[32]) {
    const int n = t.n0 + (lane & 31); const bool ok = n < t.N; const int nc = ok ? n : t.N - 1;
    const float* wp = t.W + (size_t)(t.k0 + (lane >> 5)) * t.N + nc; const size_t st = (size_t)2 * t.N;
#pragma unroll
    for (int i = 0; i < 32; ++i) v[i] = wp[i * st];
#pragma unroll
    for (int i = 0; i < 32; ++i) v[i] = ok ? v[i] : 0.f;
}
__device__ __forceinline__ void tr_store(const TrItem& t, int lane, const float (&v)[32], LAS float* scr) {
#pragma unroll
    for (int i = 0; i < 32; ++i) scr[(2 * i + (lane >> 5)) * 33 + (lane & 31)] = v[i];
    asm volatile("s_waitcnt lgkmcnt(0)" ::: "memory");
    const int c = lane & 7;
#pragma unroll
    for (int j = 0; j < 4; ++j) { const int nn = (lane >> 3) + 8 * j; const LAS float* s = scr + (8 * c) * 33 + nn;
        float e[8];
#pragma unroll
        for (int q = 0; q < 8; ++q) e[q] = s[q * 33];
        const int n = t.n0 + nn;
        if (t.kind == 0) { u32x4 o; o.x = pk2(e[0], e[1]); o.y = pk2(e[2], e[3]); o.z = pk2(e[4], e[5]); o.w = pk2(e[6], e[7]);
            *(u32x4*)((bf16*)t.WT + (size_t)n * 1024 + t.k0 + 8 * c) = o; }
        else { u32x2 o; o.x = pk4_fp8(e[0] * W8_SCALE, e[1] * W8_SCALE, e[2] * W8_SCALE, e[3] * W8_SCALE); o.y = pk4_fp8(e[4] * W8_SCALE, e[5] * W8_SCALE, e[6] * W8_SCALE, e[7] * W8_SCALE);
            int row = n; if (t.kind == 1) { const int jj = n >> 1; row = 256 * (jj >> 7) + 128 * (n & 1) + (jj & 127); }
            *(u32x2*)(t.WT + (size_t)row * 1024 + t.k0 + 8 * c) = o; } }
    asm volatile("s_waitcnt lgkmcnt(0)" ::: "memory");
}
__device__ __forceinline__ void p0_prologue(const Frame& F) {
    float* mod = WSP(float, WS_MOD);
    if (F.bx < 192) {
        LAS float* red = (LAS float*)(F.lds + 98304);
        const int cl = F.tid & 31, ks = F.tid >> 5, col = F.bx * 32 + cl;
        float a0 = 0.f, a1 = 0.f;
#pragma unroll 8
        for (int k = ks * 64; k < ks * 64 + 64; ++k) {
            const float w = F.w_ada[(size_t)k * 6144 + col];
            const float c0 = F.c[k], c1 = F.c[1024 + k];
            a0 += c0 / (1.f + __expf(-c0)) * w; a1 += c1 / (1.f + __expf(-c1)) * w;
        }
        red[(0 * 16 + ks) * 32 + cl] = a0; red[(1 * 16 + ks) * 32 + cl] = a1;
        __syncthreads();
        if (F.tid < 64) { const int b = F.tid >> 5; float s = 0.f;
#pragma unroll
            for (int i = 0; i < 16; ++i) s += red[(b * 16 + i) * 32 + cl];
            mod[b * 6144 + col] = s + F.b_ada[col]; }
        __syncthreads();
    }
    LAS float* scr = (LAS float*)(F.lds + F.wave * 8704);
    const int gw = F.bx * NWAVES + F.wave, NGW = F.G * NWAVES;
    TrItem cur, nxt; float v[32], nv[32];
    bool have = tr_decode(F, gw, cur);
    if (have) tr_load(cur, F.lane, v);
    for (int it = gw; have; it += NGW) {
        const bool hn = tr_decode(F, it + NGW, nxt);
        if (hn) tr_load(nxt, F.lane, nv);
        tr_store(cur, F.lane, v, scr);
        cur = nxt; have = hn;
#pragma unroll
        for (int i = 0; i < 32; ++i) v[i] = nv[i];
    }
}

__device__ __forceinline__ void p1_norm(const Frame& F) {
    const float* mod = WSP(float, WS_MOD); bf16* h = WSP(bf16, WS_H);
    const int gw = F.bx * NWAVES + F.wave, NGW = F.G * NWAVES;
    f32x4 v[4], nv[4];
#pragma unroll
    for (int j = 0; j < 4; ++j) v[j] = *(const f32x4*)(F.x + (size_t)gw * D + 4 * F.lane + 256 * j);
    for (int m = gw; m < T; m += NGW) {
        const int b = m >> 14; const float* modb = mod + b * 6144;
        const int mn = (m + NGW < T) ? m + NGW : m;
        f32x4 g[4], sc[4], sh[4];
#pragma unroll
        for (int j = 0; j < 4; ++j) { const int idx = 4 * F.lane + 256 * j;
            nv[j] = *(const f32x4*)(F.x + (size_t)mn * D + idx);
            g[j] = *(const f32x4*)(F.g_pre_mix + idx); sc[j] = *(const f32x4*)(modb + 1024 + idx); sh[j] = *(const f32x4*)(modb + idx); }
        float ss = 0.f;
#pragma unroll
        for (int j = 0; j < 4; ++j) ss += dot4(v[j]);
        const float r = rsqrtf(wave_sum(ss) * (1.f / D) + EPS);
#pragma unroll
        for (int j = 0; j < 4; ++j) { const int idx = 4 * F.lane + 256 * j;
            const f32x4 hv = v[j] * r * g[j] * (sc[j] + 1.f) + sh[j];
            u32x2 o; o.x = pk2(hv[0], hv[1]); o.y = pk2(hv[2], hv[3]);
            *(u32x2*)(h + (size_t)m * D + idx) = o; v[j] = nv[j]; }
    }
}

template <class Epi, class RowMap, class BSel>
__device__ __forceinline__ void simple_gemm(const Frame& F, const bf16* A, int lda, int M, int N, int K, const RowMap& rm, const BSel& bs, const Epi& E) {
    const int fr = F.lane & 15, fq = F.lane >> 4;
    const int ncg = N / 512, nbt = (M / 64) * ncg;
    for (int bt = F.bx; bt < nbt; bt += F.G) {
        const int mt = bt / ncg, cg = bt % ncg, m0 = mt * 64, n0 = cg * 512 + F.wave * 64;
        const bf16* Bt = bs(m0);
        const bf16* ap[4]; const bf16* bp[4];
#pragma unroll
        for (int i = 0; i < 4; ++i) { ap[i] = A + (size_t)rm(m0 + 16 * i + fr) * lda + 8 * fq; bp[i] = Bt + (size_t)(n0 + 16 * i + fr) * K + 8 * fq; }
        f32x4 acc[4][4];
#pragma unroll
        for (int i = 0; i < 4; ++i)
#pragma unroll
            for (int j = 0; j < 4; ++j) acc[i][j] = (f32x4){0.f, 0.f, 0.f, 0.f};
#pragma unroll 2
        for (int k0 = 0; k0 < K; k0 += 32) {
            bf16x8 a[4], b[4];
#pragma unroll
            for (int i = 0; i < 4; ++i) { a[i] = *(const bf16x8*)(ap[i] + k0); b[i] = *(const bf16x8*)(bp[i] + k0); }
#pragma unroll
            for (int i = 0; i < 4; ++i)
#pragma unroll
                for (int j = 0; j < 4; ++j) acc[i][j] = MFMA(b[j], a[i], acc[i][j]);
        }
#pragma unroll
        for (int i = 0; i < 4; ++i)
#pragma unroll
            for (int j = 0; j < 4; ++j) E(m0 + 16 * i + fr, n0 + 16 * j + 4 * fq, acc[i][j]);
    }
}
struct RowId { __device__ __forceinline__ int operator()(int m) const { return m; } };
struct RowGather { const int* slot_assign; __device__ __forceinline__ int operator()(int m) const { const int a = slot_assign[m]; return a < 0 ? 0 : (a >> 2); } };
struct BFixed { const bf16* Bt; __device__ __forceinline__ const bf16* operator()(int) const { return Bt; } };
struct BExpert { const bf16* Bt; const int* tile_e; size_t stride; __device__ __forceinline__ const bf16* operator()(int m0) const { return Bt + (size_t)tile_e[m0 >> 8] * stride; } };
struct EpiStore { bf16* O; int ldo;
    __device__ __forceinline__ void operator()(int m, int n, f32x4 v) const { u32x2 w; w.x = pk2(v[0], v[1]); w.y = pk2(v[2], v[3]); *(u32x2*)(O + (size_t)m * ldo + n) = w; } };
__device__ __forceinline__ float swiglu(float g, float l) {
    const float xg = fminf(g, 7.f), xl = fminf(fmaxf(l, -7.f), 7.f);
    return xg / (1.f + __expf(-1.702f * xg)) * (xl + 1.f);
}
struct EpiSwiglu { bf16* Aout; const float* b1; const int* tile_e;
    __device__ __forceinline__ void operator()(int m, int n, f32x4 v) const {
        const int e = tile_e[m >> 8]; const f32x4 bb = *(const f32x4*)(b1 + (size_t)e * 2048 + n);
        const float a0 = swiglu(v[0] + bb[0], v[1] + bb[1]), a1 = swiglu(v[2] + bb[2], v[3] + bb[3]);
        *(unsigned*)(Aout + (size_t)m * FF + (n >> 1)) = pk2(a0, a1); } };
struct EpiMoe2 { bf16* ys; const float* b2; const int* tile_e; const int* slot_assign; const float* slot_gate;
    __device__ __forceinline__ void operator()(int m, int n, f32x4 v) const {
        const int asg = slot_assign[m]; if (asg < 0) return;
        const int e = tile_e[m >> 8]; const f32x4 bb = *(const f32x4*)(b2 + (size_t)e * D + n); const float g = slot_gate[m];
        u32x2 w; w.x = pk2((v[0] + bb[0]) * g, (v[1] + bb[1]) * g); w.y = pk2((v[2] + bb[2]) * g, (v[3] + bb[3]) * g);
        *(u32x2*)(ys + (size_t)asg * D + n) = w; } };

namespace pg8 {
constexpr int BM = 256, BK = 64, HALF = 128, HTB = HALF * BK * 2, NXCD = 8, WGM = 8;
__device__ __forceinline__ int lds_byte(int r, int c) { const int st = (r >> 4) * 2 + (c >> 5), rr = r & 15, cc = c & 31, ob = rr * 64 + cc * 2; return st * 1024 + (ob ^ (((ob >> 9) & 1) << 5)); }
__device__ __forceinline__ void stage_rc(int b, int& R, int& C) { const int st = b / 1024, sb = b % 1024, swz = sb ^ (((sb >> 9) & 1) << 5); R = (st >> 1) * 16 + swz / 64; C = (st & 1) * 32 + (swz % 64) / 2; }
__device__ __forceinline__ int perm32(int rho) { const int n = rho >> 4, i = rho & 15; return 8 * (i >> 2) + 4 * n + (i & 3); }
struct Unit { int pm, pn; };
struct StaticOrder {
    int nM, nN, nwg, G, c;
    __device__ __forceinline__ void init(int nM_, int nN_, int G_, int c_) { nM = nM_; nN = nN_; nwg = nM * nN; G = G_; c = c_; }
    __device__ __forceinline__ bool next(int i, Unit& u) const {
        const long L = (long)i * G + c; if (L >= nwg) return false;
        int wgid = (int)L; { const int q = nwg / NXCD, r = nwg % NXCD, xcd = wgid % NXCD, off = wgid / NXCD; wgid = (xcd < r ? xcd * (q + 1) : r * (q + 1) + (xcd - r) * q) + off; }
        const int nig = WGM * nN, gid = wgid / nig, fm = gid * WGM, gsz = (nM - fm) < WGM ? (nM - fm) : WGM;
        u.pm = fm + ((wgid % nig) % gsz); u.pn = (wgid % nig) / gsz; return true;
    }
};
template <bool GATHER, int FP8, int SCW, int SCX, class Epi, class Sched, class AB>
__device__ __forceinline__ void gemm_phase(LAS unsigned char* lds, const int K, const Sched& S, const AB& ab, const Epi& E) {
    const int tid = threadIdx.x, wid = __builtin_amdgcn_readfirstlane(tid >> 6), lane = tid & 63, wr = wid >> 2, wc = wid & 3, fr = lane & 15, fq = lane >> 4;
    const int nt = K / BK;
    int sR[2], sC[2]; unsigned voffB[2], vA[2][2], nvA[2][2];
#pragma unroll
    for (int i = 0; i < 2; ++i) { int R, C; stage_rc(tid * 16 + i * 8192, R, C); sR[i] = R; sC[i] = C; const int Rb = (R & ~31) + perm32(R & 31); voffB[i] = (unsigned)(Rb * K + C) * 2u; }
    const size_t kstep = (size_t)(BK * 2);
    const size_t hstep = (size_t)HALF * K * 2;
    const unsigned ldsw = (unsigned)wid * 1024u;
    const int aoff = lds_byte(wr * 64 + fr, fq * 8), boff = lds_byte(wc * 32 + fr, fq * 8);
#define PG8_SA(b, h) (((b) * 2 + (h)) * HTB)
#define PG8_SB(b, h) ((4 + (b) * 2 + (h)) * HTB)
#define PG8_STAGE(bufoff, gbase, voff) do { _Pragma("unroll") for (int _i = 0; _i < 2; ++_i) \
        __builtin_amdgcn_global_load_lds((const unsigned*)((const char*)(gbase) + (voff)[_i]), (LAS unsigned*)(lds + (bufoff) + ldsw + _i * 8192), 16, 0, 0); } while (0)
#define PG8_LDA(dst, b, h) do { _Pragma("unroll") for (int m = 0; m < 4; ++m) _Pragma("unroll") for (int k = 0; k < 2; ++k) dst[m][k] = *(const LAS bf16x8*)(lds + PG8_SA(b, h) + aoff + m * 2048 + k * 1024); } while (0)
#define PG8_LDB(dst, b, h) do { _Pragma("unroll") for (int n = 0; n < 2; ++n) _Pragma("unroll") for (int k = 0; k < 2; ++k) dst[n][k] = *(const LAS bf16x8*)(lds + PG8_SB(b, h) + boff + n * 2048 + k * 1024); } while (0)
#define PG8_C8(x) __builtin_shufflevector(__builtin_bit_cast(i32x4, (x)[0]), __builtin_bit_cast(i32x4, (x)[1]), 0, 1, 2, 3, 4, 5, 6, 7)
#define PG8_MMA(ai, bj, At, Bt) do { __builtin_amdgcn_s_setprio(1); _Pragma("unroll") for (int m = 0; m < 4; ++m) _Pragma("unroll") for (int n = 0; n < 2; ++n) { \
        if (FP8) asm volatile("v_mfma_scale_f32_16x16x128_f8f6f4 %0, %1, %2, %0, %3, %4 op_sel_hi:[0,0,0]" : "+v"(acc[ai][bj][m][n]) : "v"(PG8_C8(Bt[n])), "v"(PG8_C8(At[m])), "v"(scw), "v"(scx)); \
        else { _Pragma("unroll") for (int k = 0; k < 2; ++k) asm volatile("v_mfma_f32_16x16x32_bf16 %0, %1, %2, %0" : "+v"(acc[ai][bj][m][n]) : "v"(Bt[n][k]), "v"(At[m][k])); } } \
        __builtin_amdgcn_s_setprio(0); } while (0)
#define PG8_WAIT_V(n) asm volatile("s_waitcnt vmcnt(" #n ")" ::: "memory")
#define PG8_WAIT_L(n) asm volatile("s_waitcnt lgkmcnt(" #n ")" ::: "memory")
#define PG8_BAR __builtin_amdgcn_s_barrier()
#define PG8_SCHED __builtin_amdgcn_sched_barrier(0)
#define PG8_AOFF(dst, u) do { _Pragma("unroll") for (int _h = 0; _h < 2; ++_h) _Pragma("unroll") for (int _i = 0; _i < 2; ++_i) \
        dst[_h][_i] = GATHER ? (unsigned)(ab.a_row((u), _h * HALF + sR[_i]) * K + sC[_i]) * 2u : (unsigned)((_h * HALF + sR[_i]) * K + sC[_i]) * 2u; } while (0)
    Unit cur, nxt; int ui = 0;
    if (!S.next(0, cur)) return;
    const int scw = SCW, scx = SCX;
    f32x4 acc[2][2][4][2];
#pragma unroll
    for (int a = 0; a < 2; ++a)
#pragma unroll
        for (int b = 0; b < 2; ++b)
#pragma unroll
            for (int m = 0; m < 4; ++m)
#pragma unroll
                for (int n = 0; n < 2; ++n) acc[a][b][m][n] = (f32x4){0.f, 0.f, 0.f, 0.f};
    bf16x8 At[4][2], B0[2][2], B1[2][2];
    const char* cA = ab.a_base(cur); const char* cB = ab.b_base(cur);
    PG8_AOFF(vA, cur);
    PG8_STAGE(PG8_SB(0, 0), cB, voffB); PG8_STAGE(PG8_SB(0, 1), cB + hstep, voffB); PG8_STAGE(PG8_SA(0, 0), cA, vA[0]); PG8_STAGE(PG8_SA(0, 1), cA, vA[1]);
    if (wr == 1) PG8_BAR;
    PG8_WAIT_V(2); PG8_BAR;
    PG8_STAGE(PG8_SB(1, 0), cB + kstep, voffB); PG8_STAGE(PG8_SA(1, 0), cA + kstep, vA[0]); PG8_STAGE(PG8_SB(1, 1), cB + hstep + kstep, voffB);
    PG8_WAIT_V(6); PG8_BAR;
    for (;;) {
        const bool has_next = S.next(ui + 1, nxt);
        const char* nA = has_next ? ab.a_base(nxt) : cA; const char* nB = has_next ? ab.b_base(nxt) : cB;
        if (GATHER) { if (has_next) { PG8_AOFF(nvA, nxt); } else {
#pragma unroll
            for (int h = 0; h < 2; ++h)
#pragma unroll
                for (int i = 0; i < 2; ++i) nvA[h][i] = vA[h][i]; } }
#pragma unroll 1
        for (int t = 0; t < nt; t += 2) {
            const bool last = (t == nt - 2);
            const char* a1 = cA + (size_t)(t + 1) * kstep;
            const char* a2 = last ? nA : cA + (size_t)(t + 2) * kstep; const char* b2 = last ? nB : cB + (size_t)(t + 2) * kstep;
            const char* a3 = a2 + kstep; const char* b3 = b2 + kstep;
            unsigned o2[2][2];
#pragma unroll
            for (int h = 0; h < 2; ++h)
#pragma unroll
                for (int i = 0; i < 2; ++i) o2[h][i] = (GATHER && last) ? nvA[h][i] : vA[h][i];
            PG8_LDB(B0, 0, 0); PG8_LDB(B1, 0, 1); PG8_SCHED; PG8_LDA(At, 0, 0); PG8_STAGE(PG8_SA(1, 1), a1, vA[1]);
            PG8_WAIT_V(8); PG8_WAIT_L(0); PG8_BAR; PG8_MMA(0, 0, At, B0); PG8_MMA(0, 1, At, B1); PG8_BAR; PG8_SCHED;
            PG8_LDA(At, 0, 1); PG8_STAGE(PG8_SB(0, 0), b2, voffB); PG8_STAGE(PG8_SB(0, 1), b2 + hstep, voffB); PG8_STAGE(PG8_SA(0, 0), a2, o2[0]);
            PG8_WAIT_V(8); PG8_WAIT_L(0); PG8_BAR; PG8_MMA(1, 0, At, B0); PG8_MMA(1, 1, At, B1); PG8_BAR; PG8_SCHED;
            PG8_LDB(B0, 1, 0); PG8_LDB(B1, 1, 1); PG8_SCHED; PG8_LDA(At, 1, 0); PG8_STAGE(PG8_SA(0, 1), a2, o2[1]);
            PG8_WAIT_V(8); PG8_WAIT_L(0); PG8_BAR; PG8_MMA(0, 0, At, B0); PG8_MMA(0, 1, At, B1); PG8_BAR; PG8_SCHED;
            PG8_LDA(At, 1, 1); PG8_STAGE(PG8_SB(1, 0), b3, voffB); PG8_STAGE(PG8_SB(1, 1), b3 + hstep, voffB); PG8_STAGE(PG8_SA(1, 0), a3, o2[0]);
            PG8_WAIT_V(8); PG8_WAIT_L(0); PG8_BAR; PG8_MMA(1, 0, At, B0); PG8_MMA(1, 1, At, B1); PG8_BAR; PG8_SCHED;
        }
        if (wr == 0) PG8_BAR;
        asm volatile("s_nop 15\n\ts_nop 15" ::: "memory");
        E(acc, cur, wr, wc, fr, fq);
        if (!has_next) break;
#pragma unroll
        for (int a = 0; a < 2; ++a)
#pragma unroll
            for (int b = 0; b < 2; ++b)
#pragma unroll
                for (int m = 0; m < 4; ++m)
#pragma unroll
                    for (int n = 0; n < 2; ++n) acc[a][b][m][n] = (f32x4){0.f, 0.f, 0.f, 0.f};
        cur = nxt; cA = nA; cB = nB; ++ui;
        if (GATHER) {
#pragma unroll
            for (int h = 0; h < 2; ++h)
#pragma unroll
                for (int i = 0; i < 2; ++i) vA[h][i] = nvA[h][i]; }
        if (wr == 1) PG8_BAR;
    }
    PG8_WAIT_V(0);
    PG8_BAR;
#undef PG8_SA
#undef PG8_SB
#undef PG8_STAGE
#undef PG8_LDA
#undef PG8_LDB
#undef PG8_MMA
#undef PG8_C8
#undef PG8_WAIT_V
#undef PG8_WAIT_L
#undef PG8_BAR
#undef PG8_SCHED
#undef PG8_AOFF
}
__device__ __forceinline__ unsigned cvt_pk_bf16(float lo, float hi) { unsigned r; asm volatile("v_cvt_pk_bf16_f32 %0, %1, %2" : "=v"(r) : "v"(lo), "v"(hi)); return r; }
struct ABDense { const bf16* A; const bf16* Bt; int K;
    __device__ __forceinline__ const char* a_base(const Unit& u) const { return (const char*)(A + (size_t)u.pm * BM * K); }
    __device__ __forceinline__ const char* b_base(const Unit& u) const { return (const char*)(Bt + (size_t)u.pn * BM * K); }
    __device__ __forceinline__ int a_row(const Unit&, int) const { return 0; } };
struct EpiStoreT { bf16* O; int ldo;
    __device__ __forceinline__ void operator()(const f32x4 (&acc)[2][2][4][2], const Unit& u, int wr, int wc, int fr, int fq) const {
        const int row0 = u.pm * BM + wr * 64 + fr, col0 = u.pn * BM + wc * 32 + 8 * fq;
#pragma unroll
        for (int ai = 0; ai < 2; ++ai)
#pragma unroll
            for (int m = 0; m < 4; ++m) { bf16* rowp = O + (size_t)(row0 + ai * HALF + m * 16) * ldo + col0;
#pragma unroll
                for (int bj = 0; bj < 2; ++bj) { const f32x4 v0 = acc[ai][bj][m][0], v1 = acc[ai][bj][m][1];
                    u32x4 w; w.x = cvt_pk_bf16(v0[0], v0[1]); w.y = cvt_pk_bf16(v0[2], v0[3]); w.z = cvt_pk_bf16(v1[0], v1[1]); w.w = cvt_pk_bf16(v1[2], v1[3]);
                    *(u32x4*)(rowp + bj * HALF) = w; } }
    } };
struct ABMoe1 { const unsigned char* H; const unsigned char* W; const int* tile_e; const int* moe_off; const unsigned* moe_cnt; const int* list_a;
    __device__ __forceinline__ const char* a_base(const Unit&) const { return (const char*)H; }
    __device__ __forceinline__ const char* b_base(const Unit& u) const { return (const char*)(W + (size_t)tile_e[u.pm] * 2048 * 1024 + (size_t)u.pn * BM * 1024); }
    __device__ __forceinline__ int a_row(const Unit& u, int rt) const { const int e = tile_e[u.pm]; const int pos = u.pm * BM + rt - moe_off[e];
        const int pc = pos < (int)moe_cnt[e] ? pos : 0; const int a = list_a[(size_t)e * T + pc]; return pos < (int)moe_cnt[e] ? (a >> 2) : 0; } };
struct ABMoe2 { const unsigned char* A; const unsigned char* W; const int* tile_e;
    __device__ __forceinline__ const char* a_base(const Unit& u) const { return (const char*)(A + (size_t)u.pm * BM * 1024); }
    __device__ __forceinline__ const char* b_base(const Unit& u) const { return (const char*)(W + (size_t)tile_e[u.pm] * 1024 * 1024 + (size_t)u.pn * BM * 1024); }
    __device__ __forceinline__ int a_row(const Unit&, int) const { return 0; } };
struct EpiSwigluT { unsigned char* Aout; const float* b1; const int* tile_e;
    __device__ __forceinline__ void operator()(const f32x4 (&acc)[2][2][4][2], const Unit& u, int wr, int wc, int fr, int fq) const {
        const int row0 = u.pm * BM + wr * 64 + fr, j0 = u.pn * HALF + wc * 32 + 8 * fq;
        const float* bp = b1 + (size_t)tile_e[u.pm] * 2048 + 2 * j0;
        f32x4 bb[4];
#pragma unroll
        for (int q = 0; q < 4; ++q) bb[q] = *(const f32x4*)(bp + 4 * q);
#pragma unroll
        for (int ai = 0; ai < 2; ++ai)
#pragma unroll
            for (int m = 0; m < 4; ++m) {
                const f32x4 g0 = acc[ai][0][m][0], g1 = acc[ai][0][m][1], l0 = acc[ai][1][m][0], l1 = acc[ai][1][m][1];
                u32x2 w;
                w.x = pk4_fp8(swiglu(g0[0] + bb[0][0], l0[0] + bb[0][1]) * A8_SCALE, swiglu(g0[1] + bb[0][2], l0[1] + bb[0][3]) * A8_SCALE,
                              swiglu(g0[2] + bb[1][0], l0[2] + bb[1][1]) * A8_SCALE, swiglu(g0[3] + bb[1][2], l0[3] + bb[1][3]) * A8_SCALE);
                w.y = pk4_fp8(swiglu(g1[0] + bb[2][0], l1[0] + bb[2][1]) * A8_SCALE, swiglu(g1[1] + bb[2][2], l1[1] + bb[2][3]) * A8_SCALE,
                              swiglu(g1[2] + bb[3][0], l1[2] + bb[3][1]) * A8_SCALE, swiglu(g1[3] + bb[3][2], l1[3] + bb[3][3]) * A8_SCALE);
                *(u32x2*)(Aout + (size_t)(row0 + ai * HALF + m * 16) * FF + j0) = w; }
    } };
struct EpiMoe2T { bf16* ys; const float* b2; const int* tile_e; const int* moe_off; const unsigned* moe_cnt; const int* list_a; const float* list_g;
    __device__ __forceinline__ void operator()(const f32x4 (&acc)[2][2][4][2], const Unit& u, int wr, int wc, int fr, int fq) const {
        const int e = tile_e[u.pm], cnt = (int)moe_cnt[e], pos0 = u.pm * BM - moe_off[e] + wr * 64 + fr, col0 = u.pn * BM + wc * 32 + 8 * fq;
        const float* bp = b2 + (size_t)e * D + col0;
        f32x4 bv[2][2];
#pragma unroll
        for (int bj = 0; bj < 2; ++bj)
#pragma unroll
            for (int n = 0; n < 2; ++n) bv[bj][n] = *(const f32x4*)(bp + bj * HALF + 4 * n);
        int asgv[2][4]; float gv[2][4];
#pragma unroll
        for (int ai = 0; ai < 2; ++ai)
#pragma unroll
            for (int m = 0; m < 4; ++m) { const int pos = pos0 + ai * HALF + m * 16; const int pc = pos < cnt ? pos : 0;
                const int a = list_a[(size_t)e * T + pc]; gv[ai][m] = list_g[(size_t)e * T + pc]; asgv[ai][m] = pos < cnt ? a : -1; }
#pragma unroll
        for (int ai = 0; ai < 2; ++ai)
#pragma unroll
            for (int m = 0; m < 4; ++m) { const int asg = asgv[ai][m]; const float g = gv[ai][m];
                if (asg >= 0) { bf16* rowp = ys + (size_t)asg * D + col0;
#pragma unroll
                    for (int bj = 0; bj < 2; ++bj) { const f32x4 v0 = (acc[ai][bj][m][0] + bv[bj][0]) * g, v1 = (acc[ai][bj][m][1] + bv[bj][1]) * g;
                        u32x4 w; w.x = cvt_pk_bf16(v0[0], v0[1]); w.y = cvt_pk_bf16(v0[2], v0[3]); w.z = cvt_pk_bf16(v1[0], v1[1]); w.w = cvt_pk_bf16(v1[2], v1[3]);
                        *(u32x4*)(rowp + bj * HALF) = w; } } }
    } };
}

__device__ __forceinline__ void attn_unit(const Frame& F, int u) {
    const int qblk = u & 127, kvh = (u >> 7) & 1, b = u >> 8;
    LAS unsigned char* Ks = F.lds; LAS unsigned char* Vs = F.lds + 256 * 144;
    const bf16* proj = WSP(bf16, WS_PROJ); bf16* mix = WSP(bf16, WS_MIX);
    const int tok0 = b * S + qblk * 128;
#pragma unroll
    for (int i = 0; i < 4; ++i) {
        const int cid = F.tid + 512 * i, row = cid >> 3, ch = cid & 7;
        u32x4 kv = (u32x4){0u, 0u, 0u, 0u}, vv = (u32x4){0u, 0u, 0u, 0u};
        if (qblk > 0 || row >= 128) {
            const bf16* rp = proj + (size_t)(tok0 - 128 + row) * INP;
            kv = *(const u32x4*)(rp + AK_OFF + kvh * 64 + ch * 8);
            vv = *(const u32x4*)(rp + AV_OFF + kvh * 64 + ch * 8);
        }
        *(LAS u32x4*)(Ks + row * 144 + ch * 16) = kv;
        *(LAS u32x4*)(Vs + row * 144 + ch * 16) = vv;
    }
    __syncthreads();
    const int g = F.wave >> 1, hw = F.wave & 1, hq = kvh * 4 + g;
    const int lane = F.lane, fr = lane & 15, fq = lane >> 4;
    const float sink = F.sinks[hq];
    const float NEG_INF = -__builtin_inff();
    const bf16* qbase = proj + (size_t)(tok0 + 64 * hw + fr) * INP + AQ_OFF + hq * 64 + 8 * fq;
    bf16x8 nq0 = *(const bf16x8*)qbase, nq1 = *(const bf16x8*)(qbase + 32);
    for (int qb = 0; qb < 4; ++qb) {
        const int i = 64 * hw + 16 * qb + fr;
        const bf16x8 q0 = nq0, q1 = nq1;
        { const bf16* qn = qbase + (size_t)(16 * (qb < 3 ? qb + 1 : qb)) * INP; nq0 = *(const bf16x8*)qn; nq1 = *(const bf16x8*)(qn + 32); }
        f32x4 st[12];
#pragma unroll
        for (int kt = 0; kt < 12; ++kt) {
            LAS const unsigned char* kp = Ks + (64 * hw + 16 * kt + fr) * 144 + fq * 16;
            const bf16x8 k0 = *(LAS const bf16x8*)kp, k1 = *(LAS const bf16x8*)(kp + 64);
            f32x4 z = (f32x4){0.f, 0.f, 0.f, 0.f}; z = MFMA(k0, q0, z); z = MFMA(k1, q1, z); st[kt] = z;
        }
        float mx = NEG_INF;
#pragma unroll
        for (int kt = 0; kt < 12; ++kt)
#pragma unroll
            for (int r = 0; r < 4; ++r) {
                const int j = 64 * hw + 16 * kt + 4 * fq + r, rel = i + 128 - j;
                const bool ok = (rel >= 0) && (rel < 128) && (qblk > 0 || j >= 128);
                const float s = ok ? st[kt][r] * 0.125f : NEG_INF;
                st[kt][r] = s; mx = fmaxf(mx, s);
            }
        mx = fmaxf(mx, __shfl_xor(mx, 16)); mx = fmaxf(mx, __shfl_xor(mx, 32)); mx = fmaxf(mx, sink);
        float sum = 0.f;
#pragma unroll
        for (int kt = 0; kt < 12; ++kt)
#pragma unroll
            for (int r = 0; r < 4; ++r) { const float p = __expf(st[kt][r] - mx); st[kt][r] = p; sum += p; }
        sum += __shfl_xor(sum, 16); sum += __shfl_xor(sum, 32); sum += __expf(sink - mx);
        const float inv = 1.f / sum;
        f32x4 o[4];
#pragma unroll
        for (int c = 0; c < 4; ++c) o[c] = (f32x4){0.f, 0.f, 0.f, 0.f};
#pragma unroll
        for (int ks = 0; ks < 6; ++ks) {
            const bf16x8 pf = pack8(st[2 * ks], st[2 * ks + 1]);
            const int rb = 64 * hw + 32 * ks + 4 * fq + (fr >> 2);
#pragma unroll
            for (int c = 0; c < 4; ++c) {
                LAS const unsigned char* vp = Vs + rb * 144 + (16 * c + 4 * (lane & 3)) * 2;
                const bf16x8 vf = cat8(trr(vp), trr(vp + 16 * 144));
                o[c] = MFMA(pf, vf, o[c]);
            }
        }
#pragma unroll
        for (int r = 0; r < 4; ++r) {
            const int qrow = 4 * fq + r; const float iv = __shfl(inv, qrow);
            bf16* op = mix + (size_t)(tok0 + 64 * hw + 16 * qb + qrow) * D + hq * 64 + fr;
#pragma unroll
            for (int c = 0; c < 4; ++c) op[16 * c] = (bf16)f2bf(o[c][r] * iv);
        }
    }
    __syncthreads();
}

__device__ __forceinline__ void gla_gate_prefix(const Frame& F, const bf16* proj, int t0, int h, LAS float* ga_s, LAS float* tot_s, float (&bv)[8], float& b_mid, float& b_last) {
#pragma unroll
    for (int i = 0; i < 2; ++i) { const int idx = F.tid + 512 * i, t = idx >> 4, r = idx & 15; ga_s[idx] = bf2f(proj[(size_t)(t0 + t) * INP + GA_OFF + r]); }
    float wu[16];
#pragma unroll
    for (int r = 0; r < 16; ++r) wu[r] = F.w_gate_up[r * 256 + h * 64 + F.lane];
    const float bg = F.b_gate[h * 64 + F.lane];
    __syncthreads();
    float run = 0.f;
#pragma unroll
    for (int i = 0; i < 8; ++i) {
        const int t = 8 * F.wave + i; float z = bg;
#pragma unroll
        for (int r = 0; r < 16; ++r) z += ga_s[t * 16 + r] * wu[r];
        const float ls = fminf(z, 0.f) - __logf(1.f + __expf(-fabsf(z)));
        run += ls * (1.f / 16.f); bv[i] = run;
    }
    tot_s[F.wave * 64 + F.lane] = run;
    __syncthreads();
    float pre = 0.f, mid = 0.f, all = 0.f;
#pragma unroll
    for (int w = 0; w < 8; ++w) { const float tv = tot_s[w * 64 + F.lane]; pre += (w < F.wave) ? tv : 0.f; mid += (w < 4) ? tv : 0.f; all += tv; }
#pragma unroll
    for (int i = 0; i < 8; ++i) bv[i] += pre;
    b_mid = mid; b_last = all;
}
__device__ __forceinline__ void gla_kv_unit(const Frame& F, int u) {
    const int h = u & 3, n = (u >> 2) & 255, b = u >> 10, t0 = b * S + n * 64;
    const bf16* proj = WSP(bf16, WS_PROJ);
    LAS unsigned char* kd_s = F.lds; LAS unsigned char* v_s = F.lds + 9216;
    LAS float* ga_s = (LAS float*)(F.lds + 26624); LAS float* tot_s = (LAS float*)(F.lds + 30720);
    const int lane = F.lane, fr = lane & 15, fq = lane >> 4;
#pragma unroll
    for (int i = 0; i < 2; ++i) { const int cid = F.tid + 512 * i, row = cid >> 4, ch = cid & 15;
        *(LAS u32x4*)(v_s + row * 272 + ch * 16) = *(const u32x4*)(proj + (size_t)(t0 + row) * INP + GV_OFF + h * 128 + ch * 8); }
    float bv[8], b_mid, b_last;
    gla_gate_prefix(F, proj, t0, h, ga_s, tot_s, bv, b_mid, b_last);
#pragma unroll
    for (int i = 0; i < 8; ++i) { const int t = 8 * F.wave + i;
        const float kx = bf2f(proj[(size_t)(t0 + t) * INP + GK_OFF + h * 64 + lane]);
        *(LAS bf16*)(kd_s + t * 144 + lane * 2) = (bf16)f2bf(kx * __expf(b_last - bv[i])); }
    if (F.wave == 0) WSP(float, WS_DECAY)[((size_t)(b * NCH + n) * 4 + h) * 64 + lane] = __expf(b_last);
    __syncthreads();
    const int c = F.wave;
    f32x4 acc[4];
#pragma unroll
    for (int d = 0; d < 4; ++d) acc[d] = (f32x4){0.f, 0.f, 0.f, 0.f};
#pragma unroll
    for (int ks = 0; ks < 2; ++ks) {
        const int rb = 32 * ks + 8 * fq + (fr >> 2);
        LAS const unsigned char* vp = v_s + rb * 272 + (16 * c + 4 * (lane & 3)) * 2;
        const bf16x8 vf = cat8(trr(vp), trr(vp + 4 * 272));
#pragma unroll
        for (int d = 0; d < 4; ++d) {
            LAS const unsigned char* kp = kd_s + rb * 144 + (16 * d + 4 * (lane & 3)) * 2;
            const bf16x8 kf = cat8(trr(kp), trr(kp + 4 * 144));
            acc[d] = MFMA(kf, vf, acc[d]);
        }
    }
    float* kvp = WSP(float, WS_KV) + (((size_t)(b * NCH + n) * 4 + h) * 128 + 16 * c + fr) * 64;
#pragma unroll
    for (int d = 0; d < 4; ++d) *(f32x4*)(kvp + 16 * d + 4 * fq) = acc[d];
    __syncthreads();
}
__device__ __forceinline__ void gla_scan(const Frame& F) {
    float* kv = WSP(float, WS_KV); const float* decay = WSP(float, WS_DECAY);
    if (F.tid >= 256) return;
    for (int idx = F.bx * 256 + F.tid; idx < 65536; idx += F.G * 256) {
        const int b = idx >> 15, h = (idx >> 13) & 3, dvdk = idx & 8191, dk = idx & 63;
        float* p = kv + ((size_t)(b * NCH) * 4 + h) * 8192 + dvdk;
        const float* dp = decay + ((size_t)(b * NCH) * 4 + h) * 64 + dk;
        float state = 0.f;
        for (int n = 0; n < NCH; n += 8) {
            float tv[8], dv[8];
#pragma unroll
            for (int i = 0; i < 8; ++i) { tv[i] = p[(size_t)(n + i) * 4 * 8192]; dv[i] = dp[(size_t)(n + i) * 4 * 64]; }
#pragma unroll
            for (int i = 0; i < 8; ++i) { p[(size_t)(n + i) * 4 * 8192] = state; state = dv[i] * state + tv[i]; }
        }
    }
}
__device__ __forceinline__ void gla_out_unit(const Frame& F, int u) {
    const int h = u & 3, n = (u >> 2) & 255, b = u >> 10, t0 = b * S + n * 64;
    const bf16* proj = WSP(bf16, WS_PROJ); bf16* mix = WSP(bf16, WS_MIX);
    LAS unsigned char* qd_s = F.lds; LAS unsigned char* kk_s = F.lds + 9216; LAS unsigned char* qe_s = F.lds + 18432;
    LAS unsigned char* v_s = F.lds + 27648; LAS unsigned char* st_s = F.lds + 45056;
    LAS float* ga_s = (LAS float*)(F.lds + 63488); LAS float* tot_s = (LAS float*)(F.lds + 67584); LAS float* ssq_s = (LAS float*)(F.lds + 69632);
    const int lane = F.lane, fr = lane & 15, fq = lane >> 4;
#pragma unroll
    for (int i = 0; i < 2; ++i) { const int cid = F.tid + 512 * i, row = cid >> 4, ch = cid & 15;
        *(LAS u32x4*)(v_s + row * 272 + ch * 16) = *(const u32x4*)(proj + (size_t)(t0 + row) * INP + GV_OFF + h * 128 + ch * 8); }
    const float* stg = WSP(float, WS_KV) + ((size_t)(b * NCH + n) * 4 + h) * 8192;
#pragma unroll
    for (int i = 0; i < 4; ++i) { const int i4 = F.tid + 512 * i, dv = i4 >> 4, dk4 = (i4 & 15) * 4;
        const f32x4 sv = *(const f32x4*)(stg + dv * 64 + dk4);
        u32x2 w; w.x = pk2(sv[0], sv[1]); w.y = pk2(sv[2], sv[3]);
        *(LAS u32x2*)(st_s + dv * 144 + dk4 * 2) = w; }
    float bv[8], b_mid, b_last;
    gla_gate_prefix(F, proj, t0, h, ga_s, tot_s, bv, b_mid, b_last);
#pragma unroll
    for (int i = 0; i < 8; ++i) { const int t = 8 * F.wave + i; const bf16* rp = proj + (size_t)(t0 + t) * INP + h * 64 + lane;
        const float qx = bf2f(rp[GQ_OFF]) * 0.125f, kx = bf2f(rp[GK_OFF]);
        *(LAS bf16*)(qd_s + t * 144 + lane * 2) = (bf16)f2bf(qx * __expf(bv[i] - b_mid));
        *(LAS bf16*)(kk_s + t * 144 + lane * 2) = (bf16)f2bf(kx * __expf(b_mid - bv[i]));
        *(LAS bf16*)(qe_s + t * 144 + lane * 2) = (bf16)f2bf(qx * __expf(bv[i])); }
    __syncthreads();
    const int ib = F.wave >> 1, dvh = F.wave & 1;
    bf16x8 qdf[2], qef[2];
#pragma unroll
    for (int ks = 0; ks < 2; ++ks) { qdf[ks] = *(LAS const bf16x8*)(qd_s + (16 * ib + fr) * 144 + (32 * ks + 8 * fq) * 2);
                                     qef[ks] = *(LAS const bf16x8*)(qe_s + (16 * ib + fr) * 144 + (32 * ks + 8 * fq) * 2); }
    f32x4 at[4];
#pragma unroll
    for (int jt = 0; jt < 4; ++jt) {
        LAS const unsigned char* kp = kk_s + (16 * jt + fr) * 144 + (8 * fq) * 2;
        const bf16x8 k0 = *(LAS const bf16x8*)kp, k1 = *(LAS const bf16x8*)(kp + 64);
        f32x4 z = (f32x4){0.f, 0.f, 0.f, 0.f}; z = MFMA(k0, qdf[0], z); z = MFMA(k1, qdf[1], z);
#pragma unroll
        for (int r = 0; r < 4; ++r) if (16 * jt + 4 * fq + r > 16 * ib + fr) z[r] = 0.f;
        at[jt] = z;
    }
    bf16x8 pf[2];
    pf[0] = pack8(at[0], at[1]); pf[1] = pack8(at[2], at[3]);
    f32x4 o[4];
#pragma unroll
    for (int c = 0; c < 4; ++c) {
        const int dvt = 4 * dvh + c; f32x4 z = (f32x4){0.f, 0.f, 0.f, 0.f};
#pragma unroll
        for (int ks = 0; ks < 2; ++ks) {
            const int rb = 32 * ks + 4 * fq + (fr >> 2);
            LAS const unsigned char* vp = v_s + rb * 272 + (16 * dvt + 4 * (lane & 3)) * 2;
            z = MFMA(pf[ks], cat8(trr(vp), trr(vp + 16 * 272)), z);
        }
#pragma unroll
        for (int ks = 0; ks < 2; ++ks) {
            const bf16x8 sf = *(LAS const bf16x8*)(st_s + (16 * dvt + fr) * 144 + (32 * ks + 8 * fq) * 2);
            z = MFMA(qef[ks], sf, z);
        }
        o[c] = z;
    }
    float ssq[4];
#pragma unroll
    for (int r = 0; r < 4; ++r) { float s = 0.f;
#pragma unroll
        for (int c = 0; c < 4; ++c) s += o[c][r] * o[c][r];
        s += __shfl_xor(s, 1); s += __shfl_xor(s, 2); s += __shfl_xor(s, 4); s += __shfl_xor(s, 8);
        ssq[r] = s; if (fr == 0) ssq_s[F.wave * 16 + 4 * fq + r] = s; }
    __syncthreads();
#pragma unroll
    for (int r = 0; r < 4; ++r) {
        const float tot = ssq[r] + ssq_s[(F.wave ^ 1) * 16 + 4 * fq + r];
        const float rinv = rsqrtf(tot * (1.f / 128.f) + EPS);
        const int t = t0 + 16 * ib + 4 * fq + r;
#pragma unroll
        for (int c = 0; c < 4; ++c) { const int dv = 16 * (4 * dvh + c) + fr;
            const float gg = bf2f(proj[(size_t)t * INP + GG_OFF + h * 128 + dv]);
            const float val = o[c][r] * rinv * F.g_gla_norm[dv] * (gg / (1.f + __expf(-gg)));
            mix[(size_t)t * D + 512 + h * 128 + dv] = (bf16)f2bf(val); }
    }
    __syncthreads();
}

template <bool OUT>
__device__ __forceinline__ void gla_super_unit(const Frame& F, int u) {
    const int sc = u & 31, h = (u >> 5) & 3, b = u >> 7;
    const bf16* proj = WSP(bf16, WS_PROJ); bf16* mix = WSP(bf16, WS_MIX);
    LAS unsigned char* qd_s = F.lds; LAS unsigned char* kk_s = F.lds + 9216; LAS unsigned char* qe_s = F.lds + 18432;
    LAS unsigned char* v_s = F.lds + 27648; LAS unsigned char* st_s = F.lds + 45056; LAS unsigned char* kd_s = F.lds + 63488;
    LAS float* ga_s = (LAS float*)(F.lds + 72704); LAS float* tot_s = (LAS float*)(F.lds + 76800); LAS float* ssq_s = (LAS float*)(F.lds + 78848); LAS float* dec_s = (LAS float*)(F.lds + 79360);
    const int lane = F.lane, fr = lane & 15, fq = lane >> 4;
    const int ib = F.wave >> 1, dvh = F.wave & 1;
    float wu[16];
#pragma unroll
    for (int r = 0; r < 16; ++r) wu[r] = F.w_gate_up[r * 256 + h * 64 + lane];
    const float bg = F.b_gate[h * 64 + lane];
    float gn[4];
#pragma unroll
    for (int cc = 0; cc < 4; ++cc) gn[cc] = OUT ? F.g_gla_norm[16 * (4 * dvh + cc) + fr] : 0.f;
    float* Sg = WSP(float, WS_KV) + (size_t)u * 8192 + (16 * F.wave + fr) * 64 + 4 * fq;
    f32x4 St[4];
#pragma unroll
    for (int d = 0; d < 4; ++d) St[d] = OUT ? *(const f32x4*)(Sg + 16 * d) : (f32x4){0.f, 0.f, 0.f, 0.f};
    float ltot = 0.f;
    u32x4 v_r[2]; unsigned ga_r[2], k_r[8], q_r[8], gg_r[16];
#define GLA_LOAD_CHUNK(tc0) do { \
        _Pragma("unroll") for (int i = 0; i < 2; ++i) { const int cid = F.tid + 512 * i, row = cid >> 4, ch = cid & 15; v_r[i] = *(const u32x4*)(proj + (size_t)((tc0) + row) * INP + GV_OFF + h * 128 + ch * 8); } \
        _Pragma("unroll") for (int i = 0; i < 2; ++i) { const int idx = F.tid + 512 * i, t = idx >> 4, r = idx & 15; ga_r[i] = proj[(size_t)((tc0) + t) * INP + GA_OFF + r]; } \
        _Pragma("unroll") for (int i = 0; i < 8; ++i) { const bf16* rp = proj + (size_t)((tc0) + 8 * F.wave + i) * INP + h * 64 + lane; k_r[i] = rp[GK_OFF]; if (OUT) q_r[i] = rp[GQ_OFF]; } \
        if (OUT) { _Pragma("unroll") for (int r = 0; r < 4; ++r) _Pragma("unroll") for (int cc = 0; cc < 4; ++cc) \
            gg_r[r * 4 + cc] = proj[(size_t)((tc0) + 16 * ib + 4 * fq + r) * INP + GG_OFF + h * 128 + 16 * (4 * dvh + cc) + fr]; } } while (0)
    const int tu0 = b * S + sc * 512;
    GLA_LOAD_CHUNK(tu0);
    for (int c = 0; c < 8; ++c) {
        const int t0 = tu0 + c * 64;
#pragma unroll
        for (int i = 0; i < 2; ++i) { const int cid = F.tid + 512 * i, row = cid >> 4, ch = cid & 15; *(LAS u32x4*)(v_s + row * 272 + ch * 16) = v_r[i]; }
#pragma unroll
        for (int i = 0; i < 2; ++i) ga_s[F.tid + 512 * i] = bf2f(ga_r[i]);
        float kx[8], qx[8], ggf[16];
#pragma unroll
        for (int i = 0; i < 8; ++i) { kx[i] = bf2f(k_r[i]); qx[i] = OUT ? bf2f(q_r[i]) * 0.125f : 0.f; }
#pragma unroll
        for (int i = 0; i < 16; ++i) ggf[i] = OUT ? bf2f(gg_r[i]) : 0.f;
        if (c < 7) GLA_LOAD_CHUNK(t0 + 64);
        __syncthreads();
        float bv[8]; float run = 0.f;
#pragma unroll
        for (int i = 0; i < 8; ++i) {
            const int t = 8 * F.wave + i; float z = bg;
#pragma unroll
            for (int r = 0; r < 16; ++r) z += ga_s[t * 16 + r] * wu[r];
            const float ls = fminf(z, 0.f) - __logf(1.f + __expf(-fabsf(z)));
            run += ls * (1.f / 16.f); bv[i] = run;
        }
        tot_s[F.wave * 64 + lane] = run;
        if (OUT) {
#pragma unroll
            for (int d = 0; d < 4; ++d) { u32x2 w; w.x = pk2(St[d][0], St[d][1]); w.y = pk2(St[d][2], St[d][3]);
                *(LAS u32x2*)(st_s + (16 * F.wave + fr) * 144 + (16 * d + 4 * fq) * 2) = w; }
        }
        __syncthreads();
        float pre = 0.f, b_mid = 0.f, b_last = 0.f;
#pragma unroll
        for (int w = 0; w < 8; ++w) { const float tv = tot_s[w * 64 + lane]; pre += (w < F.wave) ? tv : 0.f; b_mid += (w < 4) ? tv : 0.f; b_last += tv; }
        ltot += b_last;
#pragma unroll
        for (int i = 0; i < 8; ++i) { const int t = 8 * F.wave + i; const float bb = bv[i] + pre;
            *(LAS bf16*)(kd_s + t * 144 + lane * 2) = (bf16)f2bf(kx[i] * __expf(b_last - bb));
            if (OUT) {
                *(LAS bf16*)(qd_s + t * 144 + lane * 2) = (bf16)f2bf(qx[i] * __expf(bb - b_mid));
                *(LAS bf16*)(kk_s + t * 144 + lane * 2) = (bf16)f2bf(kx[i] * __expf(b_mid - bb));
                *(LAS bf16*)(qe_s + t * 144 + lane * 2) = (bf16)f2bf(qx[i] * __expf(bb)); } }
        if (F.wave == 0) dec_s[lane] = __expf(b_last);
        __syncthreads();
        if (OUT) {
            bf16x8 qdf[2], qef[2];
#pragma unroll
            for (int ks = 0; ks < 2; ++ks) { qdf[ks] = *(LAS const bf16x8*)(qd_s + (16 * ib + fr) * 144 + (32 * ks + 8 * fq) * 2);
                                             qef[ks] = *(LAS const bf16x8*)(qe_s + (16 * ib + fr) * 144 + (32 * ks + 8 * fq) * 2); }
            f32x4 at[4];
#pragma unroll
            for (int jt = 0; jt < 4; ++jt) {
                LAS const unsigned char* kp = kk_s + (16 * jt + fr) * 144 + (8 * fq) * 2;
                const bf16x8 k0 = *(LAS const bf16x8*)kp, k1 = *(LAS const bf16x8*)(kp + 64);
                f32x4 z = (f32x4){0.f, 0.f, 0.f, 0.f}; z = MFMA(k0, qdf[0], z); z = MFMA(k1, qdf[1], z);
#pragma unroll
                for (int r = 0; r < 4; ++r) if (16 * jt + 4 * fq + r > 16 * ib + fr) z[r] = 0.f;
                at[jt] = z;
            }
            bf16x8 pf[2];
            pf[0] = pack8(at[0], at[1]); pf[1] = pack8(at[2], at[3]);
            f32x4 o[4];
#pragma unroll
            for (int cc = 0; cc < 4; ++cc) {
                const int dvt = 4 * dvh + cc; f32x4 z = (f32x4){0.f, 0.f, 0.f, 0.f};
#pragma unroll
                for (int ks = 0; ks < 2; ++ks) {
                    const int rb = 32 * ks + 4 * fq + (fr >> 2);
                    LAS const unsigned char* vp = v_s + rb * 272 + (16 * dvt + 4 * (lane & 3)) * 2;
                    z = MFMA(pf[ks], cat8(trr(vp), trr(vp + 16 * 272)), z);
                }
#pragma unroll
                for (int ks = 0; ks < 2; ++ks) {
                    const bf16x8 sf = *(LAS const bf16x8*)(st_s + (16 * dvt + fr) * 144 + (32 * ks + 8 * fq) * 2);
                    z = MFMA(qef[ks], sf, z);
                }
                o[cc] = z;
            }
            float ssq[4];
#pragma unroll
            for (int r = 0; r < 4; ++r) { float sq = 0.f;
#pragma unroll
                for (int cc = 0; cc < 4; ++cc) sq += o[cc][r] * o[cc][r];
                sq += __shfl_xor(sq, 1); sq += __shfl_xor(sq, 2); sq += __shfl_xor(sq, 4); sq += __shfl_xor(sq, 8);
                ssq[r] = sq; if (fr == 0) ssq_s[F.wave * 16 + 4 * fq + r] = sq; }
            __syncthreads();
#pragma unroll
            for (int r = 0; r < 4; ++r) {
                const float tot = ssq[r] + ssq_s[(F.wave ^ 1) * 16 + 4 * fq + r];
                const float rinv = rsqrtf(tot * (1.f / 128.f) + EPS);
                const int t = t0 + 16 * ib + 4 * fq + r;
#pragma unroll
                for (int cc = 0; cc < 4; ++cc) { const int dv = 16 * (4 * dvh + cc) + fr;
                    const float gg = ggf[r * 4 + cc];
                    const float val = o[cc][r] * rinv * gn[cc] * (gg / (1.f + __expf(-gg)));
                    mix[(size_t)t * D + 512 + h * 128 + dv] = (bf16)f2bf(val); }
            }
        }
#pragma unroll
        for (int d = 0; d < 4; ++d) { const f32x4 dc = *(LAS const f32x4*)(dec_s + 16 * d + 4 * fq); St[d] = St[d] * dc; }
#pragma unroll
        for (int ks = 0; ks < 2; ++ks) {
            const int rb = 32 * ks + 8 * fq + (fr >> 2);
            LAS const unsigned char* vp = v_s + rb * 272 + (16 * F.wave + 4 * (lane & 3)) * 2;
            const bf16x8 vf = cat8(trr(vp), trr(vp + 4 * 272));
#pragma unroll
            for (int d = 0; d < 4; ++d) {
                LAS const unsigned char* kp = kd_s + rb * 144 + (16 * d + 4 * (lane & 3)) * 2;
                St[d] = MFMA(cat8(trr(kp), trr(kp + 4 * 144)), vf, St[d]);
            }
        }
        __syncthreads();
    }
#undef GLA_LOAD_CHUNK
    if (!OUT) {
#pragma unroll
        for (int d = 0; d < 4; ++d) *(f32x4*)(Sg + 16 * d) = St[d];
        if (F.wave == 0) WSP(float, WS_DECAY)[u * 64 + lane] = __expf(ltot);
    }
}
__device__ __forceinline__ void gla_super_scan(const Frame& F) {
    float* kv = WSP(float, WS_KV); const float* decay = WSP(float, WS_DECAY);
    if (F.tid >= 256) return;
    for (int idx = F.bx * 256 + F.tid; idx < 65536; idx += F.G * 256) {
        const int bh = idx >> 13, dvdk = idx & 8191, dk = idx & 63;
        float* p = kv + (size_t)(bh * 32) * 8192 + dvdk; const float* dp = decay + (bh * 32) * 64 + dk;
        float tv[32], dv[32];
#pragma unroll
        for (int i = 0; i < 32; ++i) { tv[i] = p[(size_t)i * 8192]; dv[i] = dp[i * 64]; }
        float state = 0.f;
#pragma unroll
        for (int i = 0; i < 32; ++i) { p[(size_t)i * 8192] = state; state = dv[i] * state + tv[i]; }
    }
}

__device__ __forceinline__ void p7_norm_router(const Frame& F) {
    const float* mod = WSP(float, WS_MOD); const bf16* y = WSP(bf16, WS_Y); float* x1 = WSP(float, WS_X1); unsigned char* h2 = WSP(unsigned char, WS_H);
    unsigned* ctl = WSP(unsigned, WS_CTL);
    LAS float* wr_s = (LAS float*)F.lds;
    LAS float* lg_s = (LAS float*)(F.lds + SMALL_OFF);
    LAS float* rx_s = (LAS float*)(F.lds + SMALL_OFF + 16384);
    LAS float* z_s = (LAS float*)(F.lds + SMALL_OFF + 16384 + 512);
    LAS int* cnt_s = (LAS int*)(F.lds + SMALL_OFF + 16384 + 640);
    LAS int* base_s = (LAS int*)(F.lds + SMALL_OFF + 16384 + 768);
    LAS float* zr_s = (LAS float*)(F.lds + SMALL_OFF + 16384 + 1024);
    LAS int* flag_s = (LAS int*)(F.lds + SMALL_OFF + 16384 + 1024 + 2048);
    const int lane = F.lane, fr = lane & 15, fq = lane >> 4;
    const int mb0 = F.bx * 128 + F.wave * 16;
    const float* modb = mod + (mb0 >> 14) * 6144;
#pragma unroll 4
    for (int i = 0; i < 16; ++i) { const int i4 = F.tid + 512 * i, k = i4 >> 3, e0 = (i4 & 7) * 4;
        const f32x4 w = *(const f32x4*)(F.w_router + k * 32 + e0);
        const float gs = F.g_pre_ffn[k] * (1.f + modb[4096 + k]);
        LAS float* dst = wr_s + (k >> 2) * 128 + e0 * 4 + (k & 3);
        dst[0] = w[0] * gs; dst[4] = w[1] * gs; dst[8] = w[2] * gs; dst[12] = w[3] * gs; }
    { const int e = F.tid & 31, ks = F.tid >> 5; float zz = 0.f;
#pragma unroll 8
        for (int k = ks * 64; k < ks * 64 + 64; ++k) zz += modb[3072 + k] * F.w_router[k * 32 + e];
        zr_s[ks * 32 + e] = zz; }
    if (F.tid < 32) cnt_s[F.tid] = 0;
    __syncthreads();
    if (F.tid < 32) { float zz = F.b_router[F.tid];
#pragma unroll
        for (int i = 0; i < 16; ++i) zz += zr_s[i * 32 + F.tid];
        z_s[F.tid] = zz; }
    u32x2 yr[4], nyr[4]; f32x4 xr[4], nxr[4];
#pragma unroll
    for (int j = 0; j < 4; ++j) { yr[j] = *(const u32x2*)(y + (size_t)mb0 * D + 4 * lane + 256 * j); xr[j] = *(const f32x4*)(F.x + (size_t)mb0 * D + 4 * lane + 256 * j); }
    for (int it = 0; it < 16; ++it) {
        const int m = mb0 + it, mn = mb0 + (it < 15 ? it + 1 : it);
        f32x4 xv[4], hv[4], pg[4], pgt[4], pg2[4], psc[4], psh[4];
#pragma unroll
        for (int j = 0; j < 4; ++j) { const int idx = 4 * lane + 256 * j;
            nyr[j] = *(const u32x2*)(y + (size_t)mn * D + idx); nxr[j] = *(const f32x4*)(F.x + (size_t)mn * D + idx);
            pg[j] = *(const f32x4*)(F.g_post_mix + idx); pgt[j] = *(const f32x4*)(modb + 2048 + idx); pg2[j] = *(const f32x4*)(F.g_pre_ffn + idx);
            psc[j] = *(const f32x4*)(modb + 4096 + idx); psh[j] = *(const f32x4*)(modb + 3072 + idx); }
        float ss = 0.f;
#pragma unroll
        for (int j = 0; j < 4; ++j) { hv[j] = unpack4(yr[j]); ss += dot4(hv[j]); }
        const float ry = rsqrtf(wave_sum(ss) * (1.f / D) + EPS);
        float s2 = 0.f;
#pragma unroll
        for (int j = 0; j < 4; ++j) { xv[j] = xr[j] + pgt[j] * (hv[j] * ry * pg[j]); s2 += dot4(xv[j]); }
        const float rx = rsqrtf(wave_sum(s2) * (1.f / D) + EPS);
        if (lane == 0) rx_s[F.wave * 16 + it] = rx;
#pragma unroll
        for (int j = 0; j < 4; ++j) { const int idx = 4 * lane + 256 * j;
            hv[j] = xv[j] * rx * pg2[j] * (psc[j] + 1.f) + psh[j];
            *(f32x4*)(x1 + (size_t)m * D + idx) = xv[j];
            *(unsigned*)(h2 + (size_t)m * D + idx) = pk4_fp8(hv[j][0] * H8_SCALE, hv[j][1] * H8_SCALE, hv[j][2] * H8_SCALE, hv[j][3] * H8_SCALE);
            yr[j] = nyr[j]; xr[j] = nxr[j]; }
    }
    asm volatile("s_waitcnt vmcnt(0)" ::: "memory");
    f32x4 acc0 = (f32x4){0.f, 0.f, 0.f, 0.f}, acc1 = (f32x4){0.f, 0.f, 0.f, 0.f};
    { const float* ap = x1 + (size_t)(mb0 + fr) * D + 4 * fq;
        LAS const float* bp = wr_s + fq * 128 + fr * 4;
        for (int s0 = 0; s0 < 64; s0 += 8) {
            f32x4 a[8];
#pragma unroll
            for (int q = 0; q < 8; ++q) a[q] = *(const f32x4*)(ap + 16 * (s0 + q));
#pragma unroll
            for (int q = 0; q < 8; ++q) { const f32x4 b0 = *(LAS const f32x4*)(bp + (s0 + q) * 512), b1 = *(LAS const f32x4*)(bp + (s0 + q) * 512 + 64);
#pragma unroll
                for (int t = 0; t < 4; ++t) { acc0 = __builtin_amdgcn_mfma_f32_16x16x4f32(a[q][t], b0[t], acc0, 0, 0, 0); acc1 = __builtin_amdgcn_mfma_f32_16x16x4f32(a[q][t], b1[t], acc1, 0, 0, 0); } }
        } }
    __syncthreads();
#pragma unroll
    for (int r = 0; r < 4; ++r) { const float rx = rx_s[F.wave * 16 + 4 * fq + r];
        lg_s[(F.wave * 16 + 4 * fq + r) * 32 + fr] = rx * acc0[r] + z_s[fr];
        lg_s[(F.wave * 16 + 4 * fq + r) * 32 + fr + 16] = rx * acc1[r] + z_s[fr + 16]; }
    const float NEG_INF = -__builtin_inff();
    int se[4], lp[4]; float gt[4];
    if (lane < 16) {
        float v[32];
#pragma unroll
        for (int ch = 0; ch < 8; ++ch) { const f32x4 w = *(LAS const f32x4*)(lg_s + (F.wave * 16 + lane) * 32 + 4 * ch); v[4 * ch] = w[0]; v[4 * ch + 1] = w[1]; v[4 * ch + 2] = w[2]; v[4 * ch + 3] = w[3]; }
        float sv[4];
#pragma unroll
        for (int r = 0; r < 4; ++r) { float best = v[0]; int bi = 0;
#pragma unroll
            for (int e = 1; e < 32; ++e) if (v[e] > best) { best = v[e]; bi = e; }
            se[r] = bi; sv[r] = best;
#pragma unroll
            for (int e = 0; e < 32; ++e) v[e] = (e == bi) ? NEG_INF : v[e]; }
        const float p1 = __expf(sv[1] - sv[0]), p2 = __expf(sv[2] - sv[0]), p3 = __expf(sv[3] - sv[0]);
        const float rs = 1.f / (1.f + p1 + p2 + p3);
        gt[0] = rs; gt[1] = p1 * rs; gt[2] = p2 * rs; gt[3] = p3 * rs;
#pragma unroll
        for (int r = 0; r < 4; ++r) lp[r] = __hip_atomic_fetch_add(cnt_s + se[r], 1, __ATOMIC_RELAXED, __HIP_MEMORY_SCOPE_WORKGROUP);
    }
    __syncthreads();
    if (F.tid < 32) base_s[F.tid] = (int)__hip_atomic_fetch_add(ctl + CW_GCNT + 64 * F.tid, (unsigned)cnt_s[F.tid], __ATOMIC_RELAXED, __HIP_MEMORY_SCOPE_AGENT);
    __syncthreads();
    if (lane < 16) { int* la = WSP(int, WS_LIST_A); float* lgt = WSP(float, WS_LIST_G); const int m = mb0 + lane;
#pragma unroll
        for (int r = 0; r < 4; ++r) { const size_t p = (size_t)se[r] * T + base_s[se[r]] + lp[r]; la[p] = m * 4 + r; lgt[p] = gt[r]; } }
    asm volatile("s_waitcnt vmcnt(0)" ::: "memory");
    __syncthreads();
    if (F.tid == 0) flag_s[0] = (__hip_atomic_fetch_add(ctl + CW_DONE, 1u, __ATOMIC_RELAXED, __HIP_MEMORY_SCOPE_AGENT) == (unsigned)(F.G - 1)) ? 1 : 0;
    __syncthreads();
    if (flag_s[0]) {
        LAS int* off_s = (LAS int*)zr_s;
        if (F.tid < 32) { const int c = (int)__hip_atomic_load(ctl + CW_GCNT + 64 * F.tid, __ATOMIC_RELAXED, __HIP_MEMORY_SCOPE_AGENT); cnt_s[F.tid] = c; ctl[CW_MOE_CNT + F.tid] = (unsigned)c; }
        __syncthreads();
        if (F.tid == 0) { int off = 0; for (int e = 0; e < 32; ++e) { off_s[e] = off; off += (cnt_s[e] + 255) & ~255; } off_s[32] = off; }
        __syncthreads();
        if (F.tid <= 32) WSP(int, WS_MOE_OFF)[F.tid] = off_s[F.tid];
        const int ntile = off_s[32] >> 8;
        for (int rt = F.tid; rt < ntile; rt += NTHREADS) { int e = 0;
            for (int q = 1; q < 32; ++q) e = (off_s[q] <= rt * 256) ? q : e;
            WSP(int, WS_TILE_E)[rt] = e; }
    }
}

__device__ __forceinline__ void p11_combine(const Frame& F) {
    const float* mod = WSP(float, WS_MOD); const bf16* ys = WSP(bf16, WS_YS); const float* x1 = WSP(float, WS_X1);
    const int gw = F.bx * NWAVES + F.wave, NGW = F.G * NWAVES, lane = F.lane;
    u32x2 yr[4][4], nyr[4][4]; f32x4 xr[4], nxr[4];
#pragma unroll
    for (int j = 0; j < 4; ++j) { xr[j] = *(const f32x4*)(x1 + (size_t)gw * D + 4 * lane + 256 * j);
#pragma unroll
        for (int k4 = 0; k4 < 4; ++k4) yr[j][k4] = *(const u32x2*)(ys + ((size_t)gw * 4 + k4) * D + 4 * lane + 256 * j); }
    for (int m = gw; m < T; m += NGW) {
        const int b = m >> 14; const float* modb = mod + b * 6144;
        const int mn = (m + NGW < T) ? m + NGW : m;
        f32x4 g[4], gt[4];
#pragma unroll
        for (int j = 0; j < 4; ++j) { const int idx = 4 * lane + 256 * j;
            nxr[j] = *(const f32x4*)(x1 + (size_t)mn * D + idx);
#pragma unroll
            for (int k4 = 0; k4 < 4; ++k4) nyr[j][k4] = *(const u32x2*)(ys + ((size_t)mn * 4 + k4) * D + idx);
            g[j] = *(const f32x4*)(F.g_post_ffn + idx); gt[j] = *(const f32x4*)(modb + 5120 + idx); }
        f32x4 yv[4]; float ss = 0.f;
#pragma unroll
        for (int j = 0; j < 4; ++j) { f32x4 a = (f32x4){0.f, 0.f, 0.f, 0.f};
#pragma unroll
            for (int k4 = 0; k4 < 4; ++k4) a += unpack4(yr[j][k4]);
            yv[j] = a; ss += dot4(a); }
        const float ry = rsqrtf(wave_sum(ss) * (1.f / D) + EPS);
#pragma unroll
        for (int j = 0; j < 4; ++j) { const int idx = 4 * lane + 256 * j;
            *(f32x4*)(F.out + (size_t)m * D + idx) = xr[j] + gt[j] * (yv[j] * ry * g[j]);
            xr[j] = nxr[j];
#pragma unroll
            for (int k4 = 0; k4 < 4; ++k4) yr[j][k4] = nyr[j][k4]; }
    }
}

constexpr int NPHASE = 11;
struct Args { const float* in[20]; float* out; unsigned char* ws; int ph_lo, ph_hi; };
__global__ void __launch_bounds__(NTHREADS, 2) fwd(Args args) {
    extern __shared__ __attribute__((aligned(16))) unsigned char lds[];
    Frame F;
    F.lds = (LAS unsigned char*)lds;
    F.tid = threadIdx.x; F.lane = F.tid & 63; F.wave = __builtin_amdgcn_readfirstlane(F.tid >> 6); F.bx = blockIdx.x; F.G = gridDim.x;
    F.x = args.in[0]; F.c = args.in[1]; F.w_ada = args.in[2]; F.b_ada = args.in[3]; F.g_pre_mix = args.in[4]; F.g_post_mix = args.in[5];
    F.g_pre_ffn = args.in[6]; F.g_post_ffn = args.in[7]; F.w_in = args.in[8]; F.w_gate_up = args.in[9]; F.b_gate = args.in[10]; F.g_gla_norm = args.in[11];
    F.sinks = args.in[12]; F.w_out = args.in[13]; F.w_router = args.in[14]; F.b_router = args.in[15]; F.w_mlp1 = args.in[16]; F.b_mlp1 = args.in[17];
    F.w_mlp2 = args.in[18]; F.b_mlp2 = args.in[19]; F.out = args.out; F.ws = args.ws;
    volatile LAS unsigned* MISC = (volatile LAS unsigned*)(F.lds + MISC_OFF);
    if (F.tid < 32) MISC[F.tid] = 0u;
    __syncthreads();
    const int lo = args.ph_lo, hi = args.ph_hi;
    XcdBarrier bar; bar.bar = (unsigned*)(F.ws + WS_CTL) + CW_BAR; bar.x = 0; bar.st = nullptr;
    if (hi - lo > 1) bar = xcd_barrier_post((unsigned*)(F.ws + WS_CTL) + CW_BAR, MISC + 8);
#define IN(k) (lo <= (k) && (k) < hi)
#if DUPMASK
#define REP(k) _Pragma("nounroll") for (int rep_ = 0; rep_ < 1 + ((DUPMASK >> (k)) & 1); ++rep_, __syncthreads())
#else
#define REP(k)
#endif
#define SEAM(k) do { if (IN(k) && IN((k) + 1)) xcd_barrier(bar); } while (0)

    if (IN(0)) REP(0) { p0_prologue(F); } SEAM(0);
    if (IN(1)) REP(1) { p1_norm(F); } SEAM(1);
    if (IN(2)) REP(2) { pg8::StaticOrder So; So.init(T / 256, INP / 256, F.G, F.bx);
                 pg8::gemm_phase<false, 0, 0, 0>(F.lds, D, So, pg8::ABDense{WSP(bf16, WS_H), WSP(bf16, WS_WIN), D}, pg8::EpiStoreT{WSP(bf16, WS_PROJ), INP}); } SEAM(2);
    if (IN(3)) REP(3) { for (int u = F.bx; u < 512; u += F.G) attn_unit(F, u);
                 for (int u = F.bx; u < 256; u += F.G) gla_super_unit<false>(F, u); } SEAM(3);
    if (IN(4)) REP(4) { gla_super_scan(F); } SEAM(4);
    if (IN(5)) REP(5) { for (int u = F.bx; u < 256; u += F.G) gla_super_unit<true>(F, u); } SEAM(5);
    if (IN(6)) REP(6) { pg8::StaticOrder So; So.init(T / 256, D / 256, F.G, F.bx);
                 pg8::gemm_phase<false, 0, 0, 0>(F.lds, D, So, pg8::ABDense{WSP(bf16, WS_MIX), WSP(bf16, WS_WOUT), D}, pg8::EpiStoreT{WSP(bf16, WS_Y), D}); } SEAM(6);
    if (IN(7)) REP(7) { p7_norm_router(F); } SEAM(7);
    if (IN(8)) REP(8) { const int nM = WSP(int, WS_MOE_OFF)[32] >> 8; pg8::StaticOrder So; So.init(nM, 2048 / 256, F.G, F.bx);
                 pg8::gemm_phase<true, 1, W8_E8M0, H8_E8M0>(F.lds, 512, So, pg8::ABMoe1{WSP(unsigned char, WS_H), WSP(unsigned char, WS_W1T), WSP(int, WS_TILE_E), WSP(int, WS_MOE_OFF), WSP(unsigned, WS_CTL) + CW_MOE_CNT, WSP(int, WS_LIST_A)},
                                       pg8::EpiSwigluT{WSP(unsigned char, WS_A), F.b_mlp1, WSP(int, WS_TILE_E)}); } SEAM(8);
    if (IN(9)) REP(9) { const int nM = WSP(int, WS_MOE_OFF)[32] >> 8; pg8::StaticOrder So; So.init(nM, D / 256, F.G, F.bx);
                  pg8::gemm_phase<false, 1, W8_E8M0, A8_E8M0>(F.lds, 512, So, pg8::ABMoe2{WSP(unsigned char, WS_A), WSP(unsigned char, WS_W2T), WSP(int, WS_TILE_E)},
                                         pg8::EpiMoe2T{WSP(bf16, WS_YS), F.b_mlp2, WSP(int, WS_TILE_E), WSP(int, WS_MOE_OFF), WSP(unsigned, WS_CTL) + CW_MOE_CNT, WSP(int, WS_LIST_A), WSP(float, WS_LIST_G)}); } SEAM(9);
    if (IN(10)) REP(10) { p11_combine(F); }
#undef IN
#undef SEAM
}

extern "C" void kernel_launch(void* const* d_in, const int* in_sizes, int n_in, void* d_out, int out_size, void* d_ws, size_t ws_size, hipStream_t stream) {
    static int ready = 0;
    if (ready == 0) {
        if (n_in != 20 || out_size != T * D || ws_size < WS_END) { fprintf(stderr, "kernel_launch: unexpected problem (n_in %d, out %d, ws %zu)\n", n_in, out_size, ws_size); ready = -1; return; }
        if (hipFuncSetAttribute((const void*)fwd, hipFuncAttributeMaxDynamicSharedMemorySize, LDS_BYTES) != hipSuccess) { fprintf(stderr, "kernel_launch: hipFuncSetAttribute failed\n"); ready = -1; return; }
        int per_cu = 0;
        if (hipOccupancyMaxActiveBlocksPerMultiprocessor(&per_cu, (const void*)fwd, NTHREADS, LDS_BYTES) != hipSuccess || per_cu < 1) fprintf(stderr, "kernel_launch: occupancy query says %d\n", per_cu);
        (void)hipGetLastError();
        ready = 1;
    }
    if (ready < 0) return;
    (void)hipMemsetAsync((char*)d_ws + WS_CTL, 0, CTL_ZERO_BYTES, stream);
    Args a{};
    for (int i = 0; i < 20; ++i) a.in[i] = (const float*)d_in[i];
    a.out = (float*)d_out; a.ws = (unsigned char*)d_ws;
#if MK_ONE_LAUNCH
    a.ph_lo = 0; a.ph_hi = NPHASE;
    hipLaunchKernelGGL(fwd, dim3(GRID), dim3(NTHREADS), LDS_BYTES, stream, a);
#if PROBE_PHASE >= 0
    a.ph_lo = PROBE_PHASE; a.ph_hi = PROBE_PHASE + 1;
    hipLaunchKernelGGL(fwd, dim3(GRID), dim3(NTHREADS), LDS_BYTES, stream, a);
#endif
#else
    for (int p = 0; p < NPHASE; ++p) { a.ph_lo = p; a.ph_hi = p + 1; hipLaunchKernelGGL(fwd, dim3(GRID), dim3(NTHREADS), LDS_BYTES, stream, a); }
#endif
}
```

```cpp
#include <hip/hip_runtime.h>
#include <cstdio>
#include <cstdint>

#ifndef MK_ONE_LAUNCH
#define MK_ONE_LAUNCH 1
#endif

#ifndef PROBE_PHASE
#define PROBE_PHASE -1
#endif
#ifndef DUPMASK
#define DUPMASK 0
#endif
#define LAS __attribute__((address_space(3)))
typedef unsigned short bf16;
typedef short bf16x8 __attribute__((ext_vector_type(8)));
typedef short s16x4 __attribute__((ext_vector_type(4)));
typedef float f32x4 __attribute__((ext_vector_type(4)));
typedef unsigned u32x4 __attribute__((ext_vector_type(4)));
typedef unsigned u32x2 __attribute__((ext_vector_type(2)));

constexpr int D = 1024, NB = 2, S = 16384, T = NB * S;
constexpr int INW = 2320, INP = 2560;
constexpr int AQ_OFF = 0, AK_OFF = 512, AV_OFF = 640, GQ_OFF = 768, GK_OFF = 1024, GV_OFF = 1280, GG_OFF = 1792, GA_OFF = 2304;
constexpr int NCH = 256;
constexpr int NE = 32, FF = 1024;
constexpr int NSLOT_MAX = T * 4 + NE * 256;
constexpr float EPS = 1e-6f;
constexpr int NWAVES = 8, NTHREADS = 512, GRID = 256;

constexpr size_t MiB = 1u << 20;
constexpr size_t WS_CTL = 0, CTL_ZERO_BYTES = 1 * MiB;
constexpr size_t WS_MOD = 1 * MiB;
constexpr size_t WS_DECAY = 2 * MiB;
constexpr size_t WS_ROUTE = 3 * MiB;
constexpr size_t WS_TOK_E = WS_ROUTE, WS_TOK_LPOS = WS_ROUTE + 512 * 1024, WS_TOK_GATE = WS_ROUTE + 1024 * 1024;
constexpr size_t WS_BLK_CNT = WS_ROUTE + 1536 * 1024, WS_MOE_OFF = WS_BLK_CNT + 32 * 1024, WS_TILE_E = WS_MOE_OFF + 4096;
constexpr size_t WS_SLOT_ASSIGN = WS_ROUTE + 2 * MiB, WS_SLOT_GATE = WS_ROUTE + 3 * MiB;
constexpr size_t WS_WIN = 8 * MiB, WS_WOUT = 13 * MiB, WS_W2T = 16 * MiB, WS_W1T = 80 * MiB;
constexpr size_t WS_H = 208 * MiB, WS_KV = 272 * MiB, WS_YS = 80 * MiB;
constexpr size_t WS_X1 = 336 * MiB, WS_PROJ = 464 * MiB, WS_MIX = 624 * MiB, WS_Y = 688 * MiB, WS_A = 464 * MiB;
constexpr size_t WS_LIST_A = 752 * MiB, WS_LIST_G = 756 * MiB;
constexpr size_t WS_XS = 608 * MiB;
constexpr size_t WS_END = 760 * MiB;
constexpr int CW_BAR = 4096, CW_GCNT = 8192  , CW_DONE = 8192 + 64 * 32, CW_MOE_CNT = 16384  ;

constexpr int LDS_BYTES = 163840, SMALL_OFF = 132096, MISC_OFF = 131072 + 320;

__device__ __forceinline__ float bf2f(unsigned v) { return __uint_as_float(v << 16); }
__device__ __forceinline__ unsigned f2bf(float f) { unsigned u = __float_as_uint(f); return (u + 0x7fffu + ((u >> 16) & 1u)) >> 16; }
__device__ __forceinline__ unsigned pk2(float lo, float hi) { return f2bf(lo) | (f2bf(hi) << 16); }
__device__ __forceinline__ float wave_sum(float v) {
#pragma unroll
    for (int o = 1; o < 64; o <<= 1) v += __shfl_xor(v, o);
    return v;
}
__device__ __forceinline__ f32x4 unpack4(u32x2 r) { return (f32x4){bf2f(r.x & 0xffffu), bf2f(r.x >> 16), bf2f(r.y & 0xffffu), bf2f(r.y >> 16)}; }
__device__ __forceinline__ float dot4(f32x4 a) { return (a[0] * a[0] + a[1] * a[1]) + (a[2] * a[2] + a[3] * a[3]); }
typedef short v4i16_t __attribute__((ext_vector_type(4)));
__device__ __forceinline__ s16x4 trr(LAS const unsigned char* p) { return __builtin_bit_cast(s16x4, __builtin_amdgcn_ds_read_tr16_b64_v4i16((LAS v4i16_t*)p)); }
__device__ __forceinline__ bf16x8 cat8(s16x4 lo, s16x4 hi) { return __builtin_shufflevector(lo, hi, 0, 1, 2, 3, 4, 5, 6, 7); }
__device__ __forceinline__ bf16x8 pack8(f32x4 a, f32x4 b) { u32x4 w; w.x = pk2(a[0], a[1]); w.y = pk2(a[2], a[3]); w.z = pk2(b[0], b[1]); w.w = pk2(b[2], b[3]); return __builtin_bit_cast(bf16x8, w); }
#define MFMA(a, b, c) __builtin_amdgcn_mfma_f32_16x16x32_bf16((a), (b), (c), 0, 0, 0)
typedef int i32x4 __attribute__((ext_vector_type(4)));
typedef int i32x8 __attribute__((ext_vector_type(8)));
__device__ __forceinline__ float clamp8(float v) { return fminf(fmaxf(v, -448.f), 448.f); }
__device__ __forceinline__ unsigned pk4_fp8(float a, float b, float c, float d) {
    int w = 0; w = __builtin_amdgcn_cvt_pk_fp8_f32(clamp8(a), clamp8(b), w, false); w = __builtin_amdgcn_cvt_pk_fp8_f32(clamp8(c), clamp8(d), w, true); return (unsigned)w; }
constexpr float W8_SCALE = 64.f, H8_SCALE = 16.f, A8_SCALE = 4.f, Y8_SCALE = 16.f;
constexpr int W8_E8M0 = 0x79797979  , H8_E8M0 = 0x7b7b7b7b  , A8_E8M0 = 0x7d7d7d7d  ;

#define XB_TMO      128
#define XB_XCNT(j)  (256  + 64 * (j))
#define XB_XSUB(j)  (1280 + 64 * (j))
#define XB_XGEN(j)  (2304 + 64 * (j))
#define XB_TOP      3328
#define XB_TOPGEN   3392
#define XCD_BAR_WORDS 3456
#define XB_SPIN_CAP (1u << 18)
__device__ __forceinline__ unsigned xb_ld(unsigned* p)              { return __hip_atomic_load(p, __ATOMIC_RELAXED, __HIP_MEMORY_SCOPE_AGENT); }
__device__ __forceinline__ unsigned xb_add(unsigned* p, unsigned v) { return __hip_atomic_fetch_add(p, v, __ATOMIC_RELAXED, __HIP_MEMORY_SCOPE_AGENT); }
__device__ __forceinline__ unsigned xb_xcc_id() { return (unsigned)__builtin_amdgcn_s_getreg((3 << 11) | 20) & 0xFu; }
#define XB_SPIN(cond, bar) do { unsigned _sp = 0; while (cond) { __builtin_amdgcn_s_sleep(1); \
    if ((++_sp & 255u) == 0u) { if (xb_ld(&(bar)[XB_TMO])) break; if (_sp > XB_SPIN_CAP) { atomicAdd(&(bar)[XB_TMO], 1u); break; } } } } while (0)
struct XcdBarrier { unsigned* bar; unsigned x; volatile LAS unsigned* st; };
__device__ __forceinline__ XcdBarrier xcd_barrier_post(unsigned* bar, volatile LAS unsigned* st) {
    XcdBarrier b; b.bar = bar; b.x = xb_xcc_id(); b.st = st;
    if (threadIdx.x == 0) (void)xb_add(&bar[XB_XCNT(b.x)], 1u);
    return b;
}
__device__ __forceinline__ void xcd_barrier_complete(unsigned* bar, unsigned x, unsigned& nloc, unsigned& nx) {
    const unsigned G = gridDim.x * gridDim.y * gridDim.z;
    unsigned sum, cnt, mine, sp = 0u;
    for (;;) {
        sum = 0u; cnt = 0u; mine = 0u;
#pragma unroll
        for (unsigned j = 0; j < 16; ++j) { const unsigned c = xb_ld(&bar[XB_XCNT(j)]); sum += c; cnt += (c > 0u) ? 1u : 0u; mine = (j == x) ? c : mine; }
        if (sum == G) break;
        __builtin_amdgcn_s_sleep(1);
        if ((++sp & 255u) == 0u) { if (xb_ld(&bar[XB_TMO])) break; if (sp > XB_SPIN_CAP) { atomicAdd(&bar[XB_TMO], 1u); break; } }
    }
    nloc = mine > 0u ? mine : 1u; nx = cnt > 0u ? cnt : 1u;
}
__device__ __forceinline__ void xcd_barrier(const XcdBarrier& b) {
    asm volatile("s_waitcnt vmcnt(0)" ::: "memory");
    __syncthreads();
    if (threadIdx.x == 0) {
        unsigned* bar = b.bar;
        __builtin_amdgcn_s_waitcnt(0);
        unsigned nloc = b.st[0], nx = b.st[1];
        if (nloc == 0u) { xcd_barrier_complete(bar, b.x, nloc, nx); b.st[0] = nloc; b.st[1] = nx; }
        const unsigned old = xb_add(&bar[XB_XSUB(b.x)], 1u);
        const unsigned gen = old / nloc;
        if (old + 1u == (gen + 1u) * nloc) {
            __builtin_amdgcn_fence(__ATOMIC_RELEASE, "agent");
            asm volatile("s_waitcnt vmcnt(0)" ::: "memory");
            const unsigned og = xb_add(&bar[XB_TOP], 1u);
            const unsigned tg = og / nx;
            if (og + 1u == (tg + 1u) * nx) xb_add(&bar[XB_TOPGEN], 1u);
            else XB_SPIN(xb_ld(&bar[XB_TOPGEN]) == tg, bar);
            __builtin_amdgcn_fence(__ATOMIC_ACQUIRE, "agent");
            xb_add(&bar[XB_XGEN(b.x)], 1u);
            asm volatile("s_waitcnt vmcnt(0)" ::: "memory");
        } else {
            XB_SPIN(xb_ld(&bar[XB_XGEN(b.x)]) == gen, bar);
            __builtin_amdgcn_fence(__ATOMIC_ACQUIRE, "agent");
            asm volatile("s_waitcnt vmcnt(0)" ::: "memory");
        }
    }
    __syncthreads();
}

struct Frame {
    LAS unsigned char* lds;
    int tid, lane, wave, bx, G;
    const float *x, *c, *w_ada, *b_ada, *g_pre_mix, *g_post_mix, *g_pre_ffn, *g_post_ffn, *w_in, *w_gate_up, *b_gate, *g_gla_norm, *sinks, *w_out,
                *w_router, *b_router, *w_mlp1, *b_mlp1, *w_mlp2, *b_mlp2;
    float* out;
    unsigned char* ws;
};
#define WSP(type, off) ((type*)(F.ws + (off)))

struct TrItem { const float* W; int N; int k0, n0; unsigned char* WT; int kind; };
__device__ __forceinline__ bool tr_decode(const Frame& F, int it, TrItem& t) {
    constexpr int I_IN = 16 * 80, I_OUT = 16 * 32, I_1 = 16 * 64, I_2 = 16 * 32;
    constexpr int NITEMS = I_IN + I_OUT + NE * I_1 + NE * I_2;
    if (it >= NITEMS) return false;
    int r = it, nblk, item;
    if (r < I_IN) { t.W = F.w_in; t.N = INW; t.WT = F.ws + WS_WIN; t.kind = 0; nblk = 80; item = r; }
    else if ((r -= I_IN) < I_OUT) { t.W = F.w_out; t.N = 1024; t.WT = F.ws + WS_WOUT; t.kind = 0; nblk = 32; item = r; }
    else if ((r -= I_OUT) < NE * I_1) { const int e = r / I_1; t.W = F.w_mlp1 + (size_t)e * 1024 * 2048; t.N = 2048; t.WT = F.ws + WS_W1T + (size_t)e * 2048 * 1024; t.kind = 1; nblk = 64; item = r % I_1; }
    else { r -= NE * I_1; const int e = r / I_2; t.W = F.w_mlp2 + (size_t)e * 1024 * 1024; t.N = 1024; t.WT = F.ws + WS_W2T + (size_t)e * 1024 * 1024; t.kind = 2; nblk = 32; item = r % I_2; }
    t.k0 = 64 * (item / nblk); t.n0 = 32 * (item % nblk);
    return true;
}
__device__ __forceinline__ void tr_load(const TrItem& t, int lane, float (&v)[32]) {
    const int n = t.n0 + (lane & 31); const bool ok = n < t.N; const int nc = ok ? n : t.N - 1;
    const float* wp = t.W + (size_t)(t.k0 + (lane >> 5)) * t.N + nc; const size_t st = (size_t)2 * t.N;
#pragma unroll
    for (int i = 0; i < 32; ++i) v[i] = wp[i * st];
#pragma unroll
    for (int i = 0; i < 32; ++i) v[i] = ok ? v[i] : 0.f;
}
__device__ __forceinline__ void tr_store(const TrItem& t, int lane, const float (&v)[32], LAS float* scr) {
#pragma unroll
    for (int i = 0; i < 32; ++i) scr[(2 * i + (lane >> 5)) * 33 + (lane & 31)] = v[i];
    asm volatile("s_waitcnt lgkmcnt(0)" ::: "memory");
    const int c = lane & 7;
#pragma unroll
    for (int j = 0; j < 4; ++j) { const int nn = (lane >> 3) + 8 * j; const LAS float* s = scr + (8 * c) * 33 + nn;
        float e[8];
#pragma unroll
        for (int q = 0; q < 8; ++q) e[q] = s[q * 33];
        const int n = t.n0 + nn;
        if (t.kind == 0) { u32x4 o; o.x = pk2(e[0], e[1]); o.y = pk2(e[2], e[3]); o.z = pk2(e[4], e[5]); o.w = pk2(e[6], e[7]);
            *(u32x4*)((bf16*)t.WT + (size_t)n * 1024 + t.k0 + 8 * c) = o; }
        else { u32x2 o; o.x = pk4_fp8(e[0] * W8_SCALE, e[1] * W8_SCALE, e[2] * W8_SCALE, e[3] * W8_SCALE); o.y = pk4_fp8(e[4] * W8_SCALE, e[5] * W8_SCALE, e[6] * W8_SCALE, e[7] * W8_SCALE);
            int row = n; if (t.kind == 1) { const int jj = n >> 1; row = 256 * (jj >> 7) + 128 * (n & 1) + (jj & 127); }
            *(u32x2*)(t.WT + (size_t)row * 1024 + t.k0 + 8 * c) = o; } }
    asm volatile("s_waitcnt lgkmcnt(0)" ::: "memory");
}
__device__ __forceinline__ void p0_prologue(const Frame& F) {
    float* mod = WSP(float, WS_MOD);
    if (F.bx < 192) {
        LAS float* red = (LAS float*)(F.lds + 98304);
        const int cl = F.tid & 31, ks = F.tid >> 5, col = F.bx * 32 + cl;
        float a0 = 0.f, a1 = 0.f;
#pragma unroll
        for (int k = ks * 64; k < ks * 64 + 64; ++k) {
            const float w = F.w_ada[(size_t)k * 6144 + col];
            const float c0 = F.c[k], c1 = F.c[1024 + k];
            a0 += c0 / (1.f + __expf(-c0)) * w; a1 += c1 / (1.f + __expf(-c1)) * w;
        }
        red[(0 * 16 + ks) * 32 + cl] = a0; red[(1 * 16 + ks) * 32 + cl] = a1;
        __syncthreads();
        if (F.tid < 64) { const int b = F.tid >> 5; float s = 0.f;
#pragma unroll
            for (int i = 0; i < 16; ++i) s += red[(b * 16 + i) * 32 + cl];
            mod[b * 6144 + col] = s + F.b_ada[col]; }
        __syncthreads();
    }
    LAS float* scr = (LAS float*)(F.lds + F.wave * 8704);
    constexpr int RB = 200;
    const int it0 = F.bx * RB + F.wave, itEnd = (F.bx + 1) * RB;
    TrItem t0, t1, t2; float v0[32], v1[32], v2[32];
    bool h0 = (it0 < itEnd) && tr_decode(F, it0, t0); if (h0) tr_load(t0, F.lane, v0);
    bool h1 = (it0 + NWAVES < itEnd) && tr_decode(F, it0 + NWAVES, t1); if (h1) tr_load(t1, F.lane, v1);
    bool h2 = (it0 + 2 * NWAVES < itEnd) && tr_decode(F, it0 + 2 * NWAVES, t2); if (h2) tr_load(t2, F.lane, v2);
#define P0_STEP(T, V, H, nextit) do { if (H) { tr_store(T, F.lane, V, scr); H = ((nextit) < itEnd) && tr_decode(F, (nextit), T); if (H) tr_load(T, F.lane, V); } } while (0)
#pragma unroll 1
    for (int it = it0; h0 || h1 || h2; it += 3 * NWAVES) {
        P0_STEP(t0, v0, h0, it + 3 * NWAVES); P0_STEP(t1, v1, h1, it + 4 * NWAVES); P0_STEP(t2, v2, h2, it + 5 * NWAVES);
    }
#undef P0_STEP
}

__device__ __forceinline__ void p1_norm(const Frame& F) {
    const float* mod = WSP(float, WS_MOD); bf16* h = WSP(bf16, WS_H);
    const int gw = F.bx * NWAVES + F.wave, m0 = gw * 16;
    const float* modb = mod + (m0 >> 14) * 6144;
    const float* xb = F.x + (size_t)m0 * D + 4 * F.lane;
    f32x4 g[4], sh[4], b0[4], b1[4], b2[4], b3[4];
#define P1_LOAD(B, r) do { _Pragma("unroll") for (int j = 0; j < 4; ++j) B[j] = *(const f32x4*)(xb + (size_t)(r) * D + 256 * j); } while (0)
#define P1_ROW(B, it) do { float ss = 0.f; _Pragma("unroll") for (int j = 0; j < 4; ++j) ss += dot4(B[j]); \
        const float r = rsqrtf(wave_sum(ss) * (1.f / D) + EPS); \
        _Pragma("unroll") for (int j = 0; j < 4; ++j) { const f32x4 hv = B[j] * r * g[j] + sh[j]; u32x2 o; o.x = pk2(hv[0], hv[1]); o.y = pk2(hv[2], hv[3]); \
            *(u32x2*)(h + (size_t)(m0 + (it)) * D + 4 * F.lane + 256 * j) = o; } \
        if ((it) + 4 < 16) P1_LOAD(B, (it) + 4); } while (0)
    P1_LOAD(b0, 0); P1_LOAD(b1, 1); P1_LOAD(b2, 2); P1_LOAD(b3, 3);
#pragma unroll
    for (int j = 0; j < 4; ++j) { const int idx = 4 * F.lane + 256 * j;
        g[j] = *(const f32x4*)(F.g_pre_mix + idx) * (*(const f32x4*)(modb + 1024 + idx) + 1.f); sh[j] = *(const f32x4*)(modb + idx); }
#pragma unroll 1
    for (int it = 0; it < 16; it += 4) { P1_ROW(b0, it); P1_ROW(b1, it + 1); P1_ROW(b2, it + 2); P1_ROW(b3, it + 3); }
#undef P1_LOAD
#undef P1_ROW
}

template <class Epi, class RowMap, class BSel>
__device__ __forceinline__ void simple_gemm(const Frame& F, const bf16* A, int lda, int M, int N, int K, const RowMap& rm, const BSel& bs, const Epi& E) {
    const int fr = F.lane & 15, fq = F.lane >> 4;
    const int ncg = N / 512, nbt = (M / 64) * ncg;
    for (int bt = F.bx; bt < nbt; bt += F.G) {
        const int mt = bt / ncg, cg = bt % ncg, m0 = mt * 64, n0 = cg * 512 + F.wave * 64;
        const bf16* Bt = bs(m0);
        const bf16* ap[4]; const bf16* bp[4];
#pragma unroll
        for (int i = 0; i < 4; ++i) { ap[i] = A + (size_t)rm(m0 + 16 * i + fr) * lda + 8 * fq; bp[i] = Bt + (size_t)(n0 + 16 * i + fr) * K + 8 * fq; }
        f32x4 acc[4][4];
#pragma unroll
        for (int i = 0; i < 4; ++i)
#pragma unroll
            for (int j = 0; j < 4; ++j) acc[i][j] = (f32x4){0.f, 0.f, 0.f, 0.f};
#pragma unroll 2
        for (int k0 = 0; k0 < K; k0 += 32) {
            bf16x8 a[4], b[4];
#pragma unroll
            for (int i = 0; i < 4; ++i) { a[i] = *(const bf16x8*)(ap[i] + k0); b[i] = *(const bf16x8*)(bp[i] + k0); }
#pragma unroll
            for (int i = 0; i < 4; ++i)
#pragma unroll
                for (int j = 0; j < 4; ++j) acc[i][j] = MFMA(b[j], a[i], acc[i][j]);
        }
#pragma unroll
        for (int i = 0; i < 4; ++i)
#pragma unroll
            for (int j = 0; j < 4; ++j) E(m0 + 16 * i + fr, n0 + 16 * j + 4 * fq, acc[i][j]);
    }
}
struct RowId { __device__ __forceinline__ int operator()(int m) const { return m; } };
struct RowGather { const int* slot_assign; __device__ __forceinline__ int operator()(int m) const { const int a = slot_assign[m]; return a < 0 ? 0 : (a >> 2); } };
struct BFixed { const bf16* Bt; __device__ __forceinline__ const bf16* operator()(int) const { return Bt; } };
struct BExpert { const bf16* Bt; const int* tile_e; size_t stride; __device__ __forceinline__ const bf16* operator()(int m0) const { return Bt + (size_t)tile_e[m0 >> 8] * stride; } };
struct EpiStore { bf16* O; int ldo;
    __device__ __forceinline__ void operator()(int m, int n, f32x4 v) const { u32x2 w; w.x = pk2(v[0], v[1]); w.y = pk2(v[2], v[3]); *(u32x2*)(O + (size_t)m * ldo + n) = w; } };
__device__ __forceinline__ float swiglu(float g, float l) {
    const float xg = fminf(g, 7.f), xl = fminf(fmaxf(l, -7.f), 7.f);
    return xg / (1.f + __expf(-1.702f * xg)) * (xl + 1.f);
}
struct EpiSwiglu { bf16* Aout; const float* b1; const int* tile_e;
    __device__ __forceinline__ void operator()(int m, int n, f32x4 v) const {
        const int e = tile_e[m >> 8]; const f32x4 bb = *(const f32x4*)(b1 + (size_t)e * 2048 + n);
        const float a0 = swiglu(v[0] + bb[0], v[1] + bb[1]), a1 = swiglu(v[2] + bb[2], v[3] + bb[3]);
        *(unsigned*)(Aout + (size_t)m * FF + (n >> 1)) = pk2(a0, a1); } };
struct EpiMoe2 { bf16* ys; const float* b2; const int* tile_e; const int* slot_assign; const float* slot_gate;
    __device__ __forceinline__ void operator()(int m, int n, f32x4 v) const {
        const int asg = slot_assign[m]; if (asg < 0) return;
        const int e = tile_e[m >> 8]; const f32x4 bb = *(const f32x4*)(b2 + (size_t)e * D + n); const float g = slot_gate[m];
        u32x2 w; w.x = pk2((v[0] + bb[0]) * g, (v[1] + bb[1]) * g); w.y = pk2((v[2] + bb[2]) * g, (v[3] + bb[3]) * g);
        *(u32x2*)(ys + (size_t)asg * D + n) = w; } };

namespace pg8 {
constexpr int BM = 256, BK = 64, HALF = 128, HTB = HALF * BK * 2, NXCD = 8, WGM = 8;
__device__ __forceinline__ int lds_byte(int r, int c) { const int st = (r >> 4) * 2 + (c >> 5), rr = r & 15, cc = c & 31, ob = rr * 64 + cc * 2; return st * 1024 + (ob ^ (((ob >> 9) & 1) << 5)); }
__device__ __forceinline__ void stage_rc(int b, int& R, int& C) { const int st = b / 1024, sb = b % 1024, swz = sb ^ (((sb >> 9) & 1) << 5); R = (st >> 1) * 16 + swz / 64; C = (st & 1) * 32 + (swz % 64) / 2; }
__device__ __forceinline__ int perm32(int rho) { const int n = rho >> 4, i = rho & 15; return 8 * (i >> 2) + 4 * n + (i & 3); }
struct Unit { int pm, pn; };
struct StaticOrder {
    int nM, nN, nwg, G, c;
    __device__ __forceinline__ void init(int nM_, int nN_, int G_, int c_) { nM = nM_; nN = nN_; nwg = nM * nN; G = G_; c = c_; }
    __device__ __forceinline__ bool next(int i, Unit& u) const {
        const long L = (long)i * G + c; if (L >= nwg) return false;
        int wgid = (int)L; { const int q = nwg / NXCD, r = nwg % NXCD, xcd = wgid % NXCD, off = wgid / NXCD; wgid = (xcd < r ? xcd * (q + 1) : r * (q + 1) + (xcd - r) * q) + off; }
        const int nig = WGM * nN, gid = wgid / nig, fm = gid * WGM, gsz = (nM - fm) < WGM ? (nM - fm) : WGM;
        u.pm = fm + ((wgid % nig) % gsz); u.pn = (wgid % nig) / gsz; return true;
    }
};
template <bool GATHER, int FP8, int SCW, int SCX, class Epi, class Sched, class AB>
__device__ __forceinline__ void gemm_phase(LAS unsigned char* lds, const int K, const Sched& S, const AB& ab, const Epi& E) {
    const int tid = threadIdx.x, wid = __builtin_amdgcn_readfirstlane(tid >> 6), lane = tid & 63, wr = wid >> 2, wc = wid & 3, fr = lane & 15, fq = lane >> 4;
    const int nt = K / BK;
    int sR[2], sC[2]; unsigned voffB[2], vA[2][2], nvA[2][2];
#pragma unroll
    for (int i = 0; i < 2; ++i) { int R, C; stage_rc(tid * 16 + i * 8192, R, C); sR[i] = R; sC[i] = C; const int Rb = (R & ~31) + perm32(R & 31); voffB[i] = (unsigned)(Rb * K + C) * 2u; }
    const size_t kstep = (size_t)(BK * 2);
    const size_t hstep = (size_t)HALF * K * 2;
    const unsigned ldsw = (unsigned)wid * 1024u;
    const int aoff = lds_byte(wr * 64 + fr, fq * 8), boff = lds_byte(wc * 32 + fr, fq * 8);
#define PG8_SA(b, h) (((b) * 2 + (h)) * HTB)
#define PG8_SB(b, h) ((4 + (b) * 2 + (h)) * HTB)
#define PG8_STAGE(bufoff, gbase, voff) do { _Pragma("unroll") for (int _i = 0; _i < 2; ++_i) \
        __builtin_amdgcn_global_load_lds((const unsigned*)((const char*)(gbase) + (voff)[_i]), (LAS unsigned*)(lds + (bufoff) + ldsw + _i * 8192), 16, 0, 0); } while (0)
#define PG8_LDA(dst, b, h) do { _Pragma("unroll") for (int m = 0; m < 4; ++m) _Pragma("unroll") for (int k = 0; k < 2; ++k) dst[m][k] = *(const LAS bf16x8*)(lds + PG8_SA(b, h) + aoff + m * 2048 + k * 1024); } while (0)
#define PG8_LDB(dst, b, h) do { _Pragma("unroll") for (int n = 0; n < 2; ++n) _Pragma("unroll") for (int k = 0; k < 2; ++k) dst[n][k] = *(const LAS bf16x8*)(lds + PG8_SB(b, h) + boff + n * 2048 + k * 1024); } while (0)
#define PG8_C8(x) __builtin_shufflevector(__builtin_bit_cast(i32x4, (x)[0]), __builtin_bit_cast(i32x4, (x)[1]), 0, 1, 2, 3, 4, 5, 6, 7)
#define PG8_MMA(ai, bj, At, Bt) do { __builtin_amdgcn_s_setprio(1); _Pragma("unroll") for (int m = 0; m < 4; ++m) _Pragma("unroll") for (int n = 0; n < 2; ++n) { \
        if (FP8) asm volatile("v_mfma_scale_f32_16x16x128_f8f6f4 %0, %1, %2, %0, %3, %4 op_sel_hi:[0,0,0]" : "+v"(acc[ai][bj][m][n]) : "v"(PG8_C8(Bt[n])), "v"(PG8_C8(At[m])), "v"(scw), "v"(scx)); \
        else { _Pragma("unroll") for (int k = 0; k < 2; ++k) asm volatile("v_mfma_f32_16x16x32_bf16 %0, %1, %2, %0" : "+v"(acc[ai][bj][m][n]) : "v"(Bt[n][k]), "v"(At[m][k])); } } \
        __builtin_amdgcn_s_setprio(0); } while (0)
#define PG8_WAIT_V(n) asm volatile("s_waitcnt vmcnt(" #n ")" ::: "memory")
#define PG8_WAIT_L(n) asm volatile("s_waitcnt lgkmcnt(" #n ")" ::: "memory")
#define PG8_BAR __builtin_amdgcn_s_barrier()
#define PG8_SCHED __builtin_amdgcn_sched_barrier(0)
#define PG8_AOFF(dst, u) do { _Pragma("unroll") for (int _h = 0; _h < 2; ++_h) _Pragma("unroll") for (int _i = 0; _i < 2; ++_i) \
        dst[_h][_i] = GATHER ? (unsigned)(ab.a_row((u), _h * HALF + sR[_i]) * K + sC[_i]) * 2u : (unsigned)((_h * HALF + sR[_i]) * K + sC[_i]) * 2u; } while (0)
    Unit cur, nxt; int ui = 0;
    if (!S.next(0, cur)) return;
    const int scw = SCW, scx = SCX;
    f32x4 acc[2][2][4][2];
#pragma unroll
    for (int a = 0; a < 2; ++a)
#pragma unroll
        for (int b = 0; b < 2; ++b)
#pragma unroll
            for (int m = 0; m < 4; ++m)
#pragma unroll
                for (int n = 0; n < 2; ++n) acc[a][b][m][n] = (f32x4){0.f, 0.f, 0.f, 0.f};
    bf16x8 At[4][2], B0[2][2], B1[2][2];
    const char* cA = ab.a_base(cur); const char* cB = ab.b_base(cur);
    PG8_AOFF(vA, cur);
    PG8_STAGE(PG8_SB(0, 0), cB, voffB); PG8_STAGE(PG8_SB(0, 1), cB + hstep, voffB); PG8_STAGE(PG8_SA(0, 0), cA, vA[0]); PG8_STAGE(PG8_SA(0, 1), cA, vA[1]);
    if (wr == 1) PG8_BAR;
    PG8_WAIT_V(2); PG8_BAR;
    PG8_STAGE(PG8_SB(1, 0), cB + kstep, voffB); PG8_STAGE(PG8_SA(1, 0), cA + kstep, vA[0]); PG8_STAGE(PG8_SB(1, 1), cB + hstep + kstep, voffB);
    PG8_WAIT_V(6); PG8_BAR;
    for (;;) {
        const bool has_next = S.next(ui + 1, nxt);
        const char* nA = has_next ? ab.a_base(nxt) : cA; const char* nB = has_next ? ab.b_base(nxt) : cB;
        if (GATHER) { if (has_next) { PG8_AOFF(nvA, nxt); } else {
#pragma unroll
            for (int h = 0; h < 2; ++h)
#pragma unroll
                for (int i = 0; i < 2; ++i) nvA[h][i] = vA[h][i]; } }
#pragma unroll 1
        for (int t = 0; t < nt; t += 2) {
            const bool last = (t == nt - 2);
            const char* a1 = cA + (size_t)(t + 1) * kstep;
            const char* a2 = last ? nA : cA + (size_t)(t + 2) * kstep; const char* b2 = last ? nB : cB + (size_t)(t + 2) * kstep;
            const char* a3 = a2 + kstep; const char* b3 = b2 + kstep;
            unsigned o2[2][2];
#pragma unroll
            for (int h = 0; h < 2; ++h)
#pragma unroll
                for (int i = 0; i < 2; ++i) o2[h][i] = (GATHER && last) ? nvA[h][i] : vA[h][i];
            PG8_LDB(B0, 0, 0); PG8_LDB(B1, 0, 1); PG8_SCHED; PG8_LDA(At, 0, 0); PG8_STAGE(PG8_SA(1, 1), a1, vA[1]);
            PG8_WAIT_V(8); PG8_WAIT_L(0); PG8_BAR; PG8_MMA(0, 0, At, B0); PG8_MMA(0, 1, At, B1); PG8_BAR; PG8_SCHED;
            PG8_LDA(At, 0, 1); PG8_STAGE(PG8_SB(0, 0), b2, voffB); PG8_STAGE(PG8_SB(0, 1), b2 + hstep, voffB); PG8_STAGE(PG8_SA(0, 0), a2, o2[0]);
            PG8_WAIT_V(8); PG8_WAIT_L(0); PG8_BAR; PG8_MMA(1, 0, At, B0); PG8_MMA(1, 1, At, B1); PG8_BAR; PG8_SCHED;
            PG8_LDB(B0, 1, 0); PG8_LDB(B1, 1, 1); PG8_SCHED; PG8_LDA(At, 1, 0); PG8_STAGE(PG8_SA(0, 1), a2, o2[1]);
            PG8_WAIT_V(8); PG8_WAIT_L(0); PG8_BAR; PG8_MMA(0, 0, At, B0); PG8_MMA(0, 1, At, B1); PG8_BAR; PG8_SCHED;
            PG8_LDA(At, 1, 1); PG8_STAGE(PG8_SB(1, 0), b3, voffB); PG8_STAGE(PG8_SB(1, 1), b3 + hstep, voffB); PG8_STAGE(PG8_SA(1, 0), a3, o2[0]);
            PG8_WAIT_V(8); PG8_WAIT_L(0); PG8_BAR; PG8_MMA(1, 0, At, B0); PG8_MMA(1, 1, At, B1); PG8_BAR; PG8_SCHED;
        }
        if (wr == 0) PG8_BAR;
        asm volatile("s_nop 15\n\ts_nop 15" ::: "memory");
        E(acc, cur, wr, wc, fr, fq);
        if (!has_next) break;
#pragma unroll
        for (int a = 0; a < 2; ++a)
#pragma unroll
            for (int b = 0; b < 2; ++b)
#pragma unroll
                for (int m = 0; m < 4; ++m)
#pragma unroll
                    for (int n = 0; n < 2; ++n) acc[a][b][m][n] = (f32x4){0.f, 0.f, 0.f, 0.f};
        cur = nxt; cA = nA; cB = nB; ++ui;
        if (GATHER) {
#pragma unroll
            for (int h = 0; h < 2; ++h)
#pragma unroll
                for (int i = 0; i < 2; ++i) vA[h][i] = nvA[h][i]; }
        if (wr == 1) PG8_BAR;
    }
    PG8_WAIT_V(0);
    PG8_BAR;
#undef PG8_SA
#undef PG8_SB
#undef PG8_STAGE
#undef PG8_LDA
#undef PG8_LDB
#undef PG8_MMA
#undef PG8_C8
#undef PG8_WAIT_V
#undef PG8_WAIT_L
#undef PG8_BAR
#undef PG8_SCHED
#undef PG8_AOFF
}
__device__ __forceinline__ unsigned cvt_pk_bf16(float lo, float hi) { unsigned r; asm volatile("v_cvt_pk_bf16_f32 %0, %1, %2" : "=v"(r) : "v"(lo), "v"(hi)); return r; }
struct ABDense { const bf16* A; const bf16* Bt; int K;
    __device__ __forceinline__ const char* a_base(const Unit& u) const { return (const char*)(A + (size_t)u.pm * BM * K); }
    __device__ __forceinline__ const char* b_base(const Unit& u) const { return (const char*)(Bt + (size_t)u.pn * BM * K); }
    __device__ __forceinline__ int a_row(const Unit&, int) const { return 0; } };
struct EpiStoreT { bf16* O; int ldo;
    __device__ __forceinline__ void operator()(const f32x4 (&acc)[2][2][4][2], const Unit& u, int wr, int wc, int fr, int fq) const {
        const int row0 = u.pm * BM + wr * 64 + fr, col0 = u.pn * BM + wc * 32 + 8 * fq;
#pragma unroll
        for (int ai = 0; ai < 2; ++ai)
#pragma unroll
            for (int m = 0; m < 4; ++m) { bf16* rowp = O + (size_t)(row0 + ai * HALF + m * 16) * ldo + col0;
#pragma unroll
                for (int bj = 0; bj < 2; ++bj) { const f32x4 v0 = acc[ai][bj][m][0], v1 = acc[ai][bj][m][1];
                    u32x4 w; w.x = cvt_pk_bf16(v0[0], v0[1]); w.y = cvt_pk_bf16(v0[2], v0[3]); w.z = cvt_pk_bf16(v1[0], v1[1]); w.w = cvt_pk_bf16(v1[2], v1[3]);
                    *(u32x4*)(rowp + bj * HALF) = w; } }
    } };
struct ABMoe1 { const unsigned char* H; const unsigned char* W; const int* tile_e; const int* moe_off; const unsigned* moe_cnt; const int* list_a;
    __device__ __forceinline__ const char* a_base(const Unit&) const { return (const char*)H; }
    __device__ __forceinline__ const char* b_base(const Unit& u) const { return (const char*)(W + (size_t)tile_e[u.pm] * 2048 * 1024 + (size_t)u.pn * BM * 1024); }
    __device__ __forceinline__ int a_row(const Unit& u, int rt) const { const int e = tile_e[u.pm]; const int pos = u.pm * BM + rt - moe_off[e];
        const int pc = pos < (int)moe_cnt[e] ? pos : 0; const int a = list_a[(size_t)e * T + pc]; return pos < (int)moe_cnt[e] ? (a >> 2) : 0; } };
struct ABMoe2 { const unsigned char* A; const unsigned char* W; const int* tile_e;
    __device__ __forceinline__ const char* a_base(const Unit& u) const { return (const char*)(A + (size_t)u.pm * BM * 1024); }
    __device__ __forceinline__ const char* b_base(const Unit& u) const { return (const char*)(W + (size_t)tile_e[u.pm] * 1024 * 1024 + (size_t)u.pn * BM * 1024); }
    __device__ __forceinline__ int a_row(const Unit&, int) const { return 0; } };
struct EpiSwigluT { unsigned char* Aout; const float* b1; const int* tile_e;
    __device__ __forceinline__ void operator()(const f32x4 (&acc)[2][2][4][2], const Unit& u, int wr, int wc, int fr, int fq) const {
        const int row0 = u.pm * BM + wr * 64 + fr, j0 = u.pn * HALF + wc * 32 + 8 * fq;
        const float* bp = b1 + (size_t)tile_e[u.pm] * 2048 + 2 * j0;
        f32x4 bb[4];
#pragma unroll
        for (int q = 0; q < 4; ++q) bb[q] = *(const f32x4*)(bp + 4 * q);
#pragma unroll
        for (int ai = 0; ai < 2; ++ai)
#pragma unroll
            for (int m = 0; m < 4; ++m) {
                const f32x4 g0 = acc[ai][0][m][0], g1 = acc[ai][0][m][1], l0 = acc[ai][1][m][0], l1 = acc[ai][1][m][1];
                u32x2 w;
                w.x = pk4_fp8(swiglu(g0[0] + bb[0][0], l0[0] + bb[0][1]) * A8_SCALE, swiglu(g0[1] + bb[0][2], l0[1] + bb[0][3]) * A8_SCALE,
                              swiglu(g0[2] + bb[1][0], l0[2] + bb[1][1]) * A8_SCALE, swiglu(g0[3] + bb[1][2], l0[3] + bb[1][3]) * A8_SCALE);
                w.y = pk4_fp8(swiglu(g1[0] + bb[2][0], l1[0] + bb[2][1]) * A8_SCALE, swiglu(g1[1] + bb[2][2], l1[1] + bb[2][3]) * A8_SCALE,
                              swiglu(g1[2] + bb[3][0], l1[2] + bb[3][1]) * A8_SCALE, swiglu(g1[3] + bb[3][2], l1[3] + bb[3][3]) * A8_SCALE);
                *(u32x2*)(Aout + (size_t)(row0 + ai * HALF + m * 16) * FF + j0) = w; }
    } };
struct EpiMoe2T { unsigned char* ys; const float* b2; const int* tile_e; const int* moe_off; const unsigned* moe_cnt; const int* list_a; const float* list_g;
    __device__ __forceinline__ void operator()(const f32x4 (&acc)[2][2][4][2], const Unit& u, int wr, int wc, int fr, int fq) const {
        const int e = tile_e[u.pm], cnt = (int)moe_cnt[e], pos0 = u.pm * BM - moe_off[e] + wr * 64 + fr, col0 = u.pn * BM + wc * 32 + 8 * fq;
        const float* bp = b2 + (size_t)e * D + col0;
        f32x4 bv[2][2];
#pragma unroll
        for (int bj = 0; bj < 2; ++bj)
#pragma unroll
            for (int n = 0; n < 2; ++n) bv[bj][n] = *(const f32x4*)(bp + bj * HALF + 4 * n);
        int asgv[2][4]; float gv[2][4];
#pragma unroll
        for (int ai = 0; ai < 2; ++ai)
#pragma unroll
            for (int m = 0; m < 4; ++m) { const int pos = pos0 + ai * HALF + m * 16; const int pc = pos < cnt ? pos : 0;
                const int a = list_a[(size_t)e * T + pc]; gv[ai][m] = list_g[(size_t)e * T + pc]; asgv[ai][m] = pos < cnt ? a : -1; }
#pragma unroll
        for (int ai = 0; ai < 2; ++ai)
#pragma unroll
            for (int m = 0; m < 4; ++m) { const int asg = asgv[ai][m]; const float g = gv[ai][m];
                if (asg >= 0) { unsigned char* rowp = ys + (size_t)asg * D + col0; const float gs = g * Y8_SCALE;
#pragma unroll
                    for (int bj = 0; bj < 2; ++bj) { const f32x4 v0 = (acc[ai][bj][m][0] + bv[bj][0]) * gs, v1 = (acc[ai][bj][m][1] + bv[bj][1]) * gs;
                        u32x2 w; w.x = pk4_fp8(v0[0], v0[1], v0[2], v0[3]); w.y = pk4_fp8(v1[0], v1[1], v1[2], v1[3]);
                        *(u32x2*)(rowp + bj * HALF) = w; } } }
    } };
}

__device__ __forceinline__ void attn_unit(const Frame& F, int u) {
    const int qblk = u & 127, kvh = (u >> 7) & 1, b = u >> 8;
    LAS unsigned char* Ks = F.lds; LAS unsigned char* Vs = F.lds + 256 * 144;
    const bf16* proj = WSP(bf16, WS_PROJ); bf16* mix = WSP(bf16, WS_MIX);
    const int tok0 = b * S + qblk * 128;
#pragma unroll
    for (int i = 0; i < 4; ++i) {
        const int cid = F.tid + 512 * i, row = cid >> 3, ch = cid & 7;
        u32x4 kv = (u32x4){0u, 0u, 0u, 0u}, vv = (u32x4){0u, 0u, 0u, 0u};
        if (qblk > 0 || row >= 128) {
            const bf16* rp = proj + (size_t)(tok0 - 128 + row) * INP;
            kv = *(const u32x4*)(rp + AK_OFF + kvh * 64 + ch * 8);
            vv = *(const u32x4*)(rp + AV_OFF + kvh * 64 + ch * 8);
        }
        *(LAS u32x4*)(Ks + row * 144 + ch * 16) = kv;
        *(LAS u32x4*)(Vs + row * 144 + ch * 16) = vv;
    }
    __syncthreads();
    const int g = F.wave >> 1, hw = F.wave & 1, hq = kvh * 4 + g;
    const int lane = F.lane, fr = lane & 15, fq = lane >> 4;
    const float sink = F.sinks[hq];
    const float NEG_INF = -__builtin_inff();
    const bf16* qbase = proj + (size_t)(tok0 + 64 * hw + fr) * INP + AQ_OFF + hq * 64 + 8 * fq;
    bf16x8 nq0 = *(const bf16x8*)qbase, nq1 = *(const bf16x8*)(qbase + 32);
    for (int qb = 0; qb < 4; ++qb) {
        const int i = 64 * hw + 16 * qb + fr;
        const bf16x8 q0 = nq0, q1 = nq1;
        { const bf16* qn = qbase + (size_t)(16 * (qb < 3 ? qb + 1 : qb)) * INP; nq0 = *(const bf16x8*)qn; nq1 = *(const bf16x8*)(qn + 32); }
        f32x4 st[12];
#pragma unroll
        for (int kt = 0; kt < 12; ++kt) {
            LAS const unsigned char* kp = Ks + (64 * hw + 16 * kt + fr) * 144 + fq * 16;
            const bf16x8 k0 = *(LAS const bf16x8*)kp, k1 = *(LAS const bf16x8*)(kp + 64);
            f32x4 z = (f32x4){0.f, 0.f, 0.f, 0.f}; z = MFMA(k0, q0, z); z = MFMA(k1, q1, z); st[kt] = z;
        }
        float mx = NEG_INF;
#pragma unroll
        for (int kt = 0; kt < 12; ++kt)
#pragma unroll
            for (int r = 0; r < 4; ++r) {
                const int j = 64 * hw + 16 * kt + 4 * fq + r, rel = i + 128 - j;
                const bool ok = (rel >= 0) && (rel < 128) && (qblk > 0 || j >= 128);
                const float s = ok ? st[kt][r] * 0.125f : NEG_INF;
                st[kt][r] = s; mx = fmaxf(mx, s);
            }
        mx = fmaxf(mx, __shfl_xor(mx, 16)); mx = fmaxf(mx, __shfl_xor(mx, 32)); mx = fmaxf(mx, sink);
        float sum = 0.f;
#pragma unroll
        for (int kt = 0; kt < 12; ++kt)
#pragma unroll
            for (int r = 0; r < 4; ++r) { const float p = __expf(st[kt][r] - mx); st[kt][r] = p; sum += p; }
        sum += __shfl_xor(sum, 16); sum += __shfl_xor(sum, 32); sum += __expf(sink - mx);
        const float inv = 1.f / sum;
        f32x4 o[4];
#pragma unroll
        for (int c = 0; c < 4; ++c) o[c] = (f32x4){0.f, 0.f, 0.f, 0.f};
#pragma unroll
        for (int ks = 0; ks < 6; ++ks) {
            const bf16x8 pf = pack8(st[2 * ks], st[2 * ks + 1]);
            const int rb = 64 * hw + 32 * ks + 4 * fq + (fr >> 2);
#pragma unroll
            for (int c = 0; c < 4; ++c) {
                LAS const unsigned char* vp = Vs + rb * 144 + (16 * c + 4 * (lane & 3)) * 2;
                const bf16x8 vf = cat8(trr(vp), trr(vp + 16 * 144));
                o[c] = MFMA(pf, vf, o[c]);
            }
        }
#pragma unroll
        for (int r = 0; r < 4; ++r) {
            const int qrow = 4 * fq + r; const float iv = __shfl(inv, qrow);
            bf16* op = mix + (size_t)(tok0 + 64 * hw + 16 * qb + qrow) * D + hq * 64 + fr;
#pragma unroll
            for (int c = 0; c < 4; ++c) op[16 * c] = (bf16)f2bf(o[c][r] * iv);
        }
    }
    __syncthreads();
}

__device__ __forceinline__ void gla_gate_prefix(const Frame& F, const bf16* proj, int t0, int h, LAS float* ga_s, LAS float* tot_s, float (&bv)[8], float& b_mid, float& b_last) {
#pragma unroll
    for (int i = 0; i < 2; ++i) { const int idx = F.tid + 512 * i, t = idx >> 4, r = idx & 15; ga_s[idx] = bf2f(proj[(size_t)(t0 + t) * INP + GA_OFF + r]); }
    float wu[16];
#pragma unroll
    for (int r = 0; r < 16; ++r) wu[r] = F.w_gate_up[r * 256 + h * 64 + F.lane];
    const float bg = F.b_gate[h * 64 + F.lane];
    __syncthreads();
    float run = 0.f;
#pragma unroll
    for (int i = 0; i < 8; ++i) {
        const int t = 8 * F.wave + i; float z = bg;
#pragma unroll
        for (int r = 0; r < 16; ++r) z += ga_s[t * 16 + r] * wu[r];
        const float ls = fminf(z, 0.f) - __logf(1.f + __expf(-fabsf(z)));
        run += ls * (1.f / 16.f); bv[i] = run;
    }
    tot_s[F.wave * 64 + F.lane] = run;
    __syncthreads();
    float pre = 0.f, mid = 0.f, all = 0.f;
#pragma unroll
    for (int w = 0; w < 8; ++w) { const float tv = tot_s[w * 64 + F.lane]; pre += (w < F.wave) ? tv : 0.f; mid += (w < 4) ? tv : 0.f; all += tv; }
#pragma unroll
    for (int i = 0; i < 8; ++i) bv[i] += pre;
    b_mid = mid; b_last = all;
}
__device__ __forceinline__ void gla_kv_unit(const Frame& F, int u) {
    const int h = u & 3, n = (u >> 2) & 255, b = u >> 10, t0 = b * S + n * 64;
    const bf16* proj = WSP(bf16, WS_PROJ);
    LAS unsigned char* kd_s = F.lds; LAS unsigned char* v_s = F.lds + 9216;
    LAS float* ga_s = (LAS float*)(F.lds + 26624); LAS float* tot_s = (LAS float*)(F.lds + 30720);
    const int lane = F.lane, fr = lane & 15, fq = lane >> 4;
#pragma unroll
    for (int i = 0; i < 2; ++i) { const int cid = F.tid + 512 * i, row = cid >> 4, ch = cid & 15;
        *(LAS u32x4*)(v_s + row * 272 + ch * 16) = *(const u32x4*)(proj + (size_t)(t0 + row) * INP + GV_OFF + h * 128 + ch * 8); }
    float bv[8], b_mid, b_last;
    gla_gate_prefix(F, proj, t0, h, ga_s, tot_s, bv, b_mid, b_last);
#pragma unroll
    for (int i = 0; i < 8; ++i) { const int t = 8 * F.wave + i;
        const float kx = bf2f(proj[(size_t)(t0 + t) * INP + GK_OFF + h * 64 + lane]);
        *(LAS bf16*)(kd_s + t * 144 + lane * 2) = (bf16)f2bf(kx * __expf(b_last - bv[i])); }
    if (F.wave == 0) WSP(float, WS_DECAY)[((size_t)(b * NCH + n) * 4 + h) * 64 + lane] = __expf(b_last);
    __syncthreads();
    const int c = F.wave;
    f32x4 acc[4];
#pragma unroll
    for (int d = 0; d < 4; ++d) acc[d] = (f32x4){0.f, 0.f, 0.f, 0.f};
#pragma unroll
    for (int ks = 0; ks < 2; ++ks) {
        const int rb = 32 * ks + 8 * fq + (fr >> 2);
        LAS const unsigned char* vp = v_s + rb * 272 + (16 * c + 4 * (lane & 3)) * 2;
        const bf16x8 vf = cat8(trr(vp), trr(vp + 4 * 272));
#pragma unroll
        for (int d = 0; d < 4; ++d) {
            LAS const unsigned char* kp = kd_s + rb * 144 + (16 * d + 4 * (lane & 3)) * 2;
            const bf16x8 kf = cat8(trr(kp), trr(kp + 4 * 144));
            acc[d] = MFMA(kf, vf, acc[d]);
        }
    }
    float* kvp = WSP(float, WS_KV) + (((size_t)(b * NCH + n) * 4 + h) * 128 + 16 * c + fr) * 64;
#pragma unroll
    for (int d = 0; d < 4; ++d) *(f32x4*)(kvp + 16 * d + 4 * fq) = acc[d];
    __syncthreads();
}
__device__ __forceinline__ void gla_scan(const Frame& F) {
    float* kv = WSP(float, WS_KV); const float* decay = WSP(float, WS_DECAY);
    if (F.tid >= 256) return;
    for (int idx = F.bx * 256 + F.tid; idx < 65536; idx += F.G * 256) {
        const int b = idx >> 15, h = (idx >> 13) & 3, dvdk = idx & 8191, dk = idx & 63;
        float* p = kv + ((size_t)(b * NCH) * 4 + h) * 8192 + dvdk;
        const float* dp = decay + ((size_t)(b * NCH) * 4 + h) * 64 + dk;
        float state = 0.f;
        for (int n = 0; n < NCH; n += 8) {
            float tv[8], dv[8];
#pragma unroll
            for (int i = 0; i < 8; ++i) { tv[i] = p[(size_t)(n + i) * 4 * 8192]; dv[i] = dp[(size_t)(n + i) * 4 * 64]; }
#pragma unroll
            for (int i = 0; i < 8; ++i) { p[(size_t)(n + i) * 4 * 8192] = state; state = dv[i] * state + tv[i]; }
        }
    }
}
__device__ __forceinline__ void gla_out_unit(const Frame& F, int u) {
    const int h = u & 3, n = (u >> 2) & 255, b = u >> 10, t0 = b * S + n * 64;
    const bf16* proj = WSP(bf16, WS_PROJ); bf16* mix = WSP(bf16, WS_MIX);
    LAS unsigned char* qd_s = F.lds; LAS unsigned char* kk_s = F.lds + 9216; LAS unsigned char* qe_s = F.lds + 18432;
    LAS unsigned char* v_s = F.lds + 27648; LAS unsigned char* st_s = F.lds + 45056;
    LAS float* ga_s = (LAS float*)(F.lds + 63488); LAS float* tot_s = (LAS float*)(F.lds + 67584); LAS float* ssq_s = (LAS float*)(F.lds + 69632);
    const int lane = F.lane, fr = lane & 15, fq = lane >> 4;
#pragma unroll
    for (int i = 0; i < 2; ++i) { const int cid = F.tid + 512 * i, row = cid >> 4, ch = cid & 15;
        *(LAS u32x4*)(v_s + row * 272 + ch * 16) = *(const u32x4*)(proj + (size_t)(t0 + row) * INP + GV_OFF + h * 128 + ch * 8); }
    const float* stg = WSP(float, WS_KV) + ((size_t)(b * NCH + n) * 4 + h) * 8192;
#pragma unroll
    for (int i = 0; i < 4; ++i) { const int i4 = F.tid + 512 * i, dv = i4 >> 4, dk4 = (i4 & 15) * 4;
        const f32x4 sv = *(const f32x4*)(stg + dv * 64 + dk4);
        u32x2 w; w.x = pk2(sv[0], sv[1]); w.y = pk2(sv[2], sv[3]);
        *(LAS u32x2*)(st_s + dv * 144 + dk4 * 2) = w; }
    float bv[8], b_mid, b_last;
    gla_gate_prefix(F, proj, t0, h, ga_s, tot_s, bv, b_mid, b_last);
#pragma unroll
    for (int i = 0; i < 8; ++i) { const int t = 8 * F.wave + i; const bf16* rp = proj + (size_t)(t0 + t) * INP + h * 64 + lane;
        const float qx = bf2f(rp[GQ_OFF]) * 0.125f, kx = bf2f(rp[GK_OFF]);
        *(LAS bf16*)(qd_s + t * 144 + lane * 2) = (bf16)f2bf(qx * __expf(bv[i] - b_mid));
        *(LAS bf16*)(kk_s + t * 144 + lane * 2) = (bf16)f2bf(kx * __expf(b_mid - bv[i]));
        *(LAS bf16*)(qe_s + t * 144 + lane * 2) = (bf16)f2bf(qx * __expf(bv[i])); }
    __syncthreads();
    const int ib = F.wave >> 1, dvh = F.wave & 1;
    bf16x8 qdf[2], qef[2];
#pragma unroll
    for (int ks = 0; ks < 2; ++ks) { qdf[ks] = *(LAS const bf16x8*)(qd_s + (16 * ib + fr) * 144 + (32 * ks + 8 * fq) * 2);
                                     qef[ks] = *(LAS const bf16x8*)(qe_s + (16 * ib + fr) * 144 + (32 * ks + 8 * fq) * 2); }
    f32x4 at[4];
#pragma unroll
    for (int jt = 0; jt < 4; ++jt) {
        LAS const unsigned char* kp = kk_s + (16 * jt + fr) * 144 + (8 * fq) * 2;
        const bf16x8 k0 = *(LAS const bf16x8*)kp, k1 = *(LAS const bf16x8*)(kp + 64);
        f32x4 z = (f32x4){0.f, 0.f, 0.f, 0.f}; z = MFMA(k0, qdf[0], z); z = MFMA(k1, qdf[1], z);
#pragma unroll
        for (int r = 0; r < 4; ++r) if (16 * jt + 4 * fq + r > 16 * ib + fr) z[r] = 0.f;
        at[jt] = z;
    }
    bf16x8 pf[2];
    pf[0] = pack8(at[0], at[1]); pf[1] = pack8(at[2], at[3]);
    f32x4 o[4];
#pragma unroll
    for (int c = 0; c < 4; ++c) {
        const int dvt = 4 * dvh + c; f32x4 z = (f32x4){0.f, 0.f, 0.f, 0.f};
#pragma unroll
        for (int ks = 0; ks < 2; ++ks) {
            const int rb = 32 * ks + 4 * fq + (fr >> 2);
            LAS const unsigned char* vp = v_s + rb * 272 + (16 * dvt + 4 * (lane & 3)) * 2;
            z = MFMA(pf[ks], cat8(trr(vp), trr(vp + 16 * 272)), z);
        }
#pragma unroll
        for (int ks = 0; ks < 2; ++ks) {
            const bf16x8 sf = *(LAS const bf16x8*)(st_s + (16 * dvt + fr) * 144 + (32 * ks + 8 * fq) * 2);
            z = MFMA(qef[ks], sf, z);
        }
        o[c] = z;
    }
    float ssq[4];
#pragma unroll
    for (int r = 0; r < 4; ++r) { float s = 0.f;
#pragma unroll
        for (int c = 0; c < 4; ++c) s += o[c][r] * o[c][r];
        s += __shfl_xor(s, 1); s += __shfl_xor(s, 2); s += __shfl_xor(s, 4); s += __shfl_xor(s, 8);
        ssq[r] = s; if (fr == 0) ssq_s[F.wave * 16 + 4 * fq + r] = s; }
    __syncthreads();
#pragma unroll
    for (int r = 0; r < 4; ++r) {
        const float tot = ssq[r] + ssq_s[(F.wave ^ 1) * 16 + 4 * fq + r];
        const float rinv = rsqrtf(tot * (1.f / 128.f) + EPS);
        const int t = t0 + 16 * ib + 4 * fq + r;
#pragma unroll
        for (int c = 0; c < 4; ++c) { const int dv = 16 * (4 * dvh + c) + fr;
            const float gg = bf2f(proj[(size_t)t * INP + GG_OFF + h * 128 + dv]);
            const float val = o[c][r] * rinv * F.g_gla_norm[dv] * (gg / (1.f + __expf(-gg)));
            mix[(size_t)t * D + 512 + h * 128 + dv] = (bf16)f2bf(val); }
    }
    __syncthreads();
}

template <bool OUT>
__device__ __forceinline__ void gla_super_unit(const Frame& F, int u) {
    const int sc = u & 31, h = (u >> 5) & 3, b = u >> 7;
    const bf16* proj = WSP(bf16, WS_PROJ); bf16* mix = WSP(bf16, WS_MIX);
    LAS unsigned char* qd_s = F.lds; LAS unsigned char* kk_s = F.lds + 9216; LAS unsigned char* qe_s = F.lds + 18432;
    LAS unsigned char* v_s = F.lds + 27648; LAS unsigned char* st_s = F.lds + 45056; LAS unsigned char* kd_s = F.lds + 63488;
    LAS float* ga_s = (LAS float*)(F.lds + 72704); LAS float* tot_s = (LAS float*)(F.lds + 76800); LAS float* ssq_s = (LAS float*)(F.lds + 78848); LAS float* dec_s = (LAS float*)(F.lds + 79360);
    const int lane = F.lane, fr = lane & 15, fq = lane >> 4;
    const int ib = F.wave >> 1, dvh = F.wave & 1;
    float wu[16];
#pragma unroll
    for (int r = 0; r < 16; ++r) wu[r] = F.w_gate_up[r * 256 + h * 64 + lane];
    const float bg = F.b_gate[h * 64 + lane];
    float gn[4];
#pragma unroll
    for (int cc = 0; cc < 4; ++cc) gn[cc] = OUT ? F.g_gla_norm[16 * (4 * dvh + cc) + fr] : 0.f;
    float* Sg = WSP(float, WS_KV) + (size_t)u * 8192 + (16 * F.wave + fr) * 64 + 4 * fq;
    f32x4 St[4];
#pragma unroll
    for (int d = 0; d < 4; ++d) St[d] = OUT ? *(const f32x4*)(Sg + 16 * d) : (f32x4){0.f, 0.f, 0.f, 0.f};
    float ltot = 0.f;
    u32x4 v_r[2]; unsigned ga_r[2], k_r[8], q_r[8], gg_r[16];
#define GLA_LOAD_CHUNK(tc0) do { \
        _Pragma("unroll") for (int i = 0; i < 2; ++i) { const int cid = F.tid + 512 * i, row = cid >> 4, ch = cid & 15; v_r[i] = *(const u32x4*)(proj + (size_t)((tc0) + row) * INP + GV_OFF + h * 128 + ch * 8); } \
        _Pragma("unroll") for (int i = 0; i < 2; ++i) { const int idx = F.tid + 512 * i, t = idx >> 4, r = idx & 15; ga_r[i] = proj[(size_t)((tc0) + t) * INP + GA_OFF + r]; } \
        _Pragma("unroll") for (int i = 0; i < 8; ++i) { const bf16* rp = proj + (size_t)((tc0) + 8 * F.wave + i) * INP + h * 64 + lane; k_r[i] = rp[GK_OFF]; if (OUT) q_r[i] = rp[GQ_OFF]; } \
        if (OUT) { _Pragma("unroll") for (int r = 0; r < 4; ++r) _Pragma("unroll") for (int cc = 0; cc < 4; ++cc) \
            gg_r[r * 4 + cc] = proj[(size_t)((tc0) + 16 * ib + 4 * fq + r) * INP + GG_OFF + h * 128 + 16 * (4 * dvh + cc) + fr]; } } while (0)
    const int tu0 = b * S + sc * 512;
    GLA_LOAD_CHUNK(tu0);
    for (int c = 0; c < 8; ++c) {
        const int t0 = tu0 + c * 64;
#pragma unroll
        for (int i = 0; i < 2; ++i) { const int cid = F.tid + 512 * i, row = cid >> 4, ch = cid & 15; *(LAS u32x4*)(v_s + row * 272 + ch * 16) = v_r[i]; }
#pragma unroll
        for (int i = 0; i < 2; ++i) ga_s[F.tid + 512 * i] = bf2f(ga_r[i]);
        float kx[8], qx[8], ggf[16];
#pragma unroll
        for (int i = 0; i < 8; ++i) { kx[i] = bf2f(k_r[i]); qx[i] = OUT ? bf2f(q_r[i]) * 0.125f : 0.f; }
#pragma unroll
        for (int i = 0; i < 16; ++i) ggf[i] = OUT ? bf2f(gg_r[i]) : 0.f;
        if (c < 7) GLA_LOAD_CHUNK(t0 + 64);
        __syncthreads();
        float bv[8]; float run = 0.f;
#pragma unroll
        for (int i = 0; i < 8; ++i) {
            const int t = 8 * F.wave + i; float z = bg;
#pragma unroll
            for (int r = 0; r < 16; ++r) z += ga_s[t * 16 + r] * wu[r];
            const float ls = fminf(z, 0.f) - __logf(1.f + __expf(-fabsf(z)));
            run += ls * (1.f / 16.f); bv[i] = run;
        }
        tot_s[F.wave * 64 + lane] = run;
        if (OUT) {
#pragma unroll
            for (int d = 0; d < 4; ++d) { u32x2 w; w.x = pk2(St[d][0], St[d][1]); w.y = pk2(St[d][2], St[d][3]);
                *(LAS u32x2*)(st_s + (16 * F.wave + fr) * 144 + (16 * d + 4 * fq) * 2) = w; }
        }
        __syncthreads();
        float pre = 0.f, b_mid = 0.f, b_last = 0.f;
#pragma unroll
        for (int w = 0; w < 8; ++w) { const float tv = tot_s[w * 64 + lane]; pre += (w < F.wave) ? tv : 0.f; b_mid += (w < 4) ? tv : 0.f; b_last += tv; }
        ltot += b_last;
#pragma unroll
        for (int i = 0; i < 8; ++i) { const int t = 8 * F.wave + i; const float bb = bv[i] + pre;
            *(LAS bf16*)(kd_s + t * 144 + lane * 2) = (bf16)f2bf(kx[i] * __expf(b_last - bb));
            if (OUT) {
                *(LAS bf16*)(qd_s + t * 144 + lane * 2) = (bf16)f2bf(qx[i] * __expf(bb - b_mid));
                *(LAS bf16*)(kk_s + t * 144 + lane * 2) = (bf16)f2bf(kx[i] * __expf(b_mid - bb));
                *(LAS bf16*)(qe_s + t * 144 + lane * 2) = (bf16)f2bf(qx[i] * __expf(bb)); } }
        if (F.wave == 0) dec_s[lane] = __expf(b_last);
        __syncthreads();
        if (OUT) {
            bf16x8 qdf[2], qef[2];
#pragma unroll
            for (int ks = 0; ks < 2; ++ks) { qdf[ks] = *(LAS const bf16x8*)(qd_s + (16 * ib + fr) * 144 + (32 * ks + 8 * fq) * 2);
                                             qef[ks] = *(LAS const bf16x8*)(qe_s + (16 * ib + fr) * 144 + (32 * ks + 8 * fq) * 2); }
            f32x4 at[4];
#pragma unroll
            for (int jt = 0; jt < 4; ++jt) {
                LAS const unsigned char* kp = kk_s + (16 * jt + fr) * 144 + (8 * fq) * 2;
                const bf16x8 k0 = *(LAS const bf16x8*)kp, k1 = *(LAS const bf16x8*)(kp + 64);
                f32x4 z = (f32x4){0.f, 0.f, 0.f, 0.f}; z = MFMA(k0, qdf[0], z); z = MFMA(k1, qdf[1], z);
#pragma unroll
                for (int r = 0; r < 4; ++r) if (16 * jt + 4 * fq + r > 16 * ib + fr) z[r] = 0.f;
                at[jt] = z;
            }
            bf16x8 pf[2];
            pf[0] = pack8(at[0], at[1]); pf[1] = pack8(at[2], at[3]);
            f32x4 o[4];
#pragma unroll
            for (int cc = 0; cc < 4; ++cc) {
                const int dvt = 4 * dvh + cc; f32x4 z = (f32x4){0.f, 0.f, 0.f, 0.f};
#pragma unroll
                for (int ks = 0; ks < 2; ++ks) {
                    const int rb = 32 * ks + 4 * fq + (fr >> 2);
                    LAS const unsigned char* vp = v_s + rb * 272 + (16 * dvt + 4 * (lane & 3)) * 2;
                    z = MFMA(pf[ks], cat8(trr(vp), trr(vp + 16 * 272)), z);
                }
#pragma unroll
                for (int ks = 0; ks < 2; ++ks) {
                    const bf16x8 sf = *(LAS const bf16x8*)(st_s + (16 * dvt + fr) * 144 + (32 * ks + 8 * fq) * 2);
                    z = MFMA(qef[ks], sf, z);
                }
                o[cc] = z;
            }
            float ssq[4];
#pragma unroll
            for (int r = 0; r < 4; ++r) { float sq = 0.f;
#pragma unroll
                for (int cc = 0; cc < 4; ++cc) sq += o[cc][r] * o[cc][r];
                sq += __shfl_xor(sq, 1); sq += __shfl_xor(sq, 2); sq += __shfl_xor(sq, 4); sq += __shfl_xor(sq, 8);
                ssq[r] = sq; if (fr == 0) ssq_s[F.wave * 16 + 4 * fq + r] = sq; }
            __syncthreads();
#pragma unroll
            for (int r = 0; r < 4; ++r) {
                const float tot = ssq[r] + ssq_s[(F.wave ^ 1) * 16 + 4 * fq + r];
                const float rinv = rsqrtf(tot * (1.f / 128.f) + EPS);
                const int t = t0 + 16 * ib + 4 * fq + r;
#pragma unroll
                for (int cc = 0; cc < 4; ++cc) { const int dv = 16 * (4 * dvh + cc) + fr;
                    const float gg = ggf[r * 4 + cc];
                    const float val = o[cc][r] * rinv * gn[cc] * (gg / (1.f + __expf(-gg)));
                    mix[(size_t)t * D + 512 + h * 128 + dv] = (bf16)f2bf(val); }
            }
        }
#pragma unroll
        for (int d = 0; d < 4; ++d) { const f32x4 dc = *(LAS const f32x4*)(dec_s + 16 * d + 4 * fq); St[d] = St[d] * dc; }
#pragma unroll
        for (int ks = 0; ks < 2; ++ks) {
            const int rb = 32 * ks + 8 * fq + (fr >> 2);
            LAS const unsigned char* vp = v_s + rb * 272 + (16 * F.wave + 4 * (lane & 3)) * 2;
            const bf16x8 vf = cat8(trr(vp), trr(vp + 4 * 272));
#pragma unroll
            for (int d = 0; d < 4; ++d) {
                LAS const unsigned char* kp = kd_s + rb * 144 + (16 * d + 4 * (lane & 3)) * 2;
                St[d] = MFMA(cat8(trr(kp), trr(kp + 4 * 144)), vf, St[d]);
            }
        }
        __syncthreads();
    }
#undef GLA_LOAD_CHUNK
    if (!OUT) {
#pragma unroll
        for (int d = 0; d < 4; ++d) *(f32x4*)(Sg + 16 * d) = St[d];
        if (F.wave == 0) WSP(float, WS_DECAY)[u * 64 + lane] = __expf(ltot);
    }
}
__device__ __forceinline__ void gla_super_scan(const Frame& F) {
    float* kv = WSP(float, WS_KV); const float* decay = WSP(float, WS_DECAY);
    if (F.tid >= 256) return;
    for (int idx = F.bx * 256 + F.tid; idx < 65536; idx += F.G * 256) {
        const int bh = idx >> 13, dvdk = idx & 8191, dk = idx & 63;
        float* p = kv + (size_t)(bh * 32) * 8192 + dvdk; const float* dp = decay + (bh * 32) * 64 + dk;
        float tv[32], dv[32];
#pragma unroll
        for (int i = 0; i < 32; ++i) { tv[i] = p[(size_t)i * 8192]; dv[i] = dp[i * 64]; }
        float state = 0.f;
#pragma unroll
        for (int i = 0; i < 32; ++i) { p[(size_t)i * 8192] = state; state = dv[i] * state + tv[i]; }
    }
}

__device__ __forceinline__ void p7_norm_router(const Frame& F) {
    const float* mod = WSP(float, WS_MOD); const bf16* y = WSP(bf16, WS_Y); float* x1 = WSP(float, WS_X1); unsigned char* h2 = WSP(unsigned char, WS_H);
    unsigned* ctl = WSP(unsigned, WS_CTL);
    LAS float* wr_s = (LAS float*)F.lds;
    LAS float* lg_s = (LAS float*)(F.lds + SMALL_OFF);
    LAS float* rx_s = (LAS float*)(F.lds + SMALL_OFF + 16384);
    LAS float* z_s = (LAS float*)(F.lds + SMALL_OFF + 16384 + 512);
    LAS int* cnt_s = (LAS int*)(F.lds + SMALL_OFF + 16384 + 640);
    LAS int* base_s = (LAS int*)(F.lds + SMALL_OFF + 16384 + 768);
    LAS float* zr_s = (LAS float*)(F.lds + SMALL_OFF + 16384 + 1024);
    LAS int* flag_s = (LAS int*)(F.lds + SMALL_OFF + 16384 + 1024 + 2048);
    const int lane = F.lane, fr = lane & 15, fq = lane >> 4;
    const int mb0 = F.bx * 128 + F.wave * 16;
    const float* modb = mod + (mb0 >> 14) * 6144;
#pragma unroll 4
    for (int i = 0; i < 16; ++i) { const int i4 = F.tid + 512 * i, k = i4 >> 3, e0 = (i4 & 7) * 4;
        const f32x4 w = *(const f32x4*)(F.w_router + k * 32 + e0);
        const float gs = F.g_pre_ffn[k] * (1.f + modb[4096 + k]);
        LAS float* dst = wr_s + (k >> 2) * 128 + e0 * 4 + (k & 3);
        dst[0] = w[0] * gs; dst[4] = w[1] * gs; dst[8] = w[2] * gs; dst[12] = w[3] * gs; }
    { const int e = F.tid & 31, ks = F.tid >> 5; float zz = 0.f;
#pragma unroll
        for (int k = ks * 64; k < ks * 64 + 64; ++k) zz += modb[3072 + k] * F.w_router[k * 32 + e];
        zr_s[ks * 32 + e] = zz; }
    if (F.tid < 32) cnt_s[F.tid] = 0;
    __syncthreads();
    if (F.tid < 32) { float zz = F.b_router[F.tid];
#pragma unroll
        for (int i = 0; i < 16; ++i) zz += zr_s[i * 32 + F.tid];
        z_s[F.tid] = zz; }
    f32x4 pg[4], pg2[4], psh[4];
    u32x2 ya[4], yb[4], yc[4], yd[4]; f32x4 xa[4], xbf[4], xc[4], xd[4];
    const bf16* ybase = y + (size_t)mb0 * D + 4 * lane; const float* xbase = F.x + (size_t)mb0 * D + 4 * lane;
#define P7_LOAD(Y, X, r) do { _Pragma("unroll") for (int j = 0; j < 4; ++j) { Y[j] = *(const u32x2*)(ybase + (size_t)(r) * D + 256 * j); X[j] = *(const f32x4*)(xbase + (size_t)(r) * D + 256 * j); } } while (0)
#define P7_ROW(Y, X, it) do { f32x4 xv[4], hv[4]; float ss = 0.f; \
        _Pragma("unroll") for (int j = 0; j < 4; ++j) { hv[j] = unpack4(Y[j]); ss += dot4(hv[j]); } \
        const float ry = rsqrtf(wave_sum(ss) * (1.f / D) + EPS); float s2 = 0.f; \
        _Pragma("unroll") for (int j = 0; j < 4; ++j) { xv[j] = X[j] + hv[j] * ry * pg[j]; s2 += dot4(xv[j]); } \
        const float rx = rsqrtf(wave_sum(s2) * (1.f / D) + EPS); \
        if (lane == 0) rx_s[F.wave * 16 + (it)] = rx; \
        _Pragma("unroll") for (int j = 0; j < 4; ++j) { const int idx = 4 * lane + 256 * j; \
            hv[j] = xv[j] * rx * pg2[j] + psh[j]; \
            *(f32x4*)(x1 + (size_t)(mb0 + (it)) * D + idx) = xv[j]; \
            *(unsigned*)(h2 + (size_t)(mb0 + (it)) * D + idx) = pk4_fp8(hv[j][0] * H8_SCALE, hv[j][1] * H8_SCALE, hv[j][2] * H8_SCALE, hv[j][3] * H8_SCALE); } \
        if ((it) + 4 < 16) P7_LOAD(Y, X, (it) + 4); } while (0)
    P7_LOAD(ya, xa, 0); P7_LOAD(yb, xbf, 1); P7_LOAD(yc, xc, 2); P7_LOAD(yd, xd, 3);
#pragma unroll
    for (int j = 0; j < 4; ++j) { const int idx = 4 * lane + 256 * j;
        pg[j] = *(const f32x4*)(F.g_post_mix + idx) * *(const f32x4*)(modb + 2048 + idx);
        pg2[j] = *(const f32x4*)(F.g_pre_ffn + idx) * (*(const f32x4*)(modb + 4096 + idx) + 1.f); psh[j] = *(const f32x4*)(modb + 3072 + idx); }
#pragma unroll 1
    for (int it = 0; it < 16; it += 4) { P7_ROW(ya, xa, it); P7_ROW(yb, xbf, it + 1); P7_ROW(yc, xc, it + 2); P7_ROW(yd, xd, it + 3); }
#undef P7_LOAD
#undef P7_ROW
    asm volatile("s_waitcnt vmcnt(0)" ::: "memory");
    f32x4 acc0 = (f32x4){0.f, 0.f, 0.f, 0.f}, acc1 = (f32x4){0.f, 0.f, 0.f, 0.f};
    { const float* ap = x1 + (size_t)(mb0 + fr) * D + 4 * fq;
        LAS const float* bp = wr_s + fq * 128 + fr * 4;
        f32x4 a[8], na[8];
#pragma unroll
        for (int q = 0; q < 8; ++q) a[q] = *(const f32x4*)(ap + 16 * q);
        for (int s0 = 0; s0 < 64; s0 += 8) {
            const int sn = s0 < 56 ? s0 + 8 : s0;
#pragma unroll
            for (int q = 0; q < 8; ++q) na[q] = *(const f32x4*)(ap + 16 * (sn + q));
#pragma unroll
            for (int q = 0; q < 8; ++q) { const f32x4 b0 = *(LAS const f32x4*)(bp + (s0 + q) * 512), b1 = *(LAS const f32x4*)(bp + (s0 + q) * 512 + 64);
#pragma unroll
                for (int t = 0; t < 4; ++t) { acc0 = __builtin_amdgcn_mfma_f32_16x16x4f32(a[q][t], b0[t], acc0, 0, 0, 0); acc1 = __builtin_amdgcn_mfma_f32_16x16x4f32(a[q][t], b1[t], acc1, 0, 0, 0); } }
#pragma unroll
            for (int q = 0; q < 8; ++q) a[q] = na[q];
        } }
    __syncthreads();
#pragma unroll
    for (int r = 0; r < 4; ++r) { const float rx = rx_s[F.wave * 16 + 4 * fq + r];
        lg_s[(F.wave * 16 + 4 * fq + r) * 32 + fr] = rx * acc0[r] + z_s[fr];
        lg_s[(F.wave * 16 + 4 * fq + r) * 32 + fr + 16] = rx * acc1[r] + z_s[fr + 16]; }
    const float NEG_INF = -__builtin_inff();
    int se[4], lp[4]; float gt[4];
    if (lane < 16) {
        float v[32];
#pragma unroll
        for (int ch = 0; ch < 8; ++ch) { const f32x4 w = *(LAS const f32x4*)(lg_s + (F.wave * 16 + lane) * 32 + 4 * ch); v[4 * ch] = w[0]; v[4 * ch + 1] = w[1]; v[4 * ch + 2] = w[2]; v[4 * ch + 3] = w[3]; }
        float sv[4];
#pragma unroll
        for (int r = 0; r < 4; ++r) { float best = v[0]; int bi = 0;
#pragma unroll
            for (int e = 1; e < 32; ++e) if (v[e] > best) { best = v[e]; bi = e; }
            se[r] = bi; sv[r] = best;
#pragma unroll
            for (int e = 0; e < 32; ++e) v[e] = (e == bi) ? NEG_INF : v[e]; }
        const float p1 = __expf(sv[1] - sv[0]), p2 = __expf(sv[2] - sv[0]), p3 = __expf(sv[3] - sv[0]);
        const float rs = 1.f / (1.f + p1 + p2 + p3);
        gt[0] = rs; gt[1] = p1 * rs; gt[2] = p2 * rs; gt[3] = p3 * rs;
#pragma unroll
        for (int r = 0; r < 4; ++r) lp[r] = __hip_atomic_fetch_add(cnt_s + se[r], 1, __ATOMIC_RELAXED, __HIP_MEMORY_SCOPE_WORKGROUP);
    }
    __syncthreads();
    if (F.tid < 32) base_s[F.tid] = (int)__hip_atomic_fetch_add(ctl + CW_GCNT + 64 * F.tid, (unsigned)cnt_s[F.tid], __ATOMIC_RELAXED, __HIP_MEMORY_SCOPE_AGENT);
    __syncthreads();
    if (lane < 16) { int* la = WSP(int, WS_LIST_A); float* lgt = WSP(float, WS_LIST_G); const int m = mb0 + lane;
#pragma unroll
        for (int r = 0; r < 4; ++r) { const size_t p = (size_t)se[r] * T + base_s[se[r]] + lp[r]; la[p] = m * 4 + r; lgt[p] = gt[r]; } }
    asm volatile("s_waitcnt vmcnt(0)" ::: "memory");
    __syncthreads();
    if (F.tid == 0) flag_s[0] = (__hip_atomic_fetch_add(ctl + CW_DONE, 1u, __ATOMIC_RELAXED, __HIP_MEMORY_SCOPE_AGENT) == (unsigned)(F.G - 1)) ? 1 : 0;
    __syncthreads();
    if (flag_s[0]) {
        LAS int* off_s = (LAS int*)zr_s;
        if (F.tid < 32) { const int c = (int)__hip_atomic_load(ctl + CW_GCNT + 64 * F.tid, __ATOMIC_RELAXED, __HIP_MEMORY_SCOPE_AGENT); cnt_s[F.tid] = c; ctl[CW_MOE_CNT + F.tid] = (unsigned)c; }
        __syncthreads();
        if (F.tid == 0) { int off = 0; for (int e = 0; e < 32; ++e) { off_s[e] = off; off += (cnt_s[e] + 255) & ~255; } off_s[32] = off; }
        __syncthreads();
        if (F.tid <= 32) WSP(int, WS_MOE_OFF)[F.tid] = off_s[F.tid];
        const int ntile = off_s[32] >> 8;
        for (int rt = F.tid; rt < ntile; rt += NTHREADS) { int e = 0;
            for (int q = 1; q < 32; ++q) e = (off_s[q] <= rt * 256) ? q : e;
            WSP(int, WS_TILE_E)[rt] = e; }
    }
}

__device__ __forceinline__ f32x4 unpack4_fp8(unsigned w) {
    const auto lo = __builtin_amdgcn_cvt_pk_f32_fp8((int)w, false), hi = __builtin_amdgcn_cvt_pk_f32_fp8((int)w, true);
    return (f32x4){lo[0], lo[1], hi[0], hi[1]};
}
__device__ __forceinline__ void p11_combine(const Frame& F) {
    const float* mod = WSP(float, WS_MOD); const unsigned char* ys = WSP(unsigned char, WS_YS); const float* x1 = WSP(float, WS_X1);
    const int gw = F.bx * NWAVES + F.wave, m0 = gw * 16, lane = F.lane;
    const float* modb = mod + (m0 >> 14) * 6144;
    const unsigned char* yb = ys + (size_t)m0 * 4 * D + 4 * lane; const float* xb = x1 + (size_t)m0 * D + 4 * lane;
    unsigned ya[4][4], ybb[4][4], yc[4][4], yd[4][4]; f32x4 xa[4], xbf[4], xc[4], xd[4], g[4];
#define P11_LOAD(Y, X, r) do { _Pragma("unroll") for (int j = 0; j < 4; ++j) { X[j] = *(const f32x4*)(xb + (size_t)(r) * D + 256 * j); \
        _Pragma("unroll") for (int k4 = 0; k4 < 4; ++k4) Y[j][k4] = *(const unsigned*)(yb + ((size_t)(r) * 4 + k4) * D + 256 * j); } } while (0)
#define P11_ROW(Y, X, it) do { f32x4 yv[4]; float ss = 0.f; \
        _Pragma("unroll") for (int j = 0; j < 4; ++j) { f32x4 a = (f32x4){0.f, 0.f, 0.f, 0.f}; \
            _Pragma("unroll") for (int k4 = 0; k4 < 4; ++k4) a += unpack4_fp8(Y[j][k4]); \
            yv[j] = a; ss += dot4(a); } \
        const float ry = rsqrtf(wave_sum(ss) * (1.f / D) + EPS * (Y8_SCALE * Y8_SCALE)); \
        _Pragma("unroll") for (int j = 0; j < 4; ++j) *(f32x4*)(F.out + (size_t)(m0 + (it)) * D + 4 * lane + 256 * j) = X[j] + yv[j] * ry * g[j]; \
        if ((it) + 4 < 16) P11_LOAD(Y, X, (it) + 4); } while (0)
    P11_LOAD(ya, xa, 0); P11_LOAD(ybb, xbf, 1); P11_LOAD(yc, xc, 2); P11_LOAD(yd, xd, 3);
#pragma unroll
    for (int j = 0; j < 4; ++j) { const int idx = 4 * lane + 256 * j; g[j] = *(const f32x4*)(F.g_post_ffn + idx) * *(const f32x4*)(modb + 5120 + idx); }
#pragma unroll 1
    for (int it = 0; it < 16; it += 4) { P11_ROW(ya, xa, it); P11_ROW(ybb, xbf, it + 1); P11_ROW(yc, xc, it + 2); P11_ROW(yd, xd, it + 3); }
#undef P11_LOAD
#undef P11_ROW
}

constexpr int NPHASE = 11;
struct Args { const float* in[20]; float* out; unsigned char* ws; int ph_lo, ph_hi; };
__global__ void __launch_bounds__(NTHREADS, 2) fwd(Args args) {
    extern __shared__ __attribute__((aligned(16))) unsigned char lds[];
    Frame F;
    F.lds = (LAS unsigned char*)lds;
    F.tid = threadIdx.x; F.lane = F.tid & 63; F.wave = __builtin_amdgcn_readfirstlane(F.tid >> 6); F.bx = blockIdx.x; F.G = gridDim.x;
    F.x = args.in[0]; F.c = args.in[1]; F.w_ada = args.in[2]; F.b_ada = args.in[3]; F.g_pre_mix = args.in[4]; F.g_post_mix = args.in[5];
    F.g_pre_ffn = args.in[6]; F.g_post_ffn = args.in[7]; F.w_in = args.in[8]; F.w_gate_up = args.in[9]; F.b_gate = args.in[10]; F.g_gla_norm = args.in[11];
    F.sinks = args.in[12]; F.w_out = args.in[13]; F.w_router = args.in[14]; F.b_router = args.in[15]; F.w_mlp1 = args.in[16]; F.b_mlp1 = args.in[17];
    F.w_mlp2 = args.in[18]; F.b_mlp2 = args.in[19]; F.out = args.out; F.ws = args.ws;
    volatile LAS unsigned* MISC = (volatile LAS unsigned*)(F.lds + MISC_OFF);
    if (F.tid < 32) MISC[F.tid] = 0u;
    __syncthreads();
    const int lo = args.ph_lo, hi = args.ph_hi;
    XcdBarrier bar; bar.bar = (unsigned*)(F.ws + WS_CTL) + CW_BAR; bar.x = 0; bar.st = nullptr;
    if (hi - lo > 1) bar = xcd_barrier_post((unsigned*)(F.ws + WS_CTL) + CW_BAR, MISC + 8);
#define IN(k) (lo <= (k) && (k) < hi)
#if DUPMASK
#define REP(k) _Pragma("nounroll") for (int rep_ = 0; rep_ < 1 + ((DUPMASK >> (k)) & 1); ++rep_, __syncthreads())
#else
#define REP(k)
#endif
#define SEAM(k) do { if (IN(k) && IN((k) + 1)) xcd_barrier(bar); } while (0)

    if (IN(0)) REP(0) { p0_prologue(F); } SEAM(0);
    if (IN(1)) REP(1) { p1_norm(F); } SEAM(1);
    if (IN(2)) REP(2) { pg8::StaticOrder So; So.init(T / 256, INP / 256, F.G, F.bx);
                 pg8::gemm_phase<false, 0, 0, 0>(F.lds, D, So, pg8::ABDense{WSP(bf16, WS_H), WSP(bf16, WS_WIN), D}, pg8::EpiStoreT{WSP(bf16, WS_PROJ), INP}); } SEAM(2);
    if (IN(3)) REP(3) { for (int u = F.bx; u < 512; u += F.G) attn_unit(F, u);
                 for (int u = F.bx; u < 256; u += F.G) gla_super_unit<false>(F, u); } SEAM(3);
    if (IN(4)) REP(4) { gla_super_scan(F); } SEAM(4);
    if (IN(5)) REP(5) { for (int u = F.bx; u < 256; u += F.G) gla_super_unit<true>(F, u); } SEAM(5);
    if (IN(6)) REP(6) { pg8::StaticOrder So; So.init(T / 256, D / 256, F.G, F.bx);
                 pg8::gemm_phase<false, 0, 0, 0>(F.lds, D, So, pg8::ABDense{WSP(bf16, WS_MIX), WSP(bf16, WS_WOUT), D}, pg8::EpiStoreT{WSP(bf16, WS_Y), D}); } SEAM(6);
    if (IN(7)) REP(7) { p7_norm_router(F); } SEAM(7);
    if (IN(8)) REP(8) { const int nM = WSP(int, WS_MOE_OFF)[32] >> 8; pg8::StaticOrder So; So.init(nM, 2048 / 256, F.G, F.bx);
                 pg8::gemm_phase<true, 1, W8_E8M0, H8_E8M0>(F.lds, 512, So, pg8::ABMoe1{WSP(unsigned char, WS_H), WSP(unsigned char, WS_W1T), WSP(int, WS_TILE_E), WSP(int, WS_MOE_OFF), WSP(unsigned, WS_CTL) + CW_MOE_CNT, WSP(int, WS_LIST_A)},
                                       pg8::EpiSwigluT{WSP(unsigned char, WS_A), F.b_mlp1, WSP(int, WS_TILE_E)}); } SEAM(8);
    if (IN(9)) REP(9) { const int nM = WSP(int, WS_MOE_OFF)[32] >> 8; pg8::StaticOrder So; So.init(nM, D / 256, F.G, F.bx);
                  pg8::gemm_phase<false, 1, W8_E8M0, A8_E8M0>(F.lds, 512, So, pg8::ABMoe2{WSP(unsigned char, WS_A), WSP(unsigned char, WS_W2T), WSP(int, WS_TILE_E)},
                                         pg8::EpiMoe2T{WSP(unsigned char, WS_YS), F.b_mlp2, WSP(int, WS_TILE_E), WSP(int, WS_MOE_OFF), WSP(unsigned, WS_CTL) + CW_MOE_CNT, WSP(int, WS_LIST_A), WSP(float, WS_LIST_G)}); } SEAM(9);
    if (IN(10)) REP(10) { p11_combine(F); }
#undef IN
#undef SEAM
}

extern "C" void kernel_launch(void* const* d_in, const int* in_sizes, int n_in, void* d_out, int out_size, void* d_ws, size_t ws_size, hipStream_t stream) {
    static int ready = 0;
    if (ready == 0) {
        if (n_in != 20 || out_size != T * D || ws_size < WS_END) { fprintf(stderr, "kernel_launch: unexpected problem (n_in %d, out %d, ws %zu)\n", n_in, out_size, ws_size); ready = -1; return; }
        if (hipFuncSetAttribute((const void*)fwd, hipFuncAttributeMaxDynamicSharedMemorySize, LDS_BYTES) != hipSuccess) { fprintf(stderr, "kernel_launch: hipFuncSetAttribute failed\n"); ready = -1; return; }
        int per_cu = 0;
        if (hipOccupancyMaxActiveBlocksPerMultiprocessor(&per_cu, (const void*)fwd, NTHREADS, LDS_BYTES) != hipSuccess || per_cu < 1) fprintf(stderr, "kernel_launch: occupancy query says %d\n", per_cu);
        (void)hipGetLastError();
        ready = 1;
    }
    if (ready < 0) return;
    (void)hipMemsetAsync((char*)d_ws + WS_CTL, 0, CTL_ZERO_BYTES, stream);
    Args a{};
    for (int i = 0; i < 20; ++i) a.in[i] = (const float*)d_in[i];
    a.out = (float*)d_out; a.ws = (unsigned char*)d_ws;
#if MK_ONE_LAUNCH
    a.ph_lo = 0; a.ph_hi = NPHASE;
    hipLaunchKernelGGL(fwd, dim3(GRID), dim3(NTHREADS), LDS_BYTES, stream, a);
#if PROBE_PHASE >= 0
    a.ph_lo = PROBE_PHASE; a.ph_hi = PROBE_PHASE + 1;
    hipLaunchKernelGGL(fwd, dim3(GRID), dim3(NTHREADS), LDS_BYTES, stream, a);
#endif
#else
    for (int p = 0; p < NPHASE; ++p) { a.ph_lo = p; a.ph_hi = p + 1; hipLaunchKernelGGL(fwd, dim3(GRID), dim3(NTHREADS), LDS_BYTES, stream, a); }
#endif
}
```

```cpp
#include <hip/hip_runtime.h>
#include <cstdio>
#include <cstdint>

#ifndef MK_ONE_LAUNCH
#define MK_ONE_LAUNCH 1
#endif

#ifndef PROBE_PHASE
#define PROBE_PHASE -1
#endif
#ifndef P0_MODE
#define P0_MODE 0
#endif
#ifndef DUPMASK
#define DUPMASK 0
#endif
#define LAS __attribute__((address_space(3)))
typedef unsigned short bf16;
typedef short bf16x8 __attribute__((ext_vector_type(8)));
typedef short s16x4 __attribute__((ext_vector_type(4)));
typedef float f32x4 __attribute__((ext_vector_type(4)));
typedef unsigned u32x4 __attribute__((ext_vector_type(4)));
typedef unsigned u32x2 __attribute__((ext_vector_type(2)));

constexpr int D = 1024, NB = 2, S = 16384, T = NB * S;
constexpr int INW = 2320, INP = 2560;
constexpr int AQ_OFF = 0, AK_OFF = 512, AV_OFF = 640, GQ_OFF = 768, GK_OFF = 1024, GV_OFF = 1280, GG_OFF = 1792, GA_OFF = 2304;
constexpr int NCH = 256;
constexpr int NE = 32, FF = 1024;
constexpr int NSLOT_MAX = T * 4 + NE * 256;
constexpr float EPS = 1e-6f;
constexpr int NWAVES = 8, NTHREADS = 512, GRID = 256;

constexpr size_t MiB = 1u << 20;
constexpr size_t WS_CTL = 0, CTL_ZERO_BYTES = 1 * MiB;
constexpr size_t WS_MOD = 1 * MiB;
constexpr size_t WS_DECAY = 2 * MiB;
constexpr size_t WS_ROUTE = 3 * MiB;
constexpr size_t WS_TOK_E = WS_ROUTE, WS_TOK_LPOS = WS_ROUTE + 512 * 1024, WS_TOK_GATE = WS_ROUTE + 1024 * 1024;
constexpr size_t WS_BLK_CNT = WS_ROUTE + 1536 * 1024, WS_MOE_OFF = WS_BLK_CNT + 32 * 1024, WS_TILE_E = WS_MOE_OFF + 4096;
constexpr size_t WS_SLOT_ASSIGN = WS_ROUTE + 2 * MiB, WS_SLOT_GATE = WS_ROUTE + 3 * MiB;
constexpr size_t WS_WIN = 8 * MiB, WS_WOUT = 13 * MiB, WS_W2T = 16 * MiB, WS_W1T = 80 * MiB;
constexpr size_t WS_H = 208 * MiB, WS_KV = 272 * MiB, WS_YS = 80 * MiB;
constexpr size_t WS_X1 = 336 * MiB, WS_PROJ = 464 * MiB, WS_MIX = 624 * MiB, WS_Y = 688 * MiB, WS_A = 464 * MiB;
constexpr size_t WS_LIST_A = 752 * MiB, WS_LIST_G = 756 * MiB;
constexpr size_t WS_XS = 608 * MiB;
constexpr size_t WS_END = 760 * MiB;
constexpr int CW_BAR = 4096, CW_GCNT = 8192  , CW_DONE = 8192 + 64 * 32, CW_MOE_CNT = 16384  ;

constexpr int LDS_BYTES = 163840, SMALL_OFF = 132096, MISC_OFF = 131072 + 320;

__device__ __forceinline__ float bf2f(unsigned v) { return __uint_as_float(v << 16); }
__device__ __forceinline__ unsigned f2bf(float f) { unsigned u = __float_as_uint(f); return (u + 0x7fffu + ((u >> 16) & 1u)) >> 16; }
__device__ __forceinline__ unsigned pk2(float lo, float hi) { return f2bf(lo) | (f2bf(hi) << 16); }
__device__ __forceinline__ float wave_sum(float v) {
#pragma unroll
    for (int o = 1; o < 64; o <<= 1) v += __shfl_xor(v, o);
    return v;
}
__device__ __forceinline__ f32x4 unpack4(u32x2 r) { return (f32x4){bf2f(r.x & 0xffffu), bf2f(r.x >> 16), bf2f(r.y & 0xffffu), bf2f(r.y >> 16)}; }
__device__ __forceinline__ float dot4(f32x4 a) { return (a[0] * a[0] + a[1] * a[1]) + (a[2] * a[2] + a[3] * a[3]); }
typedef short v4i16_t __attribute__((ext_vector_type(4)));
__device__ __forceinline__ s16x4 trr(LAS const unsigned char* p) { return __builtin_bit_cast(s16x4, __builtin_amdgcn_ds_read_tr16_b64_v4i16((LAS v4i16_t*)p)); }
__device__ __forceinline__ bf16x8 cat8(s16x4 lo, s16x4 hi) { return __builtin_shufflevector(lo, hi, 0, 1, 2, 3, 4, 5, 6, 7); }
__device__ __forceinline__ bf16x8 pack8(f32x4 a, f32x4 b) { u32x4 w; w.x = pk2(a[0], a[1]); w.y = pk2(a[2], a[3]); w.z = pk2(b[0], b[1]); w.w = pk2(b[2], b[3]); return __builtin_bit_cast(bf16x8, w); }
#define MFMA(a, b, c) __builtin_amdgcn_mfma_f32_16x16x32_bf16((a), (b), (c), 0, 0, 0)
typedef int i32x4 __attribute__((ext_vector_type(4)));
typedef int i32x8 __attribute__((ext_vector_type(8)));
__device__ __forceinline__ float clamp8(float v) { return fminf(fmaxf(v, -448.f), 448.f); }
__device__ __forceinline__ unsigned pk4_fp8(float a, float b, float c, float d) {
    int w = 0; w = __builtin_amdgcn_cvt_pk_fp8_f32(clamp8(a), clamp8(b), w, false); w = __builtin_amdgcn_cvt_pk_fp8_f32(clamp8(c), clamp8(d), w, true); return (unsigned)w; }
constexpr float W8_SCALE = 64.f, H8_SCALE = 16.f, A8_SCALE = 4.f, Y8_SCALE = 16.f;
constexpr int W8_E8M0 = 0x79797979  , H8_E8M0 = 0x7b7b7b7b  , A8_E8M0 = 0x7d7d7d7d  ;

#define XB_TMO      128
#define XB_XCNT(j)  (256  + 64 * (j))
#define XB_XSUB(j)  (1280 + 64 * (j))
#define XB_XGEN(j)  (2304 + 64 * (j))
#define XB_TOP      3328
#define XB_TOPGEN   3392
#define XCD_BAR_WORDS 3456
#define XB_SPIN_CAP (1u << 18)
__device__ __forceinline__ unsigned xb_ld(unsigned* p)              { return __hip_atomic_load(p, __ATOMIC_RELAXED, __HIP_MEMORY_SCOPE_AGENT); }
__device__ __forceinline__ unsigned xb_add(unsigned* p, unsigned v) { return __hip_atomic_fetch_add(p, v, __ATOMIC_RELAXED, __HIP_MEMORY_SCOPE_AGENT); }
__device__ __forceinline__ unsigned xb_xcc_id() { return (unsigned)__builtin_amdgcn_s_getreg((3 << 11) | 20) & 0xFu; }
#define XB_SPIN(cond, bar) do { unsigned _sp = 0; while (cond) { __builtin_amdgcn_s_sleep(1); \
    if ((++_sp & 255u) == 0u) { if (xb_ld(&(bar)[XB_TMO])) break; if (_sp > XB_SPIN_CAP) { atomicAdd(&(bar)[XB_TMO], 1u); break; } } } } while (0)
struct XcdBarrier { unsigned* bar; unsigned x; volatile LAS unsigned* st; };
__device__ __forceinline__ XcdBarrier xcd_barrier_post(unsigned* bar, volatile LAS unsigned* st) {
    XcdBarrier b; b.bar = bar; b.x = xb_xcc_id(); b.st = st;
    if (threadIdx.x == 0) (void)xb_add(&bar[XB_XCNT(b.x)], 1u);
    return b;
}
__device__ __forceinline__ void xcd_barrier_complete(unsigned* bar, unsigned x, unsigned& nloc, unsigned& nx) {
    const unsigned G = gridDim.x * gridDim.y * gridDim.z;
    unsigned sum, cnt, mine, sp = 0u;
    for (;;) {
        sum = 0u; cnt = 0u; mine = 0u;
#pragma unroll
        for (unsigned j = 0; j < 16; ++j) { const unsigned c = xb_ld(&bar[XB_XCNT(j)]); sum += c; cnt += (c > 0u) ? 1u : 0u; mine = (j == x) ? c : mine; }
        if (sum == G) break;
        __builtin_amdgcn_s_sleep(1);
        if ((++sp & 255u) == 0u) { if (xb_ld(&bar[XB_TMO])) break; if (sp > XB_SPIN_CAP) { atomicAdd(&bar[XB_TMO], 1u); break; } }
    }
    nloc = mine > 0u ? mine : 1u; nx = cnt > 0u ? cnt : 1u;
}
__device__ __forceinline__ void xcd_barrier(const XcdBarrier& b) {
    asm volatile("s_waitcnt vmcnt(0)" ::: "memory");
    __syncthreads();
    if (threadIdx.x == 0) {
        unsigned* bar = b.bar;
        __builtin_amdgcn_s_waitcnt(0);
        unsigned nloc = b.st[0], nx = b.st[1];
        if (nloc == 0u) { xcd_barrier_complete(bar, b.x, nloc, nx); b.st[0] = nloc; b.st[1] = nx; }
        const unsigned old = xb_add(&bar[XB_XSUB(b.x)], 1u);
        const unsigned gen = old / nloc;
        if (old + 1u == (gen + 1u) * nloc) {
            __builtin_amdgcn_fence(__ATOMIC_RELEASE, "agent");
            asm volatile("s_waitcnt vmcnt(0)" ::: "memory");
            const unsigned og = xb_add(&bar[XB_TOP], 1u);
            const unsigned tg = og / nx;
            if (og + 1u == (tg + 1u) * nx) xb_add(&bar[XB_TOPGEN], 1u);
            else XB_SPIN(xb_ld(&bar[XB_TOPGEN]) == tg, bar);
            __builtin_amdgcn_fence(__ATOMIC_ACQUIRE, "agent");
            xb_add(&bar[XB_XGEN(b.x)], 1u);
            asm volatile("s_waitcnt vmcnt(0)" ::: "memory");
        } else {
            XB_SPIN(xb_ld(&bar[XB_XGEN(b.x)]) == gen, bar);
            __builtin_amdgcn_fence(__ATOMIC_ACQUIRE, "agent");
            asm volatile("s_waitcnt vmcnt(0)" ::: "memory");
        }
    }
    __syncthreads();
}

struct Frame {
    LAS unsigned char* lds;
    int tid, lane, wave, bx, G;
    const float *x, *c, *w_ada, *b_ada, *g_pre_mix, *g_post_mix, *g_pre_ffn, *g_post_ffn, *w_in, *w_gate_up, *b_gate, *g_gla_norm, *sinks, *w_out,
                *w_router, *b_router, *w_mlp1, *b_mlp1, *w_mlp2, *b_mlp2;
    float* out;
    unsigned char* ws;
};
#define WSP(type, off) ((type*)(F.ws + (off)))

struct TrItem { const float* W; int N; int k0, n0; unsigned char* WT; int kind; };
__device__ __forceinline__ bool tr_decode(const Frame& F, int it, TrItem& t) {
    constexpr int I_IN = 16 * 80, I_OUT = 16 * 32, I_1 = 16 * 64, I_2 = 16 * 32;
    constexpr int NITEMS = I_IN + I_OUT + NE * I_1 + NE * I_2;
    if (it >= NITEMS) return false;
    int r = it, nblk, item;
    if (r < I_IN) { t.W = F.w_in; t.N = INW; t.WT = F.ws + WS_WIN; t.kind = 0; nblk = 80; item = r; }
    else if ((r -= I_IN) < I_OUT) { t.W = F.w_out; t.N = 1024; t.WT = F.ws + WS_WOUT; t.kind = 0; nblk = 32; item = r; }
    else if ((r -= I_OUT) < NE * I_1) { const int e = r / I_1; t.W = F.w_mlp1 + (size_t)e * 1024 * 2048; t.N = 2048; t.WT = F.ws + WS_W1T + (size_t)e * 2048 * 1024; t.kind = 1; nblk = 64; item = r % I_1; }
    else { r -= NE * I_1; const int e = r / I_2; t.W = F.w_mlp2 + (size_t)e * 1024 * 1024; t.N = 1024; t.WT = F.ws + WS_W2T + (size_t)e * 1024 * 1024; t.kind = 2; nblk = 32; item = r % I_2; }
    t.k0 = 64 * (item / nblk); t.n0 = 32 * (item % nblk);
    return true;
}
__device__ __forceinline__ void tr_load(const TrItem& t, int lane, float (&v)[32]) {
    const int n = t.n0 + (lane & 31); const bool ok = n < t.N; const int nc = ok ? n : t.N - 1;
    const float* wp = t.W + (size_t)(t.k0 + (lane >> 5)) * t.N + nc; const size_t st = (size_t)2 * t.N;
#pragma unroll
    for (int i = 0; i < 32; ++i) v[i] = wp[i * st];
#pragma unroll
    for (int i = 0; i < 32; ++i) v[i] = ok ? v[i] : 0.f;
}
__device__ __forceinline__ void tr_store(const TrItem& t, int lane, const float (&v)[32], LAS float* scr) {
#pragma unroll
    for (int i = 0; i < 32; ++i) scr[(2 * i + (lane >> 5)) * 33 + (lane & 31)] = v[i];
    asm volatile("s_waitcnt lgkmcnt(0)" ::: "memory");
    const int c = lane & 7;
#pragma unroll
    for (int j = 0; j < 4; ++j) { const int nn = (lane >> 3) + 8 * j; const LAS float* s = scr + (8 * c) * 33 + nn;
        float e[8];
#pragma unroll
        for (int q = 0; q < 8; ++q) e[q] = s[q * 33];
        const int n = t.n0 + nn;
        if (t.kind == 0) { u32x4 o; o.x = pk2(e[0], e[1]); o.y = pk2(e[2], e[3]); o.z = pk2(e[4], e[5]); o.w = pk2(e[6], e[7]);
            *(u32x4*)((bf16*)t.WT + (size_t)n * 1024 + t.k0 + 8 * c) = o; }
        else { u32x2 o; o.x = pk4_fp8(e[0] * W8_SCALE, e[1] * W8_SCALE, e[2] * W8_SCALE, e[3] * W8_SCALE); o.y = pk4_fp8(e[4] * W8_SCALE, e[5] * W8_SCALE, e[6] * W8_SCALE, e[7] * W8_SCALE);
            int row = n; if (t.kind == 1) { const int jj = n >> 1; row = 256 * (jj >> 7) + 128 * (n & 1) + (jj & 127); }
            *(u32x2*)(t.WT + (size_t)row * 1024 + t.k0 + 8 * c) = o; } }
    asm volatile("s_waitcnt lgkmcnt(0)" ::: "memory");
}
template <int MODE>
__device__ __forceinline__ void tr_range(const Frame& F, int itB, int itE) {
    LAS float* scr = (LAS float*)(F.lds + F.wave * 8704);
    const int it0 = itB + F.wave;
    TrItem t0, t1, t2; float v0[32], v1[32], v2[32];
    bool h0 = (it0 < itE) && tr_decode(F, it0, t0); if (h0) tr_load(t0, F.lane, v0);
    bool h1 = (it0 + NWAVES < itE) && tr_decode(F, it0 + NWAVES, t1); if (h1) tr_load(t1, F.lane, v1);
    bool h2 = (it0 + 2 * NWAVES < itE) && tr_decode(F, it0 + 2 * NWAVES, t2); if (h2) tr_load(t2, F.lane, v2);
#define P0_STEP(T, V, H, nextit) do { if (H) { if (MODE == 1) { _Pragma("unroll") for (int i_ = 0; i_ < 32; ++i_) asm volatile("" :: "v"(V[i_])); } else tr_store(T, F.lane, V, scr); \
        H = ((nextit) < itE) && tr_decode(F, (nextit), T); if (H) tr_load(T, F.lane, V); } } while (0)
#pragma unroll 1
    for (int it = it0; h0 || h1 || h2; it += 3 * NWAVES) {
        P0_STEP(t0, v0, h0, it + 3 * NWAVES); P0_STEP(t1, v1, h1, it + 4 * NWAVES); P0_STEP(t2, v2, h2, it + 5 * NWAVES);
    }
#undef P0_STEP
}
template <int MODE>
__device__ __forceinline__ void p0_prologue(const Frame& F) {
    float* mod = WSP(float, WS_MOD);
    if (F.bx < 192 && MODE != 3 && MODE != 1) {
        LAS float* red = (LAS float*)(F.lds + 98304);
        const int cl = F.tid & 31, ks = F.tid >> 5, col = F.bx * 32 + cl;
        float a0 = 0.f, a1 = 0.f;
        float wv[64];
#pragma unroll
        for (int i = 0; i < 64; ++i) wv[i] = F.w_ada[(size_t)(ks * 64 + i) * 6144 + col];
#pragma unroll
        for (int i = 0; i < 64; ++i) { const int k = ks * 64 + i;
            const float c0 = F.c[k], c1 = F.c[1024 + k];
            a0 += c0 * __builtin_amdgcn_rcpf(1.f + __expf(-c0)) * wv[i]; a1 += c1 * __builtin_amdgcn_rcpf(1.f + __expf(-c1)) * wv[i];
        }
        red[(0 * 16 + ks) * 32 + cl] = a0; red[(1 * 16 + ks) * 32 + cl] = a1;
        __syncthreads();
        if (F.tid < 64) { const int b = F.tid >> 5; float s = 0.f;
#pragma unroll
            for (int i = 0; i < 16; ++i) s += red[(b * 16 + i) * 32 + cl];
            mod[b * 6144 + col] = s + F.b_ada[col]; }
        __syncthreads();
    }
    if (MODE == 2) return;
    tr_range<MODE>(F, F.bx * 7, F.bx * 7 + 7);
}

__device__ __forceinline__ void p1_norm(const Frame& F) {
    const float* mod = WSP(float, WS_MOD); bf16* h = WSP(bf16, WS_H);
    const int gw = F.bx * NWAVES + F.wave, m0 = gw * 16;
    const float* modb = mod + (m0 >> 14) * 6144;
    const float* xb = F.x + (size_t)m0 * D + 4 * F.lane;
    f32x4 g[4], sh[4], b0[4], b1[4], b2[4], b3[4];
#define P1_LOAD(B, r) do { _Pragma("unroll") for (int j = 0; j < 4; ++j) B[j] = *(const f32x4*)(xb + (size_t)(r) * D + 256 * j); } while (0)
#define P1_ROW(B, it) do { float ss = 0.f; _Pragma("unroll") for (int j = 0; j < 4; ++j) ss += dot4(B[j]); \
        const float r = rsqrtf(wave_sum(ss) * (1.f / D) + EPS); \
        _Pragma("unroll") for (int j = 0; j < 4; ++j) { const f32x4 hv = B[j] * r * g[j] + sh[j]; u32x2 o; o.x = pk2(hv[0], hv[1]); o.y = pk2(hv[2], hv[3]); \
            *(u32x2*)(h + (size_t)(m0 + (it)) * D + 4 * F.lane + 256 * j) = o; } \
        if ((it) + 4 < 16) P1_LOAD(B, (it) + 4); } while (0)
    P1_LOAD(b0, 0); P1_LOAD(b1, 1); P1_LOAD(b2, 2); P1_LOAD(b3, 3);
#pragma unroll
    for (int j = 0; j < 4; ++j) { const int idx = 4 * F.lane + 256 * j;
        g[j] = *(const f32x4*)(F.g_pre_mix + idx) * (*(const f32x4*)(modb + 1024 + idx) + 1.f); sh[j] = *(const f32x4*)(modb + idx); }
#pragma unroll 1
    for (int it = 0; it < 16; it += 4) { P1_ROW(b0, it); P1_ROW(b1, it + 1); P1_ROW(b2, it + 2); P1_ROW(b3, it + 3); }
#undef P1_LOAD
#undef P1_ROW
}

template <class Epi, class RowMap, class BSel>
__device__ __forceinline__ void simple_gemm(const Frame& F, const bf16* A, int lda, int M, int N, int K, const RowMap& rm, const BSel& bs, const Epi& E) {
    const int fr = F.lane & 15, fq = F.lane >> 4;
    const int ncg = N / 512, nbt = (M / 64) * ncg;
    for (int bt = F.bx; bt < nbt; bt += F.G) {
        const int mt = bt / ncg, cg = bt % ncg, m0 = mt * 64, n0 = cg * 512 + F.wave * 64;
        const bf16* Bt = bs(m0);
        const bf16* ap[4]; const bf16* bp[4];
#pragma unroll
        for (int i = 0; i < 4; ++i) { ap[i] = A + (size_t)rm(m0 + 16 * i + fr) * lda + 8 * fq; bp[i] = Bt + (size_t)(n0 + 16 * i + fr) * K + 8 * fq; }
        f32x4 acc[4][4];
#pragma unroll
        for (int i = 0; i < 4; ++i)
#pragma unroll
            for (int j = 0; j < 4; ++j) acc[i][j] = (f32x4){0.f, 0.f, 0.f, 0.f};
#pragma unroll 2
        for (int k0 = 0; k0 < K; k0 += 32) {
            bf16x8 a[4], b[4];
#pragma unroll
            for (int i = 0; i < 4; ++i) { a[i] = *(const bf16x8*)(ap[i] + k0); b[i] = *(const bf16x8*)(bp[i] + k0); }
#pragma unroll
            for (int i = 0; i < 4; ++i)
#pragma unroll
                for (int j = 0; j < 4; ++j) acc[i][j] = MFMA(b[j], a[i], acc[i][j]);
        }
#pragma unroll
        for (int i = 0; i < 4; ++i)
#pragma unroll
            for (int j = 0; j < 4; ++j) E(m0 + 16 * i + fr, n0 + 16 * j + 4 * fq, acc[i][j]);
    }
}
struct RowId { __device__ __forceinline__ int operator()(int m) const { return m; } };
struct RowGather { const int* slot_assign; __device__ __forceinline__ int operator()(int m) const { const int a = slot_assign[m]; return a < 0 ? 0 : (a >> 2); } };
struct BFixed { const bf16* Bt; __device__ __forceinline__ const bf16* operator()(int) const { return Bt; } };
struct BExpert { const bf16* Bt; const int* tile_e; size_t stride; __device__ __forceinline__ const bf16* operator()(int m0) const { return Bt + (size_t)tile_e[m0 >> 8] * stride; } };
struct EpiStore { bf16* O; int ldo;
    __device__ __forceinline__ void operator()(int m, int n, f32x4 v) const { u32x2 w; w.x = pk2(v[0], v[1]); w.y = pk2(v[2], v[3]); *(u32x2*)(O + (size_t)m * ldo + n) = w; } };
__device__ __forceinline__ float swiglu(float g, float l) {
    const float xg = fminf(g, 7.f), xl = fminf(fmaxf(l, -7.f), 7.f);
    return xg / (1.f + __expf(-1.702f * xg)) * (xl + 1.f);
}
struct EpiSwiglu { bf16* Aout; const float* b1; const int* tile_e;
    __device__ __forceinline__ void operator()(int m, int n, f32x4 v) const {
        const int e = tile_e[m >> 8]; const f32x4 bb = *(const f32x4*)(b1 + (size_t)e * 2048 + n);
        const float a0 = swiglu(v[0] + bb[0], v[1] + bb[1]), a1 = swiglu(v[2] + bb[2], v[3] + bb[3]);
        *(unsigned*)(Aout + (size_t)m * FF + (n >> 1)) = pk2(a0, a1); } };
struct EpiMoe2 { bf16* ys; const float* b2; const int* tile_e; const int* slot_assign; const float* slot_gate;
    __device__ __forceinline__ void operator()(int m, int n, f32x4 v) const {
        const int asg = slot_assign[m]; if (asg < 0) return;
        const int e = tile_e[m >> 8]; const f32x4 bb = *(const f32x4*)(b2 + (size_t)e * D + n); const float g = slot_gate[m];
        u32x2 w; w.x = pk2((v[0] + bb[0]) * g, (v[1] + bb[1]) * g); w.y = pk2((v[2] + bb[2]) * g, (v[3] + bb[3]) * g);
        *(u32x2*)(ys + (size_t)asg * D + n) = w; } };

namespace pg8 {
constexpr int BM = 256, BK = 64, HALF = 128, HTB = HALF * BK * 2, NXCD = 8, WGM = 8;
__device__ __forceinline__ int lds_byte(int r, int c) { const int st = (r >> 4) * 2 + (c >> 5), rr = r & 15, cc = c & 31, ob = rr * 64 + cc * 2; return st * 1024 + (ob ^ (((ob >> 9) & 1) << 5)); }
__device__ __forceinline__ void stage_rc(int b, int& R, int& C) { const int st = b / 1024, sb = b % 1024, swz = sb ^ (((sb >> 9) & 1) << 5); R = (st >> 1) * 16 + swz / 64; C = (st & 1) * 32 + (swz % 64) / 2; }
__device__ __forceinline__ int perm32(int rho) { const int n = rho >> 4, i = rho & 15; return 8 * (i >> 2) + 4 * n + (i & 3); }
struct Unit { int pm, pn; };
struct StaticOrder {
    int nM, nN, nwg, G, c;
    __device__ __forceinline__ void init(int nM_, int nN_, int G_, int c_) { nM = nM_; nN = nN_; nwg = nM * nN; G = G_; c = c_; }
    __device__ __forceinline__ bool next(int i, Unit& u) const {
        const long L = (long)i * G + c; if (L >= nwg) return false;
        int wgid = (int)L; { const int q = nwg / NXCD, r = nwg % NXCD, xcd = wgid % NXCD, off = wgid / NXCD; wgid = (xcd < r ? xcd * (q + 1) : r * (q + 1) + (xcd - r) * q) + off; }
        const int nig = WGM * nN, gid = wgid / nig, fm = gid * WGM, gsz = (nM - fm) < WGM ? (nM - fm) : WGM;
        u.pm = fm + ((wgid % nig) % gsz); u.pn = (wgid % nig) / gsz; return true;
    }
};
template <bool GATHER, int FP8, int SCW, int SCX, class Epi, class Sched, class AB>
__device__ __forceinline__ void gemm_phase(LAS unsigned char* lds, const int K, const Sched& S, const AB& ab, const Epi& E) {
    const int tid = threadIdx.x, wid = __builtin_amdgcn_readfirstlane(tid >> 6), lane = tid & 63, wr = wid >> 2, wc = wid & 3, fr = lane & 15, fq = lane >> 4;
    const int nt = K / BK;
    int sR[2], sC[2]; unsigned voffB[2], vA[2][2], nvA[2][2];
#pragma unroll
    for (int i = 0; i < 2; ++i) { int R, C; stage_rc(tid * 16 + i * 8192, R, C); sR[i] = R; sC[i] = C; const int Rb = (R & ~31) + perm32(R & 31); voffB[i] = (unsigned)(Rb * K + C) * 2u; }
    const size_t kstep = (size_t)(BK * 2);
    const size_t hstep = (size_t)HALF * K * 2;
    const unsigned ldsw = (unsigned)wid * 1024u;
    const int aoff = lds_byte(wr * 64 + fr, fq * 8), boff = lds_byte(wc * 32 + fr, fq * 8);
#define PG8_SA(b, h) (((b) * 2 + (h)) * HTB)
#define PG8_SB(b, h) ((4 + (b) * 2 + (h)) * HTB)
#define PG8_STAGE(bufoff, gbase, voff) do { _Pragma("unroll") for (int _i = 0; _i < 2; ++_i) \
        __builtin_amdgcn_global_load_lds((const unsigned*)((const char*)(gbase) + (voff)[_i]), (LAS unsigned*)(lds + (bufoff) + ldsw + _i * 8192), 16, 0, 0); } while (0)
#define PG8_LDA(dst, b, h) do { _Pragma("unroll") for (int m = 0; m < 4; ++m) _Pragma("unroll") for (int k = 0; k < 2; ++k) dst[m][k] = *(const LAS bf16x8*)(lds + PG8_SA(b, h) + aoff + m * 2048 + k * 1024); } while (0)
#define PG8_LDB(dst, b, h) do { _Pragma("unroll") for (int n = 0; n < 2; ++n) _Pragma("unroll") for (int k = 0; k < 2; ++k) dst[n][k] = *(const LAS bf16x8*)(lds + PG8_SB(b, h) + boff + n * 2048 + k * 1024); } while (0)
#define PG8_C8(x) __builtin_shufflevector(__builtin_bit_cast(i32x4, (x)[0]), __builtin_bit_cast(i32x4, (x)[1]), 0, 1, 2, 3, 4, 5, 6, 7)
#define PG8_MMA(ai, bj, At, Bt) do { __builtin_amdgcn_s_setprio(1); _Pragma("unroll") for (int m = 0; m < 4; ++m) _Pragma("unroll") for (int n = 0; n < 2; ++n) { \
        if (FP8) asm volatile("v_mfma_scale_f32_16x16x128_f8f6f4 %0, %1, %2, %0, %3, %4 op_sel_hi:[0,0,0]" : "+v"(acc[ai][bj][m][n]) : "v"(PG8_C8(Bt[n])), "v"(PG8_C8(At[m])), "v"(scw), "v"(scx)); \
        else { _Pragma("unroll") for (int k = 0; k < 2; ++k) asm volatile("v_mfma_f32_16x16x32_bf16 %0, %1, %2, %0" : "+v"(acc[ai][bj][m][n]) : "v"(Bt[n][k]), "v"(At[m][k])); } } \
        __builtin_amdgcn_s_setprio(0); } while (0)
#define PG8_WAIT_V(n) asm volatile("s_waitcnt vmcnt(" #n ")" ::: "memory")
#define PG8_WAIT_L(n) asm volatile("s_waitcnt lgkmcnt(" #n ")" ::: "memory")
#define PG8_BAR __builtin_amdgcn_s_barrier()
#define PG8_SCHED __builtin_amdgcn_sched_barrier(0)
#define PG8_AOFF(dst, u) do { _Pragma("unroll") for (int _h = 0; _h < 2; ++_h) _Pragma("unroll") for (int _i = 0; _i < 2; ++_i) \
        dst[_h][_i] = GATHER ? (unsigned)(ab.a_row((u), _h * HALF + sR[_i]) * K + sC[_i]) * 2u : (unsigned)((_h * HALF + sR[_i]) * K + sC[_i]) * 2u; } while (0)
    Unit cur, nxt; int ui = 0;
    if (!S.next(0, cur)) return;
    const int scw = SCW, scx = SCX;
    f32x4 acc[2][2][4][2];
#pragma unroll
    for (int a = 0; a < 2; ++a)
#pragma unroll
        for (int b = 0; b < 2; ++b)
#pragma unroll
            for (int m = 0; m < 4; ++m)
#pragma unroll
                for (int n = 0; n < 2; ++n) acc[a][b][m][n] = (f32x4){0.f, 0.f, 0.f, 0.f};
    bf16x8 At[4][2], B0[2][2], B1[2][2];
    const char* cA = ab.a_base(cur); const char* cB = ab.b_base(cur);
    PG8_AOFF(vA, cur);
    PG8_STAGE(PG8_SB(0, 0), cB, voffB); PG8_STAGE(PG8_SB(0, 1), cB + hstep, voffB); PG8_STAGE(PG8_SA(0, 0), cA, vA[0]); PG8_STAGE(PG8_SA(0, 1), cA, vA[1]);
    if (wr == 1) PG8_BAR;
    PG8_WAIT_V(2); PG8_BAR;
    PG8_STAGE(PG8_SB(1, 0), cB + kstep, voffB); PG8_STAGE(PG8_SA(1, 0), cA + kstep, vA[0]); PG8_STAGE(PG8_SB(1, 1), cB + hstep + kstep, voffB);
    PG8_WAIT_V(6); PG8_BAR;
    for (;;) {
        const bool has_next = S.next(ui + 1, nxt);
        const char* nA = has_next ? ab.a_base(nxt) : cA; const char* nB = has_next ? ab.b_base(nxt) : cB;
        if (GATHER) { if (has_next) { PG8_AOFF(nvA, nxt); } else {
#pragma unroll
            for (int h = 0; h < 2; ++h)
#pragma unroll
                for (int i = 0; i < 2; ++i) nvA[h][i] = vA[h][i]; } }
#pragma unroll 1
        for (int t = 0; t < nt; t += 2) {
            const bool last = (t == nt - 2);
            const char* a1 = cA + (size_t)(t + 1) * kstep;
            const char* a2 = last ? nA : cA + (size_t)(t + 2) * kstep; const char* b2 = last ? nB : cB + (size_t)(t + 2) * kstep;
            const char* a3 = a2 + kstep; const char* b3 = b2 + kstep;
            unsigned o2[2][2];
#pragma unroll
            for (int h = 0; h < 2; ++h)
#pragma unroll
                for (int i = 0; i < 2; ++i) o2[h][i] = (GATHER && last) ? nvA[h][i] : vA[h][i];
            PG8_LDB(B0, 0, 0); PG8_LDB(B1, 0, 1); PG8_SCHED; PG8_LDA(At, 0, 0); PG8_STAGE(PG8_SA(1, 1), a1, vA[1]);
            PG8_WAIT_V(8); PG8_WAIT_L(0); PG8_BAR; PG8_MMA(0, 0, At, B0); PG8_MMA(0, 1, At, B1); PG8_BAR; PG8_SCHED;
            PG8_LDA(At, 0, 1); PG8_STAGE(PG8_SB(0, 0), b2, voffB); PG8_STAGE(PG8_SB(0, 1), b2 + hstep, voffB); PG8_STAGE(PG8_SA(0, 0), a2, o2[0]);
            PG8_WAIT_V(8); PG8_WAIT_L(0); PG8_BAR; PG8_MMA(1, 0, At, B0); PG8_MMA(1, 1, At, B1); PG8_BAR; PG8_SCHED;
            PG8_LDB(B0, 1, 0); PG8_LDB(B1, 1, 1); PG8_SCHED; PG8_LDA(At, 1, 0); PG8_STAGE(PG8_SA(0, 1), a2, o2[1]);
            PG8_WAIT_V(8); PG8_WAIT_L(0); PG8_BAR; PG8_MMA(0, 0, At, B0); PG8_MMA(0, 1, At, B1); PG8_BAR; PG8_SCHED;
            PG8_LDA(At, 1, 1); PG8_STAGE(PG8_SB(1, 0), b3, voffB); PG8_STAGE(PG8_SB(1, 1), b3 + hstep, voffB); PG8_STAGE(PG8_SA(1, 0), a3, o2[0]);
            PG8_WAIT_V(8); PG8_WAIT_L(0); PG8_BAR; PG8_MMA(1, 0, At, B0); PG8_MMA(1, 1, At, B1); PG8_BAR; PG8_SCHED;
        }
        if (wr == 0) PG8_BAR;
        asm volatile("s_nop 15\n\ts_nop 15" ::: "memory");
        E(acc, cur, wr, wc, fr, fq);
        if (!has_next) break;
#pragma unroll
        for (int a = 0; a < 2; ++a)
#pragma unroll
            for (int b = 0; b < 2; ++b)
#pragma unroll
                for (int m = 0; m < 4; ++m)
#pragma unroll
                    for (int n = 0; n < 2; ++n) acc[a][b][m][n] = (f32x4){0.f, 0.f, 0.f, 0.f};
        cur = nxt; cA = nA; cB = nB; ++ui;
        if (GATHER) {
#pragma unroll
            for (int h = 0; h < 2; ++h)
#pragma unroll
                for (int i = 0; i < 2; ++i) vA[h][i] = nvA[h][i]; }
        if (wr == 1) PG8_BAR;
    }
    PG8_WAIT_V(0);
    PG8_BAR;
#undef PG8_SA
#undef PG8_SB
#undef PG8_STAGE
#undef PG8_LDA
#undef PG8_LDB
#undef PG8_MMA
#undef PG8_C8
#undef PG8_WAIT_V
#undef PG8_WAIT_L
#undef PG8_BAR
#undef PG8_SCHED
#undef PG8_AOFF
}
__device__ __forceinline__ unsigned cvt_pk_bf16(float lo, float hi) { unsigned r; asm volatile("v_cvt_pk_bf16_f32 %0, %1, %2" : "=v"(r) : "v"(lo), "v"(hi)); return r; }
struct ABDense { const bf16* A; const bf16* Bt; int K;
    __device__ __forceinline__ const char* a_base(const Unit& u) const { return (const char*)(A + (size_t)u.pm * BM * K); }
    __device__ __forceinline__ const char* b_base(const Unit& u) const { return (const char*)(Bt + (size_t)u.pn * BM * K); }
    __device__ __forceinline__ int a_row(const Unit&, int) const { return 0; } };
struct EpiStoreT { bf16* O; int ldo;
    __device__ __forceinline__ void operator()(const f32x4 (&acc)[2][2][4][2], const Unit& u, int wr, int wc, int fr, int fq) const {
        const int row0 = u.pm * BM + wr * 64 + fr, col0 = u.pn * BM + wc * 32 + 8 * fq;
#pragma unroll
        for (int ai = 0; ai < 2; ++ai)
#pragma unroll
            for (int m = 0; m < 4; ++m) { bf16* rowp = O + (size_t)(row0 + ai * HALF + m * 16) * ldo + col0;
#pragma unroll
                for (int bj = 0; bj < 2; ++bj) { const f32x4 v0 = acc[ai][bj][m][0], v1 = acc[ai][bj][m][1];
                    u32x4 w; w.x = cvt_pk_bf16(v0[0], v0[1]); w.y = cvt_pk_bf16(v0[2], v0[3]); w.z = cvt_pk_bf16(v1[0], v1[1]); w.w = cvt_pk_bf16(v1[2], v1[3]);
                    *(u32x4*)(rowp + bj * HALF) = w; } }
    } };
struct ABMoe1 { const unsigned char* H; const unsigned char* W; const int* tile_e; const int* moe_off; const unsigned* moe_cnt; const int* list_a;
    __device__ __forceinline__ const char* a_base(const Unit&) const { return (const char*)H; }
    __device__ __forceinline__ const char* b_base(const Unit& u) const { return (const char*)(W + (size_t)tile_e[u.pm] * 2048 * 1024 + (size_t)u.pn * BM * 1024); }
    __device__ __forceinline__ int a_row(const Unit& u, int rt) const { const int e = tile_e[u.pm]; const int pos = u.pm * BM + rt - moe_off[e];
        const int pc = pos < (int)moe_cnt[e] ? pos : 0; const int a = list_a[(size_t)e * T + pc]; return pos < (int)moe_cnt[e] ? (a >> 2) : 0; } };
struct ABMoe2 { const unsigned char* A; const unsigned char* W; const int* tile_e;
    __device__ __forceinline__ const char* a_base(const Unit& u) const { return (const char*)(A + (size_t)u.pm * BM * 1024); }
    __device__ __forceinline__ const char* b_base(const Unit& u) const { return (const char*)(W + (size_t)tile_e[u.pm] * 1024 * 1024 + (size_t)u.pn * BM * 1024); }
    __device__ __forceinline__ int a_row(const Unit&, int) const { return 0; } };
struct EpiSwigluT { unsigned char* Aout; const float* b1; const int* tile_e;
    __device__ __forceinline__ void operator()(const f32x4 (&acc)[2][2][4][2], const Unit& u, int wr, int wc, int fr, int fq) const {
        const int row0 = u.pm * BM + wr * 64 + fr, j0 = u.pn * HALF + wc * 32 + 8 * fq;
        const float* bp = b1 + (size_t)tile_e[u.pm] * 2048 + 2 * j0;
        f32x4 bb[4];
#pragma unroll
        for (int q = 0; q < 4; ++q) bb[q] = *(const f32x4*)(bp + 4 * q);
#pragma unroll
        for (int ai = 0; ai < 2; ++ai)
#pragma unroll
            for (int m = 0; m < 4; ++m) {
                const f32x4 g0 = acc[ai][0][m][0], g1 = acc[ai][0][m][1], l0 = acc[ai][1][m][0], l1 = acc[ai][1][m][1];
                u32x2 w;
                w.x = pk4_fp8(swiglu(g0[0] + bb[0][0], l0[0] + bb[0][1]) * A8_SCALE, swiglu(g0[1] + bb[0][2], l0[1] + bb[0][3]) * A8_SCALE,
                              swiglu(g0[2] + bb[1][0], l0[2] + bb[1][1]) * A8_SCALE, swiglu(g0[3] + bb[1][2], l0[3] + bb[1][3]) * A8_SCALE);
                w.y = pk4_fp8(swiglu(g1[0] + bb[2][0], l1[0] + bb[2][1]) * A8_SCALE, swiglu(g1[1] + bb[2][2], l1[1] + bb[2][3]) * A8_SCALE,
                              swiglu(g1[2] + bb[3][0], l1[2] + bb[3][1]) * A8_SCALE, swiglu(g1[3] + bb[3][2], l1[3] + bb[3][3]) * A8_SCALE);
                *(u32x2*)(Aout + (size_t)(row0 + ai * HALF + m * 16) * FF + j0) = w; }
    } };
struct EpiMoe2T { unsigned char* ys; const float* b2; const int* tile_e; const int* moe_off; const unsigned* moe_cnt; const int* list_a; const float* list_g;
    __device__ __forceinline__ void operator()(const f32x4 (&acc)[2][2][4][2], const Unit& u, int wr, int wc, int fr, int fq) const {
        const int e = tile_e[u.pm], cnt = (int)moe_cnt[e], pos0 = u.pm * BM - moe_off[e] + wr * 64 + fr, col0 = u.pn * BM + wc * 32 + 8 * fq;
        const float* bp = b2 + (size_t)e * D + col0;
        f32x4 bv[2][2];
#pragma unroll
        for (int bj = 0; bj < 2; ++bj)
#pragma unroll
            for (int n = 0; n < 2; ++n) bv[bj][n] = *(const f32x4*)(bp + bj * HALF + 4 * n);
        int asgv[2][4]; float gv[2][4];
#pragma unroll
        for (int ai = 0; ai < 2; ++ai)
#pragma unroll
            for (int m = 0; m < 4; ++m) { const int pos = pos0 + ai * HALF + m * 16; const int pc = pos < cnt ? pos : 0;
                const int a = list_a[(size_t)e * T + pc]; gv[ai][m] = list_g[(size_t)e * T + pc]; asgv[ai][m] = pos < cnt ? a : -1; }
#pragma unroll
        for (int ai = 0; ai < 2; ++ai)
#pragma unroll
            for (int m = 0; m < 4; ++m) { const int asg = asgv[ai][m]; const float g = gv[ai][m];
                if (asg >= 0) { unsigned char* rowp = ys + (size_t)asg * D + col0; const float gs = g * Y8_SCALE;
#pragma unroll
                    for (int bj = 0; bj < 2; ++bj) { const f32x4 v0 = (acc[ai][bj][m][0] + bv[bj][0]) * gs, v1 = (acc[ai][bj][m][1] + bv[bj][1]) * gs;
                        u32x2 w; w.x = pk4_fp8(v0[0], v0[1], v0[2], v0[3]); w.y = pk4_fp8(v1[0], v1[1], v1[2], v1[3]);
                        *(u32x2*)(rowp + bj * HALF) = w; } } }
    } };
}

__device__ __forceinline__ void attn_unit(const Frame& F, int u) {
    const int qblk = u & 127, kvh = (u >> 7) & 1, b = u >> 8;
    LAS unsigned char* Ks = F.lds; LAS unsigned char* Vs = F.lds + 256 * 144;
    const bf16* proj = WSP(bf16, WS_PROJ); bf16* mix = WSP(bf16, WS_MIX);
    const int tok0 = b * S + qblk * 128;
#pragma unroll
    for (int i = 0; i < 4; ++i) {
        const int cid = F.tid + 512 * i, row = cid >> 3, ch = cid & 7;
        u32x4 kv = (u32x4){0u, 0u, 0u, 0u}, vv = (u32x4){0u, 0u, 0u, 0u};
        if (qblk > 0 || row >= 128) {
            const bf16* rp = proj + (size_t)(tok0 - 128 + row) * INP;
            kv = *(const u32x4*)(rp + AK_OFF + kvh * 64 + ch * 8);
            vv = *(const u32x4*)(rp + AV_OFF + kvh * 64 + ch * 8);
        }
        *(LAS u32x4*)(Ks + row * 144 + ch * 16) = kv;
        *(LAS u32x4*)(Vs + row * 144 + ch * 16) = vv;
    }
    __syncthreads();
    const int g = F.wave >> 1, hw = F.wave & 1, hq = kvh * 4 + g;
    const int lane = F.lane, fr = lane & 15, fq = lane >> 4;
    const float sink = F.sinks[hq];
    const float NEG_INF = -__builtin_inff();
    const bf16* qbase = proj + (size_t)(tok0 + 64 * hw + fr) * INP + AQ_OFF + hq * 64 + 8 * fq;
    bf16x8 nq0 = *(const bf16x8*)qbase, nq1 = *(const bf16x8*)(qbase + 32);
    for (int qb = 0; qb < 4; ++qb) {
        const int i = 64 * hw + 16 * qb + fr;
        const bf16x8 q0 = nq0, q1 = nq1;
        { const bf16* qn = qbase + (size_t)(16 * (qb < 3 ? qb + 1 : qb)) * INP; nq0 = *(const bf16x8*)qn; nq1 = *(const bf16x8*)(qn + 32); }
        f32x4 st[12];
#pragma unroll
        for (int kt = 0; kt < 12; ++kt) {
            LAS const unsigned char* kp = Ks + (64 * hw + 16 * kt + fr) * 144 + fq * 16;
            const bf16x8 k0 = *(LAS const bf16x8*)kp, k1 = *(LAS const bf16x8*)(kp + 64);
            f32x4 z = (f32x4){0.f, 0.f, 0.f, 0.f}; z = MFMA(k0, q0, z); z = MFMA(k1, q1, z); st[kt] = z;
        }
        float mx = NEG_INF;
#pragma unroll
        for (int kt = 0; kt < 12; ++kt)
#pragma unroll
            for (int r = 0; r < 4; ++r) {
                const int j = 64 * hw + 16 * kt + 4 * fq + r, rel = i + 128 - j;
                const bool ok = (rel >= 0) && (rel < 128) && (qblk > 0 || j >= 128);
                const float s = ok ? st[kt][r] * 0.125f : NEG_INF;
                st[kt][r] = s; mx = fmaxf(mx, s);
            }
        mx = fmaxf(mx, __shfl_xor(mx, 16)); mx = fmaxf(mx, __shfl_xor(mx, 32)); mx = fmaxf(mx, sink);
        float sum = 0.f;
#pragma unroll
        for (int kt = 0; kt < 12; ++kt)
#pragma unroll
            for (int r = 0; r < 4; ++r) { const float p = __expf(st[kt][r] - mx); st[kt][r] = p; sum += p; }
        sum += __shfl_xor(sum, 16); sum += __shfl_xor(sum, 32); sum += __expf(sink - mx);
        const float inv = 1.f / sum;
        f32x4 o[4];
#pragma unroll
        for (int c = 0; c < 4; ++c) o[c] = (f32x4){0.f, 0.f, 0.f, 0.f};
#pragma unroll
        for (int ks = 0; ks < 6; ++ks) {
            const bf16x8 pf = pack8(st[2 * ks], st[2 * ks + 1]);
            const int rb = 64 * hw + 32 * ks + 4 * fq + (fr >> 2);
#pragma unroll
            for (int c = 0; c < 4; ++c) {
                LAS const unsigned char* vp = Vs + rb * 144 + (16 * c + 4 * (lane & 3)) * 2;
                const bf16x8 vf = cat8(trr(vp), trr(vp + 16 * 144));
                o[c] = MFMA(pf, vf, o[c]);
            }
        }
#pragma unroll
        for (int r = 0; r < 4; ++r) {
            const int qrow = 4 * fq + r; const float iv = __shfl(inv, qrow);
            bf16* op = mix + (size_t)(tok0 + 64 * hw + 16 * qb + qrow) * D + hq * 64 + fr;
#pragma unroll
            for (int c = 0; c < 4; ++c) op[16 * c] = (bf16)f2bf(o[c][r] * iv);
        }
    }
    __syncthreads();
}

__device__ __forceinline__ void gla_gate_prefix(const Frame& F, const bf16* proj, int t0, int h, LAS float* ga_s, LAS float* tot_s, float (&bv)[8], float& b_mid, float& b_last) {
#pragma unroll
    for (int i = 0; i < 2; ++i) { const int idx = F.tid + 512 * i, t = idx >> 4, r = idx & 15; ga_s[idx] = bf2f(proj[(size_t)(t0 + t) * INP + GA_OFF + r]); }
    float wu[16];
#pragma unroll
    for (int r = 0; r < 16; ++r) wu[r] = F.w_gate_up[r * 256 + h * 64 + F.lane];
    const float bg = F.b_gate[h * 64 + F.lane];
    __syncthreads();
    float run = 0.f;
#pragma unroll
    for (int i = 0; i < 8; ++i) {
        const int t = 8 * F.wave + i; float z = bg;
#pragma unroll
        for (int r = 0; r < 16; ++r) z += ga_s[t * 16 + r] * wu[r];
        const float ls = fminf(z, 0.f) - __logf(1.f + __expf(-fabsf(z)));
        run += ls * (1.f / 16.f); bv[i] = run;
    }
    tot_s[F.wave * 64 + F.lane] = run;
    __syncthreads();
    float pre = 0.f, mid = 0.f, all = 0.f;
#pragma unroll
    for (int w = 0; w < 8; ++w) { const float tv = tot_s[w * 64 + F.lane]; pre += (w < F.wave) ? tv : 0.f; mid += (w < 4) ? tv : 0.f; all += tv; }
#pragma unroll
    for (int i = 0; i < 8; ++i) bv[i] += pre;
    b_mid = mid; b_last = all;
}
__device__ __forceinline__ void gla_kv_unit(const Frame& F, int u) {
    const int h = u & 3, n = (u >> 2) & 255, b = u >> 10, t0 = b * S + n * 64;
    const bf16* proj = WSP(bf16, WS_PROJ);
    LAS unsigned char* kd_s = F.lds; LAS unsigned char* v_s = F.lds + 9216;
    LAS float* ga_s = (LAS float*)(F.lds + 26624); LAS float* tot_s = (LAS float*)(F.lds + 30720);
    const int lane = F.lane, fr = lane & 15, fq = lane >> 4;
#pragma unroll
    for (int i = 0; i < 2; ++i) { const int cid = F.tid + 512 * i, row = cid >> 4, ch = cid & 15;
        *(LAS u32x4*)(v_s + row * 272 + ch * 16) = *(const u32x4*)(proj + (size_t)(t0 + row) * INP + GV_OFF + h * 128 + ch * 8); }
    float bv[8], b_mid, b_last;
    gla_gate_prefix(F, proj, t0, h, ga_s, tot_s, bv, b_mid, b_last);
#pragma unroll
    for (int i = 0; i < 8; ++i) { const int t = 8 * F.wave + i;
        const float kx = bf2f(proj[(size_t)(t0 + t) * INP + GK_OFF + h * 64 + lane]);
        *(LAS bf16*)(kd_s + t * 144 + lane * 2) = (bf16)f2bf(kx * __expf(b_last - bv[i])); }
    if (F.wave == 0) WSP(float, WS_DECAY)[((size_t)(b * NCH + n) * 4 + h) * 64 + lane] = __expf(b_last);
    __syncthreads();
    const int c = F.wave;
    f32x4 acc[4];
#pragma unroll
    for (int d = 0; d < 4; ++d) acc[d] = (f32x4){0.f, 0.f, 0.f, 0.f};
#pragma unroll
    for (int ks = 0; ks < 2; ++ks) {
        const int rb = 32 * ks + 8 * fq + (fr >> 2);
        LAS const unsigned char* vp = v_s + rb * 272 + (16 * c + 4 * (lane & 3)) * 2;
        const bf16x8 vf = cat8(trr(vp), trr(vp + 4 * 272));
#pragma unroll
        for (int d = 0; d < 4; ++d) {
            LAS const unsigned char* kp = kd_s + rb * 144 + (16 * d + 4 * (lane & 3)) * 2;
            const bf16x8 kf = cat8(trr(kp), trr(kp + 4 * 144));
            acc[d] = MFMA(kf, vf, acc[d]);
        }
    }
    float* kvp = WSP(float, WS_KV) + (((size_t)(b * NCH + n) * 4 + h) * 128 + 16 * c + fr) * 64;
#pragma unroll
    for (int d = 0; d < 4; ++d) *(f32x4*)(kvp + 16 * d + 4 * fq) = acc[d];
    __syncthreads();
}
__device__ __forceinline__ void gla_scan(const Frame& F) {
    float* kv = WSP(float, WS_KV); const float* decay = WSP(float, WS_DECAY);
    if (F.tid >= 256) return;
    for (int idx = F.bx * 256 + F.tid; idx < 65536; idx += F.G * 256) {
        const int b = idx >> 15, h = (idx >> 13) & 3, dvdk = idx & 8191, dk = idx & 63;
        float* p = kv + ((size_t)(b * NCH) * 4 + h) * 8192 + dvdk;
        const float* dp = decay + ((size_t)(b * NCH) * 4 + h) * 64 + dk;
        float state = 0.f;
        for (int n = 0; n < NCH; n += 8) {
            float tv[8], dv[8];
#pragma unroll
            for (int i = 0; i < 8; ++i) { tv[i] = p[(size_t)(n + i) * 4 * 8192]; dv[i] = dp[(size_t)(n + i) * 4 * 64]; }
#pragma unroll
            for (int i = 0; i < 8; ++i) { p[(size_t)(n + i) * 4 * 8192] = state; state = dv[i] * state + tv[i]; }
        }
    }
}
__device__ __forceinline__ void gla_out_unit(const Frame& F, int u) {
    const int h = u & 3, n = (u >> 2) & 255, b = u >> 10, t0 = b * S + n * 64;
    const bf16* proj = WSP(bf16, WS_PROJ); bf16* mix = WSP(bf16, WS_MIX);
    LAS unsigned char* qd_s = F.lds; LAS unsigned char* kk_s = F.lds + 9216; LAS unsigned char* qe_s = F.lds + 18432;
    LAS unsigned char* v_s = F.lds + 27648; LAS unsigned char* st_s = F.lds + 45056;
    LAS float* ga_s = (LAS float*)(F.lds + 63488); LAS float* tot_s = (LAS float*)(F.lds + 67584); LAS float* ssq_s = (LAS float*)(F.lds + 69632);
    const int lane = F.lane, fr = lane & 15, fq = lane >> 4;
#pragma unroll
    for (int i = 0; i < 2; ++i) { const int cid = F.tid + 512 * i, row = cid >> 4, ch = cid & 15;
        *(LAS u32x4*)(v_s + row * 272 + ch * 16) = *(const u32x4*)(proj + (size_t)(t0 + row) * INP + GV_OFF + h * 128 + ch * 8); }
    const float* stg = WSP(float, WS_KV) + ((size_t)(b * NCH + n) * 4 + h) * 8192;
#pragma unroll
    for (int i = 0; i < 4; ++i) { const int i4 = F.tid + 512 * i, dv = i4 >> 4, dk4 = (i4 & 15) * 4;
        const f32x4 sv = *(const f32x4*)(stg + dv * 64 + dk4);
        u32x2 w; w.x = pk2(sv[0], sv[1]); w.y = pk2(sv[2], sv[3]);
        *(LAS u32x2*)(st_s + dv * 144 + dk4 * 2) = w; }
    float bv[8], b_mid, b_last;
    gla_gate_prefix(F, proj, t0, h, ga_s, tot_s, bv, b_mid, b_last);
#pragma unroll
    for (int i = 0; i < 8; ++i) { const int t = 8 * F.wave + i; const bf16* rp = proj + (size_t)(t0 + t) * INP + h * 64 + lane;
        const float qx = bf2f(rp[GQ_OFF]) * 0.125f, kx = bf2f(rp[GK_OFF]);
        *(LAS bf16*)(qd_s + t * 144 + lane * 2) = (bf16)f2bf(qx * __expf(bv[i] - b_mid));
        *(LAS bf16*)(kk_s + t * 144 + lane * 2) = (bf16)f2bf(kx * __expf(b_mid - bv[i]));
        *(LAS bf16*)(qe_s + t * 144 + lane * 2) = (bf16)f2bf(qx * __expf(bv[i])); }
    __syncthreads();
    const int ib = F.wave >> 1, dvh = F.wave & 1;
    bf16x8 qdf[2], qef[2];
#pragma unroll
    for (int ks = 0; ks < 2; ++ks) { qdf[ks] = *(LAS const bf16x8*)(qd_s + (16 * ib + fr) * 144 + (32 * ks + 8 * fq) * 2);
                                     qef[ks] = *(LAS const bf16x8*)(qe_s + (16 * ib + fr) * 144 + (32 * ks + 8 * fq) * 2); }
    f32x4 at[4];
#pragma unroll
    for (int jt = 0; jt < 4; ++jt) {
        LAS const unsigned char* kp = kk_s + (16 * jt + fr) * 144 + (8 * fq) * 2;
        const bf16x8 k0 = *(LAS const bf16x8*)kp, k1 = *(LAS const bf16x8*)(kp + 64);
        f32x4 z = (f32x4){0.f, 0.f, 0.f, 0.f}; z = MFMA(k0, qdf[0], z); z = MFMA(k1, qdf[1], z);
#pragma unroll
        for (int r = 0; r < 4; ++r) if (16 * jt + 4 * fq + r > 16 * ib + fr) z[r] = 0.f;
        at[jt] = z;
    }
    bf16x8 pf[2];
    pf[0] = pack8(at[0], at[1]); pf[1] = pack8(at[2], at[3]);
    f32x4 o[4];
#pragma unroll
    for (int c = 0; c < 4; ++c) {
        const int dvt = 4 * dvh + c; f32x4 z = (f32x4){0.f, 0.f, 0.f, 0.f};
#pragma unroll
        for (int ks = 0; ks < 2; ++ks) {
            const int rb = 32 * ks + 4 * fq + (fr >> 2);
            LAS const unsigned char* vp = v_s + rb * 272 + (16 * dvt + 4 * (lane & 3)) * 2;
            z = MFMA(pf[ks], cat8(trr(vp), trr(vp + 16 * 272)), z);
        }
#pragma unroll
        for (int ks = 0; ks < 2; ++ks) {
            const bf16x8 sf = *(LAS const bf16x8*)(st_s + (16 * dvt + fr) * 144 + (32 * ks + 8 * fq) * 2);
            z = MFMA(qef[ks], sf, z);
        }
        o[c] = z;
    }
    float ssq[4];
#pragma unroll
    for (int r = 0; r < 4; ++r) { float s = 0.f;
#pragma unroll
        for (int c = 0; c < 4; ++c) s += o[c][r] * o[c][r];
        s += __shfl_xor(s, 1); s += __shfl_xor(s, 2); s += __shfl_xor(s, 4); s += __shfl_xor(s, 8);
        ssq[r] = s; if (fr == 0) ssq_s[F.wave * 16 + 4 * fq + r] = s; }
    __syncthreads();
#pragma unroll
    for (int r = 0; r < 4; ++r) {
        const float tot = ssq[r] + ssq_s[(F.wave ^ 1) * 16 + 4 * fq + r];
        const float rinv = rsqrtf(tot * (1.f / 128.f) + EPS);
        const int t = t0 + 16 * ib + 4 * fq + r;
#pragma unroll
        for (int c = 0; c < 4; ++c) { const int dv = 16 * (4 * dvh + c) + fr;
            const float gg = bf2f(proj[(size_t)t * INP + GG_OFF + h * 128 + dv]);
            const float val = o[c][r] * rinv * F.g_gla_norm[dv] * (gg / (1.f + __expf(-gg)));
            mix[(size_t)t * D + 512 + h * 128 + dv] = (bf16)f2bf(val); }
    }
    __syncthreads();
}

template <bool OUT>
__device__ __forceinline__ void gla_super_unit(const Frame& F, int u) {
    const int sc = u & 31, h = (u >> 5) & 3, b = u >> 7;
    const bf16* proj = WSP(bf16, WS_PROJ); bf16* mix = WSP(bf16, WS_MIX);
    LAS unsigned char* qd_s = F.lds; LAS unsigned char* kk_s = F.lds + 9216; LAS unsigned char* qe_s = F.lds + 18432;
    LAS unsigned char* v_s = F.lds + 27648; LAS unsigned char* st_s = F.lds + 45056; LAS unsigned char* kd_s = F.lds + 63488;
    LAS float* ga_s = (LAS float*)(F.lds + 72704); LAS float* tot_s = (LAS float*)(F.lds + 76800); LAS float* ssq_s = (LAS float*)(F.lds + 78848); LAS float* dec_s = (LAS float*)(F.lds + 79360);
    const int lane = F.lane, fr = lane & 15, fq = lane >> 4;
    const int ib = F.wave >> 1, dvh = F.wave & 1;
    float wu[16];
#pragma unroll
    for (int r = 0; r < 16; ++r) wu[r] = F.w_gate_up[r * 256 + h * 64 + lane];
    const float bg = F.b_gate[h * 64 + lane];
    float gn[4];
#pragma unroll
    for (int cc = 0; cc < 4; ++cc) gn[cc] = OUT ? F.g_gla_norm[16 * (4 * dvh + cc) + fr] : 0.f;
    float* Sg = WSP(float, WS_KV) + (size_t)u * 8192 + (16 * F.wave + fr) * 64 + 4 * fq;
    f32x4 St[4];
#pragma unroll
    for (int d = 0; d < 4; ++d) St[d] = OUT ? *(const f32x4*)(Sg + 16 * d) : (f32x4){0.f, 0.f, 0.f, 0.f};
    float ltot = 0.f;
    u32x4 v_r[2]; unsigned ga_r[2], k_r[8], q_r[8], gg_r[16];
#define GLA_LOAD_CHUNK(tc0) do { \
        _Pragma("unroll") for (int i = 0; i < 2; ++i) { const int cid = F.tid + 512 * i, row = cid >> 4, ch = cid & 15; v_r[i] = *(const u32x4*)(proj + (size_t)((tc0) + row) * INP + GV_OFF + h * 128 + ch * 8); } \
        _Pragma("unroll") for (int i = 0; i < 2; ++i) { const int idx = F.tid + 512 * i, t = idx >> 4, r = idx & 15; ga_r[i] = proj[(size_t)((tc0) + t) * INP + GA_OFF + r]; } \
        _Pragma("unroll") for (int i = 0; i < 8; ++i) { const bf16* rp = proj + (size_t)((tc0) + 8 * F.wave + i) * INP + h * 64 + lane; k_r[i] = rp[GK_OFF]; if (OUT) q_r[i] = rp[GQ_OFF]; } \
        if (OUT) { _Pragma("unroll") for (int r = 0; r < 4; ++r) _Pragma("unroll") for (int cc = 0; cc < 4; ++cc) \
            gg_r[r * 4 + cc] = proj[(size_t)((tc0) + 16 * ib + 4 * fq + r) * INP + GG_OFF + h * 128 + 16 * (4 * dvh + cc) + fr]; } } while (0)
    const int tu0 = b * S + sc * 512;
    GLA_LOAD_CHUNK(tu0);
    for (int c = 0; c < 8; ++c) {
        const int t0 = tu0 + c * 64;
#pragma unroll
        for (int i = 0; i < 2; ++i) { const int cid = F.tid + 512 * i, row = cid >> 4, ch = cid & 15; *(LAS u32x4*)(v_s + row * 272 + ch * 16) = v_r[i]; }
#pragma unroll
        for (int i = 0; i < 2; ++i) ga_s[F.tid + 512 * i] = bf2f(ga_r[i]);
        float kx[8], qx[8], ggf[16];
#pragma unroll
        for (int i = 0; i < 8; ++i) { kx[i] = bf2f(k_r[i]); qx[i] = OUT ? bf2f(q_r[i]) * 0.125f : 0.f; }
#pragma unroll
        for (int i = 0; i < 16; ++i) ggf[i] = OUT ? bf2f(gg_r[i]) : 0.f;
        if (c < 7) GLA_LOAD_CHUNK(t0 + 64);
        __syncthreads();
        float bv[8]; float run = 0.f;
#pragma unroll
        for (int i = 0; i < 8; ++i) {
            const int t = 8 * F.wave + i; float z = bg;
#pragma unroll
            for (int r = 0; r < 16; ++r) z += ga_s[t * 16 + r] * wu[r];
            const float ls = fminf(z, 0.f) - __logf(1.f + __expf(-fabsf(z)));
            run += ls * (1.f / 16.f); bv[i] = run;
        }
        tot_s[F.wave * 64 + lane] = run;
        if (OUT) {
#pragma unroll
            for (int d = 0; d < 4; ++d) { u32x2 w; w.x = pk2(St[d][0], St[d][1]); w.y = pk2(St[d][2], St[d][3]);
                *(LAS u32x2*)(st_s + (16 * F.wave + fr) * 144 + (16 * d + 4 * fq) * 2) = w; }
        }
        __syncthreads();
        float pre = 0.f, b_mid = 0.f, b_last = 0.f;
#pragma unroll
        for (int w = 0; w < 8; ++w) { const float tv = tot_s[w * 64 + lane]; pre += (w < F.wave) ? tv : 0.f; b_mid += (w < 4) ? tv : 0.f; b_last += tv; }
        ltot += b_last;
#pragma unroll
        for (int i = 0; i < 8; ++i) { const int t = 8 * F.wave + i; const float bb = bv[i] + pre;
            *(LAS bf16*)(kd_s + t * 144 + lane * 2) = (bf16)f2bf(kx[i] * __expf(b_last - bb));
            if (OUT) {
                *(LAS bf16*)(qd_s + t * 144 + lane * 2) = (bf16)f2bf(qx[i] * __expf(bb - b_mid));
                *(LAS bf16*)(kk_s + t * 144 + lane * 2) = (bf16)f2bf(kx[i] * __expf(b_mid - bb));
                *(LAS bf16*)(qe_s + t * 144 + lane * 2) = (bf16)f2bf(qx[i] * __expf(bb)); } }
        if (F.wave == 0) dec_s[lane] = __expf(b_last);
        __syncthreads();
        if (OUT) {
            bf16x8 qdf[2], qef[2];
#pragma unroll
            for (int ks = 0; ks < 2; ++ks) { qdf[ks] = *(LAS const bf16x8*)(qd_s + (16 * ib + fr) * 144 + (32 * ks + 8 * fq) * 2);
                                             qef[ks] = *(LAS const bf16x8*)(qe_s + (16 * ib + fr) * 144 + (32 * ks + 8 * fq) * 2); }
            f32x4 at[4];
#pragma unroll
            for (int jt = 0; jt < 4; ++jt) {
                LAS const unsigned char* kp = kk_s + (16 * jt + fr) * 144 + (8 * fq) * 2;
                const bf16x8 k0 = *(LAS const bf16x8*)kp, k1 = *(LAS const bf16x8*)(kp + 64);
                f32x4 z = (f32x4){0.f, 0.f, 0.f, 0.f}; z = MFMA(k0, qdf[0], z); z = MFMA(k1, qdf[1], z);
#pragma unroll
                for (int r = 0; r < 4; ++r) if (16 * jt + 4 * fq + r > 16 * ib + fr) z[r] = 0.f;
                at[jt] = z;
            }
            bf16x8 pf[2];
            pf[0] = pack8(at[0], at[1]); pf[1] = pack8(at[2], at[3]);
            f32x4 o[4];
#pragma unroll
            for (int cc = 0; cc < 4; ++cc) {
                const int dvt = 4 * dvh + cc; f32x4 z = (f32x4){0.f, 0.f, 0.f, 0.f};
#pragma unroll
                for (int ks = 0; ks < 2; ++ks) {
                    const int rb = 32 * ks + 4 * fq + (fr >> 2);
                    LAS const unsigned char* vp = v_s + rb * 272 + (16 * dvt + 4 * (lane & 3)) * 2;
                    z = MFMA(pf[ks], cat8(trr(vp), trr(vp + 16 * 272)), z);
                }
#pragma unroll
                for (int ks = 0; ks < 2; ++ks) {
                    const bf16x8 sf = *(LAS const bf16x8*)(st_s + (16 * dvt + fr) * 144 + (32 * ks + 8 * fq) * 2);
                    z = MFMA(qef[ks], sf, z);
                }
                o[cc] = z;
            }
            float ssq[4];
#pragma unroll
            for (int r = 0; r < 4; ++r) { float sq = 0.f;
#pragma unroll
                for (int cc = 0; cc < 4; ++cc) sq += o[cc][r] * o[cc][r];
                sq += __shfl_xor(sq, 1); sq += __shfl_xor(sq, 2); sq += __shfl_xor(sq, 4); sq += __shfl_xor(sq, 8);
                ssq[r] = sq; if (fr == 0) ssq_s[F.wave * 16 + 4 * fq + r] = sq; }
            __syncthreads();
#pragma unroll
            for (int r = 0; r < 4; ++r) {
                const float tot = ssq[r] + ssq_s[(F.wave ^ 1) * 16 + 4 * fq + r];
                const float rinv = rsqrtf(tot * (1.f / 128.f) + EPS);
                const int t = t0 + 16 * ib + 4 * fq + r;
#pragma unroll
                for (int cc = 0; cc < 4; ++cc) { const int dv = 16 * (4 * dvh + cc) + fr;
                    const float gg = ggf[r * 4 + cc];
                    const float val = o[cc][r] * rinv * gn[cc] * (gg / (1.f + __expf(-gg)));
                    mix[(size_t)t * D + 512 + h * 128 + dv] = (bf16)f2bf(val); }
            }
        }
#pragma unroll
        for (int d = 0; d < 4; ++d) { const f32x4 dc = *(LAS const f32x4*)(dec_s + 16 * d + 4 * fq); St[d] = St[d] * dc; }
#pragma unroll
        for (int ks = 0; ks < 2; ++ks) {
            const int rb = 32 * ks + 8 * fq + (fr >> 2);
            LAS const unsigned char* vp = v_s + rb * 272 + (16 * F.wave + 4 * (lane & 3)) * 2;
            const bf16x8 vf = cat8(trr(vp), trr(vp + 4 * 272));
#pragma unroll
            for (int d = 0; d < 4; ++d) {
                LAS const unsigned char* kp = kd_s + rb * 144 + (16 * d + 4 * (lane & 3)) * 2;
                St[d] = MFMA(cat8(trr(kp), trr(kp + 4 * 144)), vf, St[d]);
            }
        }
        __syncthreads();
    }
#undef GLA_LOAD_CHUNK
    if (!OUT) {
#pragma unroll
        for (int d = 0; d < 4; ++d) *(f32x4*)(Sg + 16 * d) = St[d];
        if (F.wave == 0) WSP(float, WS_DECAY)[u * 64 + lane] = __expf(ltot);
    }
}
__device__ __forceinline__ void gla_super_scan(const Frame& F) {
    float* kv = WSP(float, WS_KV); const float* decay = WSP(float, WS_DECAY);
    if (F.tid >= 256) return;
    for (int idx = F.bx * 256 + F.tid; idx < 65536; idx += F.G * 256) {
        const int bh = idx >> 13, dvdk = idx & 8191, dk = idx & 63;
        float* p = kv + (size_t)(bh * 32) * 8192 + dvdk; const float* dp = decay + (bh * 32) * 64 + dk;
        float tv[32], dv[32];
#pragma unroll
        for (int i = 0; i < 32; ++i) { tv[i] = p[(size_t)i * 8192]; dv[i] = dp[i * 64]; }
        float state = 0.f;
#pragma unroll
        for (int i = 0; i < 32; ++i) { p[(size_t)i * 8192] = state; state = dv[i] * state + tv[i]; }
    }
}

__device__ __forceinline__ void p7_norm_router(const Frame& F) {
    const float* mod = WSP(float, WS_MOD); const bf16* y = WSP(bf16, WS_Y); float* x1 = WSP(float, WS_X1); unsigned char* h2 = WSP(unsigned char, WS_H);
    unsigned* ctl = WSP(unsigned, WS_CTL);
    LAS float* wr_s = (LAS float*)F.lds;
    LAS float* lg_s = (LAS float*)(F.lds + SMALL_OFF);
    LAS float* rx_s = (LAS float*)(F.lds + SMALL_OFF + 16384);
    LAS float* z_s = (LAS float*)(F.lds + SMALL_OFF + 16384 + 512);
    LAS int* cnt_s = (LAS int*)(F.lds + SMALL_OFF + 16384 + 640);
    LAS int* base_s = (LAS int*)(F.lds + SMALL_OFF + 16384 + 768);
    LAS float* zr_s = (LAS float*)(F.lds + SMALL_OFF + 16384 + 1024);
    LAS int* flag_s = (LAS int*)(F.lds + SMALL_OFF + 16384 + 1024 + 2048);
    const int lane = F.lane, fr = lane & 15, fq = lane >> 4;
    const int mb0 = F.bx * 128 + F.wave * 16;
    const float* modb = mod + (mb0 >> 14) * 6144;
#pragma unroll 4
    for (int i = 0; i < 16; ++i) { const int i4 = F.tid + 512 * i, k = i4 >> 3, e0 = (i4 & 7) * 4;
        const f32x4 w = *(const f32x4*)(F.w_router + k * 32 + e0);
        const float gs = F.g_pre_ffn[k] * (1.f + modb[4096 + k]);
        LAS float* dst = wr_s + (k >> 2) * 128 + e0 * 4 + (k & 3);
        dst[0] = w[0] * gs; dst[4] = w[1] * gs; dst[8] = w[2] * gs; dst[12] = w[3] * gs; }
    { const int e = F.tid & 31, ks = F.tid >> 5; float zz = 0.f;
#pragma unroll
        for (int i = 0; i < 64; ++i) { const int k = ks * 64 + i; zz += modb[3072 + k] * F.w_router[k * 32 + e]; }
        zr_s[ks * 32 + e] = zz; }
    if (F.tid < 32) cnt_s[F.tid] = 0;
    __syncthreads();
    if (F.tid < 32) { float zz = F.b_router[F.tid];
#pragma unroll
        for (int i = 0; i < 16; ++i) zz += zr_s[i * 32 + F.tid];
        z_s[F.tid] = zz; }
    f32x4 pg[4], pg2[4], psh[4];
    u32x2 ya[4], yb[4], yc[4], yd[4]; f32x4 xa[4], xbf[4], xc[4], xd[4];
    const bf16* ybase = y + (size_t)mb0 * D + 4 * lane; const float* xbase = F.x + (size_t)mb0 * D + 4 * lane;
#define P7_LOAD(Y, X, r) do { _Pragma("unroll") for (int j = 0; j < 4; ++j) { Y[j] = *(const u32x2*)(ybase + (size_t)(r) * D + 256 * j); X[j] = *(const f32x4*)(xbase + (size_t)(r) * D + 256 * j); } } while (0)
#define P7_ROW(Y, X, it) do { f32x4 xv[4], hv[4]; float ss = 0.f; \
        _Pragma("unroll") for (int j = 0; j < 4; ++j) { hv[j] = unpack4(Y[j]); ss += dot4(hv[j]); } \
        const float ry = rsqrtf(wave_sum(ss) * (1.f / D) + EPS); float s2 = 0.f; \
        _Pragma("unroll") for (int j = 0; j < 4; ++j) { xv[j] = X[j] + hv[j] * ry * pg[j]; s2 += dot4(xv[j]); } \
        const float rx = rsqrtf(wave_sum(s2) * (1.f / D) + EPS); \
        if (lane == 0) rx_s[F.wave * 16 + (it)] = rx; \
        _Pragma("unroll") for (int j = 0; j < 4; ++j) { const int idx = 4 * lane + 256 * j; \
            hv[j] = xv[j] * rx * pg2[j] + psh[j]; \
            *(f32x4*)(x1 + (size_t)(mb0 + (it)) * D + idx) = xv[j]; \
            *(unsigned*)(h2 + (size_t)(mb0 + (it)) * D + idx) = pk4_fp8(hv[j][0] * H8_SCALE, hv[j][1] * H8_SCALE, hv[j][2] * H8_SCALE, hv[j][3] * H8_SCALE); } \
        if ((it) + 4 < 16) P7_LOAD(Y, X, (it) + 4); } while (0)
    P7_LOAD(ya, xa, 0); P7_LOAD(yb, xbf, 1); P7_LOAD(yc, xc, 2); P7_LOAD(yd, xd, 3);
#pragma unroll
    for (int j = 0; j < 4; ++j) { const int idx = 4 * lane + 256 * j;
        pg[j] = *(const f32x4*)(F.g_post_mix + idx) * *(const f32x4*)(modb + 2048 + idx);
        pg2[j] = *(const f32x4*)(F.g_pre_ffn + idx) * (*(const f32x4*)(modb + 4096 + idx) + 1.f); psh[j] = *(const f32x4*)(modb + 3072 + idx); }
#pragma unroll 1
    for (int it = 0; it < 16; it += 4) { P7_ROW(ya, xa, it); P7_ROW(yb, xbf, it + 1); P7_ROW(yc, xc, it + 2); P7_ROW(yd, xd, it + 3); }
#undef P7_LOAD
#undef P7_ROW
    asm volatile("s_waitcnt vmcnt(0)" ::: "memory");
    f32x4 acc0 = (f32x4){0.f, 0.f, 0.f, 0.f}, acc1 = (f32x4){0.f, 0.f, 0.f, 0.f};
    { const float* ap = x1 + (size_t)(mb0 + fr) * D + 4 * fq;
        LAS const float* bp = wr_s + fq * 128 + fr * 4;
        f32x4 a[8], na[8];
#pragma unroll
        for (int q = 0; q < 8; ++q) a[q] = *(const f32x4*)(ap + 16 * q);
        for (int s0 = 0; s0 < 64; s0 += 8) {
            const int sn = s0 < 56 ? s0 + 8 : s0;
#pragma unroll
            for (int q = 0; q < 8; ++q) na[q] = *(const f32x4*)(ap + 16 * (sn + q));
#pragma unroll
            for (int q = 0; q < 8; ++q) { const f32x4 b0 = *(LAS const f32x4*)(bp + (s0 + q) * 512), b1 = *(LAS const f32x4*)(bp + (s0 + q) * 512 + 64);
#pragma unroll
                for (int t = 0; t < 4; ++t) { acc0 = __builtin_amdgcn_mfma_f32_16x16x4f32(a[q][t], b0[t], acc0, 0, 0, 0); acc1 = __builtin_amdgcn_mfma_f32_16x16x4f32(a[q][t], b1[t], acc1, 0, 0, 0); } }
#pragma unroll
            for (int q = 0; q < 8; ++q) a[q] = na[q];
        } }
    __syncthreads();
#pragma unroll
    for (int r = 0; r < 4; ++r) { const float rx = rx_s[F.wave * 16 + 4 * fq + r];
        lg_s[(F.wave * 16 + 4 * fq + r) * 32 + fr] = rx * acc0[r] + z_s[fr];
        lg_s[(F.wave * 16 + 4 * fq + r) * 32 + fr + 16] = rx * acc1[r] + z_s[fr + 16]; }
    const float NEG_INF = -__builtin_inff();
    int se[4], lp[4]; float gt[4];
    if (lane < 16) {
        float v[32];
#pragma unroll
        for (int ch = 0; ch < 8; ++ch) { const f32x4 w = *(LAS const f32x4*)(lg_s + (F.wave * 16 + lane) * 32 + 4 * ch); v[4 * ch] = w[0]; v[4 * ch + 1] = w[1]; v[4 * ch + 2] = w[2]; v[4 * ch + 3] = w[3]; }
        float sv[4];
#pragma unroll
        for (int r = 0; r < 4; ++r) { float best = v[0]; int bi = 0;
#pragma unroll
            for (int e = 1; e < 32; ++e) if (v[e] > best) { best = v[e]; bi = e; }
            se[r] = bi; sv[r] = best;
#pragma unroll
            for (int e = 0; e < 32; ++e) v[e] = (e == bi) ? NEG_INF : v[e]; }
        const float p1 = __expf(sv[1] - sv[0]), p2 = __expf(sv[2] - sv[0]), p3 = __expf(sv[3] - sv[0]);
        const float rs = 1.f / (1.f + p1 + p2 + p3);
        gt[0] = rs; gt[1] = p1 * rs; gt[2] = p2 * rs; gt[3] = p3 * rs;
#pragma unroll
        for (int r = 0; r < 4; ++r) lp[r] = __hip_atomic_fetch_add(cnt_s + se[r], 1, __ATOMIC_RELAXED, __HIP_MEMORY_SCOPE_WORKGROUP);
    }
    __syncthreads();
    if (F.tid < 32) base_s[F.tid] = (int)__hip_atomic_fetch_add(ctl + CW_GCNT + 64 * F.tid, (unsigned)cnt_s[F.tid], __ATOMIC_RELAXED, __HIP_MEMORY_SCOPE_AGENT);
    __syncthreads();
    if (lane < 16) { int* la = WSP(int, WS_LIST_A); float* lgt = WSP(float, WS_LIST_G); const int m = mb0 + lane;
#pragma unroll
        for (int r = 0; r < 4; ++r) { const size_t p = (size_t)se[r] * T + base_s[se[r]] + lp[r]; la[p] = m * 4 + r; lgt[p] = gt[r]; } }
    asm volatile("s_waitcnt vmcnt(0)" ::: "memory");
    __syncthreads();
    if (F.tid == 0) flag_s[0] = (__hip_atomic_fetch_add(ctl + CW_DONE, 1u, __ATOMIC_RELAXED, __HIP_MEMORY_SCOPE_AGENT) == (unsigned)(F.G - 1)) ? 1 : 0;
    __syncthreads();
    if (flag_s[0]) {
        LAS int* off_s = (LAS int*)zr_s;
        if (F.tid < 32) { const int c = (int)__hip_atomic_load(ctl + CW_GCNT + 64 * F.tid, __ATOMIC_RELAXED, __HIP_MEMORY_SCOPE_AGENT); cnt_s[F.tid] = c; ctl[CW_MOE_CNT + F.tid] = (unsigned)c; }
        __syncthreads();
        if (F.tid == 0) { int off = 0; for (int e = 0; e < 32; ++e) { off_s[e] = off; off += (cnt_s[e] + 255) & ~255; } off_s[32] = off; }
        __syncthreads();
        if (F.tid <= 32) WSP(int, WS_MOE_OFF)[F.tid] = off_s[F.tid];
        const int ntile = off_s[32] >> 8;
        for (int rt = F.tid; rt < ntile; rt += NTHREADS) { int e = 0;
            for (int q = 1; q < 32; ++q) e = (off_s[q] <= rt * 256) ? q : e;
            WSP(int, WS_TILE_E)[rt] = e; }
    }
}

__device__ __forceinline__ f32x4 unpack4_fp8(unsigned w) {
    const auto lo = __builtin_amdgcn_cvt_pk_f32_fp8((int)w, false), hi = __builtin_amdgcn_cvt_pk_f32_fp8((int)w, true);
    return (f32x4){lo[0], lo[1], hi[0], hi[1]};
}
__device__ __forceinline__ void p11_combine(const Frame& F) {
    const float* mod = WSP(float, WS_MOD); const unsigned char* ys = WSP(unsigned char, WS_YS); const float* x1 = WSP(float, WS_X1);
    const int gw = F.bx * NWAVES + F.wave, m0 = gw * 16, lane = F.lane;
    const float* modb = mod + (m0 >> 14) * 6144;
    const unsigned char* yb = ys + (size_t)m0 * 4 * D + 4 * lane; const float* xb = x1 + (size_t)m0 * D + 4 * lane;
    unsigned ya[4][4], ybb[4][4], yc[4][4], yd[4][4]; f32x4 xa[4], xbf[4], xc[4], xd[4], g[4];
#define P11_LOAD(Y, X, r) do { _Pragma("unroll") for (int j = 0; j < 4; ++j) { X[j] = *(const f32x4*)(xb + (size_t)(r) * D + 256 * j); \
        _Pragma("unroll") for (int k4 = 0; k4 < 4; ++k4) Y[j][k4] = *(const unsigned*)(yb + ((size_t)(r) * 4 + k4) * D + 256 * j); } } while (0)
#define P11_ROW(Y, X, it) do { f32x4 yv[4]; float ss = 0.f; \
        _Pragma("unroll") for (int j = 0; j < 4; ++j) { f32x4 a = (f32x4){0.f, 0.f, 0.f, 0.f}; \
            _Pragma("unroll") for (int k4 = 0; k4 < 4; ++k4) a += unpack4_fp8(Y[j][k4]); \
            yv[j] = a; ss += dot4(a); } \
        const float ry = rsqrtf(wave_sum(ss) * (1.f / D) + EPS * (Y8_SCALE * Y8_SCALE)); \
        _Pragma("unroll") for (int j = 0; j < 4; ++j) *(f32x4*)(F.out + (size_t)(m0 + (it)) * D + 4 * lane + 256 * j) = X[j] + yv[j] * ry * g[j]; \
        if ((it) + 4 < 16) P11_LOAD(Y, X, (it) + 4); } while (0)
    P11_LOAD(ya, xa, 0); P11_LOAD(ybb, xbf, 1); P11_LOAD(yc, xc, 2); P11_LOAD(yd, xd, 3);
#pragma unroll
    for (int j = 0; j < 4; ++j) { const int idx = 4 * lane + 256 * j; g[j] = *(const f32x4*)(F.g_post_ffn + idx) * *(const f32x4*)(modb + 5120 + idx); }
#pragma unroll 1
    for (int it = 0; it < 16; it += 4) { P11_ROW(ya, xa, it); P11_ROW(ybb, xbf, it + 1); P11_ROW(yc, xc, it + 2); P11_ROW(yd, xd, it + 3); }
#undef P11_LOAD
#undef P11_ROW
}

constexpr int NPHASE = 11;
struct Args { const float* in[20]; float* out; unsigned char* ws; int ph_lo, ph_hi; };
__global__ void __launch_bounds__(NTHREADS, 2) fwd(Args args) {
    extern __shared__ __attribute__((aligned(16))) unsigned char lds[];
    Frame F;
    F.lds = (LAS unsigned char*)lds;
    F.tid = threadIdx.x; F.lane = F.tid & 63; F.wave = __builtin_amdgcn_readfirstlane(F.tid >> 6); F.bx = blockIdx.x; F.G = gridDim.x;
    F.x = args.in[0]; F.c = args.in[1]; F.w_ada = args.in[2]; F.b_ada = args.in[3]; F.g_pre_mix = args.in[4]; F.g_post_mix = args.in[5];
    F.g_pre_ffn = args.in[6]; F.g_post_ffn = args.in[7]; F.w_in = args.in[8]; F.w_gate_up = args.in[9]; F.b_gate = args.in[10]; F.g_gla_norm = args.in[11];
    F.sinks = args.in[12]; F.w_out = args.in[13]; F.w_router = args.in[14]; F.b_router = args.in[15]; F.w_mlp1 = args.in[16]; F.b_mlp1 = args.in[17];
    F.w_mlp2 = args.in[18]; F.b_mlp2 = args.in[19]; F.out = args.out; F.ws = args.ws;
    volatile LAS unsigned* MISC = (volatile LAS unsigned*)(F.lds + MISC_OFF);
    if (F.tid < 32) MISC[F.tid] = 0u;
    __syncthreads();
    const int lo = args.ph_lo, hi = args.ph_hi;
    XcdBarrier bar; bar.bar = (unsigned*)(F.ws + WS_CTL) + CW_BAR; bar.x = 0; bar.st = nullptr;
    if (hi - lo > 1) bar = xcd_barrier_post((unsigned*)(F.ws + WS_CTL) + CW_BAR, MISC + 8);
#define IN(k) (lo <= (k) && (k) < hi)
#if DUPMASK
#define REP(k) _Pragma("nounroll") for (int rep_ = 0; rep_ < 1 + ((DUPMASK >> (k)) & 1); ++rep_, __syncthreads())
#else
#define REP(k)
#endif
#define SEAM(k) do { if (IN(k) && IN((k) + 1)) xcd_barrier(bar); } while (0)

    if (IN(0)) { p0_prologue<0>(F);
#if DUPMASK & 1
        __syncthreads(); p0_prologue<P0_MODE>(F);
#endif
    } SEAM(0);
    if (IN(1)) REP(1) { p1_norm(F); } SEAM(1);
    if (IN(2)) REP(2) {
        constexpr int I_FIRST = 16 * 80 + 16 * 32, I_PER = (NE * 16 * 64 + NE * 16 * 32) / GRID;
        if (F.bx & 1) { tr_range<0>(F, I_FIRST + F.bx * I_PER, I_FIRST + (F.bx + 1) * I_PER); __syncthreads(); }
        { pg8::StaticOrder So; So.init(T / 256, INP / 256, F.G, F.bx);
          pg8::gemm_phase<false, 0, 0, 0>(F.lds, D, So, pg8::ABDense{WSP(bf16, WS_H), WSP(bf16, WS_WIN), D}, pg8::EpiStoreT{WSP(bf16, WS_PROJ), INP}); }
        if (!(F.bx & 1)) { __syncthreads(); tr_range<0>(F, I_FIRST + F.bx * I_PER, I_FIRST + (F.bx + 1) * I_PER); }
    } SEAM(2);
    if (IN(3)) REP(3) { for (int u = F.bx; u < 512; u += F.G) attn_unit(F, u);
                 for (int u = F.bx; u < 256; u += F.G) gla_super_unit<false>(F, u); } SEAM(3);
    if (IN(4)) REP(4) { gla_super_scan(F); } SEAM(4);
    if (IN(5)) REP(5) { for (int u = F.bx; u < 256; u += F.G) gla_super_unit<true>(F, u); } SEAM(5);
    if (IN(6)) REP(6) { pg8::StaticOrder So; So.init(T / 256, D / 256, F.G, F.bx);
                 pg8::gemm_phase<false, 0, 0, 0>(F.lds, D, So, pg8::ABDense{WSP(bf16, WS_MIX), WSP(bf16, WS_WOUT), D}, pg8::EpiStoreT{WSP(bf16, WS_Y), D}); } SEAM(6);
    if (IN(7)) REP(7) { p7_norm_router(F); } SEAM(7);
    if (IN(8)) REP(8) { const int nM = WSP(int, WS_MOE_OFF)[32] >> 8; pg8::StaticOrder So; So.init(nM, 2048 / 256, F.G, F.bx);
                 pg8::gemm_phase<true, 1, W8_E8M0, H8_E8M0>(F.lds, 512, So, pg8::ABMoe1{WSP(unsigned char, WS_H), WSP(unsigned char, WS_W1T), WSP(int, WS_TILE_E), WSP(int, WS_MOE_OFF), WSP(unsigned, WS_CTL) + CW_MOE_CNT, WSP(int, WS_LIST_A)},
                                       pg8::EpiSwigluT{WSP(unsigned char, WS_A), F.b_mlp1, WSP(int, WS_TILE_E)}); } SEAM(8);
    if (IN(9)) REP(9) { const int nM = WSP(int, WS_MOE_OFF)[32] >> 8; pg8::StaticOrder So; So.init(nM, D / 256, F.G, F.bx);
                  pg8::gemm_phase<false, 1, W8_E8M0, A8_E8M0>(F.lds, 512, So, pg8::ABMoe2{WSP(unsigned char, WS_A), WSP(unsigned char, WS_W2T), WSP(int, WS_TILE_E)},
                                         pg8::EpiMoe2T{WSP(unsigned char, WS_YS), F.b_mlp2, WSP(int, WS_TILE_E), WSP(int, WS_MOE_OFF), WSP(unsigned, WS_CTL) + CW_MOE_CNT, WSP(int, WS_LIST_A), WSP(float, WS_LIST_G)}); } SEAM(9);
    if (IN(10)) REP(10) { p11_combine(F); }
#undef IN
#undef SEAM
}

extern "C" void kernel_launch(void* const* d_in, const int* in_sizes, int n_in, void* d_out, int out_size, void* d_ws, size_t ws_size, hipStream_t stream) {
    static int ready = 0;
    if (ready == 0) {
        if (n_in != 20 || out_size != T * D || ws_size < WS_END) { fprintf(stderr, "kernel_launch: unexpected problem (n_in %d, out %d, ws %zu)\n", n_in, out_size, ws_size); ready = -1; return; }
        if (hipFuncSetAttribute((const void*)fwd, hipFuncAttributeMaxDynamicSharedMemorySize, LDS_BYTES) != hipSuccess) { fprintf(stderr, "kernel_launch: hipFuncSetAttribute failed\n"); ready = -1; return; }
        int per_cu = 0;
        if (hipOccupancyMaxActiveBlocksPerMultiprocessor(&per_cu, (const void*)fwd, NTHREADS, LDS_BYTES) != hipSuccess || per_cu < 1) fprintf(stderr, "kernel_launch: occupancy query says %d\n", per_cu);
        (void)hipGetLastError();
        ready = 1;
    }
    if (ready < 0) return;
    (void)hipMemsetAsync((char*)d_ws + WS_CTL, 0, CTL_ZERO_BYTES, stream);
    Args a{};
    for (int i = 0; i < 20; ++i) a.in[i] = (const float*)d_in[i];
    a.out = (float*)d_out; a.ws = (unsigned char*)d_ws;
#if MK_ONE_LAUNCH
    a.ph_lo = 0; a.ph_hi = NPHASE;
    hipLaunchKernelGGL(fwd, dim3(GRID), dim3(NTHREADS), LDS_BYTES, stream, a);
#if PROBE_PHASE >= 0
    a.ph_lo = PROBE_PHASE; a.ph_hi = PROBE_PHASE + 1;
    hipLaunchKernelGGL(fwd, dim3(GRID), dim3(NTHREADS), LDS_BYTES, stream, a);
#endif
#else
    for (int p = 0; p < NPHASE; ++p) { a.ph_lo = p; a.ph_hi = p + 1; hipLaunchKernelGGL(fwd, dim3(GRID), dim3(NTHREADS), LDS_BYTES, stream, a); }
#endif
}
```

```cpp
#include <hip/hip_runtime.h>
#include <cstdio>
#include <cstdint>

#ifndef MK_ONE_LAUNCH
#define MK_ONE_LAUNCH 1
#endif

#ifndef PROBE_PHASE
#define PROBE_PHASE -1
#endif
#ifndef P2_MODE
#define P2_MODE 0
#endif
#ifndef P3_MODE
#define P3_MODE 0
#endif
#ifndef P0_MODE
#define P0_MODE 0
#endif
#ifndef DUPMASK
#define DUPMASK 0
#endif
#define LAS __attribute__((address_space(3)))
typedef unsigned short bf16;
typedef short bf16x8 __attribute__((ext_vector_type(8)));
typedef short s16x4 __attribute__((ext_vector_type(4)));
typedef float f32x4 __attribute__((ext_vector_type(4)));
typedef unsigned u32x4 __attribute__((ext_vector_type(4)));
typedef unsigned u32x2 __attribute__((ext_vector_type(2)));

constexpr int D = 1024, NB = 2, S = 16384, T = NB * S;
constexpr int INW = 2320, INP = 2560;
constexpr int AQ_OFF = 0, AK_OFF = 512, AV_OFF = 640, GQ_OFF = 768, GK_OFF = 1024, GV_OFF = 1280, GG_OFF = 1792, GA_OFF = 2304;
constexpr int NCH = 256;
constexpr int NE = 32, FF = 1024;
constexpr int NSLOT_MAX = T * 4 + NE * 256;
constexpr float EPS = 1e-6f;
constexpr int NWAVES = 8, NTHREADS = 512, GRID = 256;

constexpr size_t MiB = 1u << 20;
constexpr size_t WS_CTL = 0, CTL_ZERO_BYTES = 1 * MiB;
constexpr size_t WS_MOD = 1 * MiB;
constexpr size_t WS_DECAY = 2 * MiB;
constexpr size_t WS_ROUTE = 3 * MiB;
constexpr size_t WS_TOK_E = WS_ROUTE, WS_TOK_LPOS = WS_ROUTE + 512 * 1024, WS_TOK_GATE = WS_ROUTE + 1024 * 1024;
constexpr size_t WS_BLK_CNT = WS_ROUTE + 1536 * 1024, WS_MOE_OFF = WS_BLK_CNT + 32 * 1024, WS_TILE_E = WS_MOE_OFF + 4096;
constexpr size_t WS_SLOT_ASSIGN = WS_ROUTE + 2 * MiB, WS_SLOT_GATE = WS_ROUTE + 3 * MiB;
constexpr size_t WS_WIN = 8 * MiB, WS_WOUT = 13 * MiB, WS_W2T = 16 * MiB, WS_W1T = 80 * MiB;
constexpr size_t WS_H = 208 * MiB, WS_KV = 272 * MiB, WS_YS = 80 * MiB;
constexpr size_t WS_X1 = 336 * MiB, WS_PROJ = 464 * MiB, WS_MIX = 624 * MiB, WS_Y = 688 * MiB, WS_A = 464 * MiB;
constexpr size_t WS_LIST_A = 752 * MiB, WS_LIST_G = 756 * MiB;
constexpr size_t WS_XS = 608 * MiB;
constexpr size_t WS_END = 760 * MiB;
constexpr int CW_BAR = 4096, CW_GCNT = 8192  , CW_DONE = 8192 + 64 * 32, CW_MOE_CNT = 16384  ;

constexpr int LDS_BYTES = 163840, SMALL_OFF = 132096, MISC_OFF = 131072 + 320;

__device__ __forceinline__ float bf2f(unsigned v) { return __uint_as_float(v << 16); }
__device__ __forceinline__ unsigned f2bf(float f) { unsigned u = __float_as_uint(f); return (u + 0x7fffu + ((u >> 16) & 1u)) >> 16; }
__device__ __forceinline__ unsigned pk2(float lo, float hi) { return f2bf(lo) | (f2bf(hi) << 16); }
__device__ __forceinline__ float wave_sum(float v) {
#pragma unroll
    for (int o = 1; o < 64; o <<= 1) v += __shfl_xor(v, o);
    return v;
}
__device__ __forceinline__ f32x4 unpack4(u32x2 r) { return (f32x4){bf2f(r.x & 0xffffu), bf2f(r.x >> 16), bf2f(r.y & 0xffffu), bf2f(r.y >> 16)}; }
__device__ __forceinline__ float dot4(f32x4 a) { return (a[0] * a[0] + a[1] * a[1]) + (a[2] * a[2] + a[3] * a[3]); }
typedef short v4i16_t __attribute__((ext_vector_type(4)));
__device__ __forceinline__ s16x4 trr(LAS const unsigned char* p) { return __builtin_bit_cast(s16x4, __builtin_amdgcn_ds_read_tr16_b64_v4i16((LAS v4i16_t*)p)); }
__device__ __forceinline__ bf16x8 cat8(s16x4 lo, s16x4 hi) { return __builtin_shufflevector(lo, hi, 0, 1, 2, 3, 4, 5, 6, 7); }
__device__ __forceinline__ bf16x8 pack8(f32x4 a, f32x4 b) { u32x4 w; w.x = pk2(a[0], a[1]); w.y = pk2(a[2], a[3]); w.z = pk2(b[0], b[1]); w.w = pk2(b[2], b[3]); return __builtin_bit_cast(bf16x8, w); }
#define MFMA(a, b, c) __builtin_amdgcn_mfma_f32_16x16x32_bf16((a), (b), (c), 0, 0, 0)
typedef int i32x4 __attribute__((ext_vector_type(4)));
typedef int i32x8 __attribute__((ext_vector_type(8)));
__device__ __forceinline__ float clamp8(float v) { return fminf(fmaxf(v, -448.f), 448.f); }
__device__ __forceinline__ unsigned pk4_fp8(float a, float b, float c, float d) {
    int w = 0; w = __builtin_amdgcn_cvt_pk_fp8_f32(clamp8(a), clamp8(b), w, false); w = __builtin_amdgcn_cvt_pk_fp8_f32(clamp8(c), clamp8(d), w, true); return (unsigned)w; }
constexpr float W8_SCALE = 64.f, H8_SCALE = 16.f, A8_SCALE = 4.f, Y8_SCALE = 16.f;
constexpr int W8_E8M0 = 0x79797979  , H8_E8M0 = 0x7b7b7b7b  , A8_E8M0 = 0x7d7d7d7d  ;

#define XB_TMO      128
#define XB_XCNT(j)  (256  + 64 * (j))
#define XB_XSUB(j)  (1280 + 64 * (j))
#define XB_XGEN(j)  (2304 + 64 * (j))
#define XB_TOP      3328
#define XB_TOPGEN   3392
#define XCD_BAR_WORDS 3456
#define XB_SPIN_CAP (1u << 18)
__device__ __forceinline__ unsigned xb_ld(unsigned* p)              { return __hip_atomic_load(p, __ATOMIC_RELAXED, __HIP_MEMORY_SCOPE_AGENT); }
__device__ __forceinline__ unsigned xb_add(unsigned* p, unsigned v) { return __hip_atomic_fetch_add(p, v, __ATOMIC_RELAXED, __HIP_MEMORY_SCOPE_AGENT); }
__device__ __forceinline__ unsigned xb_xcc_id() { return (unsigned)__builtin_amdgcn_s_getreg((3 << 11) | 20) & 0xFu; }
#define XB_SPIN(cond, bar) do { unsigned _sp = 0; while (cond) { __builtin_amdgcn_s_sleep(1); \
    if ((++_sp & 255u) == 0u) { if (xb_ld(&(bar)[XB_TMO])) break; if (_sp > XB_SPIN_CAP) { atomicAdd(&(bar)[XB_TMO], 1u); break; } } } } while (0)
struct XcdBarrier { unsigned* bar; unsigned x; volatile LAS unsigned* st; };
__device__ __forceinline__ XcdBarrier xcd_barrier_post(unsigned* bar, volatile LAS unsigned* st) {
    XcdBarrier b; b.bar = bar; b.x = xb_xcc_id(); b.st = st;
    if (threadIdx.x == 0) (void)xb_add(&bar[XB_XCNT(b.x)], 1u);
    return b;
}
__device__ __forceinline__ void xcd_barrier_complete(unsigned* bar, unsigned x, unsigned& nloc, unsigned& nx) {
    const unsigned G = gridDim.x * gridDim.y * gridDim.z;
    unsigned sum, cnt, mine, sp = 0u;
    for (;;) {
        sum = 0u; cnt = 0u; mine = 0u;
#pragma unroll
        for (unsigned j = 0; j < 16; ++j) { const unsigned c = xb_ld(&bar[XB_XCNT(j)]); sum += c; cnt += (c > 0u) ? 1u : 0u; mine = (j == x) ? c : mine; }
        if (sum == G) break;
        __builtin_amdgcn_s_sleep(1);
        if ((++sp & 255u) == 0u) { if (xb_ld(&bar[XB_TMO])) break; if (sp > XB_SPIN_CAP) { atomicAdd(&bar[XB_TMO], 1u); break; } }
    }
    nloc = mine > 0u ? mine : 1u; nx = cnt > 0u ? cnt : 1u;
}
__device__ __forceinline__ void xcd_barrier(const XcdBarrier& b) {
    asm volatile("s_waitcnt vmcnt(0)" ::: "memory");
    __syncthreads();
    if (threadIdx.x == 0) {
        unsigned* bar = b.bar;
        __builtin_amdgcn_s_waitcnt(0);
        unsigned nloc = b.st[0], nx = b.st[1];
        if (nloc == 0u) { xcd_barrier_complete(bar, b.x, nloc, nx); b.st[0] = nloc; b.st[1] = nx; }
        const unsigned old = xb_add(&bar[XB_XSUB(b.x)], 1u);
        const unsigned gen = old / nloc;
        if (old + 1u == (gen + 1u) * nloc) {
            __builtin_amdgcn_fence(__ATOMIC_RELEASE, "agent");
            asm volatile("s_waitcnt vmcnt(0)" ::: "memory");
            const unsigned og = xb_add(&bar[XB_TOP], 1u);
            const unsigned tg = og / nx;
            if (og + 1u == (tg + 1u) * nx) xb_add(&bar[XB_TOPGEN], 1u);
            else XB_SPIN(xb_ld(&bar[XB_TOPGEN]) == tg, bar);
            __builtin_amdgcn_fence(__ATOMIC_ACQUIRE, "agent");
            xb_add(&bar[XB_XGEN(b.x)], 1u);
            asm volatile("s_waitcnt vmcnt(0)" ::: "memory");
        } else {
            XB_SPIN(xb_ld(&bar[XB_XGEN(b.x)]) == gen, bar);
            __builtin_amdgcn_fence(__ATOMIC_ACQUIRE, "agent");
            asm volatile("s_waitcnt vmcnt(0)" ::: "memory");
        }
    }
    __syncthreads();
}

struct Frame {
    LAS unsigned char* lds;
    int tid, lane, wave, bx, G;
    const float *x, *c, *w_ada, *b_ada, *g_pre_mix, *g_post_mix, *g_pre_ffn, *g_post_ffn, *w_in, *w_gate_up, *b_gate, *g_gla_norm, *sinks, *w_out,
                *w_router, *b_router, *w_mlp1, *b_mlp1, *w_mlp2, *b_mlp2;
    float* out;
    unsigned char* ws;
};
#define WSP(type, off) ((type*)(F.ws + (off)))

struct TrItem { const float* W; int N; int k0, n0; unsigned char* WT; int kind; };
__device__ __forceinline__ bool tr_decode(const Frame& F, int it, TrItem& t) {
    constexpr int I_IN = 16 * 80, I_OUT = 16 * 32, I_1 = 16 * 64, I_2 = 16 * 32;
    constexpr int NITEMS = I_IN + I_OUT + NE * I_1 + NE * I_2;
    if (it >= NITEMS) return false;
    int r = it, item;
    if (r < I_IN) { t.W = F.w_in; t.N = INW; t.WT = F.ws + WS_WIN; t.kind = 0; item = r; }
    else if ((r -= I_IN) < I_OUT) { t.W = F.w_out; t.N = 1024; t.WT = F.ws + WS_WOUT; t.kind = 0; item = r; }
    else if ((r -= I_OUT) < NE * I_1) { const int e = r / I_1; t.W = F.w_mlp1 + (size_t)e * 1024 * 2048; t.N = 2048; t.WT = F.ws + WS_W1T + (size_t)e * 2048 * 1024; t.kind = 1; item = r % I_1; }
    else { r -= NE * I_1; const int e = r / I_2; t.W = F.w_mlp2 + (size_t)e * 1024 * 1024; t.N = 1024; t.WT = F.ws + WS_W2T + (size_t)e * 1024 * 1024; t.kind = 2; item = r % I_2; }
    const int st = item >> 4, l = item & 15, kb = 2 * (st & 7) + (l >> 3), nb = 8 * (st >> 3) + (l & 7);
    t.k0 = 64 * kb; t.n0 = 32 * nb;
    return true;
}
__device__ __forceinline__ void tr_dma(const TrItem& t, int lane, LAS unsigned char* buf) {
    const int p = lane & 7, rr = lane >> 3;
#pragma unroll
    for (int i = 0; i < 8; ++i) {
        int col = t.n0 + 4 * (p ^ i); col = col + 4 <= t.N ? col : t.N - 4;
        __builtin_amdgcn_global_load_lds((const unsigned*)(t.W + (size_t)(t.k0 + 8 * i + rr) * t.N + col), (LAS unsigned*)(buf + i * 1024), 16, 0, 0);
    }
}
__device__ __forceinline__ void tr_store(const TrItem& t, int lane, LAS const unsigned char* buf) {
    const int c = lane & 7;
#pragma unroll
    for (int j = 0; j < 4; ++j) { const int nn = (lane >> 3) + 8 * j;
        float e[8];
#pragma unroll
        for (int q = 0; q < 8; ++q) e[q] = *(LAS const float*)(buf + (8 * c + q) * 128 + (((nn >> 2) ^ c) << 4) + (nn & 3) * 4);
        const int n = t.n0 + nn; const bool ok = n < t.N;
#pragma unroll
        for (int q = 0; q < 8; ++q) e[q] = ok ? e[q] : 0.f;
        if (t.kind == 0) { u32x4 o; o.x = pk2(e[0], e[1]); o.y = pk2(e[2], e[3]); o.z = pk2(e[4], e[5]); o.w = pk2(e[6], e[7]);
            *(u32x4*)((bf16*)t.WT + (size_t)n * 1024 + t.k0 + 8 * c) = o; }
        else { u32x2 o; o.x = pk4_fp8(e[0] * W8_SCALE, e[1] * W8_SCALE, e[2] * W8_SCALE, e[3] * W8_SCALE); o.y = pk4_fp8(e[4] * W8_SCALE, e[5] * W8_SCALE, e[6] * W8_SCALE, e[7] * W8_SCALE);
            int row = n; if (t.kind == 1) { const int jj = n >> 1; row = 256 * (jj >> 7) + 128 * (n & 1) + (jj & 127); }
            *(u32x2*)(t.WT + (size_t)row * 1024 + t.k0 + 8 * c) = o; } }
}
template <int MODE>
__device__ __forceinline__ void tr_range(const Frame& F, int itB, int itE) {
    LAS unsigned char* buf0 = F.lds + F.wave * 16384; LAS unsigned char* buf1 = buf0 + 8192;
    const int it0 = itB + F.wave;
    TrItem t0, t1;
    bool h0 = (it0 < itE) && tr_decode(F, it0, t0); if (h0) tr_dma(t0, F.lane, buf0);
    bool h1 = (it0 + NWAVES < itE) && tr_decode(F, it0 + NWAVES, t1); if (h1) tr_dma(t1, F.lane, buf1);
    if (h0) { if (h1) asm volatile("s_waitcnt vmcnt(8)" ::: "memory"); else asm volatile("s_waitcnt vmcnt(0)" ::: "memory"); }
#pragma unroll 1
    for (int it = it0; h0; it += 2 * NWAVES) {
        if (MODE != 1) tr_store(t0, F.lane, buf0);
        asm volatile("s_waitcnt lgkmcnt(0)" ::: "memory");
        h0 = (it + 2 * NWAVES < itE) && tr_decode(F, it + 2 * NWAVES, t0); if (h0) tr_dma(t0, F.lane, buf0);
        if (!h1) break;
        if (h0) asm volatile("s_waitcnt vmcnt(12)" ::: "memory"); else asm volatile("s_waitcnt vmcnt(4)" ::: "memory");
        if (MODE != 1) tr_store(t1, F.lane, buf1);
        asm volatile("s_waitcnt lgkmcnt(0)" ::: "memory");
        h1 = (it + 3 * NWAVES < itE) && tr_decode(F, it + 3 * NWAVES, t1); if (h1) tr_dma(t1, F.lane, buf1);
        if (h0) { if (h1) asm volatile("s_waitcnt vmcnt(12)" ::: "memory"); else asm volatile("s_waitcnt vmcnt(4)" ::: "memory"); }
    }
    asm volatile("s_waitcnt vmcnt(0)" ::: "memory");
}
template <int MODE>
__device__ __forceinline__ void p0_prologue(const Frame& F) {
    float* mod = WSP(float, WS_MOD);
    if (F.bx < 192 && MODE != 3 && MODE != 1) {
        LAS float* red = (LAS float*)(F.lds + 98304);
        const int cl = F.tid & 31, ks = F.tid >> 5, col = F.bx * 32 + cl;
        float a0 = 0.f, a1 = 0.f;
        float wv[64];
#pragma unroll
        for (int i = 0; i < 64; ++i) wv[i] = F.w_ada[(size_t)(ks * 64 + i) * 6144 + col];
#pragma unroll
        for (int i = 0; i < 64; ++i) { const int k = ks * 64 + i;
            const float c0 = F.c[k], c1 = F.c[1024 + k];
            a0 += c0 * __builtin_amdgcn_rcpf(1.f + __expf(-c0)) * wv[i]; a1 += c1 * __builtin_amdgcn_rcpf(1.f + __expf(-c1)) * wv[i];
        }
        red[(0 * 16 + ks) * 32 + cl] = a0; red[(1 * 16 + ks) * 32 + cl] = a1;
        __syncthreads();
        if (F.tid < 64) { const int b = F.tid >> 5; float s = 0.f;
#pragma unroll
            for (int i = 0; i < 16; ++i) s += red[(b * 16 + i) * 32 + cl];
            mod[b * 6144 + col] = s + F.b_ada[col]; }
        __syncthreads();
    }
    if (MODE == 2) return;
    if (F.bx < 112) tr_range<MODE>(F, F.bx * 16, F.bx * 16 + 16);
}

__device__ __forceinline__ void p1_norm(const Frame& F) {
    const float* mod = WSP(float, WS_MOD); bf16* h = WSP(bf16, WS_H);
    const int gw = F.bx * NWAVES + F.wave, m0 = gw * 16;
    const float* modb = mod + (m0 >> 14) * 6144;
    const float* xb = F.x + (size_t)m0 * D + 4 * F.lane;
    f32x4 g[4], sh[4], b0[4], b1[4], b2[4], b3[4];
#define P1_LOAD(B, r) do { _Pragma("unroll") for (int j = 0; j < 4; ++j) B[j] = *(const f32x4*)(xb + (size_t)(r) * D + 256 * j); } while (0)
#define P1_ROW(B, it) do { float ss = 0.f; _Pragma("unroll") for (int j = 0; j < 4; ++j) ss += dot4(B[j]); \
        const float r = rsqrtf(wave_sum(ss) * (1.f / D) + EPS); \
        _Pragma("unroll") for (int j = 0; j < 4; ++j) { const f32x4 hv = B[j] * r * g[j] + sh[j]; u32x2 o; o.x = pk2(hv[0], hv[1]); o.y = pk2(hv[2], hv[3]); \
            *(u32x2*)(h + (size_t)(m0 + (it)) * D + 4 * F.lane + 256 * j) = o; } \
        if ((it) + 4 < 16) P1_LOAD(B, (it) + 4); } while (0)
    P1_LOAD(b0, 0); P1_LOAD(b1, 1); P1_LOAD(b2, 2); P1_LOAD(b3, 3);
#pragma unroll
    for (int j = 0; j < 4; ++j) { const int idx = 4 * F.lane + 256 * j;
        g[j] = *(const f32x4*)(F.g_pre_mix + idx) * (*(const f32x4*)(modb + 1024 + idx) + 1.f); sh[j] = *(const f32x4*)(modb + idx); }
#pragma unroll 1
    for (int it = 0; it < 16; it += 4) { P1_ROW(b0, it); P1_ROW(b1, it + 1); P1_ROW(b2, it + 2); P1_ROW(b3, it + 3); }
#undef P1_LOAD
#undef P1_ROW
}

template <class Epi, class RowMap, class BSel>
__device__ __forceinline__ void simple_gemm(const Frame& F, const bf16* A, int lda, int M, int N, int K, const RowMap& rm, const BSel& bs, const Epi& E) {
    const int fr = F.lane & 15, fq = F.lane >> 4;
    const int ncg = N / 512, nbt = (M / 64) * ncg;
    for (int bt = F.bx; bt < nbt; bt += F.G) {
        const int mt = bt / ncg, cg = bt % ncg, m0 = mt * 64, n0 = cg * 512 + F.wave * 64;
        const bf16* Bt = bs(m0);
        const bf16* ap[4]; const bf16* bp[4];
#pragma unroll
        for (int i = 0; i < 4; ++i) { ap[i] = A + (size_t)rm(m0 + 16 * i + fr) * lda + 8 * fq; bp[i] = Bt + (size_t)(n0 + 16 * i + fr) * K + 8 * fq; }
        f32x4 acc[4][4];
#pragma unroll
        for (int i = 0; i < 4; ++i)
#pragma unroll
            for (int j = 0; j < 4; ++j) acc[i][j] = (f32x4){0.f, 0.f, 0.f, 0.f};
#pragma unroll 2
        for (int k0 = 0; k0 < K; k0 += 32) {
            bf16x8 a[4], b[4];
#pragma unroll
            for (int i = 0; i < 4; ++i) { a[i] = *(const bf16x8*)(ap[i] + k0); b[i] = *(const bf16x8*)(bp[i] + k0); }
#pragma unroll
            for (int i = 0; i < 4; ++i)
#pragma unroll
                for (int j = 0; j < 4; ++j) acc[i][j] = MFMA(b[j], a[i], acc[i][j]);
        }
#pragma unroll
        for (int i = 0; i < 4; ++i)
#pragma unroll
            for (int j = 0; j < 4; ++j) E(m0 + 16 * i + fr, n0 + 16 * j + 4 * fq, acc[i][j]);
    }
}
struct RowId { __device__ __forceinline__ int operator()(int m) const { return m; } };
struct RowGather { const int* slot_assign; __device__ __forceinline__ int operator()(int m) const { const int a = slot_assign[m]; return a < 0 ? 0 : (a >> 2); } };
struct BFixed { const bf16* Bt; __device__ __forceinline__ const bf16* operator()(int) const { return Bt; } };
struct BExpert { const bf16* Bt; const int* tile_e; size_t stride; __device__ __forceinline__ const bf16* operator()(int m0) const { return Bt + (size_t)tile_e[m0 >> 8] * stride; } };
struct EpiStore { bf16* O; int ldo;
    __device__ __forceinline__ void operator()(int m, int n, f32x4 v) const { u32x2 w; w.x = pk2(v[0], v[1]); w.y = pk2(v[2], v[3]); *(u32x2*)(O + (size_t)m * ldo + n) = w; } };
__device__ __forceinline__ float swiglu(float g, float l) {
    const float xg = fminf(g, 7.f), xl = fminf(fmaxf(l, -7.f), 7.f);
    return xg / (1.f + __expf(-1.702f * xg)) * (xl + 1.f);
}
struct EpiSwiglu { bf16* Aout; const float* b1; const int* tile_e;
    __device__ __forceinline__ void operator()(int m, int n, f32x4 v) const {
        const int e = tile_e[m >> 8]; const f32x4 bb = *(const f32x4*)(b1 + (size_t)e * 2048 + n);
        const float a0 = swiglu(v[0] + bb[0], v[1] + bb[1]), a1 = swiglu(v[2] + bb[2], v[3] + bb[3]);
        *(unsigned*)(Aout + (size_t)m * FF + (n >> 1)) = pk2(a0, a1); } };
struct EpiMoe2 { bf16* ys; const float* b2; const int* tile_e; const int* slot_assign; const float* slot_gate;
    __device__ __forceinline__ void operator()(int m, int n, f32x4 v) const {
        const int asg = slot_assign[m]; if (asg < 0) return;
        const int e = tile_e[m >> 8]; const f32x4 bb = *(const f32x4*)(b2 + (size_t)e * D + n); const float g = slot_gate[m];
        u32x2 w; w.x = pk2((v[0] + bb[0]) * g, (v[1] + bb[1]) * g); w.y = pk2((v[2] + bb[2]) * g, (v[3] + bb[3]) * g);
        *(u32x2*)(ys + (size_t)asg * D + n) = w; } };

namespace pg8 {
constexpr int BM = 256, BK = 64, HALF = 128, HTB = HALF * BK * 2, NXCD = 8, WGM = 8;
__device__ __forceinline__ int lds_byte(int r, int c) { const int st = (r >> 4) * 2 + (c >> 5), rr = r & 15, cc = c & 31, ob = rr * 64 + cc * 2; return st * 1024 + (ob ^ (((ob >> 9) & 1) << 5)); }
__device__ __forceinline__ void stage_rc(int b, int& R, int& C) { const int st = b / 1024, sb = b % 1024, swz = sb ^ (((sb >> 9) & 1) << 5); R = (st >> 1) * 16 + swz / 64; C = (st & 1) * 32 + (swz % 64) / 2; }
__device__ __forceinline__ int perm32(int rho) { const int n = rho >> 4, i = rho & 15; return 8 * (i >> 2) + 4 * n + (i & 3); }
struct Unit { int pm, pn; };
struct StaticOrder {
    int nM, nN, nwg, G, c, i0, n;
    __device__ __forceinline__ void init(int nM_, int nN_, int G_, int c_, int i0_ = 0, int n_ = 1 << 30) { nM = nM_; nN = nN_; nwg = nM * nN; G = G_; c = c_; i0 = i0_; n = n_; }
    __device__ __forceinline__ bool next(int i, Unit& u) const {
        if (i >= n) return false;
        const long L = (long)(i0 + i) * G + c; if (L >= nwg) return false;
        int wgid = (int)L; { const int q = nwg / NXCD, r = nwg % NXCD, xcd = wgid % NXCD, off = wgid / NXCD; wgid = (xcd < r ? xcd * (q + 1) : r * (q + 1) + (xcd - r) * q) + off; }
        const int nig = WGM * nN, gid = wgid / nig, fm = gid * WGM, gsz = (nM - fm) < WGM ? (nM - fm) : WGM;
        u.pm = fm + ((wgid % nig) % gsz); u.pn = (wgid % nig) / gsz; return true;
    }
};
template <bool GATHER, int FP8, int SCW, int SCX, class Epi, class Sched, class AB>
__device__ __forceinline__ void gemm_phase(LAS unsigned char* lds, const int K, const Sched& S, const AB& ab, const Epi& E) {
    const int tid = threadIdx.x, wid = __builtin_amdgcn_readfirstlane(tid >> 6), lane = tid & 63, wr = wid >> 2, wc = wid & 3, fr = lane & 15, fq = lane >> 4;
    const int nt = K / BK;
    int sR[2], sC[2]; unsigned voffB[2], vA[2][2], nvA[2][2];
#pragma unroll
    for (int i = 0; i < 2; ++i) { int R, C; stage_rc(tid * 16 + i * 8192, R, C); sR[i] = R; sC[i] = C; const int Rb = (R & ~31) + perm32(R & 31); voffB[i] = (unsigned)(Rb * K + C) * 2u; }
    const size_t kstep = (size_t)(BK * 2);
    const size_t hstep = (size_t)HALF * K * 2;
    const unsigned ldsw = (unsigned)wid * 1024u;
    const int aoff = lds_byte(wr * 64 + fr, fq * 8), boff = lds_byte(wc * 32 + fr, fq * 8);
#define PG8_SA(b, h) (((b) * 2 + (h)) * HTB)
#define PG8_SB(b, h) ((4 + (b) * 2 + (h)) * HTB)
#define PG8_STAGE(bufoff, gbase, voff) do { _Pragma("unroll") for (int _i = 0; _i < 2; ++_i) \
        __builtin_amdgcn_global_load_lds((const unsigned*)((const char*)(gbase) + (voff)[_i]), (LAS unsigned*)(lds + (bufoff) + ldsw + _i * 8192), 16, 0, 0); } while (0)
#define PG8_LDA(dst, b, h) do { _Pragma("unroll") for (int m = 0; m < 4; ++m) _Pragma("unroll") for (int k = 0; k < 2; ++k) dst[m][k] = *(const LAS bf16x8*)(lds + PG8_SA(b, h) + aoff + m * 2048 + k * 1024); } while (0)
#define PG8_LDB(dst, b, h) do { _Pragma("unroll") for (int n = 0; n < 2; ++n) _Pragma("unroll") for (int k = 0; k < 2; ++k) dst[n][k] = *(const LAS bf16x8*)(lds + PG8_SB(b, h) + boff + n * 2048 + k * 1024); } while (0)
#define PG8_C8(x) __builtin_shufflevector(__builtin_bit_cast(i32x4, (x)[0]), __builtin_bit_cast(i32x4, (x)[1]), 0, 1, 2, 3, 4, 5, 6, 7)
#define PG8_MMA(ai, bj, At, Bt) do { __builtin_amdgcn_s_setprio(1); _Pragma("unroll") for (int m = 0; m < 4; ++m) _Pragma("unroll") for (int n = 0; n < 2; ++n) { \
        if (FP8) asm volatile("v_mfma_scale_f32_16x16x128_f8f6f4 %0, %1, %2, %0, %3, %4 op_sel_hi:[0,0,0]" : "+v"(acc[ai][bj][m][n]) : "v"(PG8_C8(Bt[n])), "v"(PG8_C8(At[m])), "v"(scw), "v"(scx)); \
        else { _Pragma("unroll") for (int k = 0; k < 2; ++k) asm volatile("v_mfma_f32_16x16x32_bf16 %0, %1, %2, %0" : "+v"(acc[ai][bj][m][n]) : "v"(Bt[n][k]), "v"(At[m][k])); } } \
        __builtin_amdgcn_s_setprio(0); } while (0)
#define PG8_WAIT_V(n) asm volatile("s_waitcnt vmcnt(" #n ")" ::: "memory")
#define PG8_WAIT_L(n) asm volatile("s_waitcnt lgkmcnt(" #n ")" ::: "memory")
#define PG8_BAR __builtin_amdgcn_s_barrier()
#define PG8_SCHED __builtin_amdgcn_sched_barrier(0)
#define PG8_AOFF(dst, u) do { _Pragma("unroll") for (int _h = 0; _h < 2; ++_h) _Pragma("unroll") for (int _i = 0; _i < 2; ++_i) \
        dst[_h][_i] = GATHER ? (unsigned)(ab.a_row((u), _h * HALF + sR[_i]) * K + sC[_i]) * 2u : (unsigned)((_h * HALF + sR[_i]) * K + sC[_i]) * 2u; } while (0)
    Unit cur, nxt; int ui = 0;
    if (!S.next(0, cur)) return;
    const int scw = SCW, scx = SCX;
    f32x4 acc[2][2][4][2];
#pragma unroll
    for (int a = 0; a < 2; ++a)
#pragma unroll
        for (int b = 0; b < 2; ++b)
#pragma unroll
            for (int m = 0; m < 4; ++m)
#pragma unroll
                for (int n = 0; n < 2; ++n) acc[a][b][m][n] = (f32x4){0.f, 0.f, 0.f, 0.f};
    bf16x8 At[4][2], B0[2][2], B1[2][2];
    const char* cA = ab.a_base(cur); const char* cB = ab.b_base(cur);
    PG8_AOFF(vA, cur);
    PG8_STAGE(PG8_SB(0, 0), cB, voffB); PG8_STAGE(PG8_SB(0, 1), cB + hstep, voffB); PG8_STAGE(PG8_SA(0, 0), cA, vA[0]); PG8_STAGE(PG8_SA(0, 1), cA, vA[1]);
    if (wr == 1) PG8_BAR;
    PG8_WAIT_V(2); PG8_BAR;
    PG8_STAGE(PG8_SB(1, 0), cB + kstep, voffB); PG8_STAGE(PG8_SA(1, 0), cA + kstep, vA[0]); PG8_STAGE(PG8_SB(1, 1), cB + hstep + kstep, voffB);
    PG8_WAIT_V(6); PG8_BAR;
    for (;;) {
        const bool has_next = S.next(ui + 1, nxt);
        const char* nA = has_next ? ab.a_base(nxt) : cA; const char* nB = has_next ? ab.b_base(nxt) : cB;
        if (GATHER) { if (has_next) { PG8_AOFF(nvA, nxt); } else {
#pragma unroll
            for (int h = 0; h < 2; ++h)
#pragma unroll
                for (int i = 0; i < 2; ++i) nvA[h][i] = vA[h][i]; } }
#pragma unroll 1
        for (int t = 0; t < nt; t += 2) {
            const bool last = (t == nt - 2);
            const char* a1 = cA + (size_t)(t + 1) * kstep;
            const char* a2 = last ? nA : cA + (size_t)(t + 2) * kstep; const char* b2 = last ? nB : cB + (size_t)(t + 2) * kstep;
            const char* a3 = a2 + kstep; const char* b3 = b2 + kstep;
            unsigned o2[2][2];
#pragma unroll
            for (int h = 0; h < 2; ++h)
#pragma unroll
                for (int i = 0; i < 2; ++i) o2[h][i] = (GATHER && last) ? nvA[h][i] : vA[h][i];
            PG8_LDB(B0, 0, 0); PG8_LDB(B1, 0, 1); PG8_SCHED; PG8_LDA(At, 0, 0); PG8_STAGE(PG8_SA(1, 1), a1, vA[1]);
            PG8_WAIT_V(8); PG8_WAIT_L(0); PG8_BAR; PG8_MMA(0, 0, At, B0); PG8_MMA(0, 1, At, B1); PG8_BAR; PG8_SCHED;
            PG8_LDA(At, 0, 1); PG8_STAGE(PG8_SB(0, 0), b2, voffB); PG8_STAGE(PG8_SB(0, 1), b2 + hstep, voffB); PG8_STAGE(PG8_SA(0, 0), a2, o2[0]);
            PG8_WAIT_V(8); PG8_WAIT_L(0); PG8_BAR; PG8_MMA(1, 0, At, B0); PG8_MMA(1, 1, At, B1); PG8_BAR; PG8_SCHED;
            PG8_LDB(B0, 1, 0); PG8_LDB(B1, 1, 1); PG8_SCHED; PG8_LDA(At, 1, 0); PG8_STAGE(PG8_SA(0, 1), a2, o2[1]);
            PG8_WAIT_V(8); PG8_WAIT_L(0); PG8_BAR; PG8_MMA(0, 0, At, B0); PG8_MMA(0, 1, At, B1); PG8_BAR; PG8_SCHED;
            PG8_LDA(At, 1, 1); PG8_STAGE(PG8_SB(1, 0), b3, voffB); PG8_STAGE(PG8_SB(1, 1), b3 + hstep, voffB); PG8_STAGE(PG8_SA(1, 0), a3, o2[0]);
            PG8_WAIT_V(8); PG8_WAIT_L(0); PG8_BAR; PG8_MMA(1, 0, At, B0); PG8_MMA(1, 1, At, B1); PG8_BAR; PG8_SCHED;
        }
        if (wr == 0) PG8_BAR;
        asm volatile("s_nop 15\n\ts_nop 15" ::: "memory");
        E(acc, cur, wr, wc, fr, fq);
        if (!has_next) break;
#pragma unroll
        for (int a = 0; a < 2; ++a)
#pragma unroll
            for (int b = 0; b < 2; ++b)
#pragma unroll
                for (int m = 0; m < 4; ++m)
#pragma unroll
                    for (int n = 0; n < 2; ++n) acc[a][b][m][n] = (f32x4){0.f, 0.f, 0.f, 0.f};
        cur = nxt; cA = nA; cB = nB; ++ui;
        if (GATHER) {
#pragma unroll
            for (int h = 0; h < 2; ++h)
#pragma unroll
                for (int i = 0; i < 2; ++i) vA[h][i] = nvA[h][i]; }
        if (wr == 1) PG8_BAR;
    }
    PG8_WAIT_V(0);
    PG8_BAR;
#undef PG8_SA
#undef PG8_SB
#undef PG8_STAGE
#undef PG8_LDA
#undef PG8_LDB
#undef PG8_MMA
#undef PG8_C8
#undef PG8_WAIT_V
#undef PG8_WAIT_L
#undef PG8_BAR
#undef PG8_SCHED
#undef PG8_AOFF
}
__device__ __forceinline__ unsigned cvt_pk_bf16(float lo, float hi) { unsigned r; asm volatile("v_cvt_pk_bf16_f32 %0, %1, %2" : "=v"(r) : "v"(lo), "v"(hi)); return r; }
struct ABDense { const bf16* A; const bf16* Bt; int K;
    __device__ __forceinline__ const char* a_base(const Unit& u) const { return (const char*)(A + (size_t)u.pm * BM * K); }
    __device__ __forceinline__ const char* b_base(const Unit& u) const { return (const char*)(Bt + (size_t)u.pn * BM * K); }
    __device__ __forceinline__ int a_row(const Unit&, int) const { return 0; } };
struct EpiStoreT { bf16* O; int ldo;
    __device__ __forceinline__ void operator()(const f32x4 (&acc)[2][2][4][2], const Unit& u, int wr, int wc, int fr, int fq) const {
        const int row0 = u.pm * BM + wr * 64 + fr, col0 = u.pn * BM + wc * 32 + 8 * fq;
#pragma unroll
        for (int ai = 0; ai < 2; ++ai)
#pragma unroll
            for (int m = 0; m < 4; ++m) { bf16* rowp = O + (size_t)(row0 + ai * HALF + m * 16) * ldo + col0;
#pragma unroll
                for (int bj = 0; bj < 2; ++bj) { const f32x4 v0 = acc[ai][bj][m][0], v1 = acc[ai][bj][m][1];
                    u32x4 w; w.x = cvt_pk_bf16(v0[0], v0[1]); w.y = cvt_pk_bf16(v0[2], v0[3]); w.z = cvt_pk_bf16(v1[0], v1[1]); w.w = cvt_pk_bf16(v1[2], v1[3]);
                    *(u32x4*)(rowp + bj * HALF) = w; } }
    } };
struct ABMoe1 { const unsigned char* H; const unsigned char* W; const int* tile_e; const int* moe_off; const unsigned* moe_cnt; const int* list_a;
    __device__ __forceinline__ const char* a_base(const Unit&) const { return (const char*)H; }
    __device__ __forceinline__ const char* b_base(const Unit& u) const { return (const char*)(W + (size_t)tile_e[u.pm] * 2048 * 1024 + (size_t)u.pn * BM * 1024); }
    __device__ __forceinline__ int a_row(const Unit& u, int rt) const { const int e = tile_e[u.pm]; const int pos = u.pm * BM + rt - moe_off[e];
        const int pc = pos < (int)moe_cnt[e] ? pos : 0; const int a = list_a[(size_t)e * T + pc]; return pos < (int)moe_cnt[e] ? (a >> 2) : 0; } };
struct ABMoe2 { const unsigned char* A; const unsigned char* W; const int* tile_e;
    __device__ __forceinline__ const char* a_base(const Unit& u) const { return (const char*)(A + (size_t)u.pm * BM * 1024); }
    __device__ __forceinline__ const char* b_base(const Unit& u) const { return (const char*)(W + (size_t)tile_e[u.pm] * 1024 * 1024 + (size_t)u.pn * BM * 1024); }
    __device__ __forceinline__ int a_row(const Unit&, int) const { return 0; } };
struct EpiSwigluT { unsigned char* Aout; const float* b1; const int* tile_e;
    __device__ __forceinline__ void operator()(const f32x4 (&acc)[2][2][4][2], const Unit& u, int wr, int wc, int fr, int fq) const {
        const int row0 = u.pm * BM + wr * 64 + fr, j0 = u.pn * HALF + wc * 32 + 8 * fq;
        const float* bp = b1 + (size_t)tile_e[u.pm] * 2048 + 2 * j0;
        f32x4 bb[4];
#pragma unroll
        for (int q = 0; q < 4; ++q) bb[q] = *(const f32x4*)(bp + 4 * q);
#pragma unroll
        for (int ai = 0; ai < 2; ++ai)
#pragma unroll
            for (int m = 0; m < 4; ++m) {
                const f32x4 g0 = acc[ai][0][m][0], g1 = acc[ai][0][m][1], l0 = acc[ai][1][m][0], l1 = acc[ai][1][m][1];
                u32x2 w;
                w.x = pk4_fp8(swiglu(g0[0] + bb[0][0], l0[0] + bb[0][1]) * A8_SCALE, swiglu(g0[1] + bb[0][2], l0[1] + bb[0][3]) * A8_SCALE,
                              swiglu(g0[2] + bb[1][0], l0[2] + bb[1][1]) * A8_SCALE, swiglu(g0[3] + bb[1][2], l0[3] + bb[1][3]) * A8_SCALE);
                w.y = pk4_fp8(swiglu(g1[0] + bb[2][0], l1[0] + bb[2][1]) * A8_SCALE, swiglu(g1[1] + bb[2][2], l1[1] + bb[2][3]) * A8_SCALE,
                              swiglu(g1[2] + bb[3][0], l1[2] + bb[3][1]) * A8_SCALE, swiglu(g1[3] + bb[3][2], l1[3] + bb[3][3]) * A8_SCALE);
                *(u32x2*)(Aout + (size_t)(row0 + ai * HALF + m * 16) * FF + j0) = w; }
    } };
struct EpiMoe2T { unsigned char* ys; const float* b2; const int* tile_e; const int* moe_off; const unsigned* moe_cnt; const int* list_a; const float* list_g;
    __device__ __forceinline__ void operator()(const f32x4 (&acc)[2][2][4][2], const Unit& u, int wr, int wc, int fr, int fq) const {
        const int e = tile_e[u.pm], cnt = (int)moe_cnt[e], pos0 = u.pm * BM - moe_off[e] + wr * 64 + fr, col0 = u.pn * BM + wc * 32 + 8 * fq;
        const float* bp = b2 + (size_t)e * D + col0;
        f32x4 bv[2][2];
#pragma unroll
        for (int bj = 0; bj < 2; ++bj)
#pragma unroll
            for (int n = 0; n < 2; ++n) bv[bj][n] = *(const f32x4*)(bp + bj * HALF + 4 * n);
        int asgv[2][4]; float gv[2][4];
#pragma unroll
        for (int ai = 0; ai < 2; ++ai)
#pragma unroll
            for (int m = 0; m < 4; ++m) { const int pos = pos0 + ai * HALF + m * 16; const int pc = pos < cnt ? pos : 0;
                const int a = list_a[(size_t)e * T + pc]; gv[ai][m] = list_g[(size_t)e * T + pc]; asgv[ai][m] = pos < cnt ? a : -1; }
#pragma unroll
        for (int ai = 0; ai < 2; ++ai)
#pragma unroll
            for (int m = 0; m < 4; ++m) { const int asg = asgv[ai][m]; const float g = gv[ai][m];
                if (asg >= 0) { unsigned char* rowp = ys + (size_t)asg * D + col0; const float gs = g * Y8_SCALE;
#pragma unroll
                    for (int bj = 0; bj < 2; ++bj) { const f32x4 v0 = (acc[ai][bj][m][0] + bv[bj][0]) * gs, v1 = (acc[ai][bj][m][1] + bv[bj][1]) * gs;
                        u32x2 w; w.x = pk4_fp8(v0[0], v0[1], v0[2], v0[3]); w.y = pk4_fp8(v1[0], v1[1], v1[2], v1[3]);
                        *(u32x2*)(rowp + bj * HALF) = w; } } }
    } };
}

__device__ __forceinline__ void attn_unit(const Frame& F, int u) {
    const int qblk = u & 127, kvh = (u >> 7) & 1, b = u >> 8;
    LAS unsigned char* Ks = F.lds; LAS unsigned char* Vs = F.lds + 256 * 144;
    const bf16* proj = WSP(bf16, WS_PROJ); bf16* mix = WSP(bf16, WS_MIX);
    const int tok0 = b * S + qblk * 128;
#pragma unroll
    for (int i = 0; i < 4; ++i) {
        const int cid = F.tid + 512 * i, row = cid >> 3, ch = cid & 7;
        u32x4 kv = (u32x4){0u, 0u, 0u, 0u}, vv = (u32x4){0u, 0u, 0u, 0u};
        if (qblk > 0 || row >= 128) {
            const bf16* rp = proj + (size_t)(tok0 - 128 + row) * INP;
            kv = *(const u32x4*)(rp + AK_OFF + kvh * 64 + ch * 8);
            vv = *(const u32x4*)(rp + AV_OFF + kvh * 64 + ch * 8);
        }
        *(LAS u32x4*)(Ks + row * 144 + ch * 16) = kv;
        *(LAS u32x4*)(Vs + row * 144 + ch * 16) = vv;
    }
    __syncthreads();
    const int g = F.wave >> 1, hw = F.wave & 1, hq = kvh * 4 + g;
    const int lane = F.lane, fr = lane & 15, fq = lane >> 4;
    const float sink = F.sinks[hq];
    const float NEG_INF = -__builtin_inff();
    const bf16* qbase = proj + (size_t)(tok0 + 64 * hw + fr) * INP + AQ_OFF + hq * 64 + 8 * fq;
    bf16x8 nq0 = *(const bf16x8*)qbase, nq1 = *(const bf16x8*)(qbase + 32);
    for (int qb = 0; qb < 4; ++qb) {
        const int i = 64 * hw + 16 * qb + fr;
        const bf16x8 q0 = nq0, q1 = nq1;
        { const bf16* qn = qbase + (size_t)(16 * (qb < 3 ? qb + 1 : qb)) * INP; nq0 = *(const bf16x8*)qn; nq1 = *(const bf16x8*)(qn + 32); }
        f32x4 st[12];
#pragma unroll
        for (int kt = 0; kt < 12; ++kt) {
            LAS const unsigned char* kp = Ks + (64 * hw + 16 * kt + fr) * 144 + fq * 16;
            const bf16x8 k0 = *(LAS const bf16x8*)kp, k1 = *(LAS const bf16x8*)(kp + 64);
            f32x4 z = (f32x4){0.f, 0.f, 0.f, 0.f}; z = MFMA(k0, q0, z); z = MFMA(k1, q1, z); st[kt] = z;
        }
        float mx = NEG_INF;
#pragma unroll
        for (int kt = 0; kt < 12; ++kt)
#pragma unroll
            for (int r = 0; r < 4; ++r) {
                const int j = 64 * hw + 16 * kt + 4 * fq + r, rel = i + 128 - j;
                const bool ok = (rel >= 0) && (rel < 128) && (qblk > 0 || j >= 128);
                const float s = ok ? st[kt][r] * 0.125f : NEG_INF;
                st[kt][r] = s; mx = fmaxf(mx, s);
            }
        mx = fmaxf(mx, __shfl_xor(mx, 16)); mx = fmaxf(mx, __shfl_xor(mx, 32)); mx = fmaxf(mx, sink);
        float sum = 0.f;
#pragma unroll
        for (int kt = 0; kt < 12; ++kt)
#pragma unroll
            for (int r = 0; r < 4; ++r) { const float p = __expf(st[kt][r] - mx); st[kt][r] = p; sum += p; }
        sum += __shfl_xor(sum, 16); sum += __shfl_xor(sum, 32); sum += __expf(sink - mx);
        const float inv = 1.f / sum;
        f32x4 o[4];
#pragma unroll
        for (int c = 0; c < 4; ++c) o[c] = (f32x4){0.f, 0.f, 0.f, 0.f};
#pragma unroll
        for (int ks = 0; ks < 6; ++ks) {
            const bf16x8 pf = pack8(st[2 * ks], st[2 * ks + 1]);
            const int rb = 64 * hw + 32 * ks + 4 * fq + (fr >> 2);
#pragma unroll
            for (int c = 0; c < 4; ++c) {
                LAS const unsigned char* vp = Vs + rb * 144 + (16 * c + 4 * (lane & 3)) * 2;
                const bf16x8 vf = cat8(trr(vp), trr(vp + 16 * 144));
                o[c] = MFMA(pf, vf, o[c]);
            }
        }
#pragma unroll
        for (int r = 0; r < 4; ++r) {
            const int qrow = 4 * fq + r; const float iv = __shfl(inv, qrow);
            bf16* op = mix + (size_t)(tok0 + 64 * hw + 16 * qb + qrow) * D + hq * 64 + fr;
#pragma unroll
            for (int c = 0; c < 4; ++c) op[16 * c] = (bf16)f2bf(o[c][r] * iv);
        }
    }
    __syncthreads();
}

__device__ __forceinline__ void gla_gate_prefix(const Frame& F, const bf16* proj, int t0, int h, LAS float* ga_s, LAS float* tot_s, float (&bv)[8], float& b_mid, float& b_last) {
#pragma unroll
    for (int i = 0; i < 2; ++i) { const int idx = F.tid + 512 * i, t = idx >> 4, r = idx & 15; ga_s[idx] = bf2f(proj[(size_t)(t0 + t) * INP + GA_OFF + r]); }
    float wu[16];
#pragma unroll
    for (int r = 0; r < 16; ++r) wu[r] = F.w_gate_up[r * 256 + h * 64 + F.lane];
    const float bg = F.b_gate[h * 64 + F.lane];
    __syncthreads();
    float run = 0.f;
#pragma unroll
    for (int i = 0; i < 8; ++i) {
        const int t = 8 * F.wave + i; float z = bg;
#pragma unroll
        for (int r = 0; r < 16; ++r) z += ga_s[t * 16 + r] * wu[r];
        const float ls = fminf(z, 0.f) - __logf(1.f + __expf(-fabsf(z)));
        run += ls * (1.f / 16.f); bv[i] = run;
    }
    tot_s[F.wave * 64 + F.lane] = run;
    __syncthreads();
    float pre = 0.f, mid = 0.f, all = 0.f;
#pragma unroll
    for (int w = 0; w < 8; ++w) { const float tv = tot_s[w * 64 + F.lane]; pre += (w < F.wave) ? tv : 0.f; mid += (w < 4) ? tv : 0.f; all += tv; }
#pragma unroll
    for (int i = 0; i < 8; ++i) bv[i] += pre;
    b_mid = mid; b_last = all;
}
__device__ __forceinline__ void gla_kv_unit(const Frame& F, int u) {
    const int h = u & 3, n = (u >> 2) & 255, b = u >> 10, t0 = b * S + n * 64;
    const bf16* proj = WSP(bf16, WS_PROJ);
    LAS unsigned char* kd_s = F.lds; LAS unsigned char* v_s = F.lds + 9216;
    LAS float* ga_s = (LAS float*)(F.lds + 26624); LAS float* tot_s = (LAS float*)(F.lds + 30720);
    const int lane = F.lane, fr = lane & 15, fq = lane >> 4;
#pragma unroll
    for (int i = 0; i < 2; ++i) { const int cid = F.tid + 512 * i, row = cid >> 4, ch = cid & 15;
        *(LAS u32x4*)(v_s + row * 272 + ch * 16) = *(const u32x4*)(proj + (size_t)(t0 + row) * INP + GV_OFF + h * 128 + ch * 8); }
    float bv[8], b_mid, b_last;
    gla_gate_prefix(F, proj, t0, h, ga_s, tot_s, bv, b_mid, b_last);
#pragma unroll
    for (int i = 0; i < 8; ++i) { const int t = 8 * F.wave + i;
        const float kx = bf2f(proj[(size_t)(t0 + t) * INP + GK_OFF + h * 64 + lane]);
        *(LAS bf16*)(kd_s + t * 144 + lane * 2) = (bf16)f2bf(kx * __expf(b_last - bv[i])); }
    if (F.wave == 0) WSP(float, WS_DECAY)[((size_t)(b * NCH + n) * 4 + h) * 64 + lane] = __expf(b_last);
    __syncthreads();
    const int c = F.wave;
    f32x4 acc[4];
#pragma unroll
    for (int d = 0; d < 4; ++d) acc[d] = (f32x4){0.f, 0.f, 0.f, 0.f};
#pragma unroll
    for (int ks = 0; ks < 2; ++ks) {
        const int rb = 32 * ks + 8 * fq + (fr >> 2);
        LAS const unsigned char* vp = v_s + rb * 272 + (16 * c + 4 * (lane & 3)) * 2;
        const bf16x8 vf = cat8(trr(vp), trr(vp + 4 * 272));
#pragma unroll
        for (int d = 0; d < 4; ++d) {
            LAS const unsigned char* kp = kd_s + rb * 144 + (16 * d + 4 * (lane & 3)) * 2;
            const bf16x8 kf = cat8(trr(kp), trr(kp + 4 * 144));
            acc[d] = MFMA(kf, vf, acc[d]);
        }
    }
    float* kvp = WSP(float, WS_KV) + (((size_t)(b * NCH + n) * 4 + h) * 128 + 16 * c + fr) * 64;
#pragma unroll
    for (int d = 0; d < 4; ++d) *(f32x4*)(kvp + 16 * d + 4 * fq) = acc[d];
    __syncthreads();
}
__device__ __forceinline__ void gla_scan(const Frame& F) {
    float* kv = WSP(float, WS_KV); const float* decay = WSP(float, WS_DECAY);
    if (F.tid >= 256) return;
    for (int idx = F.bx * 256 + F.tid; idx < 65536; idx += F.G * 256) {
        const int b = idx >> 15, h = (idx >> 13) & 3, dvdk = idx & 8191, dk = idx & 63;
        float* p = kv + ((size_t)(b * NCH) * 4 + h) * 8192 + dvdk;
        const float* dp = decay + ((size_t)(b * NCH) * 4 + h) * 64 + dk;
        float state = 0.f;
        for (int n = 0; n < NCH; n += 8) {
            float tv[8], dv[8];
#pragma unroll
            for (int i = 0; i < 8; ++i) { tv[i] = p[(size_t)(n + i) * 4 * 8192]; dv[i] = dp[(size_t)(n + i) * 4 * 64]; }
#pragma unroll
            for (int i = 0; i < 8; ++i) { p[(size_t)(n + i) * 4 * 8192] = state; state = dv[i] * state + tv[i]; }
        }
    }
}
__device__ __forceinline__ void gla_out_unit(const Frame& F, int u) {
    const int h = u & 3, n = (u >> 2) & 255, b = u >> 10, t0 = b * S + n * 64;
    const bf16* proj = WSP(bf16, WS_PROJ); bf16* mix = WSP(bf16, WS_MIX);
    LAS unsigned char* qd_s = F.lds; LAS unsigned char* kk_s = F.lds + 9216; LAS unsigned char* qe_s = F.lds + 18432;
    LAS unsigned char* v_s = F.lds + 27648; LAS unsigned char* st_s = F.lds + 45056;
    LAS float* ga_s = (LAS float*)(F.lds + 63488); LAS float* tot_s = (LAS float*)(F.lds + 67584); LAS float* ssq_s = (LAS float*)(F.lds + 69632);
    const int lane = F.lane, fr = lane & 15, fq = lane >> 4;
#pragma unroll
    for (int i = 0; i < 2; ++i) { const int cid = F.tid + 512 * i, row = cid >> 4, ch = cid & 15;
        *(LAS u32x4*)(v_s + row * 272 + ch * 16) = *(const u32x4*)(proj + (size_t)(t0 + row) * INP + GV_OFF + h * 128 + ch * 8); }
    const float* stg = WSP(float, WS_KV) + ((size_t)(b * NCH + n) * 4 + h) * 8192;
#pragma unroll
    for (int i = 0; i < 4; ++i) { const int i4 = F.tid + 512 * i, dv = i4 >> 4, dk4 = (i4 & 15) * 4;
        const f32x4 sv = *(const f32x4*)(stg + dv * 64 + dk4);
        u32x2 w; w.x = pk2(sv[0], sv[1]); w.y = pk2(sv[2], sv[3]);
        *(LAS u32x2*)(st_s + dv * 144 + dk4 * 2) = w; }
    float bv[8], b_mid, b_last;
    gla_gate_prefix(F, proj, t0, h, ga_s, tot_s, bv, b_mid, b_last);
#pragma unroll
    for (int i = 0; i < 8; ++i) { const int t = 8 * F.wave + i; const bf16* rp = proj + (size_t)(t0 + t) * INP + h * 64 + lane;
        const float qx = bf2f(rp[GQ_OFF]) * 0.125f, kx = bf2f(rp[GK_OFF]);
        *(LAS bf16*)(qd_s + t * 144 + lane * 2) = (bf16)f2bf(qx * __expf(bv[i] - b_mid));
        *(LAS bf16*)(kk_s + t * 144 + lane * 2) = (bf16)f2bf(kx * __expf(b_mid - bv[i]));
        *(LAS bf16*)(qe_s + t * 144 + lane * 2) = (bf16)f2bf(qx * __expf(bv[i])); }
    __syncthreads();
    const int ib = F.wave >> 1, dvh = F.wave & 1;
    bf16x8 qdf[2], qef[2];
#pragma unroll
    for (int ks = 0; ks < 2; ++ks) { qdf[ks] = *(LAS const bf16x8*)(qd_s + (16 * ib + fr) * 144 + (32 * ks + 8 * fq) * 2);
                                     qef[ks] = *(LAS const bf16x8*)(qe_s + (16 * ib + fr) * 144 + (32 * ks + 8 * fq) * 2); }
    f32x4 at[4];
#pragma unroll
    for (int jt = 0; jt < 4; ++jt) {
        LAS const unsigned char* kp = kk_s + (16 * jt + fr) * 144 + (8 * fq) * 2;
        const bf16x8 k0 = *(LAS const bf16x8*)kp, k1 = *(LAS const bf16x8*)(kp + 64);
        f32x4 z = (f32x4){0.f, 0.f, 0.f, 0.f}; z = MFMA(k0, qdf[0], z); z = MFMA(k1, qdf[1], z);
#pragma unroll
        for (int r = 0; r < 4; ++r) if (16 * jt + 4 * fq + r > 16 * ib + fr) z[r] = 0.f;
        at[jt] = z;
    }
    bf16x8 pf[2];
    pf[0] = pack8(at[0], at[1]); pf[1] = pack8(at[2], at[3]);
    f32x4 o[4];
#pragma unroll
    for (int c = 0; c < 4; ++c) {
        const int dvt = 4 * dvh + c; f32x4 z = (f32x4){0.f, 0.f, 0.f, 0.f};
#pragma unroll
        for (int ks = 0; ks < 2; ++ks) {
            const int rb = 32 * ks + 4 * fq + (fr >> 2);
            LAS const unsigned char* vp = v_s + rb * 272 + (16 * dvt + 4 * (lane & 3)) * 2;
            z = MFMA(pf[ks], cat8(trr(vp), trr(vp + 16 * 272)), z);
        }
#pragma unroll
        for (int ks = 0; ks < 2; ++ks) {
            const bf16x8 sf = *(LAS const bf16x8*)(st_s + (16 * dvt + fr) * 144 + (32 * ks + 8 * fq) * 2);
            z = MFMA(qef[ks], sf, z);
        }
        o[c] = z;
    }
    float ssq[4];
#pragma unroll
    for (int r = 0; r < 4; ++r) { float s = 0.f;
#pragma unroll
        for (int c = 0; c < 4; ++c) s += o[c][r] * o[c][r];
        s += __shfl_xor(s, 1); s += __shfl_xor(s, 2); s += __shfl_xor(s, 4); s += __shfl_xor(s, 8);
        ssq[r] = s; if (fr == 0) ssq_s[F.wave * 16 + 4 * fq + r] = s; }
    __syncthreads();
#pragma unroll
    for (int r = 0; r < 4; ++r) {
        const float tot = ssq[r] + ssq_s[(F.wave ^ 1) * 16 + 4 * fq + r];
        const float rinv = rsqrtf(tot * (1.f / 128.f) + EPS);
        const int t = t0 + 16 * ib + 4 * fq + r;
#pragma unroll
        for (int c = 0; c < 4; ++c) { const int dv = 16 * (4 * dvh + c) + fr;
            const float gg = bf2f(proj[(size_t)t * INP + GG_OFF + h * 128 + dv]);
            const float val = o[c][r] * rinv * F.g_gla_norm[dv] * (gg / (1.f + __expf(-gg)));
            mix[(size_t)t * D + 512 + h * 128 + dv] = (bf16)f2bf(val); }
    }
    __syncthreads();
}

template <bool OUT>
__device__ __forceinline__ void gla_super_unit(const Frame& F, int u) {
    const int sc = u & 31, h = (u >> 5) & 3, b = u >> 7;
    const bf16* proj = WSP(bf16, WS_PROJ); bf16* mix = WSP(bf16, WS_MIX);
    LAS unsigned char* qd_s = F.lds; LAS unsigned char* kk_s = F.lds + 9216; LAS unsigned char* qe_s = F.lds + 18432;
    LAS unsigned char* v_s = F.lds + 27648; LAS unsigned char* st_s = F.lds + 45056; LAS unsigned char* kd_s = F.lds + 63488;
    LAS float* ga_s = (LAS float*)(F.lds + 72704); LAS float* tot_s = (LAS float*)(F.lds + 76800); LAS float* ssq_s = (LAS float*)(F.lds + 78848); LAS float* dec_s = (LAS float*)(F.lds + 79360);
    const int lane = F.lane, fr = lane & 15, fq = lane >> 4;
    const int ib = F.wave >> 1, dvh = F.wave & 1;
    float wu[16];
#pragma unroll
    for (int r = 0; r < 16; ++r) wu[r] = F.w_gate_up[r * 256 + h * 64 + lane];
    const float bg = F.b_gate[h * 64 + lane];
    float gn[4];
#pragma unroll
    for (int cc = 0; cc < 4; ++cc) gn[cc] = OUT ? F.g_gla_norm[16 * (4 * dvh + cc) + fr] : 0.f;
    float* Sg = WSP(float, WS_KV) + (size_t)u * 8192 + (16 * F.wave + fr) * 64 + 4 * fq;
    f32x4 St[4];
#pragma unroll
    for (int d = 0; d < 4; ++d) St[d] = OUT ? *(const f32x4*)(Sg + 16 * d) : (f32x4){0.f, 0.f, 0.f, 0.f};
    float ltot = 0.f;
    u32x4 v_r[2]; unsigned ga_r[2], k_r[8], q_r[8], gg_r[16];
#define GLA_LOAD_CHUNK(tc0) do { \
        _Pragma("unroll") for (int i = 0; i < 2; ++i) { const int cid = F.tid + 512 * i, row = cid >> 4, ch = cid & 15; v_r[i] = *(const u32x4*)(proj + (size_t)((tc0) + row) * INP + GV_OFF + h * 128 + ch * 8); } \
        _Pragma("unroll") for (int i = 0; i < 2; ++i) { const int idx = F.tid + 512 * i, t = idx >> 4, r = idx & 15; ga_r[i] = proj[(size_t)((tc0) + t) * INP + GA_OFF + r]; } \
        _Pragma("unroll") for (int i = 0; i < 8; ++i) { const bf16* rp = proj + (size_t)((tc0) + 8 * F.wave + i) * INP + h * 64 + lane; k_r[i] = rp[GK_OFF]; if (OUT) q_r[i] = rp[GQ_OFF]; } \
        if (OUT) { _Pragma("unroll") for (int r = 0; r < 4; ++r) _Pragma("unroll") for (int cc = 0; cc < 4; ++cc) \
            gg_r[r * 4 + cc] = proj[(size_t)((tc0) + 16 * ib + 4 * fq + r) * INP + GG_OFF + h * 128 + 16 * (4 * dvh + cc) + fr]; } } while (0)
    const int tu0 = b * S + sc * 512;
    GLA_LOAD_CHUNK(tu0);
    for (int c = 0; c < 8; ++c) {
        const int t0 = tu0 + c * 64;
#pragma unroll
        for (int i = 0; i < 2; ++i) { const int cid = F.tid + 512 * i, row = cid >> 4, ch = cid & 15; *(LAS u32x4*)(v_s + row * 272 + ch * 16) = v_r[i]; }
#pragma unroll
        for (int i = 0; i < 2; ++i) ga_s[F.tid + 512 * i] = bf2f(ga_r[i]);
        float kx[8], qx[8], ggf[16];
#pragma unroll
        for (int i = 0; i < 8; ++i) { kx[i] = bf2f(k_r[i]); qx[i] = OUT ? bf2f(q_r[i]) * 0.125f : 0.f; }
#pragma unroll
        for (int i = 0; i < 16; ++i) ggf[i] = OUT ? bf2f(gg_r[i]) : 0.f;
        if (c < 7) GLA_LOAD_CHUNK(t0 + 64);
        __syncthreads();
        float bv[8]; float run = 0.f;
#pragma unroll
        for (int i = 0; i < 8; ++i) {
            const int t = 8 * F.wave + i; float z = bg;
#pragma unroll
            for (int r = 0; r < 16; ++r) z += ga_s[t * 16 + r] * wu[r];
            const float ls = fminf(z, 0.f) - __logf(1.f + __expf(-fabsf(z)));
            run += ls * (1.f / 16.f); bv[i] = run;
        }
        tot_s[F.wave * 64 + lane] = run;
        if (OUT) {
#pragma unroll
            for (int d = 0; d < 4; ++d) { u32x2 w; w.x = pk2(St[d][0], St[d][1]); w.y = pk2(St[d][2], St[d][3]);
                *(LAS u32x2*)(st_s + (16 * F.wave + fr) * 144 + (16 * d + 4 * fq) * 2) = w; }
        }
        __syncthreads();
        float pre = 0.f, b_mid = 0.f, b_last = 0.f;
#pragma unroll
        for (int w = 0; w < 8; ++w) { const float tv = tot_s[w * 64 + lane]; pre += (w < F.wave) ? tv : 0.f; b_mid += (w < 4) ? tv : 0.f; b_last += tv; }
        ltot += b_last;
#pragma unroll
        for (int i = 0; i < 8; ++i) { const int t = 8 * F.wave + i; const float bb = bv[i] + pre;
            *(LAS bf16*)(kd_s + t * 144 + lane * 2) = (bf16)f2bf(kx[i] * __expf(b_last - bb));
            if (OUT) {
                *(LAS bf16*)(qd_s + t * 144 + lane * 2) = (bf16)f2bf(qx[i] * __expf(bb - b_mid));
                *(LAS bf16*)(kk_s + t * 144 + lane * 2) = (bf16)f2bf(kx[i] * __expf(b_mid - bb));
                *(LAS bf16*)(qe_s + t * 144 + lane * 2) = (bf16)f2bf(qx[i] * __expf(bb)); } }
        if (F.wave == 0) dec_s[lane] = __expf(b_last);
        __syncthreads();
        if (OUT) {
            bf16x8 qdf[2], qef[2];
#pragma unroll
            for (int ks = 0; ks < 2; ++ks) { qdf[ks] = *(LAS const bf16x8*)(qd_s + (16 * ib + fr) * 144 + (32 * ks + 8 * fq) * 2);
                                             qef[ks] = *(LAS const bf16x8*)(qe_s + (16 * ib + fr) * 144 + (32 * ks + 8 * fq) * 2); }
            f32x4 at[4];
#pragma unroll
            for (int jt = 0; jt < 4; ++jt) {
                LAS const unsigned char* kp = kk_s + (16 * jt + fr) * 144 + (8 * fq) * 2;
                const bf16x8 k0 = *(LAS const bf16x8*)kp, k1 = *(LAS const bf16x8*)(kp + 64);
                f32x4 z = (f32x4){0.f, 0.f, 0.f, 0.f}; z = MFMA(k0, qdf[0], z); z = MFMA(k1, qdf[1], z);
#pragma unroll
                for (int r = 0; r < 4; ++r) if (16 * jt + 4 * fq + r > 16 * ib + fr) z[r] = 0.f;
                at[jt] = z;
            }
            bf16x8 pf[2];
            pf[0] = pack8(at[0], at[1]); pf[1] = pack8(at[2], at[3]);
            f32x4 o[4];
#pragma unroll
            for (int cc = 0; cc < 4; ++cc) {
                const int dvt = 4 * dvh + cc; f32x4 z = (f32x4){0.f, 0.f, 0.f, 0.f};
#pragma unroll
                for (int ks = 0; ks < 2; ++ks) {
                    const int rb = 32 * ks + 4 * fq + (fr >> 2);
                    LAS const unsigned char* vp = v_s + rb * 272 + (16 * dvt + 4 * (lane & 3)) * 2;
                    z = MFMA(pf[ks], cat8(trr(vp), trr(vp + 16 * 272)), z);
                }
#pragma unroll
                for (int ks = 0; ks < 2; ++ks) {
                    const bf16x8 sf = *(LAS const bf16x8*)(st_s + (16 * dvt + fr) * 144 + (32 * ks + 8 * fq) * 2);
                    z = MFMA(qef[ks], sf, z);
                }
                o[cc] = z;
            }
            float ssq[4];
#pragma unroll
            for (int r = 0; r < 4; ++r) { float sq = 0.f;
#pragma unroll
                for (int cc = 0; cc < 4; ++cc) sq += o[cc][r] * o[cc][r];
                sq += __shfl_xor(sq, 1); sq += __shfl_xor(sq, 2); sq += __shfl_xor(sq, 4); sq += __shfl_xor(sq, 8);
                ssq[r] = sq; if (fr == 0) ssq_s[F.wave * 16 + 4 * fq + r] = sq; }
            __syncthreads();
#pragma unroll
            for (int r = 0; r < 4; ++r) {
                const float tot = ssq[r] + ssq_s[(F.wave ^ 1) * 16 + 4 * fq + r];
                const float rinv = rsqrtf(tot * (1.f / 128.f) + EPS);
                const int t = t0 + 16 * ib + 4 * fq + r;
#pragma unroll
                for (int cc = 0; cc < 4; ++cc) { const int dv = 16 * (4 * dvh + cc) + fr;
                    const float gg = ggf[r * 4 + cc];
                    const float val = o[cc][r] * rinv * gn[cc] * (gg / (1.f + __expf(-gg)));
                    mix[(size_t)t * D + 512 + h * 128 + dv] = (bf16)f2bf(val); }
            }
        }
#pragma unroll
        for (int d = 0; d < 4; ++d) { const f32x4 dc = *(LAS const f32x4*)(dec_s + 16 * d + 4 * fq); St[d] = St[d] * dc; }
#pragma unroll
        for (int ks = 0; ks < 2; ++ks) {
            const int rb = 32 * ks + 8 * fq + (fr >> 2);
            LAS const unsigned char* vp = v_s + rb * 272 + (16 * F.wave + 4 * (lane & 3)) * 2;
            const bf16x8 vf = cat8(trr(vp), trr(vp + 4 * 272));
#pragma unroll
            for (int d = 0; d < 4; ++d) {
                LAS const unsigned char* kp = kd_s + rb * 144 + (16 * d + 4 * (lane & 3)) * 2;
                St[d] = MFMA(cat8(trr(kp), trr(kp + 4 * 144)), vf, St[d]);
            }
        }
        __syncthreads();
    }
#undef GLA_LOAD_CHUNK
    if (!OUT) {
#pragma unroll
        for (int d = 0; d < 4; ++d) *(f32x4*)(Sg + 16 * d) = St[d];
        if (F.wave == 0) WSP(float, WS_DECAY)[u * 64 + lane] = __expf(ltot);
    }
}
__device__ __forceinline__ void gla_super_scan(const Frame& F) {
    float* kv = WSP(float, WS_KV); const float* decay = WSP(float, WS_DECAY);
    if (F.tid >= 256) return;
    for (int idx = F.bx * 256 + F.tid; idx < 65536; idx += F.G * 256) {
        const int bh = idx >> 13, dvdk = idx & 8191, dk = idx & 63;
        float* p = kv + (size_t)(bh * 32) * 8192 + dvdk; const float* dp = decay + (bh * 32) * 64 + dk;
        float tv[32], dv[32];
#pragma unroll
        for (int i = 0; i < 32; ++i) { tv[i] = p[(size_t)i * 8192]; dv[i] = dp[i * 64]; }
        float state = 0.f;
#pragma unroll
        for (int i = 0; i < 32; ++i) { p[(size_t)i * 8192] = state; state = dv[i] * state + tv[i]; }
    }
}

__device__ __forceinline__ void p7_norm_router(const Frame& F) {
    const float* mod = WSP(float, WS_MOD); const bf16* y = WSP(bf16, WS_Y); float* x1 = WSP(float, WS_X1); unsigned char* h2 = WSP(unsigned char, WS_H);
    unsigned* ctl = WSP(unsigned, WS_CTL);
    LAS float* wr_s = (LAS float*)F.lds;
    LAS float* lg_s = (LAS float*)(F.lds + SMALL_OFF);
    LAS float* rx_s = (LAS float*)(F.lds + SMALL_OFF + 16384);
    LAS float* z_s = (LAS float*)(F.lds + SMALL_OFF + 16384 + 512);
    LAS int* cnt_s = (LAS int*)(F.lds + SMALL_OFF + 16384 + 640);
    LAS int* base_s = (LAS int*)(F.lds + SMALL_OFF + 16384 + 768);
    LAS float* zr_s = (LAS float*)(F.lds + SMALL_OFF + 16384 + 1024);
    LAS int* flag_s = (LAS int*)(F.lds + SMALL_OFF + 16384 + 1024 + 2048);
    const int lane = F.lane, fr = lane & 15, fq = lane >> 4;
    const int mb0 = F.bx * 128 + F.wave * 16;
    const float* modb = mod + (mb0 >> 14) * 6144;
#pragma unroll 4
    for (int i = 0; i < 16; ++i) { const int i4 = F.tid + 512 * i, k = i4 >> 3, e0 = (i4 & 7) * 4;
        const f32x4 w = *(const f32x4*)(F.w_router + k * 32 + e0);
        const float gs = F.g_pre_ffn[k] * (1.f + modb[4096 + k]);
        LAS float* dst = wr_s + (k >> 2) * 128 + e0 * 4 + (k & 3);
        dst[0] = w[0] * gs; dst[4] = w[1] * gs; dst[8] = w[2] * gs; dst[12] = w[3] * gs; }
    { const int e = F.tid & 31, ks = F.tid >> 5; float zz = 0.f;
#pragma unroll
        for (int i = 0; i < 64; ++i) { const int k = ks * 64 + i; zz += modb[3072 + k] * F.w_router[k * 32 + e]; }
        zr_s[ks * 32 + e] = zz; }
    if (F.tid < 32) cnt_s[F.tid] = 0;
    __syncthreads();
    if (F.tid < 32) { float zz = F.b_router[F.tid];
#pragma unroll
        for (int i = 0; i < 16; ++i) zz += zr_s[i * 32 + F.tid];
        z_s[F.tid] = zz; }
    f32x4 pg[4], pg2[4], psh[4];
    u32x2 ya[4], yb[4], yc[4], yd[4]; f32x4 xa[4], xbf[4], xc[4], xd[4];
    const bf16* ybase = y + (size_t)mb0 * D + 4 * lane; const float* xbase = F.x + (size_t)mb0 * D + 4 * lane;
#define P7_LOAD(Y, X, r) do { _Pragma("unroll") for (int j = 0; j < 4; ++j) { Y[j] = *(const u32x2*)(ybase + (size_t)(r) * D + 256 * j); X[j] = *(const f32x4*)(xbase + (size_t)(r) * D + 256 * j); } } while (0)
#define P7_ROW(Y, X, it) do { f32x4 xv[4], hv[4]; float ss = 0.f; \
        _Pragma("unroll") for (int j = 0; j < 4; ++j) { hv[j] = unpack4(Y[j]); ss += dot4(hv[j]); } \
        const float ry = rsqrtf(wave_sum(ss) * (1.f / D) + EPS); float s2 = 0.f; \
        _Pragma("unroll") for (int j = 0; j < 4; ++j) { xv[j] = X[j] + hv[j] * ry * pg[j]; s2 += dot4(xv[j]); } \
        const float rx = rsqrtf(wave_sum(s2) * (1.f / D) + EPS); \
        if (lane == 0) rx_s[F.wave * 16 + (it)] = rx; \
        _Pragma("unroll") for (int j = 0; j < 4; ++j) { const int idx = 4 * lane + 256 * j; \
            hv[j] = xv[j] * rx * pg2[j] + psh[j]; \
            *(f32x4*)(x1 + (size_t)(mb0 + (it)) * D + idx) = xv[j]; \
            *(unsigned*)(h2 + (size_t)(mb0 + (it)) * D + idx) = pk4_fp8(hv[j][0] * H8_SCALE, hv[j][1] * H8_SCALE, hv[j][2] * H8_SCALE, hv[j][3] * H8_SCALE); } \
        if ((it) + 4 < 16) P7_LOAD(Y, X, (it) + 4); } while (0)
    P7_LOAD(ya, xa, 0); P7_LOAD(yb, xbf, 1); P7_LOAD(yc, xc, 2); P7_LOAD(yd, xd, 3);
#pragma unroll
    for (int j = 0; j < 4; ++j) { const int idx = 4 * lane + 256 * j;
        pg[j] = *(const f32x4*)(F.g_post_mix + idx) * *(const f32x4*)(modb + 2048 + idx);
        pg2[j] = *(const f32x4*)(F.g_pre_ffn + idx) * (*(const f32x4*)(modb + 4096 + idx) + 1.f); psh[j] = *(const f32x4*)(modb + 3072 + idx); }
#pragma unroll 1
    for (int it = 0; it < 16; it += 4) { P7_ROW(ya, xa, it); P7_ROW(yb, xbf, it + 1); P7_ROW(yc, xc, it + 2); P7_ROW(yd, xd, it + 3); }
#undef P7_LOAD
#undef P7_ROW
    asm volatile("s_waitcnt vmcnt(0)" ::: "memory");
    f32x4 acc0 = (f32x4){0.f, 0.f, 0.f, 0.f}, acc1 = (f32x4){0.f, 0.f, 0.f, 0.f};
    { const float* ap = x1 + (size_t)(mb0 + fr) * D + 4 * fq;
        LAS const float* bp = wr_s + fq * 128 + fr * 4;
        f32x4 a[8], na[8];
#pragma unroll
        for (int q = 0; q < 8; ++q) a[q] = *(const f32x4*)(ap + 16 * q);
        for (int s0 = 0; s0 < 64; s0 += 8) {
            const int sn = s0 < 56 ? s0 + 8 : s0;
#pragma unroll
            for (int q = 0; q < 8; ++q) na[q] = *(const f32x4*)(ap + 16 * (sn + q));
#pragma unroll
            for (int q = 0; q < 8; ++q) { const f32x4 b0 = *(LAS const f32x4*)(bp + (s0 + q) * 512), b1 = *(LAS const f32x4*)(bp + (s0 + q) * 512 + 64);
#pragma unroll
                for (int t = 0; t < 4; ++t) { acc0 = __builtin_amdgcn_mfma_f32_16x16x4f32(a[q][t], b0[t], acc0, 0, 0, 0); acc1 = __builtin_amdgcn_mfma_f32_16x16x4f32(a[q][t], b1[t], acc1, 0, 0, 0); } }
#pragma unroll
            for (int q = 0; q < 8; ++q) a[q] = na[q];
        } }
    __syncthreads();
#pragma unroll
    for (int r = 0; r < 4; ++r) { const float rx = rx_s[F.wave * 16 + 4 * fq + r];
        lg_s[(F.wave * 16 + 4 * fq + r) * 32 + fr] = rx * acc0[r] + z_s[fr];
        lg_s[(F.wave * 16 + 4 * fq + r) * 32 + fr + 16] = rx * acc1[r] + z_s[fr + 16]; }
    const float NEG_INF = -__builtin_inff();
    int se[4], lp[4]; float gt[4];
    if (lane < 16) {
        float v[32];
#pragma unroll
        for (int ch = 0; ch < 8; ++ch) { const f32x4 w = *(LAS const f32x4*)(lg_s + (F.wave * 16 + lane) * 32 + 4 * ch); v[4 * ch] = w[0]; v[4 * ch + 1] = w[1]; v[4 * ch + 2] = w[2]; v[4 * ch + 3] = w[3]; }
        float sv[4];
#pragma unroll
        for (int r = 0; r < 4; ++r) { float best = v[0]; int bi = 0;
#pragma unroll
            for (int e = 1; e < 32; ++e) if (v[e] > best) { best = v[e]; bi = e; }
            se[r] = bi; sv[r] = best;
#pragma unroll
            for (int e = 0; e < 32; ++e) v[e] = (e == bi) ? NEG_INF : v[e]; }
        const float p1 = __expf(sv[1] - sv[0]), p2 = __expf(sv[2] - sv[0]), p3 = __expf(sv[3] - sv[0]);
        const float rs = 1.f / (1.f + p1 + p2 + p3);
        gt[0] = rs; gt[1] = p1 * rs; gt[2] = p2 * rs; gt[3] = p3 * rs;
#pragma unroll
        for (int r = 0; r < 4; ++r) lp[r] = __hip_atomic_fetch_add(cnt_s + se[r], 1, __ATOMIC_RELAXED, __HIP_MEMORY_SCOPE_WORKGROUP);
    }
    __syncthreads();
    if (F.tid < 32) base_s[F.tid] = (int)__hip_atomic_fetch_add(ctl + CW_GCNT + 64 * F.tid, (unsigned)cnt_s[F.tid], __ATOMIC_RELAXED, __HIP_MEMORY_SCOPE_AGENT);
    __syncthreads();
    if (lane < 16) { int* la = WSP(int, WS_LIST_A); float* lgt = WSP(float, WS_LIST_G); const int m = mb0 + lane;
#pragma unroll
        for (int r = 0; r < 4; ++r) { const size_t p = (size_t)se[r] * T + base_s[se[r]] + lp[r]; la[p] = m * 4 + r; lgt[p] = gt[r]; } }
    asm volatile("s_waitcnt vmcnt(0)" ::: "memory");
    __syncthreads();
    if (F.tid == 0) flag_s[0] = (__hip_atomic_fetch_add(ctl + CW_DONE, 1u, __ATOMIC_RELAXED, __HIP_MEMORY_SCOPE_AGENT) == (unsigned)(F.G - 1)) ? 1 : 0;
    __syncthreads();
    if (flag_s[0]) {
        LAS int* off_s = (LAS int*)zr_s;
        if (F.tid < 32) { const int c = (int)__hip_atomic_load(ctl + CW_GCNT + 64 * F.tid, __ATOMIC_RELAXED, __HIP_MEMORY_SCOPE_AGENT); cnt_s[F.tid] = c; ctl[CW_MOE_CNT + F.tid] = (unsigned)c; }
        __syncthreads();
        if (F.tid == 0) { int off = 0; for (int e = 0; e < 32; ++e) { off_s[e] = off; off += (cnt_s[e] + 255) & ~255; } off_s[32] = off; }
        __syncthreads();
        if (F.tid <= 32) WSP(int, WS_MOE_OFF)[F.tid] = off_s[F.tid];
        const int ntile = off_s[32] >> 8;
        for (int rt = F.tid; rt < ntile; rt += NTHREADS) { int e = 0;
            for (int q = 1; q < 32; ++q) e = (off_s[q] <= rt * 256) ? q : e;
            WSP(int, WS_TILE_E)[rt] = e; }
    }
}

__device__ __forceinline__ f32x4 unpack4_fp8(unsigned w) {
    const auto lo = __builtin_amdgcn_cvt_pk_f32_fp8((int)w, false), hi = __builtin_amdgcn_cvt_pk_f32_fp8((int)w, true);
    return (f32x4){lo[0], lo[1], hi[0], hi[1]};
}
__device__ __forceinline__ void p11_combine(const Frame& F) {
    const float* mod = WSP(float, WS_MOD); const unsigned char* ys = WSP(unsigned char, WS_YS); const float* x1 = WSP(float, WS_X1);
    const int gw = F.bx * NWAVES + F.wave, m0 = gw * 16, lane = F.lane;
    const float* modb = mod + (m0 >> 14) * 6144;
    const unsigned char* yb = ys + (size_t)m0 * 4 * D + 4 * lane; const float* xb = x1 + (size_t)m0 * D + 4 * lane;
    unsigned ya[4][4], ybb[4][4], yc[4][4], yd[4][4]; f32x4 xa[4], xbf[4], xc[4], xd[4], g[4];
#define P11_LOAD(Y, X, r) do { _Pragma("unroll") for (int j = 0; j < 4; ++j) { X[j] = *(const f32x4*)(xb + (size_t)(r) * D + 256 * j); \
        _Pragma("unroll") for (int k4 = 0; k4 < 4; ++k4) Y[j][k4] = *(const unsigned*)(yb + ((size_t)(r) * 4 + k4) * D + 256 * j); } } while (0)
#define P11_ROW(Y, X, it) do { f32x4 yv[4]; float ss = 0.f; \
        _Pragma("unroll") for (int j = 0; j < 4; ++j) { f32x4 a = (f32x4){0.f, 0.f, 0.f, 0.f}; \
            _Pragma("unroll") for (int k4 = 0; k4 < 4; ++k4) a += unpack4_fp8(Y[j][k4]); \
            yv[j] = a; ss += dot4(a); } \
        const float ry = rsqrtf(wave_sum(ss) * (1.f / D) + EPS * (Y8_SCALE * Y8_SCALE)); \
        _Pragma("unroll") for (int j = 0; j < 4; ++j) *(f32x4*)(F.out + (size_t)(m0 + (it)) * D + 4 * lane + 256 * j) = X[j] + yv[j] * ry * g[j]; \
        if ((it) + 4 < 16) P11_LOAD(Y, X, (it) + 4); } while (0)
    P11_LOAD(ya, xa, 0); P11_LOAD(ybb, xbf, 1); P11_LOAD(yc, xc, 2); P11_LOAD(yd, xd, 3);
#pragma unroll
    for (int j = 0; j < 4; ++j) { const int idx = 4 * lane + 256 * j; g[j] = *(const f32x4*)(F.g_post_ffn + idx) * *(const f32x4*)(modb + 5120 + idx); }
#pragma unroll 1
    for (int it = 0; it < 16; it += 4) { P11_ROW(ya, xa, it); P11_ROW(ybb, xbf, it + 1); P11_ROW(yc, xc, it + 2); P11_ROW(yd, xd, it + 3); }
#undef P11_LOAD
#undef P11_ROW
}

constexpr int NPHASE = 11;
struct Args { const float* in[20]; float* out; unsigned char* ws; int ph_lo, ph_hi; };
__global__ void __launch_bounds__(NTHREADS, 2) fwd(Args args) {
    extern __shared__ __attribute__((aligned(16))) unsigned char lds[];
    Frame F;
    F.lds = (LAS unsigned char*)lds;
    F.tid = threadIdx.x; F.lane = F.tid & 63; F.wave = __builtin_amdgcn_readfirstlane(F.tid >> 6); F.bx = blockIdx.x; F.G = gridDim.x;
    F.x = args.in[0]; F.c = args.in[1]; F.w_ada = args.in[2]; F.b_ada = args.in[3]; F.g_pre_mix = args.in[4]; F.g_post_mix = args.in[5];
    F.g_pre_ffn = args.in[6]; F.g_post_ffn = args.in[7]; F.w_in = args.in[8]; F.w_gate_up = args.in[9]; F.b_gate = args.in[10]; F.g_gla_norm = args.in[11];
    F.sinks = args.in[12]; F.w_out = args.in[13]; F.w_router = args.in[14]; F.b_router = args.in[15]; F.w_mlp1 = args.in[16]; F.b_mlp1 = args.in[17];
    F.w_mlp2 = args.in[18]; F.b_mlp2 = args.in[19]; F.out = args.out; F.ws = args.ws;
    volatile LAS unsigned* MISC = (volatile LAS unsigned*)(F.lds + MISC_OFF);
    if (F.tid < 32) MISC[F.tid] = 0u;
    __syncthreads();
    const int lo = args.ph_lo, hi = args.ph_hi;
    XcdBarrier bar; bar.bar = (unsigned*)(F.ws + WS_CTL) + CW_BAR; bar.x = 0; bar.st = nullptr;
    if (hi - lo > 1) bar = xcd_barrier_post((unsigned*)(F.ws + WS_CTL) + CW_BAR, MISC + 8);
#define IN(k) (lo <= (k) && (k) < hi)
#if DUPMASK
#define REP(k) _Pragma("nounroll") for (int rep_ = 0; rep_ < 1 + ((DUPMASK >> (k)) & 1); ++rep_, __syncthreads())
#else
#define REP(k)
#endif
#define SEAM(k) do { if (IN(k) && IN((k) + 1)) xcd_barrier(bar); } while (0)

    if (IN(0)) { p0_prologue<0>(F);
#if DUPMASK & 1
        __syncthreads(); p0_prologue<P0_MODE>(F);
#endif
    } SEAM(0);
    if (IN(1)) REP(1) { p1_norm(F); } SEAM(1);
    if (IN(2)) {
        constexpr int I_FIRST = 16 * 80 + 16 * 32, I_PER = (NE * 16 * 64 + NE * 16 * 32) / GRID;
        const int grp = F.bx & 3, pos = grp == 0 ? 0 : grp == 1 ? 1 : grp == 2 ? 3 : 4;
        { pg8::StaticOrder So; So.init(T / 256, INP / 256, F.G, F.bx, 0, pos);
          pg8::gemm_phase<false, 0, 0, 0>(F.lds, D, So, pg8::ABDense{WSP(bf16, WS_H), WSP(bf16, WS_WIN), D}, pg8::EpiStoreT{WSP(bf16, WS_PROJ), INP}); }
        __syncthreads();
        tr_range<0>(F, I_FIRST + F.bx * I_PER, I_FIRST + (F.bx + 1) * I_PER);
        __syncthreads();
        { pg8::StaticOrder So; So.init(T / 256, INP / 256, F.G, F.bx, pos);
          pg8::gemm_phase<false, 0, 0, 0>(F.lds, D, So, pg8::ABDense{WSP(bf16, WS_H), WSP(bf16, WS_WIN), D}, pg8::EpiStoreT{WSP(bf16, WS_PROJ), INP}); }
    } SEAM(2);
    if (IN(3)) { for (int u = F.bx; u < 512; u += F.G) attn_unit(F, u);
                 for (int u = F.bx; u < 256; u += F.G) gla_super_unit<false>(F, u);
#if DUPMASK & 8
                 __syncthreads();
                 if (P3_MODE == 0 || P3_MODE == 1) for (int u = F.bx; u < 512; u += F.G) attn_unit(F, u);
                 if (P3_MODE == 0 || P3_MODE == 2) for (int u = F.bx; u < 256; u += F.G) gla_super_unit<false>(F, u);
#endif
    } SEAM(3);
    if (IN(4)) REP(4) { gla_super_scan(F); } SEAM(4);
    if (IN(5)) REP(5) { for (int u = F.bx; u < 256; u += F.G) gla_super_unit<true>(F, u); } SEAM(5);
    if (IN(6)) REP(6) { pg8::StaticOrder So; So.init(T / 256, D / 256, F.G, F.bx);
                 pg8::gemm_phase<false, 0, 0, 0>(F.lds, D, So, pg8::ABDense{WSP(bf16, WS_MIX), WSP(bf16, WS_WOUT), D}, pg8::EpiStoreT{WSP(bf16, WS_Y), D}); } SEAM(6);
    if (IN(7)) { p7_norm_router(F);
#if DUPMASK & 128
        __syncthreads(); p7_norm_router(F);
#endif
    } SEAM(7);
    if (IN(8)) REP(8) { const int nM = WSP(int, WS_MOE_OFF)[32] >> 8; pg8::StaticOrder So; So.init(nM, 2048 / 256, F.G, F.bx);
                 pg8::gemm_phase<true, 1, W8_E8M0, H8_E8M0>(F.lds, 512, So, pg8::ABMoe1{WSP(unsigned char, WS_H), WSP(unsigned char, WS_W1T), WSP(int, WS_TILE_E), WSP(int, WS_MOE_OFF), WSP(unsigned, WS_CTL) + CW_MOE_CNT, WSP(int, WS_LIST_A)},
                                       pg8::EpiSwigluT{WSP(unsigned char, WS_A), F.b_mlp1, WSP(int, WS_TILE_E)}); } SEAM(8);
    if (IN(9)) REP(9) { const int nM = WSP(int, WS_MOE_OFF)[32] >> 8; pg8::StaticOrder So; So.init(nM, D / 256, F.G, F.bx);
                  pg8::gemm_phase<false, 1, W8_E8M0, A8_E8M0>(F.lds, 512, So, pg8::ABMoe2{WSP(unsigned char, WS_A), WSP(unsigned char, WS_W2T), WSP(int, WS_TILE_E)},
                                         pg8::EpiMoe2T{WSP(unsigned char, WS_YS), F.b_mlp2, WSP(int, WS_TILE_E), WSP(int, WS_MOE_OFF), WSP(unsigned, WS_CTL) + CW_MOE_CNT, WSP(int, WS_LIST_A), WSP(float, WS_LIST_G)}); } SEAM(9);
    if (IN(10)) { p11_combine(F);
#if DUPMASK & 1024
        __syncthreads(); p11_combine(F);
#endif
    }
#undef IN
#undef SEAM
}

extern "C" void kernel_launch(void* const* d_in, const int* in_sizes, int n_in, void* d_out, int out_size, void* d_ws, size_t ws_size, hipStream_t stream) {
    static int ready = 0;
    if (ready == 0) {
        if (n_in != 20 || out_size != T * D || ws_size < WS_END) { fprintf(stderr, "kernel_launch: unexpected problem (n_in %d, out %d, ws %zu)\n", n_in, out_size, ws_size); ready = -1; return; }
        if (hipFuncSetAttribute((const void*)fwd, hipFuncAttributeMaxDynamicSharedMemorySize, LDS_BYTES) != hipSuccess) { fprintf(stderr, "kernel_launch: hipFuncSetAttribute failed\n"); ready = -1; return; }
        int per_cu = 0;
        if (hipOccupancyMaxActiveBlocksPerMultiprocessor(&per_cu, (const void*)fwd, NTHREADS, LDS_BYTES) != hipSuccess || per_cu < 1) fprintf(stderr, "kernel_launch: occupancy query says %d\n", per_cu);
        (void)hipGetLastError();
        ready = 1;
    }
    if (ready < 0) return;
    (void)hipMemsetAsync((char*)d_ws + WS_CTL, 0, CTL_ZERO_BYTES, stream);
    Args a{};
    for (int i = 0; i < 20; ++i) a.in[i] = (const float*)d_in[i];
    a.out = (float*)d_out; a.ws = (unsigned char*)d_ws;
#if MK_ONE_LAUNCH
    a.ph_lo = 0; a.ph_hi = NPHASE;
    hipLaunchKernelGGL(fwd, dim3(GRID), dim3(NTHREADS), LDS_BYTES, stream, a);
#if PROBE_PHASE >= 0
    a.ph_lo = PROBE_PHASE; a.ph_hi = PROBE_PHASE + 1;
    hipLaunchKernelGGL(fwd, dim3(GRID), dim3(NTHREADS), LDS_BYTES, stream, a);
#endif
#else
    for (int p = 0; p < NPHASE; ++p) { a.ph_lo = p; a.ph_hi = p + 1; hipLaunchKernelGGL(fwd, dim3(GRID), dim3(NTHREADS), LDS_BYTES, stream, a); }
#endif
}
```

```cpp
#include <hip/hip_runtime.h>
#include <cstdio>
#include <cstdint>

#ifndef MK_ONE_LAUNCH
#define MK_ONE_LAUNCH 1
#endif

#ifndef PROBE_PHASE
#define PROBE_PHASE -1
#endif
#ifndef G1_ABL
#define G1_ABL 0
#endif
#ifndef P2_MODE
#define P2_MODE 0
#endif
#ifndef P3_MODE
#define P3_MODE 0
#endif
#ifndef P0_MODE
#define P0_MODE 0
#endif
#ifndef DUPMASK
#define DUPMASK 0
#endif
#define LAS __attribute__((address_space(3)))
typedef unsigned short bf16;
typedef short bf16x8 __attribute__((ext_vector_type(8)));
typedef short s16x4 __attribute__((ext_vector_type(4)));
typedef float f32x4 __attribute__((ext_vector_type(4)));
typedef unsigned u32x4 __attribute__((ext_vector_type(4)));
typedef unsigned u32x2 __attribute__((ext_vector_type(2)));

constexpr int D = 1024, NB = 2, S = 16384, T = NB * S;
constexpr int INW = 2320, INP = 2560;
constexpr int AQ_OFF = 0, AK_OFF = 512, AV_OFF = 640, GQ_OFF = 768, GK_OFF = 1024, GV_OFF = 1280, GG_OFF = 1792, GA_OFF = 2304;
constexpr int NCH = 256;
constexpr int NE = 32, FF = 1024;
constexpr int NSLOT_MAX = T * 4 + NE * 256;
constexpr float EPS = 1e-6f;
constexpr int NWAVES = 8, NTHREADS = 512, GRID = 256;

constexpr size_t MiB = 1u << 20;
constexpr size_t WS_CTL = 0, CTL_ZERO_BYTES = 1 * MiB;
constexpr size_t WS_MOD = 1 * MiB;
constexpr size_t WS_DECAY = 2 * MiB;
constexpr size_t WS_ROUTE = 3 * MiB;
constexpr size_t WS_TOK_E = WS_ROUTE, WS_TOK_LPOS = WS_ROUTE + 512 * 1024, WS_TOK_GATE = WS_ROUTE + 1024 * 1024;
constexpr size_t WS_BLK_CNT = WS_ROUTE + 1536 * 1024, WS_MOE_OFF = WS_BLK_CNT + 32 * 1024, WS_TILE_E = WS_MOE_OFF + 4096;
constexpr size_t WS_TDESC = WS_TILE_E + 4096;
constexpr size_t WS_SLOT_ASSIGN = WS_ROUTE + 2 * MiB, WS_SLOT_GATE = WS_ROUTE + 3 * MiB;
constexpr size_t WS_WIN = 8 * MiB, WS_WOUT = 13 * MiB, WS_W2T = 16 * MiB, WS_W1T = 80 * MiB;
constexpr size_t WS_H = 208 * MiB, WS_KV = 272 * MiB, WS_YS = 80 * MiB;
constexpr size_t WS_X1 = 336 * MiB, WS_PROJ = 464 * MiB, WS_MIX = 624 * MiB, WS_Y = 688 * MiB, WS_A = 464 * MiB;
constexpr size_t WS_LIST_A = 752 * MiB, WS_LIST_G = 756 * MiB;
constexpr size_t WS_XS = 608 * MiB;
constexpr size_t WS_END = 760 * MiB;
constexpr int CW_BAR = 4096, CW_GCNT = 8192  , CW_DONE = 8192 + 64 * 32, CW_MOE_CNT = 16384  ;

constexpr int LDS_BYTES = 163840, SMALL_OFF = 132096, MISC_OFF = 131072 + 320;

__device__ __forceinline__ float bf2f(unsigned v) { return __uint_as_float(v << 16); }
__device__ __forceinline__ unsigned f2bf(float f) { unsigned u = __float_as_uint(f); return (u + 0x7fffu + ((u >> 16) & 1u)) >> 16; }
__device__ __forceinline__ unsigned pk2(float lo, float hi) { return f2bf(lo) | (f2bf(hi) << 16); }
__device__ __forceinline__ float wave_sum(float v) {
#pragma unroll
    for (int o = 1; o < 64; o <<= 1) v += __shfl_xor(v, o);
    return v;
}
__device__ __forceinline__ f32x4 unpack4(u32x2 r) { return (f32x4){bf2f(r.x & 0xffffu), bf2f(r.x >> 16), bf2f(r.y & 0xffffu), bf2f(r.y >> 16)}; }
__device__ __forceinline__ float dot4(f32x4 a) { return (a[0] * a[0] + a[1] * a[1]) + (a[2] * a[2] + a[3] * a[3]); }
typedef short v4i16_t __attribute__((ext_vector_type(4)));
__device__ __forceinline__ s16x4 trr(LAS const unsigned char* p) { return __builtin_bit_cast(s16x4, __builtin_amdgcn_ds_read_tr16_b64_v4i16((LAS v4i16_t*)p)); }
__device__ __forceinline__ bf16x8 cat8(s16x4 lo, s16x4 hi) { return __builtin_shufflevector(lo, hi, 0, 1, 2, 3, 4, 5, 6, 7); }
__device__ __forceinline__ bf16x8 pack8(f32x4 a, f32x4 b) { u32x4 w; w.x = pk2(a[0], a[1]); w.y = pk2(a[2], a[3]); w.z = pk2(b[0], b[1]); w.w = pk2(b[2], b[3]); return __builtin_bit_cast(bf16x8, w); }
#define MFMA(a, b, c) __builtin_amdgcn_mfma_f32_16x16x32_bf16((a), (b), (c), 0, 0, 0)
typedef int i32x4 __attribute__((ext_vector_type(4)));
typedef int i32x8 __attribute__((ext_vector_type(8)));
__device__ __forceinline__ float clamp8(float v) { return fminf(fmaxf(v, -448.f), 448.f); }
__device__ __forceinline__ unsigned pk4_fp8(float a, float b, float c, float d) {
    int w = 0; w = __builtin_amdgcn_cvt_pk_fp8_f32(clamp8(a), clamp8(b), w, false); w = __builtin_amdgcn_cvt_pk_fp8_f32(clamp8(c), clamp8(d), w, true); return (unsigned)w; }
constexpr float W8_SCALE = 64.f, H8_SCALE = 16.f, A8_SCALE = 4.f, Y8_SCALE = 16.f;
constexpr int W8_E8M0 = 0x79797979  , H8_E8M0 = 0x7b7b7b7b  , A8_E8M0 = 0x7d7d7d7d  ;

#define XB_TMO      128
#define XB_XCNT(j)  (256  + 64 * (j))
#define XB_XSUB(j)  (1280 + 64 * (j))
#define XB_XGEN(j)  (2304 + 64 * (j))
#define XB_TOP      3328
#define XB_TOPGEN   3392
#define XCD_BAR_WORDS 3456
#define XB_SPIN_CAP (1u << 18)
__device__ __forceinline__ unsigned xb_ld(unsigned* p)              { return __hip_atomic_load(p, __ATOMIC_RELAXED, __HIP_MEMORY_SCOPE_AGENT); }
__device__ __forceinline__ unsigned xb_add(unsigned* p, unsigned v) { return __hip_atomic_fetch_add(p, v, __ATOMIC_RELAXED, __HIP_MEMORY_SCOPE_AGENT); }
__device__ __forceinline__ unsigned xb_xcc_id() { return (unsigned)__builtin_amdgcn_s_getreg((3 << 11) | 20) & 0xFu; }
#define XB_SPIN(cond, bar) do { unsigned _sp = 0; while (cond) { __builtin_amdgcn_s_sleep(1); \
    if ((++_sp & 255u) == 0u) { if (xb_ld(&(bar)[XB_TMO])) break; if (_sp > XB_SPIN_CAP) { atomicAdd(&(bar)[XB_TMO], 1u); break; } } } } while (0)
struct XcdBarrier { unsigned* bar; unsigned x; volatile LAS unsigned* st; };
__device__ __forceinline__ XcdBarrier xcd_barrier_post(unsigned* bar, volatile LAS unsigned* st) {
    XcdBarrier b; b.bar = bar; b.x = xb_xcc_id(); b.st = st;
    if (threadIdx.x == 0) (void)xb_add(&bar[XB_XCNT(b.x)], 1u);
    return b;
}
__device__ __forceinline__ void xcd_barrier_complete(unsigned* bar, unsigned x, unsigned& nloc, unsigned& nx) {
    const unsigned G = gridDim.x * gridDim.y * gridDim.z;
    unsigned sum, cnt, mine, sp = 0u;
    for (;;) {
        sum = 0u; cnt = 0u; mine = 0u;
#pragma unroll
        for (unsigned j = 0; j < 16; ++j) { const unsigned c = xb_ld(&bar[XB_XCNT(j)]); sum += c; cnt += (c > 0u) ? 1u : 0u; mine = (j == x) ? c : mine; }
        if (sum == G) break;
        __builtin_amdgcn_s_sleep(1);
        if ((++sp & 255u) == 0u) { if (xb_ld(&bar[XB_TMO])) break; if (sp > XB_SPIN_CAP) { atomicAdd(&bar[XB_TMO], 1u); break; } }
    }
    nloc = mine > 0u ? mine : 1u; nx = cnt > 0u ? cnt : 1u;
}
__device__ __forceinline__ void xcd_barrier(const XcdBarrier& b) {
    asm volatile("s_waitcnt vmcnt(0)" ::: "memory");
    __syncthreads();
    if (threadIdx.x == 0) {
        unsigned* bar = b.bar;
        __builtin_amdgcn_s_waitcnt(0);
        unsigned nloc = b.st[0], nx = b.st[1];
        if (nloc == 0u) { xcd_barrier_complete(bar, b.x, nloc, nx); b.st[0] = nloc; b.st[1] = nx; }
        const unsigned old = xb_add(&bar[XB_XSUB(b.x)], 1u);
        const unsigned gen = old / nloc;
        if (old + 1u == (gen + 1u) * nloc) {
            __builtin_amdgcn_fence(__ATOMIC_RELEASE, "agent");
            asm volatile("s_waitcnt vmcnt(0)" ::: "memory");
            const unsigned og = xb_add(&bar[XB_TOP], 1u);
            const unsigned tg = og / nx;
            if (og + 1u == (tg + 1u) * nx) xb_add(&bar[XB_TOPGEN], 1u);
            else XB_SPIN(xb_ld(&bar[XB_TOPGEN]) == tg, bar);
            __builtin_amdgcn_fence(__ATOMIC_ACQUIRE, "agent");
            xb_add(&bar[XB_XGEN(b.x)], 1u);
            asm volatile("s_waitcnt vmcnt(0)" ::: "memory");
        } else {
            XB_SPIN(xb_ld(&bar[XB_XGEN(b.x)]) == gen, bar);
            __builtin_amdgcn_fence(__ATOMIC_ACQUIRE, "agent");
            asm volatile("s_waitcnt vmcnt(0)" ::: "memory");
        }
    }
    __syncthreads();
}

struct Frame {
    LAS unsigned char* lds;
    int tid, lane, wave, bx, G;
    const float *x, *c, *w_ada, *b_ada, *g_pre_mix, *g_post_mix, *g_pre_ffn, *g_post_ffn, *w_in, *w_gate_up, *b_gate, *g_gla_norm, *sinks, *w_out,
                *w_router, *b_router, *w_mlp1, *b_mlp1, *w_mlp2, *b_mlp2;
    float* out;
    unsigned char* ws;
};
#define WSP(type, off) ((type*)(F.ws + (off)))

struct TrItem { const float* W; int N; int k0, n0; unsigned char* WT; int kind; };
__device__ __forceinline__ bool tr_decode(const Frame& F, int it, TrItem& t) {
    constexpr int I_IN = 16 * 80, I_OUT = 16 * 32, I_1 = 16 * 64, I_2 = 16 * 32;
    constexpr int NITEMS = I_IN + I_OUT + NE * I_1 + NE * I_2;
    if (it >= NITEMS) return false;
    int r = it, item;
    if (r < I_IN) { t.W = F.w_in; t.N = INW; t.WT = F.ws + WS_WIN; t.kind = 0; item = r; }
    else if ((r -= I_IN) < I_OUT) { t.W = F.w_out; t.N = 1024; t.WT = F.ws + WS_WOUT; t.kind = 0; item = r; }
    else if ((r -= I_OUT) < NE * I_1) { const int e = r / I_1; t.W = F.w_mlp1 + (size_t)e * 1024 * 2048; t.N = 2048; t.WT = F.ws + WS_W1T + (size_t)e * 2048 * 1024; t.kind = 1; item = r % I_1; }
    else { r -= NE * I_1; const int e = r / I_2; t.W = F.w_mlp2 + (size_t)e * 1024 * 1024; t.N = 1024; t.WT = F.ws + WS_W2T + (size_t)e * 1024 * 1024; t.kind = 2; item = r % I_2; }
    const int st = item >> 4, l = item & 15, kb = 2 * (st & 7) + (l >> 3), nb = 8 * (st >> 3) + (l & 7);
    t.k0 = 64 * kb; t.n0 = 32 * nb;
    return true;
}
__device__ __forceinline__ void tr_dma(const TrItem& t, int lane, LAS unsigned char* buf) {
    const int p = lane & 7, rr = lane >> 3;
#pragma unroll
    for (int i = 0; i < 8; ++i) {
        int col = t.n0 + 4 * (p ^ i); col = col + 4 <= t.N ? col : t.N - 4;
        __builtin_amdgcn_global_load_lds((const unsigned*)(t.W + (size_t)(t.k0 + 8 * i + rr) * t.N + col), (LAS unsigned*)(buf + i * 1024), 16, 0, 0);
    }
}
__device__ __forceinline__ void tr_store(const TrItem& t, int lane, LAS const unsigned char* buf) {
    const int c = lane & 7;
#pragma unroll
    for (int j = 0; j < 4; ++j) { const int nn = (lane >> 3) + 8 * j;
        float e[8];
#pragma unroll
        for (int q = 0; q < 8; ++q) e[q] = *(LAS const float*)(buf + (8 * c + q) * 128 + (((nn >> 2) ^ c) << 4) + (nn & 3) * 4);
        const int n = t.n0 + nn; const bool ok = n < t.N;
#pragma unroll
        for (int q = 0; q < 8; ++q) e[q] = ok ? e[q] : 0.f;
        if (t.kind == 0) { u32x4 o; o.x = pk2(e[0], e[1]); o.y = pk2(e[2], e[3]); o.z = pk2(e[4], e[5]); o.w = pk2(e[6], e[7]);
            *(u32x4*)((bf16*)t.WT + (size_t)n * 1024 + t.k0 + 8 * c) = o; }
        else { u32x2 o; o.x = pk4_fp8(e[0] * W8_SCALE, e[1] * W8_SCALE, e[2] * W8_SCALE, e[3] * W8_SCALE); o.y = pk4_fp8(e[4] * W8_SCALE, e[5] * W8_SCALE, e[6] * W8_SCALE, e[7] * W8_SCALE);
            int row = n; if (t.kind == 1) { const int jj = n >> 1; row = 256 * (jj >> 7) + 128 * (n & 1) + (jj & 127); }
            *(u32x2*)(t.WT + (size_t)row * 1024 + t.k0 + 8 * c) = o; } }
}
template <int MODE>
__device__ __forceinline__ void tr_range(const Frame& F, int itB, int itE) {
    LAS unsigned char* buf0 = F.lds + F.wave * 16384; LAS unsigned char* buf1 = buf0 + 8192;
    const int it0 = itB + F.wave;
    TrItem t0, t1;
    bool h0 = (it0 < itE) && tr_decode(F, it0, t0); if (h0) tr_dma(t0, F.lane, buf0);
    bool h1 = (it0 + NWAVES < itE) && tr_decode(F, it0 + NWAVES, t1); if (h1) tr_dma(t1, F.lane, buf1);
    if (h0) { if (h1) asm volatile("s_waitcnt vmcnt(8)" ::: "memory"); else asm volatile("s_waitcnt vmcnt(0)" ::: "memory"); }
#pragma unroll 1
    for (int it = it0; h0; it += 2 * NWAVES) {
        if (MODE != 1) tr_store(t0, F.lane, buf0);
        asm volatile("s_waitcnt lgkmcnt(0)" ::: "memory");
        h0 = (it + 2 * NWAVES < itE) && tr_decode(F, it + 2 * NWAVES, t0); if (h0) tr_dma(t0, F.lane, buf0);
        if (!h1) break;
        if (h0) asm volatile("s_waitcnt vmcnt(12)" ::: "memory"); else asm volatile("s_waitcnt vmcnt(4)" ::: "memory");
        if (MODE != 1) tr_store(t1, F.lane, buf1);
        asm volatile("s_waitcnt lgkmcnt(0)" ::: "memory");
        h1 = (it + 3 * NWAVES < itE) && tr_decode(F, it + 3 * NWAVES, t1); if (h1) tr_dma(t1, F.lane, buf1);
        if (h0) { if (h1) asm volatile("s_waitcnt vmcnt(12)" ::: "memory"); else asm volatile("s_waitcnt vmcnt(4)" ::: "memory"); }
    }
    asm volatile("s_waitcnt vmcnt(0)" ::: "memory");
}
template <int MODE>
__device__ __forceinline__ void p0_prologue(const Frame& F) {
    float* mod = WSP(float, WS_MOD);
    if (F.bx < 192 && MODE != 3 && MODE != 1) {
        LAS float* red = (LAS float*)(F.lds + 98304);
        const int cl = F.tid & 31, ks = F.tid >> 5, col = F.bx * 32 + cl;
        float a0 = 0.f, a1 = 0.f;
        float wv[64];
#pragma unroll
        for (int i = 0; i < 64; ++i) wv[i] = F.w_ada[(size_t)(ks * 64 + i) * 6144 + col];
#pragma unroll
        for (int i = 0; i < 64; ++i) { const int k = ks * 64 + i;
            const float c0 = F.c[k], c1 = F.c[1024 + k];
            a0 += c0 * __builtin_amdgcn_rcpf(1.f + __expf(-c0)) * wv[i]; a1 += c1 * __builtin_amdgcn_rcpf(1.f + __expf(-c1)) * wv[i];
        }
        red[(0 * 16 + ks) * 32 + cl] = a0; red[(1 * 16 + ks) * 32 + cl] = a1;
        __syncthreads();
        if (F.tid < 64) { const int b = F.tid >> 5; float s = 0.f;
#pragma unroll
            for (int i = 0; i < 16; ++i) s += red[(b * 16 + i) * 32 + cl];
            mod[b * 6144 + col] = s + F.b_ada[col]; }
        __syncthreads();
    }
    if (MODE == 2) return;
    if (F.bx < 112) tr_range<MODE>(F, F.bx * 16, F.bx * 16 + 16);
}

__device__ __forceinline__ void p1_norm(const Frame& F) {
    const float* mod = WSP(float, WS_MOD); bf16* h = WSP(bf16, WS_H);
    const int gw = F.bx * NWAVES + F.wave, m0 = gw * 16;
    const float* modb = mod + (m0 >> 14) * 6144;
    const float* xb = F.x + (size_t)m0 * D + 4 * F.lane;
    f32x4 g[4], sh[4], b0[4], b1[4], b2[4], b3[4];
#define P1_LOAD(B, r) do { _Pragma("unroll") for (int j = 0; j < 4; ++j) B[j] = *(const f32x4*)(xb + (size_t)(r) * D + 256 * j); } while (0)
#define P1_ROW(B, it) do { float ss = 0.f; _Pragma("unroll") for (int j = 0; j < 4; ++j) ss += dot4(B[j]); \
        const float r = rsqrtf(wave_sum(ss) * (1.f / D) + EPS); \
        _Pragma("unroll") for (int j = 0; j < 4; ++j) { const f32x4 hv = B[j] * r * g[j] + sh[j]; u32x2 o; o.x = pk2(hv[0], hv[1]); o.y = pk2(hv[2], hv[3]); \
            *(u32x2*)(h + (size_t)(m0 + (it)) * D + 4 * F.lane + 256 * j) = o; } \
        if ((it) + 4 < 16) P1_LOAD(B, (it) + 4); } while (0)
    P1_LOAD(b0, 0); P1_LOAD(b1, 1); P1_LOAD(b2, 2); P1_LOAD(b3, 3);
#pragma unroll
    for (int j = 0; j < 4; ++j) { const int idx = 4 * F.lane + 256 * j;
        g[j] = *(const f32x4*)(F.g_pre_mix + idx) * (*(const f32x4*)(modb + 1024 + idx) + 1.f); sh[j] = *(const f32x4*)(modb + idx); }
#pragma unroll 1
    for (int it = 0; it < 16; it += 4) { P1_ROW(b0, it); P1_ROW(b1, it + 1); P1_ROW(b2, it + 2); P1_ROW(b3, it + 3); }
#undef P1_LOAD
#undef P1_ROW
}

template <class Epi, class RowMap, class BSel>
__device__ __forceinline__ void simple_gemm(const Frame& F, const bf16* A, int lda, int M, int N, int K, const RowMap& rm, const BSel& bs, const Epi& E) {
    const int fr = F.lane & 15, fq = F.lane >> 4;
    const int ncg = N / 512, nbt = (M / 64) * ncg;
    for (int bt = F.bx; bt < nbt; bt += F.G) {
        const int mt = bt / ncg, cg = bt % ncg, m0 = mt * 64, n0 = cg * 512 + F.wave * 64;
        const bf16* Bt = bs(m0);
        const bf16* ap[4]; const bf16* bp[4];
#pragma unroll
        for (int i = 0; i < 4; ++i) { ap[i] = A + (size_t)rm(m0 + 16 * i + fr) * lda + 8 * fq; bp[i] = Bt + (size_t)(n0 + 16 * i + fr) * K + 8 * fq; }
        f32x4 acc[4][4];
#pragma unroll
        for (int i = 0; i < 4; ++i)
#pragma unroll
            for (int j = 0; j < 4; ++j) acc[i][j] = (f32x4){0.f, 0.f, 0.f, 0.f};
#pragma unroll 2
        for (int k0 = 0; k0 < K; k0 += 32) {
            bf16x8 a[4], b[4];
#pragma unroll
            for (int i = 0; i < 4; ++i) { a[i] = *(const bf16x8*)(ap[i] + k0); b[i] = *(const bf16x8*)(bp[i] + k0); }
#pragma unroll
            for (int i = 0; i < 4; ++i)
#pragma unroll
                for (int j = 0; j < 4; ++j) acc[i][j] = MFMA(b[j], a[i], acc[i][j]);
        }
#pragma unroll
        for (int i = 0; i < 4; ++i)
#pragma unroll
            for (int j = 0; j < 4; ++j) E(m0 + 16 * i + fr, n0 + 16 * j + 4 * fq, acc[i][j]);
    }
}
struct RowId { __device__ __forceinline__ int operator()(int m) const { return m; } };
struct RowGather { const int* slot_assign; __device__ __forceinline__ int operator()(int m) const { const int a = slot_assign[m]; return a < 0 ? 0 : (a >> 2); } };
struct BFixed { const bf16* Bt; __device__ __forceinline__ const bf16* operator()(int) const { return Bt; } };
struct BExpert { const bf16* Bt; const int* tile_e; size_t stride; __device__ __forceinline__ const bf16* operator()(int m0) const { return Bt + (size_t)tile_e[m0 >> 8] * stride; } };
struct EpiStore { bf16* O; int ldo;
    __device__ __forceinline__ void operator()(int m, int n, f32x4 v) const { u32x2 w; w.x = pk2(v[0], v[1]); w.y = pk2(v[2], v[3]); *(u32x2*)(O + (size_t)m * ldo + n) = w; } };
__device__ __forceinline__ float swiglu(float g, float l) {
    const float xg = fminf(g, 7.f), xl = fminf(fmaxf(l, -7.f), 7.f);
    return xg / (1.f + __expf(-1.702f * xg)) * (xl + 1.f);
}
__device__ __forceinline__ float swiglu_s(float g, float l) {
    const float xg = fminf(g, 7.f), xl = __builtin_amdgcn_fmed3f(l, -7.f, 7.f);
    const float den = 1.f + __builtin_amdgcn_exp2f(xg * (-1.702f * 1.4426950408889634f));
    return (xg * __builtin_amdgcn_rcpf(den)) * __builtin_fmaf(xl, A8_SCALE, A8_SCALE);
}
__device__ __forceinline__ unsigned pk4_fp8_nc(float a, float b, float c, float d) {
    int w = 0; w = __builtin_amdgcn_cvt_pk_fp8_f32(a, b, w, false); w = __builtin_amdgcn_cvt_pk_fp8_f32(c, d, w, true); return (unsigned)w; }
struct EpiSwiglu { bf16* Aout; const float* b1; const int* tile_e;
    __device__ __forceinline__ void operator()(int m, int n, f32x4 v) const {
        const int e = tile_e[m >> 8]; const f32x4 bb = *(const f32x4*)(b1 + (size_t)e * 2048 + n);
        const float a0 = swiglu(v[0] + bb[0], v[1] + bb[1]), a1 = swiglu(v[2] + bb[2], v[3] + bb[3]);
        *(unsigned*)(Aout + (size_t)m * FF + (n >> 1)) = pk2(a0, a1); } };
struct EpiMoe2 { bf16* ys; const float* b2; const int* tile_e; const int* slot_assign; const float* slot_gate;
    __device__ __forceinline__ void operator()(int m, int n, f32x4 v) const {
        const int asg = slot_assign[m]; if (asg < 0) return;
        const int e = tile_e[m >> 8]; const f32x4 bb = *(const f32x4*)(b2 + (size_t)e * D + n); const float g = slot_gate[m];
        u32x2 w; w.x = pk2((v[0] + bb[0]) * g, (v[1] + bb[1]) * g); w.y = pk2((v[2] + bb[2]) * g, (v[3] + bb[3]) * g);
        *(u32x2*)(ys + (size_t)asg * D + n) = w; } };

namespace pg8 {
constexpr int BM = 256, BK = 64, HALF = 128, HTB = HALF * BK * 2, NXCD = 8, WGM = 8;
__device__ __forceinline__ int lds_byte(int r, int c) { const int st = (r >> 4) * 2 + (c >> 5), rr = r & 15, cc = c & 31, ob = rr * 64 + cc * 2; return st * 1024 + (ob ^ (((ob >> 9) & 1) << 5)); }
__device__ __forceinline__ void stage_rc(int b, int& R, int& C) { const int st = b / 1024, sb = b % 1024, swz = sb ^ (((sb >> 9) & 1) << 5); R = (st >> 1) * 16 + swz / 64; C = (st & 1) * 32 + (swz % 64) / 2; }
__device__ __forceinline__ int perm32(int rho) { const int n = rho >> 4, i = rho & 15; return 8 * (i >> 2) + 4 * n + (i & 3); }
struct Unit { int pm, pn, e, pos0, cnt; };
struct StaticOrder {
    int nM, nN, nwg, G, c, i0, n;
    __device__ __forceinline__ void init(int nM_, int nN_, int G_, int c_, int i0_ = 0, int n_ = 1 << 30) { nM = nM_; nN = nN_; nwg = nM * nN; G = G_; c = c_; i0 = i0_; n = n_; }
    __device__ __forceinline__ bool next(int i, Unit& u) const {
        if (i >= n) return false;
        const long L = (long)(i0 + i) * G + c; if (L >= nwg) return false;
        int wgid = (int)L; { const int q = nwg / NXCD, r = nwg % NXCD, xcd = wgid % NXCD, off = wgid / NXCD; wgid = (xcd < r ? xcd * (q + 1) : r * (q + 1) + (xcd - r) * q) + off; }
        const int nig = WGM * nN, gid = wgid / nig, fm = gid * WGM, gsz = (nM - fm) < WGM ? (nM - fm) : WGM;
        u.pm = fm + ((wgid % nig) % gsz); u.pn = (wgid % nig) / gsz; return true;
    }
};
template <bool GATHER, int FP8, int SCW, int SCX, int ABL = 0, class Epi, class Sched, class AB>
__device__ __forceinline__ void gemm_phase(LAS unsigned char* lds, const int K, const Sched& S, const AB& ab, const Epi& E) {
    const int tid = threadIdx.x, wid = __builtin_amdgcn_readfirstlane(tid >> 6), lane = tid & 63, wr = wid >> 2, wc = wid & 3, fr = lane & 15, fq = lane >> 4;
    const int nt = K / BK;
    int sR[2], sC[2]; unsigned voffB[2], vA[2][2], nvA[2][2];
#pragma unroll
    for (int i = 0; i < 2; ++i) { int R, C; stage_rc(tid * 16 + i * 8192, R, C); sR[i] = R; sC[i] = C; const int Rb = (R & ~31) + perm32(R & 31); voffB[i] = (unsigned)(Rb * K + C) * 2u; }
    const size_t kstep = (size_t)(BK * 2);
    const size_t hstep = (size_t)HALF * K * 2;
    const unsigned ldsw = (unsigned)wid * 1024u;
    const int aoff = lds_byte(wr * 64 + fr, fq * 8), boff = lds_byte(wc * 32 + fr, fq * 8);
#define PG8_SA(b, h) (((b) * 2 + (h)) * HTB)
#define PG8_SB(b, h) ((4 + (b) * 2 + (h)) * HTB)
#define PG8_STAGE(bufoff, gbase, voff) do { if (ABL != 3) _Pragma("unroll") for (int _i = 0; _i < 2; ++_i) \
        __builtin_amdgcn_global_load_lds((const unsigned*)((const char*)(gbase) + (voff)[_i]), (LAS unsigned*)(lds + (bufoff) + ldsw + _i * 8192), 16, 0, 0); } while (0)
#define PG8_LDA(dst, b, h) do { _Pragma("unroll") for (int m = 0; m < 4; ++m) _Pragma("unroll") for (int k = 0; k < 2; ++k) dst[m][k] = *(const LAS bf16x8*)(lds + PG8_SA(b, h) + aoff + m * 2048 + k * 1024); } while (0)
#define PG8_LDB(dst, b, h) do { _Pragma("unroll") for (int n = 0; n < 2; ++n) _Pragma("unroll") for (int k = 0; k < 2; ++k) dst[n][k] = *(const LAS bf16x8*)(lds + PG8_SB(b, h) + boff + n * 2048 + k * 1024); } while (0)
#define PG8_C8(x) __builtin_shufflevector(__builtin_bit_cast(i32x4, (x)[0]), __builtin_bit_cast(i32x4, (x)[1]), 0, 1, 2, 3, 4, 5, 6, 7)
#define PG8_MMA(ai, bj, At, Bt) do { if (ABL == 2) break; __builtin_amdgcn_s_setprio(1); _Pragma("unroll") for (int m = 0; m < 4; ++m) _Pragma("unroll") for (int n = 0; n < 2; ++n) { \
        if (FP8) asm volatile("v_mfma_scale_f32_16x16x128_f8f6f4 %0, %1, %2, %0, %3, %4 op_sel_hi:[0,0,0]" : "+v"(acc[ai][bj][m][n]) : "v"(PG8_C8(Bt[n])), "v"(PG8_C8(At[m])), "v"(scw), "v"(scx)); \
        else { _Pragma("unroll") for (int k = 0; k < 2; ++k) asm volatile("v_mfma_f32_16x16x32_bf16 %0, %1, %2, %0" : "+v"(acc[ai][bj][m][n]) : "v"(Bt[n][k]), "v"(At[m][k])); } } \
        __builtin_amdgcn_s_setprio(0); } while (0)
#define PG8_WAIT_V(n) asm volatile("s_waitcnt vmcnt(" #n ")" ::: "memory")
#define PG8_WAIT_L(n) asm volatile("s_waitcnt lgkmcnt(" #n ")" ::: "memory")
#define PG8_BAR __builtin_amdgcn_s_barrier()
#define PG8_SCHED __builtin_amdgcn_sched_barrier(0)
#define PG8_AOFF(dst, u) do { _Pragma("unroll") for (int _h = 0; _h < 2; ++_h) _Pragma("unroll") for (int _i = 0; _i < 2; ++_i) \
        dst[_h][_i] = GATHER ? (unsigned)(ab.a_row((u), _h * HALF + sR[_i]) * K + sC[_i]) * 2u : (unsigned)((_h * HALF + sR[_i]) * K + sC[_i]) * 2u; } while (0)
    Unit cur, nxt, nn; int ui = 0;
    if (!S.next(0, cur)) return;
    ab.fill(cur);
    bool has_nn = S.next(1, nn); if (has_nn) ab.fill(nn);
    const int scw = SCW, scx = SCX;
    f32x4 acc[2][2][4][2];
#pragma unroll
    for (int a = 0; a < 2; ++a)
#pragma unroll
        for (int b = 0; b < 2; ++b)
#pragma unroll
            for (int m = 0; m < 4; ++m)
#pragma unroll
                for (int n = 0; n < 2; ++n) acc[a][b][m][n] = (f32x4){0.f, 0.f, 0.f, 0.f};
    bf16x8 At[4][2], B0[2][2], B1[2][2];
    const char* cA = ab.a_base(cur); const char* cB = ab.b_base(cur);
    PG8_AOFF(vA, cur);
    PG8_STAGE(PG8_SB(0, 0), cB, voffB); PG8_STAGE(PG8_SB(0, 1), cB + hstep, voffB); PG8_STAGE(PG8_SA(0, 0), cA, vA[0]); PG8_STAGE(PG8_SA(0, 1), cA, vA[1]);
    if (wr == 1) PG8_BAR;
    PG8_WAIT_V(2); PG8_BAR;
    PG8_STAGE(PG8_SB(1, 0), cB + kstep, voffB); PG8_STAGE(PG8_SA(1, 0), cA + kstep, vA[0]); PG8_STAGE(PG8_SB(1, 1), cB + hstep + kstep, voffB);
    PG8_WAIT_V(6); PG8_BAR;
    for (;;) {
        const bool has_next = has_nn; nxt = nn;
        has_nn = has_next && S.next(ui + 2, nn); if (has_nn) ab.fill(nn);
        const char* nA = has_next ? ab.a_base(nxt) : cA; const char* nB = has_next ? ab.b_base(nxt) : cB;
        if (GATHER) { if (has_next) { PG8_AOFF(nvA, nxt); } else {
#pragma unroll
            for (int h = 0; h < 2; ++h)
#pragma unroll
                for (int i = 0; i < 2; ++i) nvA[h][i] = vA[h][i]; } }
#pragma unroll 1
        for (int t = 0; t < nt; t += 2) {
            const bool last = (t == nt - 2);
            const char* a1 = cA + (size_t)(t + 1) * kstep;
            const char* a2 = last ? nA : cA + (size_t)(t + 2) * kstep; const char* b2 = last ? nB : cB + (size_t)(t + 2) * kstep;
            const char* a3 = a2 + kstep; const char* b3 = b2 + kstep;
            unsigned o2[2][2];
#pragma unroll
            for (int h = 0; h < 2; ++h)
#pragma unroll
                for (int i = 0; i < 2; ++i) o2[h][i] = (GATHER && last) ? nvA[h][i] : vA[h][i];
            PG8_LDB(B0, 0, 0); PG8_LDB(B1, 0, 1); PG8_SCHED; PG8_LDA(At, 0, 0); PG8_STAGE(PG8_SA(1, 1), a1, vA[1]);
            PG8_WAIT_V(8); PG8_WAIT_L(0); PG8_BAR; PG8_MMA(0, 0, At, B0); PG8_MMA(0, 1, At, B1); PG8_BAR; PG8_SCHED;
            PG8_LDA(At, 0, 1); PG8_STAGE(PG8_SB(0, 0), b2, voffB); PG8_STAGE(PG8_SB(0, 1), b2 + hstep, voffB); PG8_STAGE(PG8_SA(0, 0), a2, o2[0]);
            PG8_WAIT_V(8); PG8_WAIT_L(0); PG8_BAR; PG8_MMA(1, 0, At, B0); PG8_MMA(1, 1, At, B1); PG8_BAR; PG8_SCHED;
            PG8_LDB(B0, 1, 0); PG8_LDB(B1, 1, 1); PG8_SCHED; PG8_LDA(At, 1, 0); PG8_STAGE(PG8_SA(0, 1), a2, o2[1]);
            PG8_WAIT_V(8); PG8_WAIT_L(0); PG8_BAR; PG8_MMA(0, 0, At, B0); PG8_MMA(0, 1, At, B1); PG8_BAR; PG8_SCHED;
            PG8_LDA(At, 1, 1); PG8_STAGE(PG8_SB(1, 0), b3, voffB); PG8_STAGE(PG8_SB(1, 1), b3 + hstep, voffB); PG8_STAGE(PG8_SA(1, 0), a3, o2[0]);
            PG8_WAIT_V(8); PG8_WAIT_L(0); PG8_BAR; PG8_MMA(1, 0, At, B0); PG8_MMA(1, 1, At, B1); PG8_BAR; PG8_SCHED;
        }
        if (wr == 0) PG8_BAR;
        asm volatile("s_nop 15\n\ts_nop 15" ::: "memory");
        if (ABL == 1) { _Pragma("unroll") for (int a = 0; a < 2; ++a) _Pragma("unroll") for (int b = 0; b < 2; ++b) _Pragma("unroll") for (int m = 0; m < 4; ++m) _Pragma("unroll") for (int n = 0; n < 2; ++n) asm volatile("" :: "v"(acc[a][b][m][n])); }
        else E(acc, cur, wr, wc, fr, fq);
        if (!has_next) break;
#pragma unroll
        for (int a = 0; a < 2; ++a)
#pragma unroll
            for (int b = 0; b < 2; ++b)
#pragma unroll
                for (int m = 0; m < 4; ++m)
#pragma unroll
                    for (int n = 0; n < 2; ++n) acc[a][b][m][n] = (f32x4){0.f, 0.f, 0.f, 0.f};
        cur = nxt; cA = nA; cB = nB; ++ui;
        if (GATHER) {
#pragma unroll
            for (int h = 0; h < 2; ++h)
#pragma unroll
                for (int i = 0; i < 2; ++i) vA[h][i] = nvA[h][i]; }
        if (wr == 1) PG8_BAR;
    }
    PG8_WAIT_V(0);
    PG8_BAR;
#undef PG8_SA
#undef PG8_SB
#undef PG8_STAGE
#undef PG8_LDA
#undef PG8_LDB
#undef PG8_MMA
#undef PG8_C8
#undef PG8_WAIT_V
#undef PG8_WAIT_L
#undef PG8_BAR
#undef PG8_SCHED
#undef PG8_AOFF
}
__device__ __forceinline__ unsigned cvt_pk_bf16(float lo, float hi) { unsigned r; asm volatile("v_cvt_pk_bf16_f32 %0, %1, %2" : "=v"(r) : "v"(lo), "v"(hi)); return r; }
struct ABDense { const bf16* A; const bf16* Bt; int K;
    __device__ __forceinline__ const char* a_base(const Unit& u) const { return (const char*)(A + (size_t)u.pm * BM * K); }
    __device__ __forceinline__ const char* b_base(const Unit& u) const { return (const char*)(Bt + (size_t)u.pn * BM * K); }
    __device__ __forceinline__ void fill(Unit& u) const { u.e = 0; u.pos0 = 0; u.cnt = 0; }
    __device__ __forceinline__ int a_row(const Unit&, int) const { return 0; } };
struct EpiStoreT { bf16* O; int ldo;
    __device__ __forceinline__ void operator()(const f32x4 (&acc)[2][2][4][2], const Unit& u, int wr, int wc, int fr, int fq) const {
        const int row0 = u.pm * BM + wr * 64 + fr, col0 = u.pn * BM + wc * 32 + 8 * fq;
#pragma unroll
        for (int ai = 0; ai < 2; ++ai)
#pragma unroll
            for (int m = 0; m < 4; ++m) { bf16* rowp = O + (size_t)(row0 + ai * HALF + m * 16) * ldo + col0;
#pragma unroll
                for (int bj = 0; bj < 2; ++bj) { const f32x4 v0 = acc[ai][bj][m][0], v1 = acc[ai][bj][m][1];
                    u32x4 w; w.x = cvt_pk_bf16(v0[0], v0[1]); w.y = cvt_pk_bf16(v0[2], v0[3]); w.z = cvt_pk_bf16(v1[0], v1[1]); w.w = cvt_pk_bf16(v1[2], v1[3]);
                    *(u32x4*)(rowp + bj * HALF) = w; } }
    } };
struct ABMoe1 { const unsigned char* H; const unsigned char* W; const i32x4* tdesc; const int* list_a;
    __device__ __forceinline__ void fill(Unit& u) const { const i32x4 d = tdesc[u.pm]; u.e = d.x; u.pos0 = d.y; u.cnt = d.z; }
    __device__ __forceinline__ const char* a_base(const Unit&) const { return (const char*)H; }
    __device__ __forceinline__ const char* b_base(const Unit& u) const { return (const char*)(W + (size_t)u.e * 2048 * 1024 + (size_t)u.pn * BM * 1024); }
    __device__ __forceinline__ int a_row(const Unit& u, int rt) const { const int pos = u.pos0 + rt; const bool ok = pos < u.cnt;
        const int a = list_a[(size_t)u.e * T + (ok ? pos : 0)]; return ok ? (a >> 2) : 0; } };
struct ABMoe2 { const unsigned char* A; const unsigned char* W; const i32x4* tdesc;
    __device__ __forceinline__ void fill(Unit& u) const { const i32x4 d = tdesc[u.pm]; u.e = d.x; u.pos0 = d.y; u.cnt = d.z; }
    __device__ __forceinline__ const char* a_base(const Unit& u) const { return (const char*)(A + (size_t)u.pm * BM * 1024); }
    __device__ __forceinline__ const char* b_base(const Unit& u) const { return (const char*)(W + (size_t)u.e * 1024 * 1024 + (size_t)u.pn * BM * 1024); }
    __device__ __forceinline__ int a_row(const Unit&, int) const { return 0; } };
struct EpiSwigluT { unsigned char* Aout; const float* b1;
    __device__ __forceinline__ void operator()(const f32x4 (&acc)[2][2][4][2], const Unit& u, int wr, int wc, int fr, int fq) const {
        const int row0 = u.pm * BM + wr * 64 + fr, j0 = u.pn * HALF + wc * 32 + 8 * fq;
        const float* bp = b1 + (size_t)u.e * 2048 + 2 * j0;
        f32x4 bb[4];
#pragma unroll
        for (int q = 0; q < 4; ++q) bb[q] = *(const f32x4*)(bp + 4 * q);
#pragma unroll
        for (int ai = 0; ai < 2; ++ai)
#pragma unroll
            for (int m = 0; m < 4; ++m) {
                const f32x4 g0 = acc[ai][0][m][0], g1 = acc[ai][0][m][1], l0 = acc[ai][1][m][0], l1 = acc[ai][1][m][1];
                u32x2 w;
                w.x = pk4_fp8_nc(swiglu_s(g0[0] + bb[0][0], l0[0] + bb[0][1]), swiglu_s(g0[1] + bb[0][2], l0[1] + bb[0][3]),
                                 swiglu_s(g0[2] + bb[1][0], l0[2] + bb[1][1]), swiglu_s(g0[3] + bb[1][2], l0[3] + bb[1][3]));
                w.y = pk4_fp8_nc(swiglu_s(g1[0] + bb[2][0], l1[0] + bb[2][1]), swiglu_s(g1[1] + bb[2][2], l1[1] + bb[2][3]),
                                 swiglu_s(g1[2] + bb[3][0], l1[2] + bb[3][1]), swiglu_s(g1[3] + bb[3][2], l1[3] + bb[3][3]));
                *(u32x2*)(Aout + (size_t)(row0 + ai * HALF + m * 16) * FF + j0) = w; }
    } };
struct EpiMoe2T { unsigned char* ys; const float* b2; const int* list_a; const float* list_g;
    __device__ __forceinline__ void operator()(const f32x4 (&acc)[2][2][4][2], const Unit& u, int wr, int wc, int fr, int fq) const {
        const int e = u.e, cnt = u.cnt, pos0 = u.pos0 + wr * 64 + fr, col0 = u.pn * BM + wc * 32 + 8 * fq;
        const float* bp = b2 + (size_t)e * D + col0;
        f32x4 bv[2][2];
#pragma unroll
        for (int bj = 0; bj < 2; ++bj)
#pragma unroll
            for (int n = 0; n < 2; ++n) bv[bj][n] = *(const f32x4*)(bp + bj * HALF + 4 * n);
        int asgv[2][4]; float gv[2][4];
#pragma unroll
        for (int ai = 0; ai < 2; ++ai)
#pragma unroll
            for (int m = 0; m < 4; ++m) { const int pos = pos0 + ai * HALF + m * 16; const int pc = pos < cnt ? pos : 0;
                const int a = list_a[(size_t)e * T + pc]; gv[ai][m] = list_g[(size_t)e * T + pc]; asgv[ai][m] = pos < cnt ? a : -1; }
#pragma unroll
        for (int ai = 0; ai < 2; ++ai)
#pragma unroll
            for (int m = 0; m < 4; ++m) { const int asg = asgv[ai][m]; const float g = gv[ai][m];
                if (asg >= 0) { unsigned char* rowp = ys + (size_t)asg * D + col0; const float gs = g * Y8_SCALE;
#pragma unroll
                    for (int bj = 0; bj < 2; ++bj) { const f32x4 v0 = (acc[ai][bj][m][0] + bv[bj][0]) * gs, v1 = (acc[ai][bj][m][1] + bv[bj][1]) * gs;
                        u32x2 w; w.x = pk4_fp8(v0[0], v0[1], v0[2], v0[3]); w.y = pk4_fp8(v1[0], v1[1], v1[2], v1[3]);
                        *(u32x2*)(rowp + bj * HALF) = w; } } }
    } };
}

__device__ __forceinline__ void attn_unit(const Frame& F, int u) {
    const int qblk = u & 127, kvh = (u >> 7) & 1, b = u >> 8;
    LAS unsigned char* Ks = F.lds; LAS unsigned char* Vs = F.lds + 256 * 144;
    const bf16* proj = WSP(bf16, WS_PROJ); bf16* mix = WSP(bf16, WS_MIX);
    const int tok0 = b * S + qblk * 128;
#pragma unroll
    for (int i = 0; i < 4; ++i) {
        const int cid = F.tid + 512 * i, row = cid >> 3, ch = cid & 7;
        u32x4 kv = (u32x4){0u, 0u, 0u, 0u}, vv = (u32x4){0u, 0u, 0u, 0u};
        if (qblk > 0 || row >= 128) {
            const bf16* rp = proj + (size_t)(tok0 - 128 + row) * INP;
            kv = *(const u32x4*)(rp + AK_OFF + kvh * 64 + ch * 8);
            vv = *(const u32x4*)(rp + AV_OFF + kvh * 64 + ch * 8);
        }
        *(LAS u32x4*)(Ks + row * 144 + ch * 16) = kv;
        *(LAS u32x4*)(Vs + row * 144 + ch * 16) = vv;
    }
    __syncthreads();
    const int g = F.wave >> 1, hw = F.wave & 1, hq = kvh * 4 + g;
    const int lane = F.lane, fr = lane & 15, fq = lane >> 4;
    const float sink = F.sinks[hq];
    const float NEG_INF = -__builtin_inff();
    const bf16* qbase = proj + (size_t)(tok0 + 64 * hw + fr) * INP + AQ_OFF + hq * 64 + 8 * fq;
    bf16x8 nq0 = *(const bf16x8*)qbase, nq1 = *(const bf16x8*)(qbase + 32);
    for (int qb = 0; qb < 4; ++qb) {
        const int i = 64 * hw + 16 * qb + fr;
        const bf16x8 q0 = nq0, q1 = nq1;
        { const bf16* qn = qbase + (size_t)(16 * (qb < 3 ? qb + 1 : qb)) * INP; nq0 = *(const bf16x8*)qn; nq1 = *(const bf16x8*)(qn + 32); }
        f32x4 st[12];
#pragma unroll
        for (int kt = 0; kt < 12; ++kt) {
            LAS const unsigned char* kp = Ks + (64 * hw + 16 * kt + fr) * 144 + fq * 16;
            const bf16x8 k0 = *(LAS const bf16x8*)kp, k1 = *(LAS const bf16x8*)(kp + 64);
            f32x4 z = (f32x4){0.f, 0.f, 0.f, 0.f}; z = MFMA(k0, q0, z); z = MFMA(k1, q1, z); st[kt] = z;
        }
        float mx = NEG_INF;
#pragma unroll
        for (int kt = 0; kt < 12; ++kt)
#pragma unroll
            for (int r = 0; r < 4; ++r) {
                const int j = 64 * hw + 16 * kt + 4 * fq + r, rel = i + 128 - j;
                const bool ok = (rel >= 0) && (rel < 128) && (qblk > 0 || j >= 128);
                const float s = ok ? st[kt][r] * 0.125f : NEG_INF;
                st[kt][r] = s; mx = fmaxf(mx, s);
            }
        mx = fmaxf(mx, __shfl_xor(mx, 16)); mx = fmaxf(mx, __shfl_xor(mx, 32)); mx = fmaxf(mx, sink);
        float sum = 0.f;
#pragma unroll
        for (int kt = 0; kt < 12; ++kt)
#pragma unroll
            for (int r = 0; r < 4; ++r) { const float p = __expf(st[kt][r] - mx); st[kt][r] = p; sum += p; }
        sum += __shfl_xor(sum, 16); sum += __shfl_xor(sum, 32); sum += __expf(sink - mx);
        const float inv = 1.f / sum;
        f32x4 o[4];
#pragma unroll
        for (int c = 0; c < 4; ++c) o[c] = (f32x4){0.f, 0.f, 0.f, 0.f};
#pragma unroll
        for (int ks = 0; ks < 6; ++ks) {
            const bf16x8 pf = pack8(st[2 * ks], st[2 * ks + 1]);
            const int rb = 64 * hw + 32 * ks + 4 * fq + (fr >> 2);
#pragma unroll
            for (int c = 0; c < 4; ++c) {
                LAS const unsigned char* vp = Vs + rb * 144 + (16 * c + 4 * (lane & 3)) * 2;
                const bf16x8 vf = cat8(trr(vp), trr(vp + 16 * 144));
                o[c] = MFMA(pf, vf, o[c]);
            }
        }
#pragma unroll
        for (int r = 0; r < 4; ++r) {
            const int qrow = 4 * fq + r; const float iv = __shfl(inv, qrow);
            bf16* op = mix + (size_t)(tok0 + 64 * hw + 16 * qb + qrow) * D + hq * 64 + fr;
#pragma unroll
            for (int c = 0; c < 4; ++c) op[16 * c] = (bf16)f2bf(o[c][r] * iv);
        }
    }
    __syncthreads();
}

__device__ __forceinline__ void gla_gate_prefix(const Frame& F, const bf16* proj, int t0, int h, LAS float* ga_s, LAS float* tot_s, float (&bv)[8], float& b_mid, float& b_last) {
#pragma unroll
    for (int i = 0; i < 2; ++i) { const int idx = F.tid + 512 * i, t = idx >> 4, r = idx & 15; ga_s[idx] = bf2f(proj[(size_t)(t0 + t) * INP + GA_OFF + r]); }
    float wu[16];
#pragma unroll
    for (int r = 0; r < 16; ++r) wu[r] = F.w_gate_up[r * 256 + h * 64 + F.lane];
    const float bg = F.b_gate[h * 64 + F.lane];
    __syncthreads();
    float run = 0.f;
#pragma unroll
    for (int i = 0; i < 8; ++i) {
        const int t = 8 * F.wave + i; float z = bg;
#pragma unroll
        for (int r = 0; r < 16; ++r) z += ga_s[t * 16 + r] * wu[r];
        const float ls = fminf(z, 0.f) - __logf(1.f + __expf(-fabsf(z)));
        run += ls * (1.f / 16.f); bv[i] = run;
    }
    tot_s[F.wave * 64 + F.lane] = run;
    __syncthreads();
    float pre = 0.f, mid = 0.f, all = 0.f;
#pragma unroll
    for (int w = 0; w < 8; ++w) { const float tv = tot_s[w * 64 + F.lane]; pre += (w < F.wave) ? tv : 0.f; mid += (w < 4) ? tv : 0.f; all += tv; }
#pragma unroll
    for (int i = 0; i < 8; ++i) bv[i] += pre;
    b_mid = mid; b_last = all;
}
__device__ __forceinline__ void gla_kv_unit(const Frame& F, int u) {
    const int h = u & 3, n = (u >> 2) & 255, b = u >> 10, t0 = b * S + n * 64;
    const bf16* proj = WSP(bf16, WS_PROJ);
    LAS unsigned char* kd_s = F.lds; LAS unsigned char* v_s = F.lds + 9216;
    LAS float* ga_s = (LAS float*)(F.lds + 26624); LAS float* tot_s = (LAS float*)(F.lds + 30720);
    const int lane = F.lane, fr = lane & 15, fq = lane >> 4;
#pragma unroll
    for (int i = 0; i < 2; ++i) { const int cid = F.tid + 512 * i, row = cid >> 4, ch = cid & 15;
        *(LAS u32x4*)(v_s + row * 272 + ch * 16) = *(const u32x4*)(proj + (size_t)(t0 + row) * INP + GV_OFF + h * 128 + ch * 8); }
    float bv[8], b_mid, b_last;
    gla_gate_prefix(F, proj, t0, h, ga_s, tot_s, bv, b_mid, b_last);
#pragma unroll
    for (int i = 0; i < 8; ++i) { const int t = 8 * F.wave + i;
        const float kx = bf2f(proj[(size_t)(t0 + t) * INP + GK_OFF + h * 64 + lane]);
        *(LAS bf16*)(kd_s + t * 144 + lane * 2) = (bf16)f2bf(kx * __expf(b_last - bv[i])); }
    if (F.wave == 0) WSP(float, WS_DECAY)[((size_t)(b * NCH + n) * 4 + h) * 64 + lane] = __expf(b_last);
    __syncthreads();
    const int c = F.wave;
    f32x4 acc[4];
#pragma unroll
    for (int d = 0; d < 4; ++d) acc[d] = (f32x4){0.f, 0.f, 0.f, 0.f};
#pragma unroll
    for (int ks = 0; ks < 2; ++ks) {
        const int rb = 32 * ks + 8 * fq + (fr >> 2);
        LAS const unsigned char* vp = v_s + rb * 272 + (16 * c + 4 * (lane & 3)) * 2;
        const bf16x8 vf = cat8(trr(vp), trr(vp + 4 * 272));
#pragma unroll
        for (int d = 0; d < 4; ++d) {
            LAS const unsigned char* kp = kd_s + rb * 144 + (16 * d + 4 * (lane & 3)) * 2;
            const bf16x8 kf = cat8(trr(kp), trr(kp + 4 * 144));
            acc[d] = MFMA(kf, vf, acc[d]);
        }
    }
    float* kvp = WSP(float, WS_KV) + (((size_t)(b * NCH + n) * 4 + h) * 128 + 16 * c + fr) * 64;
#pragma unroll
    for (int d = 0; d < 4; ++d) *(f32x4*)(kvp + 16 * d + 4 * fq) = acc[d];
    __syncthreads();
}
__device__ __forceinline__ void gla_scan(const Frame& F) {
    float* kv = WSP(float, WS_KV); const float* decay = WSP(float, WS_DECAY);
    if (F.tid >= 256) return;
    for (int idx = F.bx * 256 + F.tid; idx < 65536; idx += F.G * 256) {
        const int b = idx >> 15, h = (idx >> 13) & 3, dvdk = idx & 8191, dk = idx & 63;
        float* p = kv + ((size_t)(b * NCH) * 4 + h) * 8192 + dvdk;
        const float* dp = decay + ((size_t)(b * NCH) * 4 + h) * 64 + dk;
        float state = 0.f;
        for (int n = 0; n < NCH; n += 8) {
            float tv[8], dv[8];
#pragma unroll
            for (int i = 0; i < 8; ++i) { tv[i] = p[(size_t)(n + i) * 4 * 8192]; dv[i] = dp[(size_t)(n + i) * 4 * 64]; }
#pragma unroll
            for (int i = 0; i < 8; ++i) { p[(size_t)(n + i) * 4 * 8192] = state; state = dv[i] * state + tv[i]; }
        }
    }
}
__device__ __forceinline__ void gla_out_unit(const Frame& F, int u) {
    const int h = u & 3, n = (u >> 2) & 255, b = u >> 10, t0 = b * S + n * 64;
    const bf16* proj = WSP(bf16, WS_PROJ); bf16* mix = WSP(bf16, WS_MIX);
    LAS unsigned char* qd_s = F.lds; LAS unsigned char* kk_s = F.lds + 9216; LAS unsigned char* qe_s = F.lds + 18432;
    LAS unsigned char* v_s = F.lds + 27648; LAS unsigned char* st_s = F.lds + 45056;
    LAS float* ga_s = (LAS float*)(F.lds + 63488); LAS float* tot_s = (LAS float*)(F.lds + 67584); LAS float* ssq_s = (LAS float*)(F.lds + 69632);
    const int lane = F.lane, fr = lane & 15, fq = lane >> 4;
#pragma unroll
    for (int i = 0; i < 2; ++i) { const int cid = F.tid + 512 * i, row = cid >> 4, ch = cid & 15;
        *(LAS u32x4*)(v_s + row * 272 + ch * 16) = *(const u32x4*)(proj + (size_t)(t0 + row) * INP + GV_OFF + h * 128 + ch * 8); }
    const float* stg = WSP(float, WS_KV) + ((size_t)(b * NCH + n) * 4 + h) * 8192;
#pragma unroll
    for (int i = 0; i < 4; ++i) { const int i4 = F.tid + 512 * i, dv = i4 >> 4, dk4 = (i4 & 15) * 4;
        const f32x4 sv = *(const f32x4*)(stg + dv * 64 + dk4);
        u32x2 w; w.x = pk2(sv[0], sv[1]); w.y = pk2(sv[2], sv[3]);
        *(LAS u32x2*)(st_s + dv * 144 + dk4 * 2) = w; }
    float bv[8], b_mid, b_last;
    gla_gate_prefix(F, proj, t0, h, ga_s, tot_s, bv, b_mid, b_last);
#pragma unroll
    for (int i = 0; i < 8; ++i) { const int t = 8 * F.wave + i; const bf16* rp = proj + (size_t)(t0 + t) * INP + h * 64 + lane;
        const float qx = bf2f(rp[GQ_OFF]) * 0.125f, kx = bf2f(rp[GK_OFF]);
        *(LAS bf16*)(qd_s + t * 144 + lane * 2) = (bf16)f2bf(qx * __expf(bv[i] - b_mid));
        *(LAS bf16*)(kk_s + t * 144 + lane * 2) = (bf16)f2bf(kx * __expf(b_mid - bv[i]));
        *(LAS bf16*)(qe_s + t * 144 + lane * 2) = (bf16)f2bf(qx * __expf(bv[i])); }
    __syncthreads();
    const int ib = F.wave >> 1, dvh = F.wave & 1;
    bf16x8 qdf[2], qef[2];
#pragma unroll
    for (int ks = 0; ks < 2; ++ks) { qdf[ks] = *(LAS const bf16x8*)(qd_s + (16 * ib + fr) * 144 + (32 * ks + 8 * fq) * 2);
                                     qef[ks] = *(LAS const bf16x8*)(qe_s + (16 * ib + fr) * 144 + (32 * ks + 8 * fq) * 2); }
    f32x4 at[4];
#pragma unroll
    for (int jt = 0; jt < 4; ++jt) {
        LAS const unsigned char* kp = kk_s + (16 * jt + fr) * 144 + (8 * fq) * 2;
        const bf16x8 k0 = *(LAS const bf16x8*)kp, k1 = *(LAS const bf16x8*)(kp + 64);
        f32x4 z = (f32x4){0.f, 0.f, 0.f, 0.f}; z = MFMA(k0, qdf[0], z); z = MFMA(k1, qdf[1], z);
#pragma unroll
        for (int r = 0; r < 4; ++r) if (16 * jt + 4 * fq + r > 16 * ib + fr) z[r] = 0.f;
        at[jt] = z;
    }
    bf16x8 pf[2];
    pf[0] = pack8(at[0], at[1]); pf[1] = pack8(at[2], at[3]);
    f32x4 o[4];
#pragma unroll
    for (int c = 0; c < 4; ++c) {
        const int dvt = 4 * dvh + c; f32x4 z = (f32x4){0.f, 0.f, 0.f, 0.f};
#pragma unroll
        for (int ks = 0; ks < 2; ++ks) {
            const int rb = 32 * ks + 4 * fq + (fr >> 2);
            LAS const unsigned char* vp = v_s + rb * 272 + (16 * dvt + 4 * (lane & 3)) * 2;
            z = MFMA(pf[ks], cat8(trr(vp), trr(vp + 16 * 272)), z);
        }
#pragma unroll
        for (int ks = 0; ks < 2; ++ks) {
            const bf16x8 sf = *(LAS const bf16x8*)(st_s + (16 * dvt + fr) * 144 + (32 * ks + 8 * fq) * 2);
            z = MFMA(qef[ks], sf, z);
        }
        o[c] = z;
    }
    float ssq[4];
#pragma unroll
    for (int r = 0; r < 4; ++r) { float s = 0.f;
#pragma unroll
        for (int c = 0; c < 4; ++c) s += o[c][r] * o[c][r];
        s += __shfl_xor(s, 1); s += __shfl_xor(s, 2); s += __shfl_xor(s, 4); s += __shfl_xor(s, 8);
        ssq[r] = s; if (fr == 0) ssq_s[F.wave * 16 + 4 * fq + r] = s; }
    __syncthreads();
#pragma unroll
    for (int r = 0; r < 4; ++r) {
        const float tot = ssq[r] + ssq_s[(F.wave ^ 1) * 16 + 4 * fq + r];
        const float rinv = rsqrtf(tot * (1.f / 128.f) + EPS);
        const int t = t0 + 16 * ib + 4 * fq + r;
#pragma unroll
        for (int c = 0; c < 4; ++c) { const int dv = 16 * (4 * dvh + c) + fr;
            const float gg = bf2f(proj[(size_t)t * INP + GG_OFF + h * 128 + dv]);
            const float val = o[c][r] * rinv * F.g_gla_norm[dv] * (gg / (1.f + __expf(-gg)));
            mix[(size_t)t * D + 512 + h * 128 + dv] = (bf16)f2bf(val); }
    }
    __syncthreads();
}

template <bool OUT>
__device__ __forceinline__ void gla_super_unit(const Frame& F, int u) {
    const int sc = u & 31, h = (u >> 5) & 3, b = u >> 7;
    const bf16* proj = WSP(bf16, WS_PROJ); bf16* mix = WSP(bf16, WS_MIX);
    LAS unsigned char* qd_s = F.lds; LAS unsigned char* kk_s = F.lds + 9216; LAS unsigned char* qe_s = F.lds + 18432;
    LAS unsigned char* v_s = F.lds + 27648; LAS unsigned char* st_s = F.lds + 45056; LAS unsigned char* kd_s = F.lds + 63488;
    LAS float* ga_s = (LAS float*)(F.lds + 72704); LAS float* tot_s = (LAS float*)(F.lds + 76800); LAS float* ssq_s = (LAS float*)(F.lds + 78848); LAS float* dec_s = (LAS float*)(F.lds + 79360);
    const int lane = F.lane, fr = lane & 15, fq = lane >> 4;
    const int ib = F.wave >> 1, dvh = F.wave & 1;
    float wu[16];
#pragma unroll
    for (int r = 0; r < 16; ++r) wu[r] = F.w_gate_up[r * 256 + h * 64 + lane];
    const float bg = F.b_gate[h * 64 + lane];
    float gn[4];
#pragma unroll
    for (int cc = 0; cc < 4; ++cc) gn[cc] = OUT ? F.g_gla_norm[16 * (4 * dvh + cc) + fr] : 0.f;
    float* Sg = WSP(float, WS_KV) + (size_t)u * 8192 + (16 * F.wave + fr) * 64 + 4 * fq;
    f32x4 St[4];
#pragma unroll
    for (int d = 0; d < 4; ++d) St[d] = OUT ? *(const f32x4*)(Sg + 16 * d) : (f32x4){0.f, 0.f, 0.f, 0.f};
    float ltot = 0.f;
    u32x4 v_r[2]; unsigned ga_r[2], k_r[8], q_r[8], gg_r[16];
#define GLA_LOAD_CHUNK(tc0) do { \
        _Pragma("unroll") for (int i = 0; i < 2; ++i) { const int cid = F.tid + 512 * i, row = cid >> 4, ch = cid & 15; v_r[i] = *(const u32x4*)(proj + (size_t)((tc0) + row) * INP + GV_OFF + h * 128 + ch * 8); } \
        _Pragma("unroll") for (int i = 0; i < 2; ++i) { const int idx = F.tid + 512 * i, t = idx >> 4, r = idx & 15; ga_r[i] = proj[(size_t)((tc0) + t) * INP + GA_OFF + r]; } \
        _Pragma("unroll") for (int i = 0; i < 8; ++i) { const bf16* rp = proj + (size_t)((tc0) + 8 * F.wave + i) * INP + h * 64 + lane; k_r[i] = rp[GK_OFF]; if (OUT) q_r[i] = rp[GQ_OFF]; } \
        if (OUT) { _Pragma("unroll") for (int r = 0; r < 4; ++r) _Pragma("unroll") for (int cc = 0; cc < 4; ++cc) \
            gg_r[r * 4 + cc] = proj[(size_t)((tc0) + 16 * ib + 4 * fq + r) * INP + GG_OFF + h * 128 + 16 * (4 * dvh + cc) + fr]; } } while (0)
    const int tu0 = b * S + sc * 512;
    GLA_LOAD_CHUNK(tu0);
    for (int c = 0; c < 8; ++c) {
        const int t0 = tu0 + c * 64;
#pragma unroll
        for (int i = 0; i < 2; ++i) { const int cid = F.tid + 512 * i, row = cid >> 4, ch = cid & 15; *(LAS u32x4*)(v_s + row * 272 + ch * 16) = v_r[i]; }
#pragma unroll
        for (int i = 0; i < 2; ++i) ga_s[F.tid + 512 * i] = bf2f(ga_r[i]);
        float kx[8], qx[8], ggf[16];
#pragma unroll
        for (int i = 0; i < 8; ++i) { kx[i] = bf2f(k_r[i]); qx[i] = OUT ? bf2f(q_r[i]) * 0.125f : 0.f; }
#pragma unroll
        for (int i = 0; i < 16; ++i) ggf[i] = OUT ? bf2f(gg_r[i]) : 0.f;
        if (c < 7) GLA_LOAD_CHUNK(t0 + 64);
        __syncthreads();
        float bv[8]; float run = 0.f;
#pragma unroll
        for (int i = 0; i < 8; ++i) {
            const int t = 8 * F.wave + i; float z = bg;
#pragma unroll
            for (int r = 0; r < 16; ++r) z += ga_s[t * 16 + r] * wu[r];
            const float ls = fminf(z, 0.f) - __logf(1.f + __expf(-fabsf(z)));
            run += ls * (1.f / 16.f); bv[i] = run;
        }
        tot_s[F.wave * 64 + lane] = run;
        if (OUT) {
#pragma unroll
            for (int d = 0; d < 4; ++d) { u32x2 w; w.x = pk2(St[d][0], St[d][1]); w.y = pk2(St[d][2], St[d][3]);
                *(LAS u32x2*)(st_s + (16 * F.wave + fr) * 144 + (16 * d + 4 * fq) * 2) = w; }
        }
        __syncthreads();
        float pre = 0.f, b_mid = 0.f, b_last = 0.f;
#pragma unroll
        for (int w = 0; w < 8; ++w) { const float tv = tot_s[w * 64 + lane]; pre += (w < F.wave) ? tv : 0.f; b_mid += (w < 4) ? tv : 0.f; b_last += tv; }
        ltot += b_last;
#pragma unroll
        for (int i = 0; i < 8; ++i) { const int t = 8 * F.wave + i; const float bb = bv[i] + pre;
            *(LAS bf16*)(kd_s + t * 144 + lane * 2) = (bf16)f2bf(kx[i] * __expf(b_last - bb));
            if (OUT) {
                *(LAS bf16*)(qd_s + t * 144 + lane * 2) = (bf16)f2bf(qx[i] * __expf(bb - b_mid));
                *(LAS bf16*)(kk_s + t * 144 + lane * 2) = (bf16)f2bf(kx[i] * __expf(b_mid - bb));
                *(LAS bf16*)(qe_s + t * 144 + lane * 2) = (bf16)f2bf(qx[i] * __expf(bb)); } }
        if (F.wave == 0) dec_s[lane] = __expf(b_last);
        __syncthreads();
        if (OUT) {
            bf16x8 qdf[2], qef[2];
#pragma unroll
            for (int ks = 0; ks < 2; ++ks) { qdf[ks] = *(LAS const bf16x8*)(qd_s + (16 * ib + fr) * 144 + (32 * ks + 8 * fq) * 2);
                                             qef[ks] = *(LAS const bf16x8*)(qe_s + (16 * ib + fr) * 144 + (32 * ks + 8 * fq) * 2); }
            f32x4 at[4];
#pragma unroll
            for (int jt = 0; jt < 4; ++jt) {
                LAS const unsigned char* kp = kk_s + (16 * jt + fr) * 144 + (8 * fq) * 2;
                const bf16x8 k0 = *(LAS const bf16x8*)kp, k1 = *(LAS const bf16x8*)(kp + 64);
                f32x4 z = (f32x4){0.f, 0.f, 0.f, 0.f}; z = MFMA(k0, qdf[0], z); z = MFMA(k1, qdf[1], z);
#pragma unroll
                for (int r = 0; r < 4; ++r) if (16 * jt + 4 * fq + r > 16 * ib + fr) z[r] = 0.f;
                at[jt] = z;
            }
            bf16x8 pf[2];
            pf[0] = pack8(at[0], at[1]); pf[1] = pack8(at[2], at[3]);
            f32x4 o[4];
#pragma unroll
            for (int cc = 0; cc < 4; ++cc) {
                const int dvt = 4 * dvh + cc; f32x4 z = (f32x4){0.f, 0.f, 0.f, 0.f};
#pragma unroll
                for (int ks = 0; ks < 2; ++ks) {
                    const int rb = 32 * ks + 4 * fq + (fr >> 2);
                    LAS const unsigned char* vp = v_s + rb * 272 + (16 * dvt + 4 * (lane & 3)) * 2;
                    z = MFMA(pf[ks], cat8(trr(vp), trr(vp + 16 * 272)), z);
                }
#pragma unroll
                for (int ks = 0; ks < 2; ++ks) {
                    const bf16x8 sf = *(LAS const bf16x8*)(st_s + (16 * dvt + fr) * 144 + (32 * ks + 8 * fq) * 2);
                    z = MFMA(qef[ks], sf, z);
                }
                o[cc] = z;
            }
            float ssq[4];
#pragma unroll
            for (int r = 0; r < 4; ++r) { float sq = 0.f;
#pragma unroll
                for (int cc = 0; cc < 4; ++cc) sq += o[cc][r] * o[cc][r];
                sq += __shfl_xor(sq, 1); sq += __shfl_xor(sq, 2); sq += __shfl_xor(sq, 4); sq += __shfl_xor(sq, 8);
                ssq[r] = sq; if (fr == 0) ssq_s[F.wave * 16 + 4 * fq + r] = sq; }
            __syncthreads();
#pragma unroll
            for (int r = 0; r < 4; ++r) {
                const float tot = ssq[r] + ssq_s[(F.wave ^ 1) * 16 + 4 * fq + r];
                const float rinv = rsqrtf(tot * (1.f / 128.f) + EPS);
                const int t = t0 + 16 * ib + 4 * fq + r;
#pragma unroll
                for (int cc = 0; cc < 4; ++cc) { const int dv = 16 * (4 * dvh + cc) + fr;
                    const float gg = ggf[r * 4 + cc];
                    const float val = o[cc][r] * rinv * gn[cc] * (gg / (1.f + __expf(-gg)));
                    mix[(size_t)t * D + 512 + h * 128 + dv] = (bf16)f2bf(val); }
            }
        }
#pragma unroll
        for (int d = 0; d < 4; ++d) { const f32x4 dc = *(LAS const f32x4*)(dec_s + 16 * d + 4 * fq); St[d] = St[d] * dc; }
#pragma unroll
        for (int ks = 0; ks < 2; ++ks) {
            const int rb = 32 * ks + 8 * fq + (fr >> 2);
            LAS const unsigned char* vp = v_s + rb * 272 + (16 * F.wave + 4 * (lane & 3)) * 2;
            const bf16x8 vf = cat8(trr(vp), trr(vp + 4 * 272));
#pragma unroll
            for (int d = 0; d < 4; ++d) {
                LAS const unsigned char* kp = kd_s + rb * 144 + (16 * d + 4 * (lane & 3)) * 2;
                St[d] = MFMA(cat8(trr(kp), trr(kp + 4 * 144)), vf, St[d]);
            }
        }
        __syncthreads();
    }
#undef GLA_LOAD_CHUNK
    if (!OUT) {
#pragma unroll
        for (int d = 0; d < 4; ++d) *(f32x4*)(Sg + 16 * d) = St[d];
        if (F.wave == 0) WSP(float, WS_DECAY)[u * 64 + lane] = __expf(ltot);
    }
}
__device__ __forceinline__ void gla_super_scan(const Frame& F) {
    float* kv = WSP(float, WS_KV); const float* decay = WSP(float, WS_DECAY);
    if (F.tid >= 256) return;
    for (int idx = F.bx * 256 + F.tid; idx < 65536; idx += F.G * 256) {
        const int bh = idx >> 13, dvdk = idx & 8191, dk = idx & 63;
        float* p = kv + (size_t)(bh * 32) * 8192 + dvdk; const float* dp = decay + (bh * 32) * 64 + dk;
        float tv[32], dv[32];
#pragma unroll
        for (int i = 0; i < 32; ++i) { tv[i] = p[(size_t)i * 8192]; dv[i] = dp[i * 64]; }
        float state = 0.f;
#pragma unroll
        for (int i = 0; i < 32; ++i) { p[(size_t)i * 8192] = state; state = dv[i] * state + tv[i]; }
    }
}

__device__ __forceinline__ void p7_norm_router(const Frame& F) {
    const float* mod = WSP(float, WS_MOD); const bf16* y = WSP(bf16, WS_Y); float* x1 = WSP(float, WS_X1); unsigned char* h2 = WSP(unsigned char, WS_H);
    unsigned* ctl = WSP(unsigned, WS_CTL);
    LAS float* wr_s = (LAS float*)F.lds;
    LAS float* lg_s = (LAS float*)(F.lds + SMALL_OFF);
    LAS float* rx_s = (LAS float*)(F.lds + SMALL_OFF + 16384);
    LAS float* z_s = (LAS float*)(F.lds + SMALL_OFF + 16384 + 512);
    LAS int* cnt_s = (LAS int*)(F.lds + SMALL_OFF + 16384 + 640);
    LAS int* base_s = (LAS int*)(F.lds + SMALL_OFF + 16384 + 768);
    LAS float* zr_s = (LAS float*)(F.lds + SMALL_OFF + 16384 + 1024);
    LAS int* flag_s = (LAS int*)(F.lds + SMALL_OFF + 16384 + 1024 + 2048);
    const int lane = F.lane, fr = lane & 15, fq = lane >> 4;
    const int mb0 = F.bx * 128 + F.wave * 16;
    const float* modb = mod + (mb0 >> 14) * 6144;
#pragma unroll 4
    for (int i = 0; i < 16; ++i) { const int i4 = F.tid + 512 * i, k = i4 >> 3, e0 = (i4 & 7) * 4;
        const f32x4 w = *(const f32x4*)(F.w_router + k * 32 + e0);
        const float gs = F.g_pre_ffn[k] * (1.f + modb[4096 + k]);
        LAS float* dst = wr_s + (k >> 2) * 128 + e0 * 4 + (k & 3);
        dst[0] = w[0] * gs; dst[4] = w[1] * gs; dst[8] = w[2] * gs; dst[12] = w[3] * gs; }
    { const int e = F.tid & 31, ks = F.tid >> 5; float zz = 0.f;
#pragma unroll
        for (int i = 0; i < 64; ++i) { const int k = ks * 64 + i; zz += modb[3072 + k] * F.w_router[k * 32 + e]; }
        zr_s[ks * 32 + e] = zz; }
    if (F.tid < 32) cnt_s[F.tid] = 0;
    __syncthreads();
    if (F.tid < 32) { float zz = F.b_router[F.tid];
#pragma unroll
        for (int i = 0; i < 16; ++i) zz += zr_s[i * 32 + F.tid];
        z_s[F.tid] = zz; }
    f32x4 pg[4], pg2[4], psh[4];
    u32x2 ya[4], yb[4], yc[4], yd[4]; f32x4 xa[4], xbf[4], xc[4], xd[4];
    const bf16* ybase = y + (size_t)mb0 * D + 4 * lane; const float* xbase = F.x + (size_t)mb0 * D + 4 * lane;
#define P7_LOAD(Y, X, r) do { _Pragma("unroll") for (int j = 0; j < 4; ++j) { Y[j] = *(const u32x2*)(ybase + (size_t)(r) * D + 256 * j); X[j] = *(const f32x4*)(xbase + (size_t)(r) * D + 256 * j); } } while (0)
#define P7_ROW(Y, X, it) do { f32x4 xv[4], hv[4]; float ss = 0.f; \
        _Pragma("unroll") for (int j = 0; j < 4; ++j) { hv[j] = unpack4(Y[j]); ss += dot4(hv[j]); } \
        const float ry = rsqrtf(wave_sum(ss) * (1.f / D) + EPS); float s2 = 0.f; \
        _Pragma("unroll") for (int j = 0; j < 4; ++j) { xv[j] = X[j] + hv[j] * ry * pg[j]; s2 += dot4(xv[j]); } \
        const float rx = rsqrtf(wave_sum(s2) * (1.f / D) + EPS); \
        if (lane == 0) rx_s[F.wave * 16 + (it)] = rx; \
        _Pragma("unroll") for (int j = 0; j < 4; ++j) { const int idx = 4 * lane + 256 * j; \
            hv[j] = xv[j] * rx * pg2[j] + psh[j]; \
            *(f32x4*)(x1 + (size_t)(mb0 + (it)) * D + idx) = xv[j]; \
            *(unsigned*)(h2 + (size_t)(mb0 + (it)) * D + idx) = pk4_fp8(hv[j][0] * H8_SCALE, hv[j][1] * H8_SCALE, hv[j][2] * H8_SCALE, hv[j][3] * H8_SCALE); } \
        if ((it) + 4 < 16) P7_LOAD(Y, X, (it) + 4); } while (0)
    P7_LOAD(ya, xa, 0); P7_LOAD(yb, xbf, 1); P7_LOAD(yc, xc, 2); P7_LOAD(yd, xd, 3);
#pragma unroll
    for (int j = 0; j < 4; ++j) { const int idx = 4 * lane + 256 * j;
        pg[j] = *(const f32x4*)(F.g_post_mix + idx) * *(const f32x4*)(modb + 2048 + idx);
        pg2[j] = *(const f32x4*)(F.g_pre_ffn + idx) * (*(const f32x4*)(modb + 4096 + idx) + 1.f); psh[j] = *(const f32x4*)(modb + 3072 + idx); }
#pragma unroll 1
    for (int it = 0; it < 16; it += 4) { P7_ROW(ya, xa, it); P7_ROW(yb, xbf, it + 1); P7_ROW(yc, xc, it + 2); P7_ROW(yd, xd, it + 3); }
#undef P7_LOAD
#undef P7_ROW
    asm volatile("s_waitcnt vmcnt(0)" ::: "memory");
    f32x4 acc0 = (f32x4){0.f, 0.f, 0.f, 0.f}, acc1 = (f32x4){0.f, 0.f, 0.f, 0.f};
    { const float* ap = x1 + (size_t)(mb0 + fr) * D + 4 * fq;
        LAS const float* bp = wr_s + fq * 128 + fr * 4;
        f32x4 a[8], na[8];
#pragma unroll
        for (int q = 0; q < 8; ++q) a[q] = *(const f32x4*)(ap + 16 * q);
        for (int s0 = 0; s0 < 64; s0 += 8) {
            const int sn = s0 < 56 ? s0 + 8 : s0;
#pragma unroll
            for (int q = 0; q < 8; ++q) na[q] = *(const f32x4*)(ap + 16 * (sn + q));
#pragma unroll
            for (int q = 0; q < 8; ++q) { const f32x4 b0 = *(LAS const f32x4*)(bp + (s0 + q) * 512), b1 = *(LAS const f32x4*)(bp + (s0 + q) * 512 + 64);
#pragma unroll
                for (int t = 0; t < 4; ++t) { acc0 = __builtin_amdgcn_mfma_f32_16x16x4f32(a[q][t], b0[t], acc0, 0, 0, 0); acc1 = __builtin_amdgcn_mfma_f32_16x16x4f32(a[q][t], b1[t], acc1, 0, 0, 0); } }
#pragma unroll
            for (int q = 0; q < 8; ++q) a[q] = na[q];
        } }
    __syncthreads();
#pragma unroll
    for (int r = 0; r < 4; ++r) { const float rx = rx_s[F.wave * 16 + 4 * fq + r];
        lg_s[(F.wave * 16 + 4 * fq + r) * 32 + fr] = rx * acc0[r] + z_s[fr];
        lg_s[(F.wave * 16 + 4 * fq + r) * 32 + fr + 16] = rx * acc1[r] + z_s[fr + 16]; }
    const float NEG_INF = -__builtin_inff();
    int se[4], lp[4]; float gt[4];
    if (lane < 16) {
        float v[32];
#pragma unroll
        for (int ch = 0; ch < 8; ++ch) { const f32x4 w = *(LAS const f32x4*)(lg_s + (F.wave * 16 + lane) * 32 + 4 * ch); v[4 * ch] = w[0]; v[4 * ch + 1] = w[1]; v[4 * ch + 2] = w[2]; v[4 * ch + 3] = w[3]; }
        float sv[4];
#pragma unroll
        for (int r = 0; r < 4; ++r) { float best = v[0]; int bi = 0;
#pragma unroll
            for (int e = 1; e < 32; ++e) if (v[e] > best) { best = v[e]; bi = e; }
            se[r] = bi; sv[r] = best;
#pragma unroll
            for (int e = 0; e < 32; ++e) v[e] = (e == bi) ? NEG_INF : v[e]; }
        const float p1 = __expf(sv[1] - sv[0]), p2 = __expf(sv[2] - sv[0]), p3 = __expf(sv[3] - sv[0]);
        const float rs = 1.f / (1.f + p1 + p2 + p3);
        gt[0] = rs; gt[1] = p1 * rs; gt[2] = p2 * rs; gt[3] = p3 * rs;
#pragma unroll
        for (int r = 0; r < 4; ++r) lp[r] = __hip_atomic_fetch_add(cnt_s + se[r], 1, __ATOMIC_RELAXED, __HIP_MEMORY_SCOPE_WORKGROUP);
    }
    __syncthreads();
    if (F.tid < 32) base_s[F.tid] = (int)__hip_atomic_fetch_add(ctl + CW_GCNT + 64 * F.tid, (unsigned)cnt_s[F.tid], __ATOMIC_RELAXED, __HIP_MEMORY_SCOPE_AGENT);
    __syncthreads();
    if (lane < 16) { int* la = WSP(int, WS_LIST_A); float* lgt = WSP(float, WS_LIST_G); const int m = mb0 + lane;
#pragma unroll
        for (int r = 0; r < 4; ++r) { const size_t p = (size_t)se[r] * T + base_s[se[r]] + lp[r]; la[p] = m * 4 + r; lgt[p] = gt[r]; } }
    asm volatile("s_waitcnt vmcnt(0)" ::: "memory");
    __syncthreads();
    if (F.tid == 0) flag_s[0] = (__hip_atomic_fetch_add(ctl + CW_DONE, 1u, __ATOMIC_RELAXED, __HIP_MEMORY_SCOPE_AGENT) == (unsigned)(F.G - 1)) ? 1 : 0;
    __syncthreads();
    if (flag_s[0]) {
        LAS int* off_s = (LAS int*)zr_s;
        if (F.tid < 32) { const int c = (int)__hip_atomic_load(ctl + CW_GCNT + 64 * F.tid, __ATOMIC_RELAXED, __HIP_MEMORY_SCOPE_AGENT); cnt_s[F.tid] = c; ctl[CW_MOE_CNT + F.tid] = (unsigned)c; }
        __syncthreads();
        if (F.tid == 0) { int off = 0; for (int e = 0; e < 32; ++e) { off_s[e] = off; off += (cnt_s[e] + 255) & ~255; } off_s[32] = off; }
        __syncthreads();
        if (F.tid <= 32) WSP(int, WS_MOE_OFF)[F.tid] = off_s[F.tid];
        const int ntile = off_s[32] >> 8;
        for (int rt = F.tid; rt < ntile; rt += NTHREADS) { int e = 0;
            for (int q = 1; q < 32; ++q) e = (off_s[q] <= rt * 256) ? q : e;
            WSP(int, WS_TILE_E)[rt] = e;
            i32x4 dsc; dsc.x = e; dsc.y = rt * 256 - off_s[e]; dsc.z = cnt_s[e]; dsc.w = 0; WSP(i32x4, WS_TDESC)[rt] = dsc; }
    }
}

__device__ __forceinline__ f32x4 unpack4_fp8(unsigned w) {
    const auto lo = __builtin_amdgcn_cvt_pk_f32_fp8((int)w, false), hi = __builtin_amdgcn_cvt_pk_f32_fp8((int)w, true);
    return (f32x4){lo[0], lo[1], hi[0], hi[1]};
}
__device__ __forceinline__ void p11_combine(const Frame& F) {
    const float* mod = WSP(float, WS_MOD); const unsigned char* ys = WSP(unsigned char, WS_YS); const float* x1 = WSP(float, WS_X1);
    const int gw = F.bx * NWAVES + F.wave, m0 = gw * 16, lane = F.lane;
    const float* modb = mod + (m0 >> 14) * 6144;
    const unsigned char* yb = ys + (size_t)m0 * 4 * D + 4 * lane; const float* xb = x1 + (size_t)m0 * D + 4 * lane;
    unsigned ya[4][4], ybb[4][4], yc[4][4], yd[4][4]; f32x4 xa[4], xbf[4], xc[4], xd[4], g[4];
#define P11_LOAD(Y, X, r) do { _Pragma("unroll") for (int j = 0; j < 4; ++j) { X[j] = *(const f32x4*)(xb + (size_t)(r) * D + 256 * j); \
        _Pragma("unroll") for (int k4 = 0; k4 < 4; ++k4) Y[j][k4] = *(const unsigned*)(yb + ((size_t)(r) * 4 + k4) * D + 256 * j); } } while (0)
#define P11_ROW(Y, X, it) do { f32x4 yv[4]; float ss = 0.f; \
        _Pragma("unroll") for (int j = 0; j < 4; ++j) { f32x4 a = (f32x4){0.f, 0.f, 0.f, 0.f}; \
            _Pragma("unroll") for (int k4 = 0; k4 < 4; ++k4) a += unpack4_fp8(Y[j][k4]); \
            yv[j] = a; ss += dot4(a); } \
        const float ry = rsqrtf(wave_sum(ss) * (1.f / D) + EPS * (Y8_SCALE * Y8_SCALE)); \
        _Pragma("unroll") for (int j = 0; j < 4; ++j) *(f32x4*)(F.out + (size_t)(m0 + (it)) * D + 4 * lane + 256 * j) = X[j] + yv[j] * ry * g[j]; \
        if ((it) + 4 < 16) P11_LOAD(Y, X, (it) + 4); } while (0)
    P11_LOAD(ya, xa, 0); P11_LOAD(ybb, xbf, 1); P11_LOAD(yc, xc, 2); P11_LOAD(yd, xd, 3);
#pragma unroll
    for (int j = 0; j < 4; ++j) { const int idx = 4 * lane + 256 * j; g[j] = *(const f32x4*)(F.g_post_ffn + idx) * *(const f32x4*)(modb + 5120 + idx); }
#pragma unroll 1
    for (int it = 0; it < 16; it += 4) { P11_ROW(ya, xa, it); P11_ROW(ybb, xbf, it + 1); P11_ROW(yc, xc, it + 2); P11_ROW(yd, xd, it + 3); }
#undef P11_LOAD
#undef P11_ROW
}

constexpr int NPHASE = 11;
struct Args { const float* in[20]; float* out; unsigned char* ws; int ph_lo, ph_hi; };
__global__ void __launch_bounds__(NTHREADS, 2) fwd(Args args) {
    extern __shared__ __attribute__((aligned(16))) unsigned char lds[];
    Frame F;
    F.lds = (LAS unsigned char*)lds;
    F.tid = threadIdx.x; F.lane = F.tid & 63; F.wave = __builtin_amdgcn_readfirstlane(F.tid >> 6); F.bx = blockIdx.x; F.G = gridDim.x;
    F.x = args.in[0]; F.c = args.in[1]; F.w_ada = args.in[2]; F.b_ada = args.in[3]; F.g_pre_mix = args.in[4]; F.g_post_mix = args.in[5];
    F.g_pre_ffn = args.in[6]; F.g_post_ffn = args.in[7]; F.w_in = args.in[8]; F.w_gate_up = args.in[9]; F.b_gate = args.in[10]; F.g_gla_norm = args.in[11];
    F.sinks = args.in[12]; F.w_out = args.in[13]; F.w_router = args.in[14]; F.b_router = args.in[15]; F.w_mlp1 = args.in[16]; F.b_mlp1 = args.in[17];
    F.w_mlp2 = args.in[18]; F.b_mlp2 = args.in[19]; F.out = args.out; F.ws = args.ws;
    volatile LAS unsigned* MISC = (volatile LAS unsigned*)(F.lds + MISC_OFF);
    if (F.tid < 32) MISC[F.tid] = 0u;
    __syncthreads();
    const int lo = args.ph_lo, hi = args.ph_hi;
    XcdBarrier bar; bar.bar = (unsigned*)(F.ws + WS_CTL) + CW_BAR; bar.x = 0; bar.st = nullptr;
    if (hi - lo > 1) bar = xcd_barrier_post((unsigned*)(F.ws + WS_CTL) + CW_BAR, MISC + 8);
#define IN(k) (lo <= (k) && (k) < hi)
#if DUPMASK
#define REP(k) _Pragma("nounroll") for (int rep_ = 0; rep_ < 1 + ((DUPMASK >> (k)) & 1); ++rep_, __syncthreads())
#else
#define REP(k)
#endif
#define SEAM(k) do { if (IN(k) && IN((k) + 1)) xcd_barrier(bar); } while (0)

    if (IN(0)) { p0_prologue<0>(F);
#if DUPMASK & 1
        __syncthreads(); p0_prologue<P0_MODE>(F);
#endif
    } SEAM(0);
    if (IN(1)) REP(1) { p1_norm(F); } SEAM(1);
    if (IN(2)) {
        constexpr int I_FIRST = 16 * 80 + 16 * 32, I_PER = (NE * 16 * 64 + NE * 16 * 32) / GRID;
        const int grp = F.bx & 3, pos = grp == 0 ? 0 : grp == 1 ? 1 : grp == 2 ? 3 : 4;
        { pg8::StaticOrder So; So.init(T / 256, INP / 256, F.G, F.bx, 0, pos);
          pg8::gemm_phase<false, 0, 0, 0>(F.lds, D, So, pg8::ABDense{WSP(bf16, WS_H), WSP(bf16, WS_WIN), D}, pg8::EpiStoreT{WSP(bf16, WS_PROJ), INP}); }
        __syncthreads();
        tr_range<0>(F, I_FIRST + F.bx * I_PER, I_FIRST + (F.bx + 1) * I_PER);
        __syncthreads();
        { pg8::StaticOrder So; So.init(T / 256, INP / 256, F.G, F.bx, pos);
          pg8::gemm_phase<false, 0, 0, 0>(F.lds, D, So, pg8::ABDense{WSP(bf16, WS_H), WSP(bf16, WS_WIN), D}, pg8::EpiStoreT{WSP(bf16, WS_PROJ), INP}); }
    } SEAM(2);
    if (IN(3)) { for (int u = F.bx; u < 512; u += F.G) attn_unit(F, u);
                 for (int u = F.bx; u < 256; u += F.G) gla_super_unit<false>(F, u);
#if DUPMASK & 8
                 __syncthreads();
                 if (P3_MODE == 0 || P3_MODE == 1) for (int u = F.bx; u < 512; u += F.G) attn_unit(F, u);
                 if (P3_MODE == 0 || P3_MODE == 2) for (int u = F.bx; u < 256; u += F.G) gla_super_unit<false>(F, u);
#endif
    } SEAM(3);
    if (IN(4)) REP(4) { gla_super_scan(F); } SEAM(4);
    if (IN(5)) REP(5) { for (int u = F.bx; u < 256; u += F.G) gla_super_unit<true>(F, u); } SEAM(5);
    if (IN(6)) REP(6) { pg8::StaticOrder So; So.init(T / 256, D / 256, F.G, F.bx);
                 pg8::gemm_phase<false, 0, 0, 0>(F.lds, D, So, pg8::ABDense{WSP(bf16, WS_MIX), WSP(bf16, WS_WOUT), D}, pg8::EpiStoreT{WSP(bf16, WS_Y), D}); } SEAM(6);
    if (IN(7)) { p7_norm_router(F);
#if DUPMASK & 128
        __syncthreads(); p7_norm_router(F);
#endif
    } SEAM(7);
    if (IN(8)) { const int nM = WSP(int, WS_MOE_OFF)[32] >> 8;
                 { pg8::StaticOrder So; So.init(nM, 2048 / 256, F.G, F.bx);
                 pg8::gemm_phase<true, 1, W8_E8M0, H8_E8M0>(F.lds, 512, So, pg8::ABMoe1{WSP(unsigned char, WS_H), WSP(unsigned char, WS_W1T), WSP(i32x4, WS_TDESC), WSP(int, WS_LIST_A)},
                                       pg8::EpiSwigluT{WSP(unsigned char, WS_A), F.b_mlp1}); }
#if DUPMASK & 256
                 __syncthreads();
                 { pg8::StaticOrder So; So.init(nM, 2048 / 256, F.G, F.bx);
                 pg8::gemm_phase<true, 1, W8_E8M0, H8_E8M0, G1_ABL>(F.lds, 512, So, pg8::ABMoe1{WSP(unsigned char, WS_H), WSP(unsigned char, WS_W1T), WSP(i32x4, WS_TDESC), WSP(int, WS_LIST_A)},
                                       pg8::EpiSwigluT{WSP(unsigned char, WS_XS), F.b_mlp1}); }
#endif
    } SEAM(8);
    if (IN(9)) REP(9) { const int nM = WSP(int, WS_MOE_OFF)[32] >> 8; pg8::StaticOrder So; So.init(nM, D / 256, F.G, F.bx);
                  pg8::gemm_phase<false, 1, W8_E8M0, A8_E8M0>(F.lds, 512, So, pg8::ABMoe2{WSP(unsigned char, WS_A), WSP(unsigned char, WS_W2T), WSP(i32x4, WS_TDESC)},
                                         pg8::EpiMoe2T{WSP(unsigned char, WS_YS), F.b_mlp2, WSP(int, WS_LIST_A), WSP(float, WS_LIST_G)}); } SEAM(9);
    if (IN(10)) { p11_combine(F);
#if DUPMASK & 1024
        __syncthreads(); p11_combine(F);
#endif
    }
#undef IN
#undef SEAM
}

extern "C" void kernel_launch(void* const* d_in, const int* in_sizes, int n_in, void* d_out, int out_size, void* d_ws, size_t ws_size, hipStream_t stream) {
    static int ready = 0;
    if (ready == 0) {
        if (n_in != 20 || out_size != T * D || ws_size < WS_END) { fprintf(stderr, "kernel_launch: unexpected problem (n_in %d, out %d, ws %zu)\n", n_in, out_size, ws_size); ready = -1; return; }
        if (hipFuncSetAttribute((const void*)fwd, hipFuncAttributeMaxDynamicSharedMemorySize, LDS_BYTES) != hipSuccess) { fprintf(stderr, "kernel_launch: hipFuncSetAttribute failed\n"); ready = -1; return; }
        int per_cu = 0;
        if (hipOccupancyMaxActiveBlocksPerMultiprocessor(&per_cu, (const void*)fwd, NTHREADS, LDS_BYTES) != hipSuccess || per_cu < 1) fprintf(stderr, "kernel_launch: occupancy query says %d\n", per_cu);
        (void)hipGetLastError();
        ready = 1;
    }
    if (ready < 0) return;
    (void)hipMemsetAsync((char*)d_ws + WS_CTL, 0, CTL_ZERO_BYTES, stream);
    Args a{};
    for (int i = 0; i < 20; ++i) a.in[i] = (const float*)d_in[i];
    a.out = (float*)d_out; a.ws = (unsigned char*)d_ws;
#if MK_ONE_LAUNCH
    a.ph_lo = 0; a.ph_hi = NPHASE;
    hipLaunchKernelGGL(fwd, dim3(GRID), dim3(NTHREADS), LDS_BYTES, stream, a);
#if PROBE_PHASE >= 0
    a.ph_lo = PROBE_PHASE; a.ph_hi = PROBE_PHASE + 1;
    hipLaunchKernelGGL(fwd, dim3(GRID), dim3(NTHREADS), LDS_BYTES, stream, a);
#endif
#else
    for (int p = 0; p < NPHASE; ++p) { a.ph_lo = p; a.ph_hi = p + 1; hipLaunchKernelGGL(fwd, dim3(GRID), dim3(NTHREADS), LDS_BYTES, stream, a); }
#endif
}
```

```cpp
#include <hip/hip_runtime.h>
#include <cstdio>
#include <cstdint>

#ifndef MK_ONE_LAUNCH
#define MK_ONE_LAUNCH 1
#endif

#ifndef PROBE_PHASE
#define PROBE_PHASE -1
#endif
#ifndef G2_ABL
#define G2_ABL 0
#endif
#ifndef G1_ABL
#define G1_ABL 0
#endif
#ifndef P2_MODE
#define P2_MODE 0
#endif
#ifndef P3_MODE
#define P3_MODE 0
#endif
#ifndef P0_MODE
#define P0_MODE 0
#endif
#ifndef DUPMASK
#define DUPMASK 0
#endif
#define LAS __attribute__((address_space(3)))
typedef unsigned short bf16;
typedef short bf16x8 __attribute__((ext_vector_type(8)));
typedef short s16x4 __attribute__((ext_vector_type(4)));
typedef float f32x4 __attribute__((ext_vector_type(4)));
typedef unsigned u32x4 __attribute__((ext_vector_type(4)));
typedef unsigned u32x2 __attribute__((ext_vector_type(2)));

constexpr int D = 1024, NB = 2, S = 16384, T = NB * S;
constexpr int INW = 2320, INP = 2560;
constexpr int AQ_OFF = 0, AK_OFF = 512, AV_OFF = 640, GQ_OFF = 768, GK_OFF = 1024, GV_OFF = 1280, GG_OFF = 1792, GA_OFF = 2304;
constexpr int NCH = 256;
constexpr int NE = 32, FF = 1024;
constexpr int NSLOT_MAX = T * 4 + NE * 256;
constexpr float EPS = 1e-6f;
constexpr int NWAVES = 8, NTHREADS = 512, GRID = 256;

constexpr size_t MiB = 1u << 20;
constexpr size_t WS_CTL = 0, CTL_ZERO_BYTES = 1 * MiB;
constexpr size_t WS_MOD = 1 * MiB;
constexpr size_t WS_DECAY = 2 * MiB;
constexpr size_t WS_ROUTE = 3 * MiB;
constexpr size_t WS_TOK_E = WS_ROUTE, WS_TOK_LPOS = WS_ROUTE + 512 * 1024, WS_TOK_GATE = WS_ROUTE + 1024 * 1024;
constexpr size_t WS_BLK_CNT = WS_ROUTE + 1536 * 1024, WS_MOE_OFF = WS_BLK_CNT + 32 * 1024, WS_TILE_E = WS_MOE_OFF + 4096;
constexpr size_t WS_TDESC = WS_TILE_E + 4096;
constexpr size_t WS_SLOT_ASSIGN = WS_ROUTE + 2 * MiB, WS_SLOT_GATE = WS_ROUTE + 3 * MiB;
constexpr size_t WS_WIN = 8 * MiB, WS_WOUT = 13 * MiB, WS_W2T = 16 * MiB, WS_W1T = 80 * MiB;
constexpr size_t WS_H = 208 * MiB, WS_KV = 272 * MiB, WS_YS = 80 * MiB;
constexpr size_t WS_X1 = 336 * MiB, WS_PROJ = 464 * MiB, WS_MIX = 624 * MiB, WS_Y = 688 * MiB, WS_A = 464 * MiB;
constexpr size_t WS_LIST_A = 752 * MiB, WS_LIST_G = 756 * MiB;
constexpr size_t WS_XS = 608 * MiB;
constexpr size_t WS_END = 760 * MiB;
constexpr int CW_BAR = 4096, CW_GCNT = 8192  , CW_DONE = 8192 + 64 * 32, CW_MOE_CNT = 16384  ;

constexpr int LDS_BYTES = 163840, SMALL_OFF = 132096, MISC_OFF = 131072 + 320;

__device__ __forceinline__ float bf2f(unsigned v) { return __uint_as_float(v << 16); }
__device__ __forceinline__ unsigned f2bf(float f) { unsigned u = __float_as_uint(f); return (u + 0x7fffu + ((u >> 16) & 1u)) >> 16; }
__device__ __forceinline__ unsigned pk2(float lo, float hi) { return f2bf(lo) | (f2bf(hi) << 16); }
__device__ __forceinline__ float wave_sum(float v) {
#pragma unroll
    for (int o = 1; o < 64; o <<= 1) v += __shfl_xor(v, o);
    return v;
}
__device__ __forceinline__ f32x4 unpack4(u32x2 r) { return (f32x4){bf2f(r.x & 0xffffu), bf2f(r.x >> 16), bf2f(r.y & 0xffffu), bf2f(r.y >> 16)}; }
__device__ __forceinline__ float dot4(f32x4 a) { return (a[0] * a[0] + a[1] * a[1]) + (a[2] * a[2] + a[3] * a[3]); }
typedef short v4i16_t __attribute__((ext_vector_type(4)));
__device__ __forceinline__ s16x4 trr(LAS const unsigned char* p) { return __builtin_bit_cast(s16x4, __builtin_amdgcn_ds_read_tr16_b64_v4i16((LAS v4i16_t*)p)); }
__device__ __forceinline__ bf16x8 cat8(s16x4 lo, s16x4 hi) { return __builtin_shufflevector(lo, hi, 0, 1, 2, 3, 4, 5, 6, 7); }
__device__ __forceinline__ bf16x8 pack8(f32x4 a, f32x4 b) { u32x4 w; w.x = pk2(a[0], a[1]); w.y = pk2(a[2], a[3]); w.z = pk2(b[0], b[1]); w.w = pk2(b[2], b[3]); return __builtin_bit_cast(bf16x8, w); }
#define MFMA(a, b, c) __builtin_amdgcn_mfma_f32_16x16x32_bf16((a), (b), (c), 0, 0, 0)
typedef int i32x4 __attribute__((ext_vector_type(4)));
typedef int i32x8 __attribute__((ext_vector_type(8)));
__device__ __forceinline__ float clamp8(float v) { return __builtin_amdgcn_fmed3f(v, -448.f, 448.f); }
__device__ __forceinline__ unsigned pk4_fp8(float a, float b, float c, float d) {
    int w = 0; w = __builtin_amdgcn_cvt_pk_fp8_f32(clamp8(a), clamp8(b), w, false); w = __builtin_amdgcn_cvt_pk_fp8_f32(clamp8(c), clamp8(d), w, true); return (unsigned)w; }
constexpr float W8_SCALE = 64.f, H8_SCALE = 16.f, A8_SCALE = 4.f, Y8_SCALE = 16.f;
constexpr int W8_E8M0 = 0x79797979  , H8_E8M0 = 0x7b7b7b7b  , A8_E8M0 = 0x7d7d7d7d  ;

#define XB_TMO      128
#define XB_XCNT(j)  (256  + 64 * (j))
#define XB_XSUB(j)  (1280 + 64 * (j))
#define XB_XGEN(j)  (2304 + 64 * (j))
#define XB_TOP      3328
#define XB_TOPGEN   3392
#define XCD_BAR_WORDS 3456
#define XB_SPIN_CAP (1u << 18)
__device__ __forceinline__ unsigned xb_ld(unsigned* p)              { return __hip_atomic_load(p, __ATOMIC_RELAXED, __HIP_MEMORY_SCOPE_AGENT); }
__device__ __forceinline__ unsigned xb_add(unsigned* p, unsigned v) { return __hip_atomic_fetch_add(p, v, __ATOMIC_RELAXED, __HIP_MEMORY_SCOPE_AGENT); }
__device__ __forceinline__ unsigned xb_xcc_id() { return (unsigned)__builtin_amdgcn_s_getreg((3 << 11) | 20) & 0xFu; }
#define XB_SPIN(cond, bar) do { unsigned _sp = 0; while (cond) { __builtin_amdgcn_s_sleep(1); \
    if ((++_sp & 255u) == 0u) { if (xb_ld(&(bar)[XB_TMO])) break; if (_sp > XB_SPIN_CAP) { atomicAdd(&(bar)[XB_TMO], 1u); break; } } } } while (0)
struct XcdBarrier { unsigned* bar; unsigned x; volatile LAS unsigned* st; };
__device__ __forceinline__ XcdBarrier xcd_barrier_post(unsigned* bar, volatile LAS unsigned* st) {
    XcdBarrier b; b.bar = bar; b.x = xb_xcc_id(); b.st = st;
    if (threadIdx.x == 0) (void)xb_add(&bar[XB_XCNT(b.x)], 1u);
    return b;
}
__device__ __forceinline__ void xcd_barrier_complete(unsigned* bar, unsigned x, unsigned& nloc, unsigned& nx) {
    const unsigned G = gridDim.x * gridDim.y * gridDim.z;
    unsigned sum, cnt, mine, sp = 0u;
    for (;;) {
        sum = 0u; cnt = 0u; mine = 0u;
#pragma unroll
        for (unsigned j = 0; j < 16; ++j) { const unsigned c = xb_ld(&bar[XB_XCNT(j)]); sum += c; cnt += (c > 0u) ? 1u : 0u; mine = (j == x) ? c : mine; }
        if (sum == G) break;
        __builtin_amdgcn_s_sleep(1);
        if ((++sp & 255u) == 0u) { if (xb_ld(&bar[XB_TMO])) break; if (sp > XB_SPIN_CAP) { atomicAdd(&bar[XB_TMO], 1u); break; } }
    }
    nloc = mine > 0u ? mine : 1u; nx = cnt > 0u ? cnt : 1u;
}
__device__ __forceinline__ void xcd_barrier(const XcdBarrier& b) {
    asm volatile("s_waitcnt vmcnt(0)" ::: "memory");
    __syncthreads();
    if (threadIdx.x == 0) {
        unsigned* bar = b.bar;
        __builtin_amdgcn_s_waitcnt(0);
        unsigned nloc = b.st[0], nx = b.st[1];
        if (nloc == 0u) { xcd_barrier_complete(bar, b.x, nloc, nx); b.st[0] = nloc; b.st[1] = nx; }
        const unsigned old = xb_add(&bar[XB_XSUB(b.x)], 1u);
        const unsigned gen = old / nloc;
        if (old + 1u == (gen + 1u) * nloc) {
            __builtin_amdgcn_fence(__ATOMIC_RELEASE, "agent");
            asm volatile("s_waitcnt vmcnt(0)" ::: "memory");
            const unsigned og = xb_add(&bar[XB_TOP], 1u);
            const unsigned tg = og / nx;
            if (og + 1u == (tg + 1u) * nx) xb_add(&bar[XB_TOPGEN], 1u);
            else XB_SPIN(xb_ld(&bar[XB_TOPGEN]) == tg, bar);
            __builtin_amdgcn_fence(__ATOMIC_ACQUIRE, "agent");
            xb_add(&bar[XB_XGEN(b.x)], 1u);
            asm volatile("s_waitcnt vmcnt(0)" ::: "memory");
        } else {
            XB_SPIN(xb_ld(&bar[XB_XGEN(b.x)]) == gen, bar);
            __builtin_amdgcn_fence(__ATOMIC_ACQUIRE, "agent");
            asm volatile("s_waitcnt vmcnt(0)" ::: "memory");
        }
    }
    __syncthreads();
}

struct Frame {
    LAS unsigned char* lds;
    int tid, lane, wave, bx, G;
    const float *x, *c, *w_ada, *b_ada, *g_pre_mix, *g_post_mix, *g_pre_ffn, *g_post_ffn, *w_in, *w_gate_up, *b_gate, *g_gla_norm, *sinks, *w_out,
                *w_router, *b_router, *w_mlp1, *b_mlp1, *w_mlp2, *b_mlp2;
    float* out;
    unsigned char* ws;
};
#define WSP(type, off) ((type*)(F.ws + (off)))

struct TrItem { const float* W; int N; int k0, n0; unsigned char* WT; int kind; };
__device__ __forceinline__ bool tr_decode(const Frame& F, int it, TrItem& t) {
    constexpr int I_IN = 16 * 80, I_OUT = 16 * 32, I_1 = 16 * 64, I_2 = 16 * 32;
    constexpr int NITEMS = I_IN + I_OUT + NE * I_1 + NE * I_2;
    if (it >= NITEMS) return false;
    int r = it, item;
    if (r < I_IN) { t.W = F.w_in; t.N = INW; t.WT = F.ws + WS_WIN; t.kind = 0; item = r; }
    else if ((r -= I_IN) < I_OUT) { t.W = F.w_out; t.N = 1024; t.WT = F.ws + WS_WOUT; t.kind = 0; item = r; }
    else if ((r -= I_OUT) < NE * I_1) { const int e = r / I_1; t.W = F.w_mlp1 + (size_t)e * 1024 * 2048; t.N = 2048; t.WT = F.ws + WS_W1T + (size_t)e * 2048 * 1024; t.kind = 1; item = r % I_1; }
    else { r -= NE * I_1; const int e = r / I_2; t.W = F.w_mlp2 + (size_t)e * 1024 * 1024; t.N = 1024; t.WT = F.ws + WS_W2T + (size_t)e * 1024 * 1024; t.kind = 2; item = r % I_2; }
    const int st = item >> 4, l = item & 15, kb = 2 * (st & 7) + (l >> 3), nb = 8 * (st >> 3) + (l & 7);
    t.k0 = 64 * kb; t.n0 = 32 * nb;
    return true;
}
__device__ __forceinline__ void tr_dma(const TrItem& t, int lane, LAS unsigned char* buf) {
    const int p = lane & 7, rr = lane >> 3;
#pragma unroll
    for (int i = 0; i < 8; ++i) {
        int col = t.n0 + 4 * (p ^ i); col = col + 4 <= t.N ? col : t.N - 4;
        __builtin_amdgcn_global_load_lds((const unsigned*)(t.W + (size_t)(t.k0 + 8 * i + rr) * t.N + col), (LAS unsigned*)(buf + i * 1024), 16, 0, 0);
    }
}
__device__ __forceinline__ void tr_store(const TrItem& t, int lane, LAS const unsigned char* buf) {
    const int c = lane & 7;
#pragma unroll
    for (int j = 0; j < 4; ++j) { const int nn = (lane >> 3) + 8 * j;
        float e[8];
#pragma unroll
        for (int q = 0; q < 8; ++q) e[q] = *(LAS const float*)(buf + (8 * c + q) * 128 + (((nn >> 2) ^ c) << 4) + (nn & 3) * 4);
        const int n = t.n0 + nn; const bool ok = n < t.N;
#pragma unroll
        for (int q = 0; q < 8; ++q) e[q] = ok ? e[q] : 0.f;
        if (t.kind == 0) { u32x4 o; o.x = pk2(e[0], e[1]); o.y = pk2(e[2], e[3]); o.z = pk2(e[4], e[5]); o.w = pk2(e[6], e[7]);
            *(u32x4*)((bf16*)t.WT + (size_t)n * 1024 + t.k0 + 8 * c) = o; }
        else { u32x2 o; o.x = pk4_fp8(e[0] * W8_SCALE, e[1] * W8_SCALE, e[2] * W8_SCALE, e[3] * W8_SCALE); o.y = pk4_fp8(e[4] * W8_SCALE, e[5] * W8_SCALE, e[6] * W8_SCALE, e[7] * W8_SCALE);
            int row = n; if (t.kind == 1) { const int jj = n >> 1; row = 256 * (jj >> 7) + 128 * (n & 1) + (jj & 127); }
            *(u32x2*)(t.WT + (size_t)row * 1024 + t.k0 + 8 * c) = o; } }
}
template <int MODE>
__device__ __forceinline__ void tr_range(const Frame& F, int itB, int itE) {
    LAS unsigned char* buf0 = F.lds + F.wave * 16384; LAS unsigned char* buf1 = buf0 + 8192;
    const int it0 = itB + F.wave;
    TrItem t0, t1;
    bool h0 = (it0 < itE) && tr_decode(F, it0, t0); if (h0) tr_dma(t0, F.lane, buf0);
    bool h1 = (it0 + NWAVES < itE) && tr_decode(F, it0 + NWAVES, t1); if (h1) tr_dma(t1, F.lane, buf1);
    if (h0) { if (h1) asm volatile("s_waitcnt vmcnt(8)" ::: "memory"); else asm volatile("s_waitcnt vmcnt(0)" ::: "memory"); }
#pragma unroll 1
    for (int it = it0; h0; it += 2 * NWAVES) {
        if (MODE != 1) tr_store(t0, F.lane, buf0);
        asm volatile("s_waitcnt lgkmcnt(0)" ::: "memory");
        h0 = (it + 2 * NWAVES < itE) && tr_decode(F, it + 2 * NWAVES, t0); if (h0) tr_dma(t0, F.lane, buf0);
        if (!h1) break;
        if (h0) asm volatile("s_waitcnt vmcnt(12)" ::: "memory"); else asm volatile("s_waitcnt vmcnt(4)" ::: "memory");
        if (MODE != 1) tr_store(t1, F.lane, buf1);
        asm volatile("s_waitcnt lgkmcnt(0)" ::: "memory");
        h1 = (it + 3 * NWAVES < itE) && tr_decode(F, it + 3 * NWAVES, t1); if (h1) tr_dma(t1, F.lane, buf1);
        if (h0) { if (h1) asm volatile("s_waitcnt vmcnt(12)" ::: "memory"); else asm volatile("s_waitcnt vmcnt(4)" ::: "memory"); }
    }
    asm volatile("s_waitcnt vmcnt(0)" ::: "memory");
}
template <int MODE>
__device__ __forceinline__ void p0_prologue(const Frame& F) {
    float* mod = WSP(float, WS_MOD);
    if (F.bx < 192 && MODE != 3 && MODE != 1) {
        LAS float* red = (LAS float*)(F.lds + 98304);
        const int cl = F.tid & 31, ks = F.tid >> 5, col = F.bx * 32 + cl;
        float a0 = 0.f, a1 = 0.f;
        float wv[64];
#pragma unroll
        for (int i = 0; i < 64; ++i) wv[i] = F.w_ada[(size_t)(ks * 64 + i) * 6144 + col];
#pragma unroll
        for (int i = 0; i < 64; ++i) { const int k = ks * 64 + i;
            const float c0 = F.c[k], c1 = F.c[1024 + k];
            a0 += c0 * __builtin_amdgcn_rcpf(1.f + __expf(-c0)) * wv[i]; a1 += c1 * __builtin_amdgcn_rcpf(1.f + __expf(-c1)) * wv[i];
        }
        red[(0 * 16 + ks) * 32 + cl] = a0; red[(1 * 16 + ks) * 32 + cl] = a1;
        __syncthreads();
        if (F.tid < 64) { const int b = F.tid >> 5; float s = 0.f;
#pragma unroll
            for (int i = 0; i < 16; ++i) s += red[(b * 16 + i) * 32 + cl];
            mod[b * 6144 + col] = s + F.b_ada[col]; }
        __syncthreads();
    }
    if (MODE == 2) return;
    if (F.bx < 112) tr_range<MODE>(F, F.bx * 16, F.bx * 16 + 16);
}

__device__ __forceinline__ void p1_norm(const Frame& F) {
    const float* mod = WSP(float, WS_MOD); bf16* h = WSP(bf16, WS_H);
    const int gw = F.bx * NWAVES + F.wave, m0 = gw * 16;
    const float* modb = mod + (m0 >> 14) * 6144;
    const float* xb = F.x + (size_t)m0 * D + 4 * F.lane;
    f32x4 g[4], sh[4], b0[4], b1[4], b2[4], b3[4];
#define P1_LOAD(B, r) do { _Pragma("unroll") for (int j = 0; j < 4; ++j) B[j] = *(const f32x4*)(xb + (size_t)(r) * D + 256 * j); } while (0)
#define P1_ROW(B, it) do { float ss = 0.f; _Pragma("unroll") for (int j = 0; j < 4; ++j) ss += dot4(B[j]); \
        const float r = rsqrtf(wave_sum(ss) * (1.f / D) + EPS); \
        _Pragma("unroll") for (int j = 0; j < 4; ++j) { const f32x4 hv = B[j] * r * g[j] + sh[j]; u32x2 o; o.x = pk2(hv[0], hv[1]); o.y = pk2(hv[2], hv[3]); \
            *(u32x2*)(h + (size_t)(m0 + (it)) * D + 4 * F.lane + 256 * j) = o; } \
        if ((it) + 4 < 16) P1_LOAD(B, (it) + 4); } while (0)
    P1_LOAD(b0, 0); P1_LOAD(b1, 1); P1_LOAD(b2, 2); P1_LOAD(b3, 3);
#pragma unroll
    for (int j = 0; j < 4; ++j) { const int idx = 4 * F.lane + 256 * j;
        g[j] = *(const f32x4*)(F.g_pre_mix + idx) * (*(const f32x4*)(modb + 1024 + idx) + 1.f); sh[j] = *(const f32x4*)(modb + idx); }
#pragma unroll 1
    for (int it = 0; it < 16; it += 4) { P1_ROW(b0, it); P1_ROW(b1, it + 1); P1_ROW(b2, it + 2); P1_ROW(b3, it + 3); }
#undef P1_LOAD
#undef P1_ROW
}

template <class Epi, class RowMap, class BSel>
__device__ __forceinline__ void simple_gemm(const Frame& F, const bf16* A, int lda, int M, int N, int K, const RowMap& rm, const BSel& bs, const Epi& E) {
    const int fr = F.lane & 15, fq = F.lane >> 4;
    const int ncg = N / 512, nbt = (M / 64) * ncg;
    for (int bt = F.bx; bt < nbt; bt += F.G) {
        const int mt = bt / ncg, cg = bt % ncg, m0 = mt * 64, n0 = cg * 512 + F.wave * 64;
        const bf16* Bt = bs(m0);
        const bf16* ap[4]; const bf16* bp[4];
#pragma unroll
        for (int i = 0; i < 4; ++i) { ap[i] = A + (size_t)rm(m0 + 16 * i + fr) * lda + 8 * fq; bp[i] = Bt + (size_t)(n0 + 16 * i + fr) * K + 8 * fq; }
        f32x4 acc[4][4];
#pragma unroll
        for (int i = 0; i < 4; ++i)
#pragma unroll
            for (int j = 0; j < 4; ++j) acc[i][j] = (f32x4){0.f, 0.f, 0.f, 0.f};
#pragma unroll 2
        for (int k0 = 0; k0 < K; k0 += 32) {
            bf16x8 a[4], b[4];
#pragma unroll
            for (int i = 0; i < 4; ++i) { a[i] = *(const bf16x8*)(ap[i] + k0); b[i] = *(const bf16x8*)(bp[i] + k0); }
#pragma unroll
            for (int i = 0; i < 4; ++i)
#pragma unroll
                for (int j = 0; j < 4; ++j) acc[i][j] = MFMA(b[j], a[i], acc[i][j]);
        }
#pragma unroll
        for (int i = 0; i < 4; ++i)
#pragma unroll
            for (int j = 0; j < 4; ++j) E(m0 + 16 * i + fr, n0 + 16 * j + 4 * fq, acc[i][j]);
    }
}
struct RowId { __device__ __forceinline__ int operator()(int m) const { return m; } };
struct RowGather { const int* slot_assign; __device__ __forceinline__ int operator()(int m) const { const int a = slot_assign[m]; return a < 0 ? 0 : (a >> 2); } };
struct BFixed { const bf16* Bt; __device__ __forceinline__ const bf16* operator()(int) const { return Bt; } };
struct BExpert { const bf16* Bt; const int* tile_e; size_t stride; __device__ __forceinline__ const bf16* operator()(int m0) const { return Bt + (size_t)tile_e[m0 >> 8] * stride; } };
struct EpiStore { bf16* O; int ldo;
    __device__ __forceinline__ void operator()(int m, int n, f32x4 v) const { u32x2 w; w.x = pk2(v[0], v[1]); w.y = pk2(v[2], v[3]); *(u32x2*)(O + (size_t)m * ldo + n) = w; } };
__device__ __forceinline__ float swiglu(float g, float l) {
    const float xg = fminf(g, 7.f), xl = fminf(fmaxf(l, -7.f), 7.f);
    return xg / (1.f + __expf(-1.702f * xg)) * (xl + 1.f);
}
typedef float f32x2 __attribute__((ext_vector_type(2)));
__device__ __forceinline__ f32x2 swiglu_s2(f32x2 g, f32x2 l) {
    f32x2 xg, xl; xg.x = fminf(g.x, 7.f); xg.y = fminf(g.y, 7.f); xl.x = __builtin_amdgcn_fmed3f(l.x, -7.f, 7.f); xl.y = __builtin_amdgcn_fmed3f(l.y, -7.f, 7.f);
    const f32x2 t = xg * (-1.702f * 1.4426950408889634f);
    f32x2 ex; ex.x = __builtin_amdgcn_exp2f(t.x); ex.y = __builtin_amdgcn_exp2f(t.y);
    const f32x2 den = ex + 1.f;
    f32x2 rc; rc.x = __builtin_amdgcn_rcpf(den.x); rc.y = __builtin_amdgcn_rcpf(den.y);
    return (xg * rc) * (xl * A8_SCALE + A8_SCALE);
}
__device__ __forceinline__ unsigned pk4_fp8_nc(float a, float b, float c, float d) {
    int w = 0; w = __builtin_amdgcn_cvt_pk_fp8_f32(a, b, w, false); w = __builtin_amdgcn_cvt_pk_fp8_f32(c, d, w, true); return (unsigned)w; }
struct EpiSwiglu { bf16* Aout; const float* b1; const int* tile_e;
    __device__ __forceinline__ void operator()(int m, int n, f32x4 v) const {
        const int e = tile_e[m >> 8]; const f32x4 bb = *(const f32x4*)(b1 + (size_t)e * 2048 + n);
        const float a0 = swiglu(v[0] + bb[0], v[1] + bb[1]), a1 = swiglu(v[2] + bb[2], v[3] + bb[3]);
        *(unsigned*)(Aout + (size_t)m * FF + (n >> 1)) = pk2(a0, a1); } };
struct EpiMoe2 { bf16* ys; const float* b2; const int* tile_e; const int* slot_assign; const float* slot_gate;
    __device__ __forceinline__ void operator()(int m, int n, f32x4 v) const {
        const int asg = slot_assign[m]; if (asg < 0) return;
        const int e = tile_e[m >> 8]; const f32x4 bb = *(const f32x4*)(b2 + (size_t)e * D + n); const float g = slot_gate[m];
        u32x2 w; w.x = pk2((v[0] + bb[0]) * g, (v[1] + bb[1]) * g); w.y = pk2((v[2] + bb[2]) * g, (v[3] + bb[3]) * g);
        *(u32x2*)(ys + (size_t)asg * D + n) = w; } };

namespace pg8 {
constexpr int BM = 256, BK = 64, HALF = 128, HTB = HALF * BK * 2, NXCD = 8, WGM = 8;
__device__ __forceinline__ int lds_byte(int r, int c) { const int st = (r >> 4) * 2 + (c >> 5), rr = r & 15, cc = c & 31, ob = rr * 64 + cc * 2; return st * 1024 + (ob ^ (((ob >> 9) & 1) << 5)); }
__device__ __forceinline__ void stage_rc(int b, int& R, int& C) { const int st = b / 1024, sb = b % 1024, swz = sb ^ (((sb >> 9) & 1) << 5); R = (st >> 1) * 16 + swz / 64; C = (st & 1) * 32 + (swz % 64) / 2; }
__device__ __forceinline__ int perm32(int rho) { const int n = rho >> 4, i = rho & 15; return 8 * (i >> 2) + 4 * n + (i & 3); }
struct Unit { int pm, pn, e, pos0, cnt; };
struct StaticOrder {
    int nM, nN, nwg, G, c, i0, n;
    __device__ __forceinline__ void init(int nM_, int nN_, int G_, int c_, int i0_ = 0, int n_ = 1 << 30) { nM = nM_; nN = nN_; nwg = nM * nN; G = G_; c = c_; i0 = i0_; n = n_; }
    __device__ __forceinline__ bool next(int i, Unit& u) const {
        if (i >= n) return false;
        const long L = (long)(i0 + i) * G + c; if (L >= nwg) return false;
        int wgid = (int)L; { const int q = nwg / NXCD, r = nwg % NXCD, xcd = wgid % NXCD, off = wgid / NXCD; wgid = (xcd < r ? xcd * (q + 1) : r * (q + 1) + (xcd - r) * q) + off; }
        const int nig = WGM * nN, gid = wgid / nig, fm = gid * WGM, gsz = (nM - fm) < WGM ? (nM - fm) : WGM;
        u.pm = fm + ((wgid % nig) % gsz); u.pn = (wgid % nig) / gsz; return true;
    }
};
template <bool GATHER, int FP8, int SCW, int SCX, int ABL = 0, class Epi, class Sched, class AB>
__device__ __forceinline__ void gemm_phase(LAS unsigned char* lds, const int K, const Sched& S, const AB& ab, const Epi& E) {
    const int tid = threadIdx.x, wid = __builtin_amdgcn_readfirstlane(tid >> 6), lane = tid & 63, wr = wid >> 2, wc = wid & 3, fr = lane & 15, fq = lane >> 4;
    const int nt = K / BK;
    int sR[2], sC[2]; unsigned voffB[2], vA[2][2], nvA[2][2];
#pragma unroll
    for (int i = 0; i < 2; ++i) { int R, C; stage_rc(tid * 16 + i * 8192, R, C); sR[i] = R; sC[i] = C; const int Rb = (R & ~31) + perm32(R & 31); voffB[i] = (unsigned)(Rb * K + C) * 2u; }
    const size_t kstep = (size_t)(BK * 2);
    const size_t hstep = (size_t)HALF * K * 2;
    const unsigned ldsw = (unsigned)wid * 1024u;
    const int aoff = lds_byte(wr * 64 + fr, fq * 8), boff = lds_byte(wc * 32 + fr, fq * 8);
#define PG8_SA(b, h) (((b) * 2 + (h)) * HTB)
#define PG8_SB(b, h) ((4 + (b) * 2 + (h)) * HTB)
#define PG8_STAGE(bufoff, gbase, voff) do { if (ABL != 3) _Pragma("unroll") for (int _i = 0; _i < 2; ++_i) \
        __builtin_amdgcn_global_load_lds((const unsigned*)((const char*)(gbase) + (voff)[_i]), (LAS unsigned*)(lds + (bufoff) + ldsw + _i * 8192), 16, 0, 0); } while (0)
#define PG8_LDA(dst, b, h) do { _Pragma("unroll") for (int m = 0; m < 4; ++m) _Pragma("unroll") for (int k = 0; k < 2; ++k) dst[m][k] = *(const LAS bf16x8*)(lds + PG8_SA(b, h) + aoff + m * 2048 + k * 1024); } while (0)
#define PG8_LDB(dst, b, h) do { _Pragma("unroll") for (int n = 0; n < 2; ++n) _Pragma("unroll") for (int k = 0; k < 2; ++k) dst[n][k] = *(const LAS bf16x8*)(lds + PG8_SB(b, h) + boff + n * 2048 + k * 1024); } while (0)
#define PG8_C8(x) __builtin_shufflevector(__builtin_bit_cast(i32x4, (x)[0]), __builtin_bit_cast(i32x4, (x)[1]), 0, 1, 2, 3, 4, 5, 6, 7)
#define PG8_MMA(ai, bj, At, Bt) do { if (ABL == 2) break; __builtin_amdgcn_s_setprio(1); _Pragma("unroll") for (int m = 0; m < 4; ++m) _Pragma("unroll") for (int n = 0; n < 2; ++n) { \
        if (FP8) asm volatile("v_mfma_scale_f32_16x16x128_f8f6f4 %0, %1, %2, %0, %3, %4 op_sel_hi:[0,0,0]" : "+v"(acc[ai][bj][m][n]) : "v"(PG8_C8(Bt[n])), "v"(PG8_C8(At[m])), "v"(scw), "v"(scx)); \
        else { _Pragma("unroll") for (int k = 0; k < 2; ++k) asm volatile("v_mfma_f32_16x16x32_bf16 %0, %1, %2, %0" : "+v"(acc[ai][bj][m][n]) : "v"(Bt[n][k]), "v"(At[m][k])); } } \
        __builtin_amdgcn_s_setprio(0); } while (0)
#define PG8_WAIT_V(n) asm volatile("s_waitcnt vmcnt(" #n ")" ::: "memory")
#define PG8_WAIT_L(n) asm volatile("s_waitcnt lgkmcnt(" #n ")" ::: "memory")
#define PG8_BAR __builtin_amdgcn_s_barrier()
#define PG8_SCHED __builtin_amdgcn_sched_barrier(0)
#define PG8_AOFF(dst, u) do { _Pragma("unroll") for (int _h = 0; _h < 2; ++_h) _Pragma("unroll") for (int _i = 0; _i < 2; ++_i) \
        dst[_h][_i] = GATHER ? (unsigned)(ab.a_row((u), _h * HALF + sR[_i]) * K + sC[_i]) * 2u : (unsigned)((_h * HALF + sR[_i]) * K + sC[_i]) * 2u; } while (0)
    Unit cur, nxt, nn; int ui = 0;
    if (!S.next(0, cur)) return;
    ab.fill(cur);
    bool has_nn = S.next(1, nn); if (has_nn) ab.fill(nn);
    const int scw = SCW, scx = SCX;
    f32x4 acc[2][2][4][2];
#pragma unroll
    for (int a = 0; a < 2; ++a)
#pragma unroll
        for (int b = 0; b < 2; ++b)
#pragma unroll
            for (int m = 0; m < 4; ++m)
#pragma unroll
                for (int n = 0; n < 2; ++n) acc[a][b][m][n] = (f32x4){0.f, 0.f, 0.f, 0.f};
    bf16x8 At[4][2], B0[2][2], B1[2][2];
    const char* cA = ab.a_base(cur); const char* cB = ab.b_base(cur);
    PG8_AOFF(vA, cur);
    PG8_STAGE(PG8_SB(0, 0), cB, voffB); PG8_STAGE(PG8_SB(0, 1), cB + hstep, voffB); PG8_STAGE(PG8_SA(0, 0), cA, vA[0]); PG8_STAGE(PG8_SA(0, 1), cA, vA[1]);
    if (wr == 1) PG8_BAR;
    PG8_WAIT_V(2); PG8_BAR;
    PG8_STAGE(PG8_SB(1, 0), cB + kstep, voffB); PG8_STAGE(PG8_SA(1, 0), cA + kstep, vA[0]); PG8_STAGE(PG8_SB(1, 1), cB + hstep + kstep, voffB);
    PG8_WAIT_V(6); PG8_BAR;
    for (;;) {
        const bool has_next = has_nn; nxt = nn;
        has_nn = has_next && S.next(ui + 2, nn); if (has_nn) ab.fill(nn);
        const char* nA = has_next ? ab.a_base(nxt) : cA; const char* nB = has_next ? ab.b_base(nxt) : cB;
        if (GATHER) { if (has_next) { PG8_AOFF(nvA, nxt); } else {
#pragma unroll
            for (int h = 0; h < 2; ++h)
#pragma unroll
                for (int i = 0; i < 2; ++i) nvA[h][i] = vA[h][i]; } }
#pragma unroll 1
        for (int t = 0; t < nt; t += 2) {
            const bool last = (t == nt - 2);
            const char* a1 = cA + (size_t)(t + 1) * kstep;
            const char* a2 = last ? nA : cA + (size_t)(t + 2) * kstep; const char* b2 = last ? nB : cB + (size_t)(t + 2) * kstep;
            const char* a3 = a2 + kstep; const char* b3 = b2 + kstep;
            unsigned o2[2][2];
#pragma unroll
            for (int h = 0; h < 2; ++h)
#pragma unroll
                for (int i = 0; i < 2; ++i) o2[h][i] = (GATHER && last) ? nvA[h][i] : vA[h][i];
            PG8_LDB(B0, 0, 0); PG8_LDB(B1, 0, 1); PG8_SCHED; PG8_LDA(At, 0, 0); PG8_STAGE(PG8_SA(1, 1), a1, vA[1]);
            PG8_WAIT_V(8); PG8_WAIT_L(0); PG8_BAR; PG8_MMA(0, 0, At, B0); PG8_MMA(0, 1, At, B1); PG8_BAR; PG8_SCHED;
            PG8_LDA(At, 0, 1); PG8_STAGE(PG8_SB(0, 0), b2, voffB); PG8_STAGE(PG8_SB(0, 1), b2 + hstep, voffB); PG8_STAGE(PG8_SA(0, 0), a2, o2[0]);
            PG8_WAIT_V(8); PG8_WAIT_L(0); PG8_BAR; PG8_MMA(1, 0, At, B0); PG8_MMA(1, 1, At, B1); PG8_BAR; PG8_SCHED;
            PG8_LDB(B0, 1, 0); PG8_LDB(B1, 1, 1); PG8_SCHED; PG8_LDA(At, 1, 0); PG8_STAGE(PG8_SA(0, 1), a2, o2[1]);
            PG8_WAIT_V(8); PG8_WAIT_L(0); PG8_BAR; PG8_MMA(0, 0, At, B0); PG8_MMA(0, 1, At, B1); PG8_BAR; PG8_SCHED;
            PG8_LDA(At, 1, 1); PG8_STAGE(PG8_SB(1, 0), b3, voffB); PG8_STAGE(PG8_SB(1, 1), b3 + hstep, voffB); PG8_STAGE(PG8_SA(1, 0), a3, o2[0]);
            PG8_WAIT_V(8); PG8_WAIT_L(0); PG8_BAR; PG8_MMA(1, 0, At, B0); PG8_MMA(1, 1, At, B1); PG8_BAR; PG8_SCHED;
        }
        if (wr == 0) PG8_BAR;
        asm volatile("s_nop 15\n\ts_nop 15" ::: "memory");
        if (ABL == 1) { _Pragma("unroll") for (int a = 0; a < 2; ++a) _Pragma("unroll") for (int b = 0; b < 2; ++b) _Pragma("unroll") for (int m = 0; m < 4; ++m) _Pragma("unroll") for (int n = 0; n < 2; ++n) asm volatile("" :: "v"(acc[a][b][m][n])); }
        else E(acc, cur, wr, wc, fr, fq);
        if (!has_next) break;
#pragma unroll
        for (int a = 0; a < 2; ++a)
#pragma unroll
            for (int b = 0; b < 2; ++b)
#pragma unroll
                for (int m = 0; m < 4; ++m)
#pragma unroll
                    for (int n = 0; n < 2; ++n) acc[a][b][m][n] = (f32x4){0.f, 0.f, 0.f, 0.f};
        cur = nxt; cA = nA; cB = nB; ++ui;
        if (GATHER) {
#pragma unroll
            for (int h = 0; h < 2; ++h)
#pragma unroll
                for (int i = 0; i < 2; ++i) vA[h][i] = nvA[h][i]; }
        if (wr == 1) PG8_BAR;
    }
    PG8_WAIT_V(0);
    PG8_BAR;
#undef PG8_SA
#undef PG8_SB
#undef PG8_STAGE
#undef PG8_LDA
#undef PG8_LDB
#undef PG8_MMA
#undef PG8_C8
#undef PG8_WAIT_V
#undef PG8_WAIT_L
#undef PG8_BAR
#undef PG8_SCHED
#undef PG8_AOFF
}
__device__ __forceinline__ unsigned cvt_pk_bf16(float lo, float hi) { unsigned r; asm volatile("v_cvt_pk_bf16_f32 %0, %1, %2" : "=v"(r) : "v"(lo), "v"(hi)); return r; }
struct ABDense { const bf16* A; const bf16* Bt; int K;
    __device__ __forceinline__ const char* a_base(const Unit& u) const { return (const char*)(A + (size_t)u.pm * BM * K); }
    __device__ __forceinline__ const char* b_base(const Unit& u) const { return (const char*)(Bt + (size_t)u.pn * BM * K); }
    __device__ __forceinline__ void fill(Unit& u) const { u.e = 0; u.pos0 = 0; u.cnt = 0; }
    __device__ __forceinline__ int a_row(const Unit&, int) const { return 0; } };
struct EpiStoreT { bf16* O; int ldo;
    __device__ __forceinline__ void operator()(const f32x4 (&acc)[2][2][4][2], const Unit& u, int wr, int wc, int fr, int fq) const {
        const int row0 = u.pm * BM + wr * 64 + fr, col0 = u.pn * BM + wc * 32 + 8 * fq;
#pragma unroll
        for (int ai = 0; ai < 2; ++ai)
#pragma unroll
            for (int m = 0; m < 4; ++m) { bf16* rowp = O + (size_t)(row0 + ai * HALF + m * 16) * ldo + col0;
#pragma unroll
                for (int bj = 0; bj < 2; ++bj) { const f32x4 v0 = acc[ai][bj][m][0], v1 = acc[ai][bj][m][1];
                    u32x4 w; w.x = cvt_pk_bf16(v0[0], v0[1]); w.y = cvt_pk_bf16(v0[2], v0[3]); w.z = cvt_pk_bf16(v1[0], v1[1]); w.w = cvt_pk_bf16(v1[2], v1[3]);
                    *(u32x4*)(rowp + bj * HALF) = w; } }
    } };
struct ABMoe1 { const unsigned char* H; const unsigned char* W; const i32x4* tdesc; const int* list_a;
    __device__ __forceinline__ void fill(Unit& u) const { const i32x4 d = tdesc[u.pm]; u.e = d.x; u.pos0 = d.y; u.cnt = d.z; }
    __device__ __forceinline__ const char* a_base(const Unit&) const { return (const char*)H; }
    __device__ __forceinline__ const char* b_base(const Unit& u) const { return (const char*)(W + (size_t)u.e * 2048 * 1024 + (size_t)u.pn * BM * 1024); }
    __device__ __forceinline__ int a_row(const Unit& u, int rt) const { const int pos = u.pos0 + rt; const bool ok = pos < u.cnt;
        const int a = list_a[(size_t)u.e * T + (ok ? pos : 0)]; return ok ? (a >> 2) : 0; } };
struct ABMoe2 { const unsigned char* A; const unsigned char* W; const i32x4* tdesc;
    __device__ __forceinline__ void fill(Unit& u) const { const i32x4 d = tdesc[u.pm]; u.e = d.x; u.pos0 = d.y; u.cnt = d.z; }
    __device__ __forceinline__ const char* a_base(const Unit& u) const { return (const char*)(A + (size_t)u.pm * BM * 1024); }
    __device__ __forceinline__ const char* b_base(const Unit& u) const { return (const char*)(W + (size_t)u.e * 1024 * 1024 + (size_t)u.pn * BM * 1024); }
    __device__ __forceinline__ int a_row(const Unit&, int) const { return 0; } };
struct EpiSwigluT { unsigned char* Aout; const float* b1;
    __device__ __forceinline__ void operator()(const f32x4 (&acc)[2][2][4][2], const Unit& u, int wr, int wc, int fr, int fq) const {
        const int row0 = u.pm * BM + wr * 64 + fr, j0 = u.pn * HALF + wc * 32 + 8 * fq;
        const float* bp = b1 + (size_t)u.e * 2048 + 2 * j0;
        f32x2 bg[4], bl[4];
#pragma unroll
        for (int q = 0; q < 4; ++q) { const f32x4 b4 = *(const f32x4*)(bp + 4 * q); bg[q] = (f32x2){b4[0], b4[2]}; bl[q] = (f32x2){b4[1], b4[3]}; }
#pragma unroll
        for (int ai = 0; ai < 2; ++ai) {
            u32x2 wv[4];
#pragma unroll
            for (int m = 0; m < 4; ++m) {
                const f32x4 g0 = acc[ai][0][m][0], g1 = acc[ai][0][m][1], l0 = acc[ai][1][m][0], l1 = acc[ai][1][m][1];
                const f32x2 r0 = swiglu_s2((f32x2){g0[0], g0[1]} + bg[0], (f32x2){l0[0], l0[1]} + bl[0]), r1 = swiglu_s2((f32x2){g0[2], g0[3]} + bg[1], (f32x2){l0[2], l0[3]} + bl[1]);
                const f32x2 r2 = swiglu_s2((f32x2){g1[0], g1[1]} + bg[2], (f32x2){l1[0], l1[1]} + bl[2]), r3 = swiglu_s2((f32x2){g1[2], g1[3]} + bg[3], (f32x2){l1[2], l1[3]} + bl[3]);
                wv[m].x = pk4_fp8_nc(r0.x, r0.y, r1.x, r1.y); wv[m].y = pk4_fp8_nc(r2.x, r2.y, r3.x, r3.y); }
#pragma unroll
            for (int m = 0; m < 4; m += 2) {
                const auto rx = __builtin_amdgcn_permlane16_swap(wv[m].x, wv[m + 1].x, false, false), ry = __builtin_amdgcn_permlane16_swap(wv[m].y, wv[m + 1].y, false, false);
                u32x4 v; v.x = rx[0]; v.y = ry[0]; v.z = rx[1]; v.w = ry[1];
                *(u32x4*)(Aout + (size_t)(row0 + ai * HALF + (m + (fq & 1)) * 16) * FF + j0 - 8 * (fq & 1)) = v; }
        }
    } };
struct EpiMoe2T { unsigned char* ys; const float* b2;
    __device__ __forceinline__ void operator()(const f32x4 (&acc)[2][2][4][2], const Unit& u, int wr, int wc, int fr, int fq) const {
        const int row0 = u.pm * BM + wr * 64 + fr, col0 = u.pn * BM + wc * 32 + 8 * fq;
        const float* bp = b2 + (size_t)u.e * D + col0;
        f32x4 bv[2][2];
#pragma unroll
        for (int bj = 0; bj < 2; ++bj)
#pragma unroll
            for (int n = 0; n < 2; ++n) bv[bj][n] = *(const f32x4*)(bp + bj * HALF + 4 * n) * Y8_SCALE;
#pragma unroll
        for (int ai = 0; ai < 2; ++ai)
#pragma unroll
            for (int m = 0; m < 4; ++m) { unsigned char* rowp = ys + (size_t)(row0 + ai * HALF + m * 16) * D + col0;
                u32x2 w[2];
#pragma unroll
                for (int bj = 0; bj < 2; ++bj) { const f32x4 v0 = acc[ai][bj][m][0] * Y8_SCALE + bv[bj][0], v1 = acc[ai][bj][m][1] * Y8_SCALE + bv[bj][1];
                    w[bj].x = pk4_fp8(v0[0], v0[1], v0[2], v0[3]); w[bj].y = pk4_fp8(v1[0], v1[1], v1[2], v1[3]); }
                const auto rx = __builtin_amdgcn_permlane16_swap(w[0].x, w[1].x, false, false), ry = __builtin_amdgcn_permlane16_swap(w[0].y, w[1].y, false, false);
                u32x4 v; v.x = rx[0]; v.y = ry[0]; v.z = rx[1]; v.w = ry[1];
                *(u32x4*)(rowp + ((fq & 1) ? (HALF - 8) : 0)) = v; }
    } };
}

__device__ __forceinline__ void attn_unit(const Frame& F, int u) {
    const int qblk = u & 127, kvh = (u >> 7) & 1, b = u >> 8;
    LAS unsigned char* Ks = F.lds; LAS unsigned char* Vs = F.lds + 256 * 144;
    const bf16* proj = WSP(bf16, WS_PROJ); bf16* mix = WSP(bf16, WS_MIX);
    const int tok0 = b * S + qblk * 128;
#pragma unroll
    for (int i = 0; i < 4; ++i) {
        const int cid = F.tid + 512 * i, row = cid >> 3, ch = cid & 7;
        u32x4 kv = (u32x4){0u, 0u, 0u, 0u}, vv = (u32x4){0u, 0u, 0u, 0u};
        if (qblk > 0 || row >= 128) {
            const bf16* rp = proj + (size_t)(tok0 - 128 + row) * INP;
            kv = *(const u32x4*)(rp + AK_OFF + kvh * 64 + ch * 8);
            vv = *(const u32x4*)(rp + AV_OFF + kvh * 64 + ch * 8);
        }
        *(LAS u32x4*)(Ks + row * 144 + ch * 16) = kv;
        *(LAS u32x4*)(Vs + row * 144 + ch * 16) = vv;
    }
    __syncthreads();
    const int g = F.wave >> 1, hw = F.wave & 1, hq = kvh * 4 + g;
    const int lane = F.lane, fr = lane & 15, fq = lane >> 4;
    const float sink = F.sinks[hq];
    const float NEG_INF = -__builtin_inff();
    const bf16* qbase = proj + (size_t)(tok0 + 64 * hw + fr) * INP + AQ_OFF + hq * 64 + 8 * fq;
    bf16x8 nq0 = *(const bf16x8*)qbase, nq1 = *(const bf16x8*)(qbase + 32);
    for (int qb = 0; qb < 4; ++qb) {
        const int i = 64 * hw + 16 * qb + fr;
        const bf16x8 q0 = nq0, q1 = nq1;
        { const bf16* qn = qbase + (size_t)(16 * (qb < 3 ? qb + 1 : qb)) * INP; nq0 = *(const bf16x8*)qn; nq1 = *(const bf16x8*)(qn + 32); }
        f32x4 st[12];
#pragma unroll
        for (int kt = 0; kt < 12; ++kt) {
            LAS const unsigned char* kp = Ks + (64 * hw + 16 * kt + fr) * 144 + fq * 16;
            const bf16x8 k0 = *(LAS const bf16x8*)kp, k1 = *(LAS const bf16x8*)(kp + 64);
            f32x4 z = (f32x4){0.f, 0.f, 0.f, 0.f}; z = MFMA(k0, q0, z); z = MFMA(k1, q1, z); st[kt] = z;
        }
        float mx = NEG_INF;
#pragma unroll
        for (int kt = 0; kt < 12; ++kt)
#pragma unroll
            for (int r = 0; r < 4; ++r) {
                const int j = 64 * hw + 16 * kt + 4 * fq + r, rel = i + 128 - j;
                const bool ok = (rel >= 0) && (rel < 128) && (qblk > 0 || j >= 128);
                const float s = ok ? st[kt][r] * 0.125f : NEG_INF;
                st[kt][r] = s; mx = fmaxf(mx, s);
            }
        mx = fmaxf(mx, __shfl_xor(mx, 16)); mx = fmaxf(mx, __shfl_xor(mx, 32)); mx = fmaxf(mx, sink);
        float sum = 0.f;
#pragma unroll
        for (int kt = 0; kt < 12; ++kt)
#pragma unroll
            for (int r = 0; r < 4; ++r) { const float p = __expf(st[kt][r] - mx); st[kt][r] = p; sum += p; }
        sum += __shfl_xor(sum, 16); sum += __shfl_xor(sum, 32); sum += __expf(sink - mx);
        const float inv = 1.f / sum;
        f32x4 o[4];
#pragma unroll
        for (int c = 0; c < 4; ++c) o[c] = (f32x4){0.f, 0.f, 0.f, 0.f};
#pragma unroll
        for (int ks = 0; ks < 6; ++ks) {
            const bf16x8 pf = pack8(st[2 * ks], st[2 * ks + 1]);
            const int rb = 64 * hw + 32 * ks + 4 * fq + (fr >> 2);
#pragma unroll
            for (int c = 0; c < 4; ++c) {
                LAS const unsigned char* vp = Vs + rb * 144 + (16 * c + 4 * (lane & 3)) * 2;
                const bf16x8 vf = cat8(trr(vp), trr(vp + 16 * 144));
                o[c] = MFMA(pf, vf, o[c]);
            }
        }
#pragma unroll
        for (int r = 0; r < 4; ++r) {
            const int qrow = 4 * fq + r; const float iv = __shfl(inv, qrow);
            bf16* op = mix + (size_t)(tok0 + 64 * hw + 16 * qb + qrow) * D + hq * 64 + fr;
#pragma unroll
            for (int c = 0; c < 4; ++c) op[16 * c] = (bf16)f2bf(o[c][r] * iv);
        }
    }
    __syncthreads();
}

__device__ __forceinline__ void gla_gate_prefix(const Frame& F, const bf16* proj, int t0, int h, LAS float* ga_s, LAS float* tot_s, float (&bv)[8], float& b_mid, float& b_last) {
#pragma unroll
    for (int i = 0; i < 2; ++i) { const int idx = F.tid + 512 * i, t = idx >> 4, r = idx & 15; ga_s[idx] = bf2f(proj[(size_t)(t0 + t) * INP + GA_OFF + r]); }
    float wu[16];
#pragma unroll
    for (int r = 0; r < 16; ++r) wu[r] = F.w_gate_up[r * 256 + h * 64 + F.lane];
    const float bg = F.b_gate[h * 64 + F.lane];
    __syncthreads();
    float run = 0.f;
#pragma unroll
    for (int i = 0; i < 8; ++i) {
        const int t = 8 * F.wave + i; float z = bg;
#pragma unroll
        for (int r = 0; r < 16; ++r) z += ga_s[t * 16 + r] * wu[r];
        const float ls = fminf(z, 0.f) - __logf(1.f + __expf(-fabsf(z)));
        run += ls * (1.f / 16.f); bv[i] = run;
    }
    tot_s[F.wave * 64 + F.lane] = run;
    __syncthreads();
    float pre = 0.f, mid = 0.f, all = 0.f;
#pragma unroll
    for (int w = 0; w < 8; ++w) { const float tv = tot_s[w * 64 + F.lane]; pre += (w < F.wave) ? tv : 0.f; mid += (w < 4) ? tv : 0.f; all += tv; }
#pragma unroll
    for (int i = 0; i < 8; ++i) bv[i] += pre;
    b_mid = mid; b_last = all;
}
__device__ __forceinline__ void gla_kv_unit(const Frame& F, int u) {
    const int h = u & 3, n = (u >> 2) & 255, b = u >> 10, t0 = b * S + n * 64;
    const bf16* proj = WSP(bf16, WS_PROJ);
    LAS unsigned char* kd_s = F.lds; LAS unsigned char* v_s = F.lds + 9216;
    LAS float* ga_s = (LAS float*)(F.lds + 26624); LAS float* tot_s = (LAS float*)(F.lds + 30720);
    const int lane = F.lane, fr = lane & 15, fq = lane >> 4;
#pragma unroll
    for (int i = 0; i < 2; ++i) { const int cid = F.tid + 512 * i, row = cid >> 4, ch = cid & 15;
        *(LAS u32x4*)(v_s + row * 272 + ch * 16) = *(const u32x4*)(proj + (size_t)(t0 + row) * INP + GV_OFF + h * 128 + ch * 8); }
    float bv[8], b_mid, b_last;
    gla_gate_prefix(F, proj, t0, h, ga_s, tot_s, bv, b_mid, b_last);
#pragma unroll
    for (int i = 0; i < 8; ++i) { const int t = 8 * F.wave + i;
        const float kx = bf2f(proj[(size_t)(t0 + t) * INP + GK_OFF + h * 64 + lane]);
        *(LAS bf16*)(kd_s + t * 144 + lane * 2) = (bf16)f2bf(kx * __expf(b_last - bv[i])); }
    if (F.wave == 0) WSP(float, WS_DECAY)[((size_t)(b * NCH + n) * 4 + h) * 64 + lane] = __expf(b_last);
    __syncthreads();
    const int c = F.wave;
    f32x4 acc[4];
#pragma unroll
    for (int d = 0; d < 4; ++d) acc[d] = (f32x4){0.f, 0.f, 0.f, 0.f};
#pragma unroll
    for (int ks = 0; ks < 2; ++ks) {
        const int rb = 32 * ks + 8 * fq + (fr >> 2);
        LAS const unsigned char* vp = v_s + rb * 272 + (16 * c + 4 * (lane & 3)) * 2;
        const bf16x8 vf = cat8(trr(vp), trr(vp + 4 * 272));
#pragma unroll
        for (int d = 0; d < 4; ++d) {
            LAS const unsigned char* kp = kd_s + rb * 144 + (16 * d + 4 * (lane & 3)) * 2;
            const bf16x8 kf = cat8(trr(kp), trr(kp + 4 * 144));
            acc[d] = MFMA(kf, vf, acc[d]);
        }
    }
    float* kvp = WSP(float, WS_KV) + (((size_t)(b * NCH + n) * 4 + h) * 128 + 16 * c + fr) * 64;
#pragma unroll
    for (int d = 0; d < 4; ++d) *(f32x4*)(kvp + 16 * d + 4 * fq) = acc[d];
    __syncthreads();
}
__device__ __forceinline__ void gla_scan(const Frame& F) {
    float* kv = WSP(float, WS_KV); const float* decay = WSP(float, WS_DECAY);
    if (F.tid >= 256) return;
    for (int idx = F.bx * 256 + F.tid; idx < 65536; idx += F.G * 256) {
        const int b = idx >> 15, h = (idx >> 13) & 3, dvdk = idx & 8191, dk = idx & 63;
        float* p = kv + ((size_t)(b * NCH) * 4 + h) * 8192 + dvdk;
        const float* dp = decay + ((size_t)(b * NCH) * 4 + h) * 64 + dk;
        float state = 0.f;
        for (int n = 0; n < NCH; n += 8) {
            float tv[8], dv[8];
#pragma unroll
            for (int i = 0; i < 8; ++i) { tv[i] = p[(size_t)(n + i) * 4 * 8192]; dv[i] = dp[(size_t)(n + i) * 4 * 64]; }
#pragma unroll
            for (int i = 0; i < 8; ++i) { p[(size_t)(n + i) * 4 * 8192] = state; state = dv[i] * state + tv[i]; }
        }
    }
}
__device__ __forceinline__ void gla_out_unit(const Frame& F, int u) {
    const int h = u & 3, n = (u >> 2) & 255, b = u >> 10, t0 = b * S + n * 64;
    const bf16* proj = WSP(bf16, WS_PROJ); bf16* mix = WSP(bf16, WS_MIX);
    LAS unsigned char* qd_s = F.lds; LAS unsigned char* kk_s = F.lds + 9216; LAS unsigned char* qe_s = F.lds + 18432;
    LAS unsigned char* v_s = F.lds + 27648; LAS unsigned char* st_s = F.lds + 45056;
    LAS float* ga_s = (LAS float*)(F.lds + 63488); LAS float* tot_s = (LAS float*)(F.lds + 67584); LAS float* ssq_s = (LAS float*)(F.lds + 69632);
    const int lane = F.lane, fr = lane & 15, fq = lane >> 4;
#pragma unroll
    for (int i = 0; i < 2; ++i) { const int cid = F.tid + 512 * i, row = cid >> 4, ch = cid & 15;
        *(LAS u32x4*)(v_s + row * 272 + ch * 16) = *(const u32x4*)(proj + (size_t)(t0 + row) * INP + GV_OFF + h * 128 + ch * 8); }
    const float* stg = WSP(float, WS_KV) + ((size_t)(b * NCH + n) * 4 + h) * 8192;
#pragma unroll
    for (int i = 0; i < 4; ++i) { const int i4 = F.tid + 512 * i, dv = i4 >> 4, dk4 = (i4 & 15) * 4;
        const f32x4 sv = *(const f32x4*)(stg + dv * 64 + dk4);
        u32x2 w; w.x = pk2(sv[0], sv[1]); w.y = pk2(sv[2], sv[3]);
        *(LAS u32x2*)(st_s + dv * 144 + dk4 * 2) = w; }
    float bv[8], b_mid, b_last;
    gla_gate_prefix(F, proj, t0, h, ga_s, tot_s, bv, b_mid, b_last);
#pragma unroll
    for (int i = 0; i < 8; ++i) { const int t = 8 * F.wave + i; const bf16* rp = proj + (size_t)(t0 + t) * INP + h * 64 + lane;
        const float qx = bf2f(rp[GQ_OFF]) * 0.125f, kx = bf2f(rp[GK_OFF]);
        *(LAS bf16*)(qd_s + t * 144 + lane * 2) = (bf16)f2bf(qx * __expf(bv[i] - b_mid));
        *(LAS bf16*)(kk_s + t * 144 + lane * 2) = (bf16)f2bf(kx * __expf(b_mid - bv[i]));
        *(LAS bf16*)(qe_s + t * 144 + lane * 2) = (bf16)f2bf(qx * __expf(bv[i])); }
    __syncthreads();
    const int ib = F.wave >> 1, dvh = F.wave & 1;
    bf16x8 qdf[2], qef[2];
#pragma unroll
    for (int ks = 0; ks < 2; ++ks) { qdf[ks] = *(LAS const bf16x8*)(qd_s + (16 * ib + fr) * 144 + (32 * ks + 8 * fq) * 2);
                                     qef[ks] = *(LAS const bf16x8*)(qe_s + (16 * ib + fr) * 144 + (32 * ks + 8 * fq) * 2); }
    f32x4 at[4];
#pragma unroll
    for (int jt = 0; jt < 4; ++jt) {
        LAS const unsigned char* kp = kk_s + (16 * jt + fr) * 144 + (8 * fq) * 2;
        const bf16x8 k0 = *(LAS const bf16x8*)kp, k1 = *(LAS const bf16x8*)(kp + 64);
        f32x4 z = (f32x4){0.f, 0.f, 0.f, 0.f}; z = MFMA(k0, qdf[0], z); z = MFMA(k1, qdf[1], z);
#pragma unroll
        for (int r = 0; r < 4; ++r) if (16 * jt + 4 * fq + r > 16 * ib + fr) z[r] = 0.f;
        at[jt] = z;
    }
    bf16x8 pf[2];
    pf[0] = pack8(at[0], at[1]); pf[1] = pack8(at[2], at[3]);
    f32x4 o[4];
#pragma unroll
    for (int c = 0; c < 4; ++c) {
        const int dvt = 4 * dvh + c; f32x4 z = (f32x4){0.f, 0.f, 0.f, 0.f};
#pragma unroll
        for (int ks = 0; ks < 2; ++ks) {
            const int rb = 32 * ks + 4 * fq + (fr >> 2);
            LAS const unsigned char* vp = v_s + rb * 272 + (16 * dvt + 4 * (lane & 3)) * 2;
            z = MFMA(pf[ks], cat8(trr(vp), trr(vp + 16 * 272)), z);
        }
#pragma unroll
        for (int ks = 0; ks < 2; ++ks) {
            const bf16x8 sf = *(LAS const bf16x8*)(st_s + (16 * dvt + fr) * 144 + (32 * ks + 8 * fq) * 2);
            z = MFMA(qef[ks], sf, z);
        }
        o[c] = z;
    }
    float ssq[4];
#pragma unroll
    for (int r = 0; r < 4; ++r) { float s = 0.f;
#pragma unroll
        for (int c = 0; c < 4; ++c) s += o[c][r] * o[c][r];
        s += __shfl_xor(s, 1); s += __shfl_xor(s, 2); s += __shfl_xor(s, 4); s += __shfl_xor(s, 8);
        ssq[r] = s; if (fr == 0) ssq_s[F.wave * 16 + 4 * fq + r] = s; }
    __syncthreads();
#pragma unroll
    for (int r = 0; r < 4; ++r) {
        const float tot = ssq[r] + ssq_s[(F.wave ^ 1) * 16 + 4 * fq + r];
        const float rinv = rsqrtf(tot * (1.f / 128.f) + EPS);
        const int t = t0 + 16 * ib + 4 * fq + r;
#pragma unroll
        for (int c = 0; c < 4; ++c) { const int dv = 16 * (4 * dvh + c) + fr;
            const float gg = bf2f(proj[(size_t)t * INP + GG_OFF + h * 128 + dv]);
            const float val = o[c][r] * rinv * F.g_gla_norm[dv] * (gg / (1.f + __expf(-gg)));
            mix[(size_t)t * D + 512 + h * 128 + dv] = (bf16)f2bf(val); }
    }
    __syncthreads();
}

template <bool OUT>
__device__ __forceinline__ void gla_super_unit(const Frame& F, int u) {
    const int sc = u & 31, h = (u >> 5) & 3, b = u >> 7;
    const bf16* proj = WSP(bf16, WS_PROJ); bf16* mix = WSP(bf16, WS_MIX);
    LAS unsigned char* qd_s = F.lds; LAS unsigned char* kk_s = F.lds + 9216; LAS unsigned char* qe_s = F.lds + 18432;
    LAS unsigned char* v_s = F.lds + 27648; LAS unsigned char* st_s = F.lds + 45056; LAS unsigned char* kd_s = F.lds + 63488;
    LAS float* ga_s = (LAS float*)(F.lds + 72704); LAS float* tot_s = (LAS float*)(F.lds + 76800); LAS float* ssq_s = (LAS float*)(F.lds + 78848); LAS float* dec_s = (LAS float*)(F.lds + 79360);
    const int lane = F.lane, fr = lane & 15, fq = lane >> 4;
    const int ib = F.wave >> 1, dvh = F.wave & 1;
    float wu[16];
#pragma unroll
    for (int r = 0; r < 16; ++r) wu[r] = F.w_gate_up[r * 256 + h * 64 + lane];
    const float bg = F.b_gate[h * 64 + lane];
    float gn[4];
#pragma unroll
    for (int cc = 0; cc < 4; ++cc) gn[cc] = OUT ? F.g_gla_norm[16 * (4 * dvh + cc) + fr] : 0.f;
    float* Sg = WSP(float, WS_KV) + (size_t)u * 8192 + (16 * F.wave + fr) * 64 + 4 * fq;
    f32x4 St[4];
#pragma unroll
    for (int d = 0; d < 4; ++d) St[d] = OUT ? *(const f32x4*)(Sg + 16 * d) : (f32x4){0.f, 0.f, 0.f, 0.f};
    float ltot = 0.f;
    u32x4 v_r[2]; unsigned ga_r[2], k_r[8], q_r[8], gg_r[16];
#define GLA_LOAD_CHUNK(tc0) do { \
        _Pragma("unroll") for (int i = 0; i < 2; ++i) { const int cid = F.tid + 512 * i, row = cid >> 4, ch = cid & 15; v_r[i] = *(const u32x4*)(proj + (size_t)((tc0) + row) * INP + GV_OFF + h * 128 + ch * 8); } \
        _Pragma("unroll") for (int i = 0; i < 2; ++i) { const int idx = F.tid + 512 * i, t = idx >> 4, r = idx & 15; ga_r[i] = proj[(size_t)((tc0) + t) * INP + GA_OFF + r]; } \
        _Pragma("unroll") for (int i = 0; i < 8; ++i) { const bf16* rp = proj + (size_t)((tc0) + 8 * F.wave + i) * INP + h * 64 + lane; k_r[i] = rp[GK_OFF]; if (OUT) q_r[i] = rp[GQ_OFF]; } \
        if (OUT) { _Pragma("unroll") for (int r = 0; r < 4; ++r) _Pragma("unroll") for (int cc = 0; cc < 4; ++cc) \
            gg_r[r * 4 + cc] = proj[(size_t)((tc0) + 16 * ib + 4 * fq + r) * INP + GG_OFF + h * 128 + 16 * (4 * dvh + cc) + fr]; } } while (0)
    const int tu0 = b * S + sc * 512;
    GLA_LOAD_CHUNK(tu0);
    for (int c = 0; c < 8; ++c) {
        const int t0 = tu0 + c * 64;
#pragma unroll
        for (int i = 0; i < 2; ++i) { const int cid = F.tid + 512 * i, row = cid >> 4, ch = cid & 15; *(LAS u32x4*)(v_s + row * 272 + ch * 16) = v_r[i]; }
#pragma unroll
        for (int i = 0; i < 2; ++i) ga_s[F.tid + 512 * i] = bf2f(ga_r[i]);
        float kx[8], qx[8], ggf[16];
#pragma unroll
        for (int i = 0; i < 8; ++i) { kx[i] = bf2f(k_r[i]); qx[i] = OUT ? bf2f(q_r[i]) * 0.125f : 0.f; }
#pragma unroll
        for (int i = 0; i < 16; ++i) ggf[i] = OUT ? bf2f(gg_r[i]) : 0.f;
        if (c < 7) GLA_LOAD_CHUNK(t0 + 64);
        __syncthreads();
        float bv[8]; float run = 0.f;
#pragma unroll
        for (int i = 0; i < 8; ++i) {
            const int t = 8 * F.wave + i; float z = bg;
#pragma unroll
            for (int r = 0; r < 16; ++r) z += ga_s[t * 16 + r] * wu[r];
            const float ls = fminf(z, 0.f) - __logf(1.f + __expf(-fabsf(z)));
            run += ls * (1.f / 16.f); bv[i] = run;
        }
        tot_s[F.wave * 64 + lane] = run;
        if (OUT) {
#pragma unroll
            for (int d = 0; d < 4; ++d) { u32x2 w; w.x = pk2(St[d][0], St[d][1]); w.y = pk2(St[d][2], St[d][3]);
                *(LAS u32x2*)(st_s + (16 * F.wave + fr) * 144 + (16 * d + 4 * fq) * 2) = w; }
        }
        __syncthreads();
        float pre = 0.f, b_mid = 0.f, b_last = 0.f;
#pragma unroll
        for (int w = 0; w < 8; ++w) { const float tv = tot_s[w * 64 + lane]; pre += (w < F.wave) ? tv : 0.f; b_mid += (w < 4) ? tv : 0.f; b_last += tv; }
        ltot += b_last;
#pragma unroll
        for (int i = 0; i < 8; ++i) { const int t = 8 * F.wave + i; const float bb = bv[i] + pre;
            *(LAS bf16*)(kd_s + t * 144 + lane * 2) = (bf16)f2bf(kx[i] * __expf(b_last - bb));
            if (OUT) {
                *(LAS bf16*)(qd_s + t * 144 + lane * 2) = (bf16)f2bf(qx[i] * __expf(bb - b_mid));
                *(LAS bf16*)(kk_s + t * 144 + lane * 2) = (bf16)f2bf(kx[i] * __expf(b_mid - bb));
                *(LAS bf16*)(qe_s + t * 144 + lane * 2) = (bf16)f2bf(qx[i] * __expf(bb)); } }
        if (F.wave == 0) dec_s[lane] = __expf(b_last);
        __syncthreads();
        if (OUT) {
            bf16x8 qdf[2], qef[2];
#pragma unroll
            for (int ks = 0; ks < 2; ++ks) { qdf[ks] = *(LAS const bf16x8*)(qd_s + (16 * ib + fr) * 144 + (32 * ks + 8 * fq) * 2);
                                             qef[ks] = *(LAS const bf16x8*)(qe_s + (16 * ib + fr) * 144 + (32 * ks + 8 * fq) * 2); }
            f32x4 at[4];
#pragma unroll
            for (int jt = 0; jt < 4; ++jt) {
                LAS const unsigned char* kp = kk_s + (16 * jt + fr) * 144 + (8 * fq) * 2;
                const bf16x8 k0 = *(LAS const bf16x8*)kp, k1 = *(LAS const bf16x8*)(kp + 64);
                f32x4 z = (f32x4){0.f, 0.f, 0.f, 0.f}; z = MFMA(k0, qdf[0], z); z = MFMA(k1, qdf[1], z);
#pragma unroll
                for (int r = 0; r < 4; ++r) if (16 * jt + 4 * fq + r > 16 * ib + fr) z[r] = 0.f;
                at[jt] = z;
            }
            bf16x8 pf[2];
            pf[0] = pack8(at[0], at[1]); pf[1] = pack8(at[2], at[3]);
            f32x4 o[4];
#pragma unroll
            for (int cc = 0; cc < 4; ++cc) {
                const int dvt = 4 * dvh + cc; f32x4 z = (f32x4){0.f, 0.f, 0.f, 0.f};
#pragma unroll
                for (int ks = 0; ks < 2; ++ks) {
                    const int rb = 32 * ks + 4 * fq + (fr >> 2);
                    LAS const unsigned char* vp = v_s + rb * 272 + (16 * dvt + 4 * (lane & 3)) * 2;
                    z = MFMA(pf[ks], cat8(trr(vp), trr(vp + 16 * 272)), z);
                }
#pragma unroll
                for (int ks = 0; ks < 2; ++ks) {
                    const bf16x8 sf = *(LAS const bf16x8*)(st_s + (16 * dvt + fr) * 144 + (32 * ks + 8 * fq) * 2);
                    z = MFMA(qef[ks], sf, z);
                }
                o[cc] = z;
            }
            float ssq[4];
#pragma unroll
            for (int r = 0; r < 4; ++r) { float sq = 0.f;
#pragma unroll
                for (int cc = 0; cc < 4; ++cc) sq += o[cc][r] * o[cc][r];
                sq += __shfl_xor(sq, 1); sq += __shfl_xor(sq, 2); sq += __shfl_xor(sq, 4); sq += __shfl_xor(sq, 8);
                ssq[r] = sq; if (fr == 0) ssq_s[F.wave * 16 + 4 * fq + r] = sq; }
            __syncthreads();
#pragma unroll
            for (int r = 0; r < 4; ++r) {
                const float tot = ssq[r] + ssq_s[(F.wave ^ 1) * 16 + 4 * fq + r];
                const float rinv = rsqrtf(tot * (1.f / 128.f) + EPS);
                const int t = t0 + 16 * ib + 4 * fq + r;
#pragma unroll
                for (int cc = 0; cc < 4; ++cc) { const int dv = 16 * (4 * dvh + cc) + fr;
                    const float gg = ggf[r * 4 + cc];
                    const float val = o[cc][r] * rinv * gn[cc] * (gg / (1.f + __expf(-gg)));
                    mix[(size_t)t * D + 512 + h * 128 + dv] = (bf16)f2bf(val); }
            }
        }
#pragma unroll
        for (int d = 0; d < 4; ++d) { const f32x4 dc = *(LAS const f32x4*)(dec_s + 16 * d + 4 * fq); St[d] = St[d] * dc; }
#pragma unroll
        for (int ks = 0; ks < 2; ++ks) {
            const int rb = 32 * ks + 8 * fq + (fr >> 2);
            LAS const unsigned char* vp = v_s + rb * 272 + (16 * F.wave + 4 * (lane & 3)) * 2;
            const bf16x8 vf = cat8(trr(vp), trr(vp + 4 * 272));
#pragma unroll
            for (int d = 0; d < 4; ++d) {
                LAS const unsigned char* kp = kd_s + rb * 144 + (16 * d + 4 * (lane & 3)) * 2;
                St[d] = MFMA(cat8(trr(kp), trr(kp + 4 * 144)), vf, St[d]);
            }
        }
        __syncthreads();
    }
#undef GLA_LOAD_CHUNK
    if (!OUT) {
#pragma unroll
        for (int d = 0; d < 4; ++d) *(f32x4*)(Sg + 16 * d) = St[d];
        if (F.wave == 0) WSP(float, WS_DECAY)[u * 64 + lane] = __expf(ltot);
    }
}
__device__ __forceinline__ void gla_super_scan(const Frame& F) {
    float* kv = WSP(float, WS_KV); const float* decay = WSP(float, WS_DECAY);
    if (F.tid >= 256) return;
    for (int idx = F.bx * 256 + F.tid; idx < 65536; idx += F.G * 256) {
        const int bh = idx >> 13, dvdk = idx & 8191, dk = idx & 63;
        float* p = kv + (size_t)(bh * 32) * 8192 + dvdk; const float* dp = decay + (bh * 32) * 64 + dk;
        float tv[32], dv[32];
#pragma unroll
        for (int i = 0; i < 32; ++i) { tv[i] = p[(size_t)i * 8192]; dv[i] = dp[i * 64]; }
        float state = 0.f;
#pragma unroll
        for (int i = 0; i < 32; ++i) { p[(size_t)i * 8192] = state; state = dv[i] * state + tv[i]; }
    }
}

__device__ __forceinline__ void p7_norm_router(const Frame& F) {
    const float* mod = WSP(float, WS_MOD); const bf16* y = WSP(bf16, WS_Y); float* x1 = WSP(float, WS_X1); unsigned char* h2 = WSP(unsigned char, WS_H);
    unsigned* ctl = WSP(unsigned, WS_CTL);
    LAS float* wr_s = (LAS float*)F.lds;
    LAS float* lg_s = (LAS float*)(F.lds + SMALL_OFF);
    LAS float* rx_s = (LAS float*)(F.lds + SMALL_OFF + 16384);
    LAS float* z_s = (LAS float*)(F.lds + SMALL_OFF + 16384 + 512);
    LAS int* cnt_s = (LAS int*)(F.lds + SMALL_OFF + 16384 + 640);
    LAS int* base_s = (LAS int*)(F.lds + SMALL_OFF + 16384 + 768);
    LAS float* zr_s = (LAS float*)(F.lds + SMALL_OFF + 16384 + 1024);
    LAS int* flag_s = (LAS int*)(F.lds + SMALL_OFF + 16384 + 1024 + 2048);
    const int lane = F.lane, fr = lane & 15, fq = lane >> 4;
    const int mb0 = F.bx * 128 + F.wave * 16;
    const float* modb = mod + (mb0 >> 14) * 6144;
#pragma unroll 4
    for (int i = 0; i < 16; ++i) { const int i4 = F.tid + 512 * i, k = i4 >> 3, e0 = (i4 & 7) * 4;
        const f32x4 w = *(const f32x4*)(F.w_router + k * 32 + e0);
        const float gs = F.g_pre_ffn[k] * (1.f + modb[4096 + k]);
        LAS float* dst = wr_s + (k >> 2) * 128 + e0 * 4 + (k & 3);
        dst[0] = w[0] * gs; dst[4] = w[1] * gs; dst[8] = w[2] * gs; dst[12] = w[3] * gs; }
    { const int e = F.tid & 31, ks = F.tid >> 5; float zz = 0.f;
#pragma unroll
        for (int i = 0; i < 64; ++i) { const int k = ks * 64 + i; zz += modb[3072 + k] * F.w_router[k * 32 + e]; }
        zr_s[ks * 32 + e] = zz; }
    if (F.tid < 32) cnt_s[F.tid] = 0;
    __syncthreads();
    if (F.tid < 32) { float zz = F.b_router[F.tid];
#pragma unroll
        for (int i = 0; i < 16; ++i) zz += zr_s[i * 32 + F.tid];
        z_s[F.tid] = zz; }
    f32x4 pg[4], pg2[4], psh[4];
    u32x2 ya[4], yb[4], yc[4], yd[4]; f32x4 xa[4], xbf[4], xc[4], xd[4];
    const bf16* ybase = y + (size_t)mb0 * D + 4 * lane; const float* xbase = F.x + (size_t)mb0 * D + 4 * lane;
#define P7_LOAD(Y, X, r) do { _Pragma("unroll") for (int j = 0; j < 4; ++j) { Y[j] = *(const u32x2*)(ybase + (size_t)(r) * D + 256 * j); X[j] = *(const f32x4*)(xbase + (size_t)(r) * D + 256 * j); } } while (0)
#define P7_ROW(Y, X, it) do { f32x4 xv[4], hv[4]; float ss = 0.f; \
        _Pragma("unroll") for (int j = 0; j < 4; ++j) { hv[j] = unpack4(Y[j]); ss += dot4(hv[j]); } \
        const float ry = rsqrtf(wave_sum(ss) * (1.f / D) + EPS); float s2 = 0.f; \
        _Pragma("unroll") for (int j = 0; j < 4; ++j) { xv[j] = X[j] + hv[j] * ry * pg[j]; s2 += dot4(xv[j]); } \
        const float rx = rsqrtf(wave_sum(s2) * (1.f / D) + EPS); \
        if (lane == 0) rx_s[F.wave * 16 + (it)] = rx; \
        _Pragma("unroll") for (int j = 0; j < 4; ++j) { const int idx = 4 * lane + 256 * j; \
            hv[j] = xv[j] * rx * pg2[j] + psh[j]; \
            *(f32x4*)(x1 + (size_t)(mb0 + (it)) * D + idx) = xv[j]; \
            *(unsigned*)(h2 + (size_t)(mb0 + (it)) * D + idx) = pk4_fp8(hv[j][0] * H8_SCALE, hv[j][1] * H8_SCALE, hv[j][2] * H8_SCALE, hv[j][3] * H8_SCALE); } \
        if ((it) + 4 < 16) P7_LOAD(Y, X, (it) + 4); } while (0)
    P7_LOAD(ya, xa, 0); P7_LOAD(yb, xbf, 1); P7_LOAD(yc, xc, 2); P7_LOAD(yd, xd, 3);
#pragma unroll
    for (int j = 0; j < 4; ++j) { const int idx = 4 * lane + 256 * j;
        pg[j] = *(const f32x4*)(F.g_post_mix + idx) * *(const f32x4*)(modb + 2048 + idx);
        pg2[j] = *(const f32x4*)(F.g_pre_ffn + idx) * (*(const f32x4*)(modb + 4096 + idx) + 1.f); psh[j] = *(const f32x4*)(modb + 3072 + idx); }
#pragma unroll 1
    for (int it = 0; it < 16; it += 4) { P7_ROW(ya, xa, it); P7_ROW(yb, xbf, it + 1); P7_ROW(yc, xc, it + 2); P7_ROW(yd, xd, it + 3); }
#undef P7_LOAD
#undef P7_ROW
    asm volatile("s_waitcnt vmcnt(0)" ::: "memory");
    f32x4 acc0 = (f32x4){0.f, 0.f, 0.f, 0.f}, acc1 = (f32x4){0.f, 0.f, 0.f, 0.f};
    { const float* ap = x1 + (size_t)(mb0 + fr) * D + 4 * fq;
        LAS const float* bp = wr_s + fq * 128 + fr * 4;
        f32x4 a[8], na[8];
#pragma unroll
        for (int q = 0; q < 8; ++q) a[q] = *(const f32x4*)(ap + 16 * q);
        for (int s0 = 0; s0 < 64; s0 += 8) {
            const int sn = s0 < 56 ? s0 + 8 : s0;
#pragma unroll
            for (int q = 0; q < 8; ++q) na[q] = *(const f32x4*)(ap + 16 * (sn + q));
#pragma unroll
            for (int q = 0; q < 8; ++q) { const f32x4 b0 = *(LAS const f32x4*)(bp + (s0 + q) * 512), b1 = *(LAS const f32x4*)(bp + (s0 + q) * 512 + 64);
#pragma unroll
                for (int t = 0; t < 4; ++t) { acc0 = __builtin_amdgcn_mfma_f32_16x16x4f32(a[q][t], b0[t], acc0, 0, 0, 0); acc1 = __builtin_amdgcn_mfma_f32_16x16x4f32(a[q][t], b1[t], acc1, 0, 0, 0); } }
#pragma unroll
            for (int q = 0; q < 8; ++q) a[q] = na[q];
        } }
    __syncthreads();
#pragma unroll
    for (int r = 0; r < 4; ++r) { const float rx = rx_s[F.wave * 16 + 4 * fq + r];
        lg_s[(F.wave * 16 + 4 * fq + r) * 32 + fr] = rx * acc0[r] + z_s[fr];
        lg_s[(F.wave * 16 + 4 * fq + r) * 32 + fr + 16] = rx * acc1[r] + z_s[fr + 16]; }
    const float NEG_INF = -__builtin_inff();
    int se[4], lp[4]; float gt[4];
    if (lane < 16) {
        float v[32];
#pragma unroll
        for (int ch = 0; ch < 8; ++ch) { const f32x4 w = *(LAS const f32x4*)(lg_s + (F.wave * 16 + lane) * 32 + 4 * ch); v[4 * ch] = w[0]; v[4 * ch + 1] = w[1]; v[4 * ch + 2] = w[2]; v[4 * ch + 3] = w[3]; }
        float sv[4];
#pragma unroll
        for (int r = 0; r < 4; ++r) { float best = v[0]; int bi = 0;
#pragma unroll
            for (int e = 1; e < 32; ++e) if (v[e] > best) { best = v[e]; bi = e; }
            se[r] = bi; sv[r] = best;
#pragma unroll
            for (int e = 0; e < 32; ++e) v[e] = (e == bi) ? NEG_INF : v[e]; }
        const float p1 = __expf(sv[1] - sv[0]), p2 = __expf(sv[2] - sv[0]), p3 = __expf(sv[3] - sv[0]);
        const float rs = 1.f / (1.f + p1 + p2 + p3);
        gt[0] = rs; gt[1] = p1 * rs; gt[2] = p2 * rs; gt[3] = p3 * rs;
#pragma unroll
        for (int r = 0; r < 4; ++r) lp[r] = __hip_atomic_fetch_add(cnt_s + se[r], 1, __ATOMIC_RELAXED, __HIP_MEMORY_SCOPE_WORKGROUP);
    }
    __syncthreads();
    if (F.tid < 32) base_s[F.tid] = (int)__hip_atomic_fetch_add(ctl + CW_GCNT + 64 * F.tid, (unsigned)cnt_s[F.tid], __ATOMIC_RELAXED, __HIP_MEMORY_SCOPE_AGENT);
    __syncthreads();
    if (lane < 16) { int* la = WSP(int, WS_LIST_A); const int m = mb0 + lane;
#pragma unroll
        for (int r = 0; r < 4; ++r) { const int pos = base_s[se[r]] + lp[r]; la[(size_t)se[r] * T + pos] = m * 4 + r;
            WSP(int, WS_TOK_E)[m * 4 + r] = (se[r] << 20) | pos; WSP(float, WS_TOK_GATE)[m * 4 + r] = gt[r]; } }
    asm volatile("s_waitcnt vmcnt(0)" ::: "memory");
    __syncthreads();
    if (F.tid == 0) flag_s[0] = (__hip_atomic_fetch_add(ctl + CW_DONE, 1u, __ATOMIC_RELAXED, __HIP_MEMORY_SCOPE_AGENT) == (unsigned)(F.G - 1)) ? 1 : 0;
    __syncthreads();
    if (flag_s[0]) {
        LAS int* off_s = (LAS int*)zr_s;
        if (F.tid < 32) { const int c = (int)__hip_atomic_load(ctl + CW_GCNT + 64 * F.tid, __ATOMIC_RELAXED, __HIP_MEMORY_SCOPE_AGENT); cnt_s[F.tid] = c; ctl[CW_MOE_CNT + F.tid] = (unsigned)c; }
        __syncthreads();
        if (F.tid == 0) { int off = 0; for (int e = 0; e < 32; ++e) { off_s[e] = off; off += (cnt_s[e] + 255) & ~255; } off_s[32] = off; }
        __syncthreads();
        if (F.tid <= 32) WSP(int, WS_MOE_OFF)[F.tid] = off_s[F.tid];
        const int ntile = off_s[32] >> 8;
        for (int rt = F.tid; rt < ntile; rt += NTHREADS) { int e = 0;
            for (int q = 1; q < 32; ++q) e = (off_s[q] <= rt * 256) ? q : e;
            WSP(int, WS_TILE_E)[rt] = e;
            i32x4 dsc; dsc.x = e; dsc.y = rt * 256 - off_s[e]; dsc.z = cnt_s[e]; dsc.w = 0; WSP(i32x4, WS_TDESC)[rt] = dsc; }
    }
}

__device__ __forceinline__ f32x4 unpack4_fp8(unsigned w) {
    const auto lo = __builtin_amdgcn_cvt_pk_f32_fp8((int)w, false), hi = __builtin_amdgcn_cvt_pk_f32_fp8((int)w, true);
    return (f32x4){lo[0], lo[1], hi[0], hi[1]};
}
__device__ __forceinline__ void p11_combine(const Frame& F) {
    const float* mod = WSP(float, WS_MOD); const unsigned char* ys = WSP(unsigned char, WS_YS); const float* x1 = WSP(float, WS_X1);
    const int gw = F.bx * NWAVES + F.wave, m0 = gw * 16, lane = F.lane;
    const float* modb = mod + (m0 >> 14) * 6144;
    LAS int* slot_s = (LAS int*)(F.lds + F.wave * 512); LAS float* gate_s = (LAS float*)(F.lds + F.wave * 512 + 256);
    { const int ep = WSP(int, WS_TOK_E)[m0 * 4 + lane]; slot_s[lane] = WSP(int, WS_MOE_OFF)[ep >> 20] + (ep & 0xfffff); gate_s[lane] = WSP(float, WS_TOK_GATE)[m0 * 4 + lane]; }
    const float* xb = x1 + (size_t)m0 * D + 4 * lane;
    unsigned ya[4][4], ybb[4][4], yc[4][4], yd[4][4]; f32x4 xa[4], xbf[4], xc[4], xd[4], g[4];
#define P11_LOAD(Y, X, r) do { _Pragma("unroll") for (int k4 = 0; k4 < 4; ++k4) { const unsigned char* yp = ys + (size_t)__builtin_amdgcn_readfirstlane(slot_s[(r) * 4 + k4]) * D + 4 * lane; \
            _Pragma("unroll") for (int j = 0; j < 4; ++j) Y[j][k4] = *(const unsigned*)(yp + 256 * j); } \
        _Pragma("unroll") for (int j = 0; j < 4; ++j) X[j] = *(const f32x4*)(xb + (size_t)(r) * D + 256 * j); } while (0)
#define P11_ROW(Y, X, it) do { f32x4 yv[4]; float ss = 0.f; const f32x4 gk = *(LAS const f32x4*)(gate_s + (it) * 4); \
        _Pragma("unroll") for (int j = 0; j < 4; ++j) { f32x4 a = unpack4_fp8(Y[j][0]) * gk[0]; a += unpack4_fp8(Y[j][1]) * gk[1]; a += unpack4_fp8(Y[j][2]) * gk[2]; a += unpack4_fp8(Y[j][3]) * gk[3]; \
            yv[j] = a; ss += dot4(a); } \
        const float ry = rsqrtf(wave_sum(ss) * (1.f / D) + EPS * (Y8_SCALE * Y8_SCALE)); \
        _Pragma("unroll") for (int j = 0; j < 4; ++j) *(f32x4*)(F.out + (size_t)(m0 + (it)) * D + 4 * lane + 256 * j) = X[j] + yv[j] * ry * g[j]; \
        if ((it) + 4 < 16) P11_LOAD(Y, X, (it) + 4); } while (0)
    P11_LOAD(ya, xa, 0); P11_LOAD(ybb, xbf, 1); P11_LOAD(yc, xc, 2); P11_LOAD(yd, xd, 3);
#pragma unroll
    for (int j = 0; j < 4; ++j) { const int idx = 4 * lane + 256 * j; g[j] = *(const f32x4*)(F.g_post_ffn + idx) * *(const f32x4*)(modb + 5120 + idx); }
#pragma unroll 1
    for (int it = 0; it < 16; it += 4) { P11_ROW(ya, xa, it); P11_ROW(ybb, xbf, it + 1); P11_ROW(yc, xc, it + 2); P11_ROW(yd, xd, it + 3); }
#undef P11_LOAD
#undef P11_ROW
}

constexpr int NPHASE = 11;
struct Args { const float* in[20]; float* out; unsigned char* ws; int ph_lo, ph_hi; };
__global__ void __launch_bounds__(NTHREADS, 2) fwd(Args args) {
    extern __shared__ __attribute__((aligned(16))) unsigned char lds[];
    Frame F;
    F.lds = (LAS unsigned char*)lds;
    F.tid = threadIdx.x; F.lane = F.tid & 63; F.wave = __builtin_amdgcn_readfirstlane(F.tid >> 6); F.bx = blockIdx.x; F.G = gridDim.x;
    F.x = args.in[0]; F.c = args.in[1]; F.w_ada = args.in[2]; F.b_ada = args.in[3]; F.g_pre_mix = args.in[4]; F.g_post_mix = args.in[5];
    F.g_pre_ffn = args.in[6]; F.g_post_ffn = args.in[7]; F.w_in = args.in[8]; F.w_gate_up = args.in[9]; F.b_gate = args.in[10]; F.g_gla_norm = args.in[11];
    F.sinks = args.in[12]; F.w_out = args.in[13]; F.w_router = args.in[14]; F.b_router = args.in[15]; F.w_mlp1 = args.in[16]; F.b_mlp1 = args.in[17];
    F.w_mlp2 = args.in[18]; F.b_mlp2 = args.in[19]; F.out = args.out; F.ws = args.ws;
    volatile LAS unsigned* MISC = (volatile LAS unsigned*)(F.lds + MISC_OFF);
    if (F.tid < 32) MISC[F.tid] = 0u;
    __syncthreads();
    const int lo = args.ph_lo, hi = args.ph_hi;
    XcdBarrier bar; bar.bar = (unsigned*)(F.ws + WS_CTL) + CW_BAR; bar.x = 0; bar.st = nullptr;
    if (hi - lo > 1) bar = xcd_barrier_post((unsigned*)(F.ws + WS_CTL) + CW_BAR, MISC + 8);
#define IN(k) (lo <= (k) && (k) < hi)
#if DUPMASK
#define REP(k) _Pragma("nounroll") for (int rep_ = 0; rep_ < 1 + ((DUPMASK >> (k)) & 1); ++rep_, __syncthreads())
#else
#define REP(k)
#endif
#define SEAM(k) do { if (IN(k) && IN((k) + 1)) xcd_barrier(bar); } while (0)

    if (IN(0)) { p0_prologue<0>(F);
#if DUPMASK & 1
        __syncthreads(); p0_prologue<P0_MODE>(F);
#endif
    } SEAM(0);
    if (IN(1)) REP(1) { p1_norm(F); } SEAM(1);
    if (IN(2)) {
        constexpr int I_FIRST = 16 * 80 + 16 * 32, I_PER = (NE * 16 * 64 + NE * 16 * 32) / GRID;
        const int grp = F.bx & 3, pos = grp == 0 ? 0 : grp == 1 ? 1 : grp == 2 ? 3 : 4;
        { pg8::StaticOrder So; So.init(T / 256, INP / 256, F.G, F.bx, 0, pos);
          pg8::gemm_phase<false, 0, 0, 0>(F.lds, D, So, pg8::ABDense{WSP(bf16, WS_H), WSP(bf16, WS_WIN), D}, pg8::EpiStoreT{WSP(bf16, WS_PROJ), INP}); }
        __syncthreads();
        tr_range<0>(F, I_FIRST + F.bx * I_PER, I_FIRST + (F.bx + 1) * I_PER);
        __syncthreads();
        { pg8::StaticOrder So; So.init(T / 256, INP / 256, F.G, F.bx, pos);
          pg8::gemm_phase<false, 0, 0, 0>(F.lds, D, So, pg8::ABDense{WSP(bf16, WS_H), WSP(bf16, WS_WIN), D}, pg8::EpiStoreT{WSP(bf16, WS_PROJ), INP}); }
    } SEAM(2);
    if (IN(3)) { for (int u = F.bx; u < 512; u += F.G) attn_unit(F, u);
                 for (int u = F.bx; u < 256; u += F.G) gla_super_unit<false>(F, u);
#if DUPMASK & 8
                 __syncthreads();
                 if (P3_MODE == 0 || P3_MODE == 1) for (int u = F.bx; u < 512; u += F.G) attn_unit(F, u);
                 if (P3_MODE == 0 || P3_MODE == 2) for (int u = F.bx; u < 256; u += F.G) gla_super_unit<false>(F, u);
#endif
    } SEAM(3);
    if (IN(4)) REP(4) { gla_super_scan(F); } SEAM(4);
    if (IN(5)) REP(5) { for (int u = F.bx; u < 256; u += F.G) gla_super_unit<true>(F, u); } SEAM(5);
    if (IN(6)) REP(6) { pg8::StaticOrder So; So.init(T / 256, D / 256, F.G, F.bx);
                 pg8::gemm_phase<false, 0, 0, 0>(F.lds, D, So, pg8::ABDense{WSP(bf16, WS_MIX), WSP(bf16, WS_WOUT), D}, pg8::EpiStoreT{WSP(bf16, WS_Y), D}); } SEAM(6);
    if (IN(7)) { p7_norm_router(F);
#if DUPMASK & 128
        __syncthreads(); p7_norm_router(F);
#endif
    } SEAM(7);
    if (IN(8)) { const int nM = WSP(int, WS_MOE_OFF)[32] >> 8;
                 { pg8::StaticOrder So; So.init(nM, 2048 / 256, F.G, F.bx);
                 pg8::gemm_phase<true, 1, W8_E8M0, H8_E8M0>(F.lds, 512, So, pg8::ABMoe1{WSP(unsigned char, WS_H), WSP(unsigned char, WS_W1T), WSP(i32x4, WS_TDESC), WSP(int, WS_LIST_A)},
                                       pg8::EpiSwigluT{WSP(unsigned char, WS_A), F.b_mlp1}); }
#if DUPMASK & 256
                 __syncthreads();
                 { pg8::StaticOrder So; So.init(nM, 2048 / 256, F.G, F.bx);
                 pg8::gemm_phase<true, 1, W8_E8M0, H8_E8M0, G1_ABL>(F.lds, 512, So, pg8::ABMoe1{WSP(unsigned char, WS_H), WSP(unsigned char, WS_W1T), WSP(i32x4, WS_TDESC), WSP(int, WS_LIST_A)},
                                       pg8::EpiSwigluT{WSP(unsigned char, WS_XS), F.b_mlp1}); }
#endif
    } SEAM(8);
    if (IN(9)) { const int nM = WSP(int, WS_MOE_OFF)[32] >> 8;
                  { pg8::StaticOrder So; So.init(nM, D / 256, F.G, F.bx);
                  pg8::gemm_phase<false, 1, W8_E8M0, A8_E8M0>(F.lds, 512, So, pg8::ABMoe2{WSP(unsigned char, WS_A), WSP(unsigned char, WS_W2T), WSP(i32x4, WS_TDESC)},
                                         pg8::EpiMoe2T{WSP(unsigned char, WS_YS), F.b_mlp2}); }
#if DUPMASK & 512
                  __syncthreads();
                  { pg8::StaticOrder So; So.init(nM, D / 256, F.G, F.bx);
                  pg8::gemm_phase<false, 1, W8_E8M0, A8_E8M0, G2_ABL>(F.lds, 512, So, pg8::ABMoe2{WSP(unsigned char, WS_A), WSP(unsigned char, WS_W2T), WSP(i32x4, WS_TDESC)},
                                         pg8::EpiMoe2T{WSP(unsigned char, WS_YS), F.b_mlp2}); }
#endif
    } SEAM(9);
    if (IN(10)) { p11_combine(F);
#if DUPMASK & 1024
        __syncthreads(); p11_combine(F);
#endif
    }
#undef IN
#undef SEAM
}

extern "C" void kernel_launch(void* const* d_in, const int* in_sizes, int n_in, void* d_out, int out_size, void* d_ws, size_t ws_size, hipStream_t stream) {
    static int ready = 0;
    if (ready == 0) {
        if (n_in != 20 || out_size != T * D || ws_size < WS_END) { fprintf(stderr, "kernel_launch: unexpected problem (n_in %d, out %d, ws %zu)\n", n_in, out_size, ws_size); ready = -1; return; }
        if (hipFuncSetAttribute((const void*)fwd, hipFuncAttributeMaxDynamicSharedMemorySize, LDS_BYTES) != hipSuccess) { fprintf(stderr, "kernel_launch: hipFuncSetAttribute failed\n"); ready = -1; return; }
        int per_cu = 0;
        if (hipOccupancyMaxActiveBlocksPerMultiprocessor(&per_cu, (const void*)fwd, NTHREADS, LDS_BYTES) != hipSuccess || per_cu < 1) fprintf(stderr, "kernel_launch: occupancy query says %d\n", per_cu);
        (void)hipGetLastError();
        ready = 1;
    }
    if (ready < 0) return;
    (void)hipMemsetAsync((char*)d_ws + WS_CTL, 0, CTL_ZERO_BYTES, stream);
    Args a{};
    for (int i = 0; i < 20; ++i) a.in[i] = (const float*)d_in[i];
    a.out = (float*)d_out; a.ws = (unsigned char*)d_ws;
#if MK_ONE_LAUNCH
    a.ph_lo = 0; a.ph_hi = NPHASE;
    hipLaunchKernelGGL(fwd, dim3(GRID), dim3(NTHREADS), LDS_BYTES, stream, a);
#if PROBE_PHASE >= 0
    a.ph_lo = PROBE_PHASE; a.ph_hi = PROBE_PHASE + 1;
    hipLaunchKernelGGL(fwd, dim3(GRID), dim3(NTHREADS), LDS_BYTES, stream, a);
#endif
#else
    for (int p = 0; p < NPHASE; ++p) { a.ph_lo = p; a.ph_hi = p + 1; hipLaunchKernelGGL(fwd, dim3(GRID), dim3(NTHREADS), LDS_BYTES, stream, a); }
#endif
}
```

```cpp
#include <hip/hip_runtime.h>
#include <cstdio>
#include <cstdint>

#ifndef MK_ONE_LAUNCH
#define MK_ONE_LAUNCH 1
#endif
#define LAS __attribute__((address_space(3)))
typedef unsigned short bf16;
typedef short bf16x8 __attribute__((ext_vector_type(8)));
typedef short s16x4 __attribute__((ext_vector_type(4)));
typedef float f32x4 __attribute__((ext_vector_type(4)));
typedef unsigned u32x4 __attribute__((ext_vector_type(4)));
typedef unsigned u32x2 __attribute__((ext_vector_type(2)));

constexpr int D = 1024, NB = 2, S = 16384, T = NB * S;
constexpr int INW = 2320, INP = 2560;
constexpr int AQ_OFF = 0, AK_OFF = 512, AV_OFF = 640, GQ_OFF = 768, GK_OFF = 1024, GV_OFF = 1280, GG_OFF = 1792, GA_OFF = 2304;
constexpr size_t PJ_TILE = (size_t)T * 256;
__device__ __forceinline__ size_t pj(int row, int col) { return (size_t)(col >> 8) * PJ_TILE + (size_t)row * 256 + (col & 255); }
constexpr int NCH = 256;
constexpr int NE = 32, FF = 1024;
constexpr int NSLOT_MAX = T * 4 + NE * 256;
constexpr float EPS = 1e-6f;
constexpr int NWAVES = 8, NTHREADS = 512, GRID = 256;

constexpr size_t MiB = 1u << 20;
constexpr size_t WS_CTL = 0, CTL_ZERO_BYTES = 64 * 1024;
constexpr size_t WS_MOD = 1 * MiB;
constexpr size_t WS_DECAY = 2 * MiB;
constexpr size_t WS_ROUTE = 3 * MiB;
constexpr size_t WS_TOK_E = WS_ROUTE, WS_TOK_LPOS = WS_ROUTE + 512 * 1024, WS_TOK_GATE = WS_ROUTE + 1024 * 1024;
constexpr size_t WS_BLK_CNT = WS_ROUTE + 1536 * 1024, WS_MOE_OFF = WS_BLK_CNT + 32 * 1024, WS_TILE_E = WS_MOE_OFF + 4096;
constexpr size_t WS_TDESC = WS_TILE_E + 4096;
constexpr size_t WS_RIMG = WS_ROUTE + 2 * MiB, WS_ZPART = WS_RIMG + 256 * 1024;
constexpr size_t WS_WIN = 8 * MiB, WS_WOUT = 13 * MiB, WS_W2T = 16 * MiB, WS_W1T = 80 * MiB;
constexpr size_t WS_H = 208 * MiB, WS_KV = 272 * MiB, WS_YS = 80 * MiB;
constexpr size_t WS_X1 = 336 * MiB, WS_PROJ = 464 * MiB, WS_MIX = 624 * MiB, WS_Y = 688 * MiB, WS_A = 464 * MiB;
constexpr size_t WS_LIST_A = 752 * MiB, WS_LIST_G = 756 * MiB;
constexpr size_t WS_XS = 608 * MiB;
constexpr size_t WS_END = 760 * MiB;
constexpr int CW_BAR = 4096, CW_GCNT = 8192  ;

constexpr int TDESC_OFF = 132096, MOFF_OFF = TDESC_OFF + 544 * 16, MCNT_OFF = MOFF_OFF + 256;
constexpr int LDS_BYTES = 163840, SMALL_OFF = 132096, MISC_OFF = 163840 - 256;

__device__ __forceinline__ float bf2f(unsigned v) { return __uint_as_float(v << 16); }
typedef float f32x2_t __attribute__((ext_vector_type(2))); typedef __bf16 bf16x2_t __attribute__((ext_vector_type(2)));
__device__ __forceinline__ unsigned pk2(float lo, float hi) { f32x2_t v = {lo, hi}; return __builtin_bit_cast(unsigned, __builtin_convertvector(v, bf16x2_t)); }
__device__ __forceinline__ unsigned f2bf(float f) { return pk2(f, f) & 0xffffu; }
__device__ __forceinline__ float wave_sum(float v) {
#pragma unroll
    for (int o = 1; o < 64; o <<= 1) v += __shfl_xor(v, o);
    return v;
}
__device__ __forceinline__ f32x4 unpack4(u32x2 r) { return (f32x4){bf2f(r.x & 0xffffu), bf2f(r.x >> 16), bf2f(r.y & 0xffffu), bf2f(r.y >> 16)}; }
__device__ __forceinline__ float dot4(f32x4 a) { return (a[0] * a[0] + a[1] * a[1]) + (a[2] * a[2] + a[3] * a[3]); }
typedef short v4i16_t __attribute__((ext_vector_type(4)));
__device__ __forceinline__ s16x4 trr(LAS const unsigned char* p) { return __builtin_bit_cast(s16x4, __builtin_amdgcn_ds_read_tr16_b64_v4i16((LAS v4i16_t*)p)); }
__device__ __forceinline__ bf16x8 cat8(s16x4 lo, s16x4 hi) { return __builtin_shufflevector(lo, hi, 0, 1, 2, 3, 4, 5, 6, 7); }
__device__ __forceinline__ bf16x8 pack8(f32x4 a, f32x4 b) { u32x4 w; w.x = pk2(a[0], a[1]); w.y = pk2(a[2], a[3]); w.z = pk2(b[0], b[1]); w.w = pk2(b[2], b[3]); return __builtin_bit_cast(bf16x8, w); }
#define MFMA(a, b, c) __builtin_amdgcn_mfma_f32_16x16x32_bf16((a), (b), (c), 0, 0, 0)
typedef int i32x4 __attribute__((ext_vector_type(4)));
typedef int i32x8 __attribute__((ext_vector_type(8)));
__device__ __forceinline__ float clamp8(float v) { return __builtin_amdgcn_fmed3f(v, -448.f, 448.f); }
__device__ __forceinline__ unsigned pk4_fp8(float a, float b, float c, float d) {
    int w = 0; w = __builtin_amdgcn_cvt_pk_fp8_f32(clamp8(a), clamp8(b), w, false); w = __builtin_amdgcn_cvt_pk_fp8_f32(clamp8(c), clamp8(d), w, true); return (unsigned)w; }
constexpr float W8_SCALE = 64.f, H8_SCALE = 16.f, A8_SCALE = 4.f, Y8_SCALE = 16.f;
constexpr int W8_E8M0 = 0x79797979  , H8_E8M0 = 0x7b7b7b7b  , A8_E8M0 = 0x7d7d7d7d  ;

#define XB_TMO      128
#define XB_XCNT(j)  (256  + 64 * (j))
#define XB_XSUB(j)  (1280 + 64 * (j))
#define XB_XGEN(j)  (2304 + 64 * (j))
#define XB_TOP      3328
#define XB_TOPGEN   3392
#define XCD_BAR_WORDS 3456
#define XB_SPIN_CAP (1u << 18)
__device__ __forceinline__ unsigned xb_ld(unsigned* p)              { return __hip_atomic_load(p, __ATOMIC_RELAXED, __HIP_MEMORY_SCOPE_AGENT); }
__device__ __forceinline__ unsigned xb_add(unsigned* p, unsigned v) { return __hip_atomic_fetch_add(p, v, __ATOMIC_RELAXED, __HIP_MEMORY_SCOPE_AGENT); }
__device__ __forceinline__ unsigned xb_xcc_id() { return (unsigned)__builtin_amdgcn_s_getreg((3 << 11) | 20) & 0xFu; }
#define XB_SPIN(cond, bar) do { unsigned _sp = 0; while (cond) { __builtin_amdgcn_s_sleep(1); \
    if ((++_sp & 255u) == 0u) { if (xb_ld(&(bar)[XB_TMO])) break; if (_sp > XB_SPIN_CAP) { atomicAdd(&(bar)[XB_TMO], 1u); break; } } } } while (0)
struct XcdBarrier { unsigned* bar; unsigned x; volatile LAS unsigned* st; };
__device__ __forceinline__ XcdBarrier xcd_barrier_post(unsigned* bar, volatile LAS unsigned* st) {
    XcdBarrier b; b.bar = bar; b.x = xb_xcc_id(); b.st = st;
    if (threadIdx.x == 0) (void)xb_add(&bar[XB_XCNT(b.x)], 1u);
    return b;
}
__device__ __forceinline__ void xcd_barrier_complete(unsigned* bar, unsigned x, unsigned& nloc, unsigned& nx) {
    const unsigned G = gridDim.x * gridDim.y * gridDim.z;
    unsigned sum, cnt, mine, sp = 0u;
    for (;;) {
        sum = 0u; cnt = 0u; mine = 0u;
#pragma unroll
        for (unsigned j = 0; j < 16; ++j) { const unsigned c = xb_ld(&bar[XB_XCNT(j)]); sum += c; cnt += (c > 0u) ? 1u : 0u; mine = (j == x) ? c : mine; }
        if (sum == G) break;
        __builtin_amdgcn_s_sleep(1);
        if ((++sp & 255u) == 0u) { if (xb_ld(&bar[XB_TMO])) break; if (sp > XB_SPIN_CAP) { atomicAdd(&bar[XB_TMO], 1u); break; } }
    }
    nloc = mine > 0u ? mine : 1u; nx = cnt > 0u ? cnt : 1u;
}
__device__ __forceinline__ void xcd_barrier(const XcdBarrier& b) {
    asm volatile("s_waitcnt vmcnt(0)" ::: "memory");
    __syncthreads();
    if (threadIdx.x == 0) {
        unsigned* bar = b.bar;
        __builtin_amdgcn_s_waitcnt(0);
        unsigned nloc = b.st[0], nx = b.st[1];
        if (nloc == 0u) { xcd_barrier_complete(bar, b.x, nloc, nx); b.st[0] = nloc; b.st[1] = nx; }
        const unsigned old = xb_add(&bar[XB_XSUB(b.x)], 1u);
        const unsigned gen = old / nloc;
        if (old + 1u == (gen + 1u) * nloc) {
            __builtin_amdgcn_fence(__ATOMIC_RELEASE, "agent");
            asm volatile("s_waitcnt vmcnt(0)" ::: "memory");
            const unsigned og = xb_add(&bar[XB_TOP], 1u);
            const unsigned tg = og / nx;
            if (og + 1u == (tg + 1u) * nx) xb_add(&bar[XB_TOPGEN], 1u);
            else XB_SPIN(xb_ld(&bar[XB_TOPGEN]) == tg, bar);
            __builtin_amdgcn_fence(__ATOMIC_ACQUIRE, "agent");
            xb_add(&bar[XB_XGEN(b.x)], 1u);
            asm volatile("s_waitcnt vmcnt(0)" ::: "memory");
        } else {
            XB_SPIN(xb_ld(&bar[XB_XGEN(b.x)]) == gen, bar);
            __builtin_amdgcn_fence(__ATOMIC_ACQUIRE, "agent");
            asm volatile("s_waitcnt vmcnt(0)" ::: "memory");
        }
    }
    __syncthreads();
}

struct Frame {
    LAS unsigned char* lds;
    int tid, lane, wave, bx, G;
    const float *x, *c, *w_ada, *b_ada, *g_pre_mix, *g_post_mix, *g_pre_ffn, *g_post_ffn, *w_in, *w_gate_up, *b_gate, *g_gla_norm, *sinks, *w_out,
                *w_router, *b_router, *w_mlp1, *b_mlp1, *w_mlp2, *b_mlp2;
    float* out;
    unsigned char* ws;
};
#define WSP(type, off) ((type*)(F.ws + (off)))

struct TrItem { const float* W; int N; int k0, n0; unsigned char* WT; int kind; };
__device__ __forceinline__ bool tr_decode(const Frame& F, int it, TrItem& t) {
    constexpr int I_IN = 16 * 80, I_OUT = 16 * 32, I_1 = 16 * 64, I_2 = 16 * 32;
    constexpr int NITEMS = I_IN + I_OUT + NE * I_1 + NE * I_2;
    if (it >= NITEMS) return false;
    int r = it, item;
    if (r < I_IN) { t.W = F.w_in; t.N = INW; t.WT = F.ws + WS_WIN; t.kind = 0; item = r; }
    else if ((r -= I_IN) < I_OUT) { t.W = F.w_out; t.N = 1024; t.WT = F.ws + WS_WOUT; t.kind = 0; item = r; }
    else if ((r -= I_OUT) < NE * I_1) { const int e = r / I_1; t.W = F.w_mlp1 + (size_t)e * 1024 * 2048; t.N = 2048; t.WT = F.ws + WS_W1T + (size_t)e * 2048 * 1024; t.kind = 1; item = r % I_1; }
    else { r -= NE * I_1; const int e = r / I_2; t.W = F.w_mlp2 + (size_t)e * 1024 * 1024; t.N = 1024; t.WT = F.ws + WS_W2T + (size_t)e * 1024 * 1024; t.kind = 2; item = r % I_2; }
    const int st = item >> 4, l = item & 15, kb = 2 * (st & 7) + (l >> 3), nb = 8 * (st >> 3) + (l & 7);
    t.k0 = 64 * kb; t.n0 = 32 * nb;
    return true;
}
__device__ __forceinline__ void tr_dma(const TrItem& t, int lane, LAS unsigned char* buf) {
    const int p = lane & 7, rr = lane >> 3;
#pragma unroll
    for (int i = 0; i < 8; ++i) {
        int col = t.n0 + 4 * (p ^ i); col = col + 4 <= t.N ? col : t.N - 4;
        __builtin_amdgcn_global_load_lds((const unsigned*)(t.W + (size_t)(t.k0 + 8 * i + rr) * t.N + col), (LAS unsigned*)(buf + i * 1024), 16, 0, 2);
    }
}
__device__ __forceinline__ void tr_store(const TrItem& t, int lane, LAS const unsigned char* buf) {
    const int c = lane & 7;
#pragma unroll
    for (int j = 0; j < 4; ++j) { const int nn = (lane >> 3) + 8 * j;
        float e[8];
#pragma unroll
        for (int q = 0; q < 8; ++q) e[q] = *(LAS const float*)(buf + (8 * c + q) * 128 + (((nn >> 2) ^ c) << 4) + (nn & 3) * 4);
        const int n = t.n0 + nn; const bool ok = n < t.N;
#pragma unroll
        for (int q = 0; q < 8; ++q) e[q] = ok ? e[q] : 0.f;
        if (t.kind == 0) { u32x4 o; o.x = pk2(e[0], e[1]); o.y = pk2(e[2], e[3]); o.z = pk2(e[4], e[5]); o.w = pk2(e[6], e[7]);
            *(u32x4*)((bf16*)t.WT + (size_t)n * 1024 + t.k0 + 8 * c) = o; }
        else { u32x2 o; o.x = pk4_fp8(e[0] * W8_SCALE, e[1] * W8_SCALE, e[2] * W8_SCALE, e[3] * W8_SCALE); o.y = pk4_fp8(e[4] * W8_SCALE, e[5] * W8_SCALE, e[6] * W8_SCALE, e[7] * W8_SCALE);
            int row = n; if (t.kind == 1) { const int jj = n >> 1; row = 256 * (jj >> 7) + 128 * (n & 1) + (jj & 127); }
            *(u32x2*)(t.WT + (size_t)row * 1024 + t.k0 + 8 * c) = o; } }
}
template <int MODE>
__device__ __forceinline__ void tr_range(const Frame& F, int itB, int itE) {
    LAS unsigned char* buf0 = F.lds + F.wave * 16384; LAS unsigned char* buf1 = buf0 + 8192;
    const int it0 = itB + F.wave;
    TrItem t0, t1;
    bool h0 = (it0 < itE) && tr_decode(F, it0, t0); if (h0) tr_dma(t0, F.lane, buf0);
    bool h1 = (it0 + NWAVES < itE) && tr_decode(F, it0 + NWAVES, t1); if (h1) tr_dma(t1, F.lane, buf1);
    if (h0) { if (h1) asm volatile("s_waitcnt vmcnt(8)" ::: "memory"); else asm volatile("s_waitcnt vmcnt(0)" ::: "memory"); }
#pragma unroll 1
    for (int it = it0; h0; it += 2 * NWAVES) {
        if (MODE != 1) tr_store(t0, F.lane, buf0);
        asm volatile("s_waitcnt lgkmcnt(0)" ::: "memory");
        h0 = (it + 2 * NWAVES < itE) && tr_decode(F, it + 2 * NWAVES, t0); if (h0) tr_dma(t0, F.lane, buf0);
        if (!h1) break;
        if (h0) asm volatile("s_waitcnt vmcnt(12)" ::: "memory"); else asm volatile("s_waitcnt vmcnt(4)" ::: "memory");
        if (MODE != 1) tr_store(t1, F.lane, buf1);
        asm volatile("s_waitcnt lgkmcnt(0)" ::: "memory");
        h1 = (it + 3 * NWAVES < itE) && tr_decode(F, it + 3 * NWAVES, t1); if (h1) tr_dma(t1, F.lane, buf1);
        if (h0) { if (h1) asm volatile("s_waitcnt vmcnt(12)" ::: "memory"); else asm volatile("s_waitcnt vmcnt(4)" ::: "memory"); }
    }
    asm volatile("s_waitcnt vmcnt(0)" ::: "memory");
}
template <int MODE>
__device__ __forceinline__ void p0_prologue(const Frame& F) {
    float* mod = WSP(float, WS_MOD);
    if (F.bx < 192 && MODE != 3 && MODE != 1) {
        LAS float* red = (LAS float*)(F.lds + 98304);
        const int cl = F.tid & 31, ks = F.tid >> 5, col = F.bx * 32 + cl;
        LAS float* sc_s = (LAS float*)(F.lds + 98304 + 4096);
        float a0 = 0.f, a1 = 0.f;
        float wv[64];
#pragma unroll
        for (int i = 0; i < 64; ++i) wv[i] = F.w_ada[(size_t)(ks * 64 + i) * 6144 + col];
#pragma unroll
        for (int i = 0; i < 4; ++i) { const float cv = F.c[F.tid + 512 * i]; sc_s[F.tid + 512 * i] = cv * __builtin_amdgcn_rcpf(1.f + __expf(-cv)); }
        __syncthreads();
#pragma unroll
        for (int i = 0; i < 64; ++i) { const int k = ks * 64 + i; a0 += sc_s[k] * wv[i]; a1 += sc_s[1024 + k] * wv[i]; }
        red[(0 * 16 + ks) * 32 + cl] = a0; red[(1 * 16 + ks) * 32 + cl] = a1;
        __syncthreads();
        if (F.tid < 64) { const int b = F.tid >> 5; float s = 0.f;
#pragma unroll
            for (int i = 0; i < 16; ++i) s += red[(b * 16 + i) * 32 + cl];
            mod[b * 6144 + col] = s + F.b_ada[col]; }
        __syncthreads();
    }
    if (MODE == 2) return;
    if (F.bx >= 192) tr_range<MODE>(F, (F.bx - 192) * 16, (F.bx - 192) * 16 + 16);
    else if (F.bx < 96) tr_range<MODE>(F, 1024 + F.bx * 8, 1024 + F.bx * 8 + 8);
}

__device__ __forceinline__ void p1_norm(const Frame& F) {
    const float* mod = WSP(float, WS_MOD); bf16* h = WSP(bf16, WS_H);
    const int gw = F.bx * NWAVES + F.wave, m0 = gw * 16;
    const float* modb = mod + (m0 >> 14) * 6144;
    const float* xb = F.x + (size_t)m0 * D + 4 * F.lane;
    f32x4 g[4], sh[4], b0[4], b1[4], b2[4], b3[4];
#define P1_LOAD(B, r) do { _Pragma("unroll") for (int j = 0; j < 4; ++j) B[j] = __builtin_nontemporal_load((const f32x4*)(xb + (size_t)(r) * D + 256 * j)); } while (0)
#define P1_ROW(B, it) do { float ss = 0.f; _Pragma("unroll") for (int j = 0; j < 4; ++j) ss += dot4(B[j]); \
        const float r = rsqrtf(wave_sum(ss) * (1.f / D) + EPS); \
        _Pragma("unroll") for (int j = 0; j < 4; ++j) { const f32x4 hv = B[j] * r * g[j] + sh[j]; u32x2 o; o.x = pk2(hv[0], hv[1]); o.y = pk2(hv[2], hv[3]); \
            *(u32x2*)(h + (size_t)(m0 + (it)) * D + 4 * F.lane + 256 * j) = o; } \
        if ((it) + 4 < 16) P1_LOAD(B, (it) + 4); } while (0)
    P1_LOAD(b0, 0); P1_LOAD(b1, 1); P1_LOAD(b2, 2); P1_LOAD(b3, 3);
#pragma unroll
    for (int j = 0; j < 4; ++j) { const int idx = 4 * F.lane + 256 * j;
        g[j] = *(const f32x4*)(F.g_pre_mix + idx) * (*(const f32x4*)(modb + 1024 + idx) + 1.f); sh[j] = *(const f32x4*)(modb + idx); }
#pragma unroll 1
    for (int it = 0; it < 16; it += 4) { P1_ROW(b0, it); P1_ROW(b1, it + 1); P1_ROW(b2, it + 2); P1_ROW(b3, it + 3); }
#undef P1_LOAD
#undef P1_ROW
}

typedef float f32x2 __attribute__((ext_vector_type(2)));
__device__ __forceinline__ f32x2 swiglu_s2(f32x2 g, f32x2 l) {
    f32x2 xg, xl; xg.x = fminf(g.x, 7.f); xg.y = fminf(g.y, 7.f); xl.x = __builtin_amdgcn_fmed3f(l.x, -7.f, 7.f); xl.y = __builtin_amdgcn_fmed3f(l.y, -7.f, 7.f);
    const f32x2 t = xg * (-1.702f * 1.4426950408889634f);
    f32x2 ex; ex.x = __builtin_amdgcn_exp2f(t.x); ex.y = __builtin_amdgcn_exp2f(t.y);
    const f32x2 den = ex + 1.f;
    f32x2 rc; rc.x = __builtin_amdgcn_rcpf(den.x); rc.y = __builtin_amdgcn_rcpf(den.y);
    return (xg * rc) * (xl * A8_SCALE + A8_SCALE);
}
__device__ __forceinline__ unsigned pk4_fp8_nc(float a, float b, float c, float d) {
    int w = 0; w = __builtin_amdgcn_cvt_pk_fp8_f32(a, b, w, false); w = __builtin_amdgcn_cvt_pk_fp8_f32(c, d, w, true); return (unsigned)w; }
namespace pg8 {
constexpr int BM = 256, BK = 64, HALF = 128, HTB = HALF * BK * 2, NXCD = 8, WGM = 8;
__device__ __forceinline__ int lds_byte(int r, int c) { const int st = (r >> 4) * 2 + (c >> 5), rr = r & 15, cc = c & 31, ob = rr * 64 + cc * 2; return st * 1024 + (ob ^ (((ob >> 9) & 1) << 5)); }
__device__ __forceinline__ void stage_rc(int b, int& R, int& C) { const int st = b / 1024, sb = b % 1024, swz = sb ^ (((sb >> 9) & 1) << 5); R = (st >> 1) * 16 + swz / 64; C = (st & 1) * 32 + (swz % 64) / 2; }
__device__ __forceinline__ int perm32(int rho) { const int n = rho >> 4, i = rho & 15; return 8 * (i >> 2) + 4 * n + (i & 3); }
struct Unit { int pm, pn, e, pos0, cnt, hf; i32x4 dr; };
struct StaticOrder {
    int nM, nN, nwg, G, c, i0, n, split;
    __device__ __forceinline__ void init(int nM_, int nN_, int G_, int c_, int i0_ = 0, int n_ = 1 << 30, int split_ = 0) { nM = nM_; nN = nN_; nwg = nM * nN; G = G_; c = c_; i0 = i0_; n = n_; split = split_; }
    __device__ __forceinline__ bool next(int i, Unit& u) const {
        if (i >= n) return false;
        const int r = i0 + i, R = nwg / G, tail = nwg - R * G;
        long L; u.hf = 0;
        if (split && r == R && tail > 0 && 2 * tail <= G) { if (c >= 2 * tail) return false; L = (long)R * G + (c >> 1); u.hf = 1 + (c & 1); }
        else { L = (long)r * G + c; if (L >= nwg) return false; }
        int wgid = (int)L; { const int q = nwg / NXCD, r = nwg % NXCD, xcd = wgid % NXCD, off = wgid / NXCD; wgid = (xcd < r ? xcd * (q + 1) : r * (q + 1) + (xcd - r) * q) + off; }
        const int nig = WGM * nN, gid = wgid / nig, fm = gid * WGM, gsz = (nM - fm) < WGM ? (nM - fm) : WGM;
        u.pm = fm + ((wgid % nig) % gsz); u.pn = (wgid % nig) / gsz; return true;
    }
};
template <bool GATHER, int FP8, int SCW, int SCX, int ABL = 0, class Epi, class Sched, class AB>
__device__ __forceinline__ void gemm_phase(LAS unsigned char* lds, const int K, const Sched& S, const AB& ab, const Epi& E) {
    const int tid = threadIdx.x, wid = __builtin_amdgcn_readfirstlane(tid >> 6), lane = tid & 63, wr = wid >> 2, wc = wid & 3, fr = lane & 15, fq = lane >> 4;
    const int nt = K / BK;
    int sR[2], sC[2]; unsigned voffB[2], vA[2][2], nvA[2][2];
#pragma unroll
    for (int i = 0; i < 2; ++i) { int R, C; stage_rc(tid * 16 + i * 8192, R, C); sR[i] = R; sC[i] = C; const int Rb = (R & ~31) + perm32(R & 31); voffB[i] = (unsigned)(Rb * K + C) * 2u; }
    const size_t kstep = (size_t)(BK * 2);
    const size_t hstep = (size_t)HALF * K * 2;
    const unsigned ldsw = (unsigned)wid * 1024u;
    const int aoff = lds_byte(wr * 64 + fr, fq * 8), boff = lds_byte(wc * 32 + fr, fq * 8);
#define PG8_SA(b, h) (((b) * 2 + (h)) * HTB)
#define PG8_SB(b, h) ((4 + (b) * 2 + (h)) * HTB)
#define PG8_STAGE(bufoff, gbase, voff) do { if (ABL != 3) _Pragma("unroll") for (int _i = 0; _i < 2; ++_i) \
        __builtin_amdgcn_global_load_lds((const unsigned*)((const char*)(gbase) + (voff)[_i]), (LAS unsigned*)(lds + (bufoff) + ldsw + _i * 8192), 16, 0, 0); } while (0)
#define PG8_LDA(dst, b, h) do { _Pragma("unroll") for (int m = 0; m < 4; ++m) _Pragma("unroll") for (int k = 0; k < 2; ++k) dst[m][k] = *(const LAS bf16x8*)(lds + PG8_SA(b, h) + aoff + m * 2048 + k * 1024); } while (0)
#define PG8_LDB(dst, b, h) do { _Pragma("unroll") for (int n = 0; n < 2; ++n) _Pragma("unroll") for (int k = 0; k < 2; ++k) dst[n][k] = *(const LAS bf16x8*)(lds + PG8_SB(b, h) + boff + n * 2048 + k * 1024); } while (0)
#define PG8_C8(x) __builtin_shufflevector(__builtin_bit_cast(i32x4, (x)[0]), __builtin_bit_cast(i32x4, (x)[1]), 0, 1, 2, 3, 4, 5, 6, 7)
#define PG8_MMA(ai, bj, At, Bt) do { if (ABL == 2) break; __builtin_amdgcn_s_setprio(1); _Pragma("unroll") for (int m = 0; m < 4; ++m) _Pragma("unroll") for (int n = 0; n < 2; ++n) { \
        if (FP8) asm volatile("v_mfma_scale_f32_16x16x128_f8f6f4 %0, %1, %2, %0, %3, %4 op_sel_hi:[0,0,0]" : "+v"(acc[ai][bj][m][n]) : "v"(PG8_C8(Bt[n])), "v"(PG8_C8(At[m])), "v"(scw), "v"(scx)); \
        else { _Pragma("unroll") for (int k = 0; k < 2; ++k) asm volatile("v_mfma_f32_16x16x32_bf16 %0, %1, %2, %0" : "+v"(acc[ai][bj][m][n]) : "v"(Bt[n][k]), "v"(At[m][k])); } } \
        __builtin_amdgcn_s_setprio(0); } while (0)
#define PG8_WAIT_V(n) asm volatile("s_waitcnt vmcnt(" #n ")" ::: "memory")
#define PG8_WAIT_L(n) asm volatile("s_waitcnt lgkmcnt(" #n ")" ::: "memory")
#define PG8_BAR __builtin_amdgcn_s_barrier()
#define PG8_SCHED __builtin_amdgcn_sched_barrier(0)
#define PG8_AOFF(dst, u) do { _Pragma("unroll") for (int _h = 0; _h < 2; ++_h) _Pragma("unroll") for (int _i = 0; _i < 2; ++_i) \
        dst[_h][_i] = GATHER ? (unsigned)(ab.a_row((u), _h * HALF + sR[_i]) * K + sC[_i]) * 2u : (unsigned)((_h * HALF + sR[_i]) * K + sC[_i]) * 2u; } while (0)
    Unit cur, nxt, nn; int ui = 0;
    if (!S.next(0, cur)) return;
    ab.fill_sync(cur);
    bool has_nn = S.next(1, nn); if (has_nn) ab.fill(nn);
    const int scw = SCW, scx = SCX;
    f32x4 acc[2][2][4][2];
#pragma unroll
    for (int a = 0; a < 2; ++a)
#pragma unroll
        for (int b = 0; b < 2; ++b)
#pragma unroll
            for (int m = 0; m < 4; ++m)
#pragma unroll
                for (int n = 0; n < 2; ++n) acc[a][b][m][n] = (f32x4){0.f, 0.f, 0.f, 0.f};
    bf16x8 At[4][2], B0[2][2], B1[2][2];
    const char* cA = ab.a_base(cur); const char* cB = ab.b_base(cur);
    PG8_AOFF(vA, cur);
    PG8_STAGE(PG8_SB(0, 0), cB, voffB); PG8_STAGE(PG8_SB(0, 1), cB + hstep, voffB); PG8_STAGE(PG8_SA(0, 0), cA, vA[0]); PG8_STAGE(PG8_SA(0, 1), cA, vA[1]);
    if (wr == 1) PG8_BAR;
    PG8_WAIT_V(2); PG8_BAR;
    PG8_STAGE(PG8_SB(1, 0), cB + kstep, voffB); PG8_STAGE(PG8_SA(1, 0), cA + kstep, vA[0]); PG8_STAGE(PG8_SB(1, 1), cB + hstep + kstep, voffB);
    PG8_WAIT_V(6); PG8_BAR;
    for (;;) {
        const bool has_next = has_nn; nxt = nn; if (has_next) ab.commit(nxt);
        has_nn = has_next && S.next(ui + 2, nn); if (has_nn) ab.fill(nn);
        const char* nA = has_next ? ab.a_base(nxt) : cA; const char* nB = has_next ? ab.b_base(nxt) : cB;
        int raw[2][2];
        if (GATHER) {
#pragma unroll
            for (int h = 0; h < 2; ++h)
#pragma unroll
                for (int i = 0; i < 2; ++i) { raw[h][i] = 0;
                    if (has_next) { const int* lp_ = ab.a_ptr(nxt, h * HALF + sR[i]); asm volatile("global_load_dword %0, %1, off" : "=v"(raw[h][i]) : "v"(lp_) : "memory"); } } }
        const bool h1 = cur.hf != 2, h2 = cur.hf != 1;
#pragma unroll 1
        for (int t = 0; t < nt; t += 2) {
            const bool last = (t == nt - 2);
            const char* a1 = cA + (size_t)(t + 1) * kstep;
            const char* a2 = last ? nA : cA + (size_t)(t + 2) * kstep; const char* b2 = last ? nB : cB + (size_t)(t + 2) * kstep;
            const char* a3 = a2 + kstep; const char* b3 = b2 + kstep;
            unsigned o2[2][2];
            if (GATHER && last) {
                asm volatile("" : "+v"(raw[0][0]), "+v"(raw[0][1]), "+v"(raw[1][0]), "+v"(raw[1][1]));
#pragma unroll
                for (int h = 0; h < 2; ++h)
#pragma unroll
                    for (int i = 0; i < 2; ++i) nvA[h][i] = has_next ? (unsigned)(ab.a_fin(nxt, h * HALF + sR[i], raw[h][i]) * K + sC[i]) * 2u : vA[h][i]; }
#pragma unroll
            for (int h = 0; h < 2; ++h)
#pragma unroll
                for (int i = 0; i < 2; ++i) o2[h][i] = (GATHER && last) ? nvA[h][i] : vA[h][i];
            PG8_LDB(B0, 0, 0); PG8_LDB(B1, 0, 1); PG8_SCHED; if (h1) PG8_LDA(At, 0, 0); PG8_STAGE(PG8_SA(1, 1), a1, vA[1]);
            PG8_WAIT_V(8); PG8_WAIT_L(0); PG8_BAR; if (h1) { PG8_MMA(0, 0, At, B0); PG8_MMA(0, 1, At, B1); } PG8_BAR; PG8_SCHED;
            if (h2) PG8_LDA(At, 0, 1); PG8_STAGE(PG8_SB(0, 0), b2, voffB); PG8_STAGE(PG8_SB(0, 1), b2 + hstep, voffB); PG8_STAGE(PG8_SA(0, 0), a2, o2[0]);
            PG8_WAIT_V(8); PG8_WAIT_L(0); PG8_BAR; if (h2) { PG8_MMA(1, 0, At, B0); PG8_MMA(1, 1, At, B1); } PG8_BAR; PG8_SCHED;
            PG8_LDB(B0, 1, 0); PG8_LDB(B1, 1, 1); PG8_SCHED; if (h1) PG8_LDA(At, 1, 0); PG8_STAGE(PG8_SA(0, 1), a2, o2[1]);
            PG8_WAIT_V(8); PG8_WAIT_L(0); PG8_BAR; if (h1) { PG8_MMA(0, 0, At, B0); PG8_MMA(0, 1, At, B1); } PG8_BAR; PG8_SCHED;
            if (h2) PG8_LDA(At, 1, 1); PG8_STAGE(PG8_SB(1, 0), b3, voffB); PG8_STAGE(PG8_SB(1, 1), b3 + hstep, voffB); PG8_STAGE(PG8_SA(1, 0), a3, o2[0]);
            PG8_WAIT_V(8); PG8_WAIT_L(0); PG8_BAR; if (h2) { PG8_MMA(1, 0, At, B0); PG8_MMA(1, 1, At, B1); } PG8_BAR; PG8_SCHED;
        }
        if (wr == 0) PG8_BAR;
        asm volatile("s_nop 15\n\ts_nop 15" ::: "memory");
        if (ABL == 1) { _Pragma("unroll") for (int a = 0; a < 2; ++a) _Pragma("unroll") for (int b = 0; b < 2; ++b) _Pragma("unroll") for (int m = 0; m < 4; ++m) _Pragma("unroll") for (int n = 0; n < 2; ++n) asm volatile("" :: "v"(acc[a][b][m][n])); }
        else E(acc, cur, wr, wc, fr, fq);
        if (!has_next) break;
#pragma unroll
        for (int a = 0; a < 2; ++a)
#pragma unroll
            for (int b = 0; b < 2; ++b)
#pragma unroll
                for (int m = 0; m < 4; ++m)
#pragma unroll
                    for (int n = 0; n < 2; ++n) acc[a][b][m][n] = (f32x4){0.f, 0.f, 0.f, 0.f};
        cur = nxt; cA = nA; cB = nB; ++ui;
        if (GATHER) {
#pragma unroll
            for (int h = 0; h < 2; ++h)
#pragma unroll
                for (int i = 0; i < 2; ++i) vA[h][i] = nvA[h][i]; }
        if (wr == 1) PG8_BAR;
    }
    PG8_WAIT_V(0);
    PG8_BAR;
#undef PG8_SA
#undef PG8_SB
#undef PG8_STAGE
#undef PG8_LDA
#undef PG8_LDB
#undef PG8_MMA
#undef PG8_C8
#undef PG8_WAIT_V
#undef PG8_WAIT_L
#undef PG8_BAR
#undef PG8_SCHED
#undef PG8_AOFF
}
__device__ __forceinline__ unsigned cvt_pk_bf16(float lo, float hi) { unsigned r; asm volatile("v_cvt_pk_bf16_f32 %0, %1, %2" : "=v"(r) : "v"(lo), "v"(hi)); return r; }
struct ABDense { const bf16* A; const bf16* Bt; int K;
    __device__ __forceinline__ const char* a_base(const Unit& u) const { return (const char*)(A + (size_t)u.pm * BM * K); }
    __device__ __forceinline__ const char* b_base(const Unit& u) const { return (const char*)(Bt + (size_t)u.pn * BM * K); }
    __device__ __forceinline__ void fill(Unit& u) const { u.e = 0; u.pos0 = 0; u.cnt = 0; }
    __device__ __forceinline__ void fill_sync(Unit& u) const { u.e = 0; u.pos0 = 0; u.cnt = 0; }
    __device__ __forceinline__ void commit(Unit&) const {}
    __device__ __forceinline__ const int* a_ptr(const Unit&, int) const { return nullptr; }
    __device__ __forceinline__ int a_fin(const Unit&, int, int) const { return 0; }
    __device__ __forceinline__ int a_row(const Unit&, int) const { return 0; } };
struct EpiStoreT { bf16* O; int ldo; size_t tst;
    __device__ __forceinline__ void operator()(const f32x4 (&acc)[2][2][4][2], const Unit& u, int wr, int wc, int fr, int fq) const {
        const int row0 = u.pm * BM + wr * 64 + fr, col0 = wc * 32 + 8 * fq;
        bf16* Ot = O + (size_t)u.pn * tst;
#pragma unroll
        for (int ai = 0; ai < 2; ++ai)
#pragma unroll
            for (int m = 0; m < 4; ++m) { bf16* rowp = Ot + (size_t)(row0 + ai * HALF + m * 16) * ldo + col0;
#pragma unroll
                for (int bj = 0; bj < 2; ++bj) { const f32x4 v0 = acc[ai][bj][m][0], v1 = acc[ai][bj][m][1];
                    u32x4 w; w.x = cvt_pk_bf16(v0[0], v0[1]); w.y = cvt_pk_bf16(v0[2], v0[3]); w.z = cvt_pk_bf16(v1[0], v1[1]); w.w = cvt_pk_bf16(v1[2], v1[3]);
                    *(u32x4*)(rowp + bj * HALF) = w; } }
    } };
struct ABMoe1 { const unsigned char* H; const unsigned char* W; LAS const i32x4* tdesc; const int* list_a;
    __device__ __forceinline__ void fill(Unit& u) const { const unsigned a = (unsigned)(size_t)(tdesc + u.pm); asm volatile("ds_read_b128 %0, %1" : "=v"(u.dr) : "v"(a) : "memory"); }
    __device__ __forceinline__ void commit(Unit& u) const { asm volatile("" : "+v"(u.dr)); u.e = __builtin_amdgcn_readfirstlane(u.dr.x); u.pos0 = __builtin_amdgcn_readfirstlane(u.dr.y); u.cnt = __builtin_amdgcn_readfirstlane(u.dr.z); }
    __device__ __forceinline__ void fill_sync(Unit& u) const { fill(u); asm volatile("s_waitcnt lgkmcnt(0)" ::: "memory"); commit(u); }
    __device__ __forceinline__ const char* a_base(const Unit&) const { return (const char*)H; }
    __device__ __forceinline__ const char* b_base(const Unit& u) const { return (const char*)(W + (size_t)u.e * 2048 * 1024 + (size_t)u.pn * BM * 1024); }
    __device__ __forceinline__ int a_row(const Unit& u, int rt) const { const int pos = u.pos0 + rt; const bool ok = pos < u.cnt;
        const int a = list_a[(size_t)u.e * T + (ok ? pos : 0)]; return ok ? (a >> 2) : 0; }
    __device__ __forceinline__ const int* a_ptr(const Unit& u, int rt) const { const int pos = u.pos0 + rt; return list_a + (size_t)u.e * T + (pos < u.cnt ? pos : 0); }
    __device__ __forceinline__ int a_fin(const Unit& u, int rt, int a) const { return (u.pos0 + rt) < u.cnt ? (a >> 2) : 0; } };
struct ABMoe2 { const unsigned char* A; const unsigned char* W; LAS const i32x4* tdesc;
    __device__ __forceinline__ void fill(Unit& u) const { const unsigned a = (unsigned)(size_t)(tdesc + u.pm); asm volatile("ds_read_b128 %0, %1" : "=v"(u.dr) : "v"(a) : "memory"); }
    __device__ __forceinline__ void commit(Unit& u) const { asm volatile("" : "+v"(u.dr)); u.e = __builtin_amdgcn_readfirstlane(u.dr.x); u.pos0 = __builtin_amdgcn_readfirstlane(u.dr.y); u.cnt = __builtin_amdgcn_readfirstlane(u.dr.z); }
    __device__ __forceinline__ void fill_sync(Unit& u) const { fill(u); asm volatile("s_waitcnt lgkmcnt(0)" ::: "memory"); commit(u); }
    __device__ __forceinline__ const char* a_base(const Unit& u) const { return (const char*)(A + (size_t)u.pm * BM * 1024); }
    __device__ __forceinline__ const char* b_base(const Unit& u) const { return (const char*)(W + (size_t)u.e * 1024 * 1024 + (size_t)u.pn * BM * 1024); }
    __device__ __forceinline__ const int* a_ptr(const Unit&, int) const { return nullptr; }
    __device__ __forceinline__ int a_fin(const Unit&, int, int) const { return 0; }
    __device__ __forceinline__ int a_row(const Unit&, int) const { return 0; } };
struct EpiSwigluT { unsigned char* Aout; const float* b1;
    __device__ __forceinline__ void operator()(const f32x4 (&acc)[2][2][4][2], const Unit& u, int wr, int wc, int fr, int fq) const {
        const int row0 = u.pm * BM + wr * 64 + fr, j0 = u.pn * HALF + wc * 32 + 8 * fq;
        const float* bp = b1 + (size_t)u.e * 2048 + 2 * j0;
        f32x2 bg[4], bl[4];
#pragma unroll
        for (int q = 0; q < 4; ++q) { const f32x4 b4 = *(const f32x4*)(bp + 4 * q); bg[q] = (f32x2){b4[0], b4[2]}; bl[q] = (f32x2){b4[1], b4[3]}; }
#pragma unroll
        for (int ai = 0; ai < 2; ++ai) {
            if (u.hf == 2 - ai) continue;
            u32x2 wv[4];
#pragma unroll
            for (int m = 0; m < 4; ++m) {
                const f32x4 g0 = acc[ai][0][m][0], g1 = acc[ai][0][m][1], l0 = acc[ai][1][m][0], l1 = acc[ai][1][m][1];
                const f32x2 r0 = swiglu_s2((f32x2){g0[0], g0[1]} + bg[0], (f32x2){l0[0], l0[1]} + bl[0]), r1 = swiglu_s2((f32x2){g0[2], g0[3]} + bg[1], (f32x2){l0[2], l0[3]} + bl[1]);
                const f32x2 r2 = swiglu_s2((f32x2){g1[0], g1[1]} + bg[2], (f32x2){l1[0], l1[1]} + bl[2]), r3 = swiglu_s2((f32x2){g1[2], g1[3]} + bg[3], (f32x2){l1[2], l1[3]} + bl[3]);
                wv[m].x = pk4_fp8_nc(r0.x, r0.y, r1.x, r1.y); wv[m].y = pk4_fp8_nc(r2.x, r2.y, r3.x, r3.y); }
#pragma unroll
            for (int m = 0; m < 4; m += 2) {
                const auto rx = __builtin_amdgcn_permlane16_swap(wv[m].x, wv[m + 1].x, false, false), ry = __builtin_amdgcn_permlane16_swap(wv[m].y, wv[m + 1].y, false, false);
                u32x4 v; v.x = rx[0]; v.y = ry[0]; v.z = rx[1]; v.w = ry[1];
                *(u32x4*)(Aout + (size_t)(row0 + ai * HALF + (m + (fq & 1)) * 16) * FF + j0 - 8 * (fq & 1)) = v; }
        }
    } };
struct EpiMoe2T { unsigned char* ys; const float* b2;
    __device__ __forceinline__ void operator()(const f32x4 (&acc)[2][2][4][2], const Unit& u, int wr, int wc, int fr, int fq) const {
        const int row0 = u.pm * BM + wr * 64 + fr, col0 = u.pn * BM + wc * 32 + 8 * fq;
        const float* bp = b2 + (size_t)u.e * D + col0;
        f32x4 bv[2][2];
#pragma unroll
        for (int bj = 0; bj < 2; ++bj)
#pragma unroll
            for (int n = 0; n < 2; ++n) bv[bj][n] = *(const f32x4*)(bp + bj * HALF + 4 * n) * Y8_SCALE;
#pragma unroll
        for (int ai = 0; ai < 2; ++ai) {
            if (u.hf == 2 - ai) continue;
#pragma unroll
            for (int m = 0; m < 4; ++m) { unsigned char* rowp = ys + (size_t)(row0 + ai * HALF + m * 16) * D + col0;
                u32x2 w[2];
#pragma unroll
                for (int bj = 0; bj < 2; ++bj) { const f32x4 v0 = acc[ai][bj][m][0] * Y8_SCALE + bv[bj][0], v1 = acc[ai][bj][m][1] * Y8_SCALE + bv[bj][1];
                    w[bj].x = pk4_fp8(v0[0], v0[1], v0[2], v0[3]); w[bj].y = pk4_fp8(v1[0], v1[1], v1[2], v1[3]); }
                const auto rx = __builtin_amdgcn_permlane16_swap(w[0].x, w[1].x, false, false), ry = __builtin_amdgcn_permlane16_swap(w[0].y, w[1].y, false, false);
                u32x4 v; v.x = rx[0]; v.y = ry[0]; v.z = rx[1]; v.w = ry[1];
                *(u32x4*)(rowp + ((fq & 1) ? (HALF - 8) : 0)) = v; } }
    } };
}

__device__ __forceinline__ void attn_issue(const Frame& F, int u, u32x4 (&kr)[4], u32x4 (&vr)[4], bf16x8 (&qr)[4][2]) {
    const int qblk = u & 127, kvh = (u >> 7) & 1, b = u >> 8;
    const bf16* proj = WSP(bf16, WS_PROJ);
    const int tok0 = b * S + qblk * 128;
#pragma unroll
    for (int i = 0; i < 4; ++i) {
        const int cid = F.tid + 512 * i, row = cid >> 3, ch = cid & 7;
        const int tr = tok0 - 128 + ((qblk > 0 || row >= 128) ? row : row + 128);
        kr[i] = *(const u32x4*)(proj + pj(tr, AK_OFF + kvh * 64 + ch * 8));
        vr[i] = *(const u32x4*)(proj + pj(tr, AV_OFF + kvh * 64 + ch * 8));
    }
    const int g = F.wave >> 1, hw = F.wave & 1, hq = kvh * 4 + g, fr = F.lane & 15, fq = F.lane >> 4;
    const bf16* qbase = proj + pj(tok0 + 64 * hw + fr, AQ_OFF + hq * 64 + 8 * fq);
#pragma unroll
    for (int qb = 0; qb < 4; ++qb) { qr[qb][0] = *(const bf16x8*)(qbase + (size_t)(16 * qb) * 256); qr[qb][1] = *(const bf16x8*)(qbase + (size_t)(16 * qb) * 256 + 32); }
}
__device__ __forceinline__ void attn_fill(const Frame& F, LAS unsigned char* Ks, const u32x4 (&kr)[4], const u32x4 (&vr)[4]) {
#pragma unroll
    for (int i = 0; i < 4; ++i) {
        const int cid = F.tid + 512 * i, row = cid >> 3, ch = cid & 7;
        *(LAS u32x4*)(Ks + row * 144 + ch * 16) = kr[i];
        *(LAS u32x4*)(Ks + 256 * 144 + row * 144 + ch * 16) = vr[i];
    }
}
__device__ __forceinline__ void attn_compute(const Frame& F, int u, LAS const unsigned char* Ks, const bf16x8 (&qr)[4][2]) {
    const int qblk = u & 127, kvh = (u >> 7) & 1, b = u >> 8;
    LAS const unsigned char* Vs = Ks + 256 * 144;
    bf16* mix = WSP(bf16, WS_MIX);
    const int tok0 = b * S + qblk * 128;
    const int g = F.wave >> 1, hw = F.wave & 1, hq = kvh * 4 + g;
    const int lane = F.lane, fr = lane & 15, fq = lane >> 4;
    const float NEG_INF = -__builtin_inff();
    const float SC = 0.125f * 1.44269504f, sink2 = F.sinks[hq] * 1.44269504f;
#pragma unroll
    for (int qb = 0; qb < 4; ++qb) {
        const bf16x8 q0 = qr[qb][0], q1 = qr[qb][1];
        f32x4 st[9];
#pragma unroll
        for (int n = 0; n < 9; ++n) {
            LAS const unsigned char* kp = Ks + (64 * hw + 16 * (qb + n) + fr) * 144 + fq * 16;
            const bf16x8 k0 = *(LAS const bf16x8*)kp, k1 = *(LAS const bf16x8*)(kp + 64);
            f32x4 z = (f32x4){0.f, 0.f, 0.f, 0.f}; z = MFMA(k0, q0, z); z = MFMA(k1, q1, z); st[n] = z;
        }
#pragma unroll
        for (int r = 0; r < 4; ++r) { const int c = 4 * fq + r; st[0][r] = (c > fr) ? st[0][r] : NEG_INF; st[8][r] = (c <= fr) ? st[8][r] : NEG_INF; }
        if (qblk == 0) {
#pragma unroll
            for (int n = 0; n < 9; ++n)
#pragma unroll
                for (int r = 0; r < 4; ++r) st[n][r] = (64 * hw + 16 * (qb + n) + 4 * fq + r >= 128) ? st[n][r] : NEG_INF;
        }
        float mx = NEG_INF;
#pragma unroll
        for (int n = 0; n < 9; ++n)
#pragma unroll
            for (int r = 0; r < 4; ++r) mx = fmaxf(mx, st[n][r]);
        mx = fmaxf(mx, __shfl_xor(mx, 16)); mx = fmaxf(mx, __shfl_xor(mx, 32));
        const float m2 = fmaxf(mx * SC, sink2);
        float sum = 0.f;
#pragma unroll
        for (int n = 0; n < 9; ++n)
#pragma unroll
            for (int r = 0; r < 4; ++r) { const float p = __builtin_amdgcn_exp2f(__builtin_fmaf(st[n][r], SC, -m2)); st[n][r] = p; sum += p; }
        sum += __shfl_xor(sum, 16); sum += __shfl_xor(sum, 32); sum += __builtin_amdgcn_exp2f(sink2 - m2);
        const float inv = 1.f / sum;
        f32x4 o[4];
#pragma unroll
        for (int c = 0; c < 4; ++c) o[c] = (f32x4){0.f, 0.f, 0.f, 0.f};
#pragma unroll
        for (int ks = 0; ks < 4; ++ks) {
            const bf16x8 pf = pack8(st[2 * ks], st[2 * ks + 1]);
            const int rb = 64 * hw + 16 * (qb + 2 * ks) + 4 * fq + (fr >> 2);
#pragma unroll
            for (int c = 0; c < 4; ++c) {
                LAS const unsigned char* vp = Vs + rb * 144 + (16 * c + 4 * (lane & 3)) * 2;
                const bf16x8 vf = cat8(trr(vp), trr(vp + 16 * 144));
                o[c] = MFMA(vf, pf, o[c]);
            }
        }
        { u32x2 w; w.x = pk2(st[8][0], st[8][1]); w.y = pk2(st[8][2], st[8][3]);
          const s16x4 pf4 = __builtin_bit_cast(s16x4, w);
          const int rb = 64 * hw + 16 * (qb + 8) + 4 * fq + (fr >> 2);
#pragma unroll
          for (int c = 0; c < 4; ++c) {
              LAS const unsigned char* vp = Vs + rb * 144 + (16 * c + 4 * (lane & 3)) * 2;
              o[c] = __builtin_amdgcn_mfma_f32_16x16x16bf16_1k(trr(vp), pf4, o[c], 0, 0, 0); } }
        { bf16* op = mix + (size_t)(tok0 + 64 * hw + 16 * qb + fr) * D + hq * 64 + 4 * fq;
#pragma unroll
            for (int c = 0; c < 4; ++c) { u32x2 w; w.x = pk2(o[c][0] * inv, o[c][1] * inv); w.y = pk2(o[c][2] * inv, o[c][3] * inv); *(u32x2*)(op + 16 * c) = w; } }
    }
}
__device__ __forceinline__ void attn_units(const Frame& F) {
    int u = F.bx; if (u >= 512) return;
    u32x4 kr[4], vr[4]; bf16x8 qr[4][2];
    attn_issue(F, u, kr, vr, qr);
    int buf = 0;
#pragma unroll 1
    for (; u < 512; u += F.G) {
        LAS unsigned char* Ks = F.lds + buf * 73728;
        attn_fill(F, Ks, kr, vr);
        bf16x8 q[4][2];
#pragma unroll
        for (int i = 0; i < 4; ++i) { q[i][0] = qr[i][0]; q[i][1] = qr[i][1]; }
        __syncthreads();
        if (u + F.G < 512) attn_issue(F, u + F.G, kr, vr, qr);
        attn_compute(F, u, Ks, q);
        buf ^= 1;
    }
    __syncthreads();
}

template <bool OUT>
__device__ __forceinline__ void gla_super_unit(const Frame& F, int u) {
    const int sc = u & 31, h = (u >> 5) & 3, b = u >> 7;
    const bf16* proj = WSP(bf16, WS_PROJ); bf16* mix = WSP(bf16, WS_MIX);
    LAS unsigned char* qd_s = F.lds; LAS unsigned char* kk_s = F.lds + 9216; LAS unsigned char* qe_s = F.lds + 18432;
    LAS unsigned char* v_s0 = F.lds + 27648; LAS unsigned char* st_s = F.lds + 45056; LAS unsigned char* kd_s = F.lds + 63488;
    LAS float* ga_w = (LAS float*)(F.lds + 72704 + F.wave * 512);
    LAS float* tot_s = (LAS float*)(F.lds + 76800); LAS float* ssq_s = (LAS float*)(F.lds + 78848); LAS float* dec_s = (LAS float*)(F.lds + 79360);
    LAS unsigned char* v_s1 = F.lds + 79872;
    const int lane = F.lane, fr = lane & 15, fq = lane >> 4;
    const int ib = F.wave >> 1, dvh = F.wave & 1;
    float wu[16];
#pragma unroll
    for (int r = 0; r < 16; ++r) wu[r] = F.w_gate_up[r * 256 + h * 64 + lane];
    const float bg = F.b_gate[h * 64 + lane];
    f32x4 gn[4];
#pragma unroll
    for (int cc = 0; cc < 4; ++cc) gn[cc] = OUT ? *(const f32x4*)(F.g_gla_norm + 16 * (4 * dvh + cc) + 4 * fq) : (f32x4){0.f, 0.f, 0.f, 0.f};
    float* Sg = WSP(float, WS_KV) + (size_t)u * 8192 + (16 * F.wave + fr) * 64 + 4 * fq;
    f32x4 St[4];
#pragma unroll
    for (int d = 0; d < 4; ++d) St[d] = OUT ? *(const f32x4*)(Sg + 16 * d) : (f32x4){0.f, 0.f, 0.f, 0.f};
    float ltot = 0.f;
    u32x4 v_r[2]; unsigned ga_r, k_r[8], q_r[8]; u32x2 gg_r[4];
#define GLA_LOAD_CHUNK(tc0) do { \
        _Pragma("unroll") for (int i = 0; i < 2; ++i) { const int cid = F.tid + 512 * i, row = cid >> 4, ch = cid & 15; v_r[i] = *(const u32x4*)(proj + pj((tc0) + row, GV_OFF + h * 128 + ch * 8)); } \
        ga_r = *(const unsigned*)(proj + pj((tc0) + 8 * F.wave + (lane >> 3), GA_OFF + 2 * (lane & 7))); \
        _Pragma("unroll") for (int i = 0; i < 8; ++i) { const int rw = (tc0) + 8 * F.wave + i; k_r[i] = proj[pj(rw, GK_OFF + h * 64 + lane)]; if (OUT) q_r[i] = proj[pj(rw, GQ_OFF + h * 64 + lane)]; } \
        if (OUT) { _Pragma("unroll") for (int cc = 0; cc < 4; ++cc) \
            gg_r[cc] = *(const u32x2*)(proj + pj((tc0) + 16 * ib + fr, GG_OFF + h * 128 + 16 * (4 * dvh + cc) + 4 * fq)); } } while (0)
    const int tu0 = b * S + sc * 512;
    GLA_LOAD_CHUNK(tu0);
    for (int c = 0; c < 8; ++c) {
        const int t0 = tu0 + c * 64;
        LAS unsigned char* v_s = (c & 1) ? v_s1 : v_s0;
#pragma unroll
        for (int i = 0; i < 2; ++i) { const int cid = F.tid + 512 * i, row = cid >> 4, ch = cid & 15; *(LAS u32x4*)(v_s + row * 272 + ch * 16) = v_r[i]; }
        { typedef float f32x2v __attribute__((ext_vector_type(2))); *(LAS f32x2v*)(ga_w + 2 * lane) = (f32x2v){bf2f(ga_r & 0xffffu), bf2f(ga_r >> 16)}; }
        float kx[8], qx[8]; f32x4 ggf[4];
#pragma unroll
        for (int i = 0; i < 8; ++i) { kx[i] = bf2f(k_r[i]); qx[i] = OUT ? bf2f(q_r[i]) * 0.125f : 0.f; }
#pragma unroll
        for (int i = 0; i < 4; ++i) ggf[i] = OUT ? unpack4(gg_r[i]) : (f32x4){0.f, 0.f, 0.f, 0.f};
        if (c < 7) GLA_LOAD_CHUNK(t0 + 64);
        float bv[8]; float run = 0.f;
#pragma unroll
        for (int i = 0; i < 8; ++i) {
            float z = bg;
#pragma unroll
            for (int r4 = 0; r4 < 4; ++r4) { const f32x4 g4 = *(LAS const f32x4*)(ga_w + i * 16 + 4 * r4); z += g4[0] * wu[4 * r4] + g4[1] * wu[4 * r4 + 1] + g4[2] * wu[4 * r4 + 2] + g4[3] * wu[4 * r4 + 3]; }
            const float ls = fminf(z, 0.f) - __logf(1.f + __expf(-fabsf(z)));
            run += ls * (1.f / 16.f); bv[i] = run;
        }
        tot_s[F.wave * 64 + lane] = run;
        if (OUT) {
#pragma unroll
            for (int d = 0; d < 4; ++d) { u32x2 w; w.x = pk2(St[d][0], St[d][1]); w.y = pk2(St[d][2], St[d][3]);
                *(LAS u32x2*)(st_s + (16 * F.wave + fr) * 144 + (16 * d + 4 * fq) * 2) = w; }
        }
        __syncthreads();
        float pre = 0.f, b_mid = 0.f, b_last = 0.f;
#pragma unroll
        for (int w = 0; w < 8; ++w) { const float tv = tot_s[w * 64 + lane]; pre += (w < F.wave) ? tv : 0.f; b_mid += (w < 4) ? tv : 0.f; b_last += tv; }
        ltot += b_last;
        const float e_lm = __expf(b_last - b_mid), e_mid = __expf(b_mid);
#pragma unroll
        for (int i = 0; i < 8; ++i) { const int t = 8 * F.wave + i; const float bb = bv[i] + pre;
            const float e1 = __expf(bb - b_mid), r1 = __builtin_amdgcn_rcpf(e1);
            const float kk = kx[i] * r1;
            *(LAS bf16*)(kd_s + t * 144 + lane * 2) = (bf16)f2bf(kk * e_lm);
            if (OUT) { const float qd = qx[i] * e1;
                *(LAS bf16*)(qd_s + t * 144 + lane * 2) = (bf16)f2bf(qd);
                *(LAS bf16*)(kk_s + t * 144 + lane * 2) = (bf16)f2bf(kk);
                *(LAS bf16*)(qe_s + t * 144 + lane * 2) = (bf16)f2bf(qd * e_mid); } }
        if (F.wave == 0) dec_s[lane] = e_lm * e_mid;
        __syncthreads();
        if (OUT) {
            bf16x8 qdf[2], qef[2];
#pragma unroll
            for (int ks = 0; ks < 2; ++ks) { qdf[ks] = *(LAS const bf16x8*)(qd_s + (16 * ib + fr) * 144 + (32 * ks + 8 * fq) * 2);
                                             qef[ks] = *(LAS const bf16x8*)(qe_s + (16 * ib + fr) * 144 + (32 * ks + 8 * fq) * 2); }
            f32x4 at[4];
#pragma unroll
            for (int jt = 0; jt < 4; ++jt) {
                LAS const unsigned char* kp = kk_s + (16 * jt + fr) * 144 + (8 * fq) * 2;
                const bf16x8 k0 = *(LAS const bf16x8*)kp, k1 = *(LAS const bf16x8*)(kp + 64);
                f32x4 z = (f32x4){0.f, 0.f, 0.f, 0.f}; z = MFMA(k0, qdf[0], z); z = MFMA(k1, qdf[1], z);
#pragma unroll
                for (int r = 0; r < 4; ++r) if (16 * jt + 4 * fq + r > 16 * ib + fr) z[r] = 0.f;
                at[jt] = z;
            }
            bf16x8 pf[2];
            pf[0] = pack8(at[0], at[1]); pf[1] = pack8(at[2], at[3]);
            f32x4 o[4];
#pragma unroll
            for (int cc = 0; cc < 4; ++cc) {
                const int dvt = 4 * dvh + cc; f32x4 z = (f32x4){0.f, 0.f, 0.f, 0.f};
#pragma unroll
                for (int ks = 0; ks < 2; ++ks) {
                    const int rb = 32 * ks + 4 * fq + (fr >> 2);
                    LAS const unsigned char* vp = v_s + rb * 272 + (16 * dvt + 4 * (lane & 3)) * 2;
                    z = MFMA(cat8(trr(vp), trr(vp + 16 * 272)), pf[ks], z);
                }
#pragma unroll
                for (int ks = 0; ks < 2; ++ks) {
                    const bf16x8 sf = *(LAS const bf16x8*)(st_s + (16 * dvt + fr) * 144 + (32 * ks + 8 * fq) * 2);
                    z = MFMA(sf, qef[ks], z);
                }
                o[cc] = z;
            }
            float sq = 0.f;
#pragma unroll
            for (int cc = 0; cc < 4; ++cc) sq += dot4(o[cc]);
            sq += __shfl_xor(sq, 16); sq += __shfl_xor(sq, 32);
            if (fq == 0) ssq_s[F.wave * 16 + fr] = sq;
            __syncthreads();
            { const float tot = sq + ssq_s[(F.wave ^ 1) * 16 + fr];
              const float rinv = rsqrtf(tot * (1.f / 128.f) + EPS);
              bf16* op = mix + (size_t)(t0 + 16 * ib + fr) * D + 512 + h * 128 + 64 * dvh + 4 * fq;
#pragma unroll
              for (int cc = 0; cc < 4; ++cc) { f32x4 sg;
#pragma unroll
                  for (int r = 0; r < 4; ++r) sg[r] = ggf[cc][r] * __builtin_amdgcn_rcpf(1.f + __expf(-ggf[cc][r]));
                  const f32x4 val = o[cc] * rinv * gn[cc] * sg;
                  u32x2 w; w.x = pk2(val[0], val[1]); w.y = pk2(val[2], val[3]); *(u32x2*)(op + 16 * cc) = w; } }
        }
#pragma unroll
        for (int d = 0; d < 4; ++d) { const f32x4 dc = *(LAS const f32x4*)(dec_s + 16 * d + 4 * fq); St[d] = St[d] * dc; }
#pragma unroll
        for (int ks = 0; ks < 2; ++ks) {
            const int rb = 32 * ks + 8 * fq + (fr >> 2);
            LAS const unsigned char* vp = v_s + rb * 272 + (16 * F.wave + 4 * (lane & 3)) * 2;
            const bf16x8 vf = cat8(trr(vp), trr(vp + 4 * 272));
#pragma unroll
            for (int d = 0; d < 4; ++d) {
                LAS const unsigned char* kp = kd_s + rb * 144 + (16 * d + 4 * (lane & 3)) * 2;
                St[d] = MFMA(cat8(trr(kp), trr(kp + 4 * 144)), vf, St[d]);
            }
        }
    }
#undef GLA_LOAD_CHUNK
    if (!OUT) {
#pragma unroll
        for (int d = 0; d < 4; ++d) *(f32x4*)(Sg + 16 * d) = St[d];
        if (F.wave == 0) WSP(float, WS_DECAY)[u * 64 + lane] = __expf(ltot);
    }
    __syncthreads();
}
__device__ __forceinline__ void gla_super_scan(const Frame& F) {
    float* kv = WSP(float, WS_KV); const float* decay = WSP(float, WS_DECAY);
    if (F.tid >= 256) {
        if (F.tid < 288) { const int e = F.tid - 256; const float* mod = WSP(float, WS_MOD);
            for (int pq = F.bx; pq < 256; pq += F.G) { const int b = pq >> 7, kb = pq & 127; const float* modb = mod + b * 6144;
                float w[8]; float zp = 0.f;
#pragma unroll
                for (int q = 0; q < 8; ++q) { const int k = 8 * kb + q; const float wr = F.w_router[k * 32 + e]; w[q] = wr * (F.g_pre_ffn[k] * (1.f + modb[4096 + k])); zp += modb[3072 + k] * wr; }
                u32x4 hi, lo; unsigned hh[4];
#pragma unroll
                for (int q = 0; q < 4; ++q) { hh[q] = pg8::cvt_pk_bf16(w[2 * q], w[2 * q + 1]); }
                hi.x = hh[0]; hi.y = hh[1]; hi.z = hh[2]; hi.w = hh[3];
#pragma unroll
                for (int q = 0; q < 4; ++q) hh[q] = pg8::cvt_pk_bf16(w[2 * q] - bf2f(hh[q] & 0xffffu), w[2 * q + 1] - bf2f(hh[q] >> 16));
                lo.x = hh[0]; lo.y = hh[1]; lo.z = hh[2]; lo.w = hh[3];
                u32x4* img = WSP(u32x4, WS_RIMG) + (size_t)b * 8192;
                img[kb * 32 + e] = hi; img[4096 + kb * 32 + e] = lo;
                WSP(float, WS_ZPART)[(b * 128 + kb) * 32 + e] = zp; } }
        return;
    }
    for (int idx = F.bx * 256 + F.tid; idx < 65536; idx += F.G * 256) {
        const int bh = idx >> 13, dvdk = idx & 8191, dk = idx & 63;
        float* p = kv + (size_t)(bh * 32) * 8192 + dvdk; const float* dp = decay + (bh * 32) * 64 + dk;
        float tv[32], dv[32];
#pragma unroll
        for (int i = 0; i < 32; ++i) { tv[i] = p[(size_t)i * 8192]; dv[i] = dp[i * 64]; }
        float state = 0.f;
#pragma unroll
        for (int i = 0; i < 32; ++i) { p[(size_t)i * 8192] = state; state = dv[i] * state + tv[i]; }
    }
}

__device__ __forceinline__ void p7_norm_router(const Frame& F) {
    const float* mod = WSP(float, WS_MOD); const bf16* y = WSP(bf16, WS_Y); bf16* x1h = WSP(bf16, WS_X1); bf16* x1l = x1h + (size_t)T * D; unsigned char* h2 = WSP(unsigned char, WS_H);
    unsigned* ctl = WSP(unsigned, WS_CTL);
    LAS unsigned char* wrh_s = F.lds; LAS unsigned char* wrl_s = F.lds + 65536;
    LAS float* lg_s = (LAS float*)(F.lds + SMALL_OFF);
    LAS float* rx_s = (LAS float*)(F.lds + SMALL_OFF + 16384);
    LAS float* z_s = (LAS float*)(F.lds + SMALL_OFF + 16384 + 512);
    LAS int* cnt_s = (LAS int*)(F.lds + SMALL_OFF + 16384 + 640);
    LAS int* base_s = (LAS int*)(F.lds + SMALL_OFF + 16384 + 768);
    LAS float* zr_s = (LAS float*)(F.lds + SMALL_OFF + 16384 + 1024);
    const int lane = F.lane, fr = lane & 15, fq = lane >> 4;
    const int mb0 = F.bx * 128 + F.wave * 16;
    const float* modb = mod + (mb0 >> 14) * 6144;
    f32x4 pg[4], pg2[4], psh[4];
    u32x2 ya[4], yb[4], yc[4], yd[4]; f32x4 xa[4], xbf[4], xc[4], xd[4];
    const bf16* ybase = y + (size_t)mb0 * D + 4 * lane; const float* xbase = F.x + (size_t)mb0 * D + 4 * lane;
#define P7_LOAD(Y, X, r) do { _Pragma("unroll") for (int j = 0; j < 4; ++j) { Y[j] = __builtin_nontemporal_load((const u32x2*)(ybase + (size_t)(r) * D + 256 * j)); X[j] = __builtin_nontemporal_load((const f32x4*)(xbase + (size_t)(r) * D + 256 * j)); } } while (0)
    P7_LOAD(ya, xa, 0); P7_LOAD(yb, xbf, 1); P7_LOAD(yc, xc, 2); P7_LOAD(yd, xd, 3);
    if (F.tid < 32) cnt_s[F.tid] = 0;
    { const int bt = mb0 >> 14; const u32x4* img = WSP(u32x4, WS_RIMG) + (size_t)bt * 8192;
        const int e = F.tid & 31, ks = F.tid >> 5; float zz = 0.f;
#pragma unroll
        for (int i = 0; i < 8; ++i) zz += WSP(float, WS_ZPART)[(bt * 128 + ks * 8 + i) * 32 + e];
        zr_s[ks * 32 + e] = zz;
#pragma unroll
        for (int h = 0; h < 2; ++h) { u32x4 cimg[8];
#pragma unroll
            for (int i = 0; i < 8; ++i) cimg[i] = img[F.tid + 512 * (8 * h + i)];
#pragma unroll
            for (int i = 0; i < 8; ++i) *(LAS u32x4*)(F.lds + (F.tid + 512 * (8 * h + i)) * 16) = cimg[i]; } }
    __syncthreads();
    if (F.tid < 32) { float zz = F.b_router[F.tid];
#pragma unroll
        for (int i = 0; i < 16; ++i) zz += zr_s[i * 32 + F.tid];
        z_s[F.tid] = zz; }
#define P7_ROW(Y, X, it) do { f32x4 xv[4], hv[4]; float ss = 0.f; \
        _Pragma("unroll") for (int j = 0; j < 4; ++j) { hv[j] = unpack4(Y[j]); ss += dot4(hv[j]); } \
        const float ry = rsqrtf(wave_sum(ss) * (1.f / D) + EPS); float s2 = 0.f; \
        _Pragma("unroll") for (int j = 0; j < 4; ++j) { xv[j] = X[j] + hv[j] * ry * pg[j]; s2 += dot4(xv[j]); } \
        const float rx = rsqrtf(wave_sum(s2) * (1.f / D) + EPS); \
        if (lane == 0) rx_s[F.wave * 16 + (it)] = rx; \
        _Pragma("unroll") for (int j = 0; j < 4; ++j) { const int idx = 4 * lane + 256 * j; \
            hv[j] = xv[j] * rx * pg2[j] + psh[j]; \
            { u32x2 xh, xl; xh.x = pg8::cvt_pk_bf16(xv[j][0], xv[j][1]); xh.y = pg8::cvt_pk_bf16(xv[j][2], xv[j][3]); \
              xl.x = pg8::cvt_pk_bf16(xv[j][0] - bf2f(xh.x & 0xffffu), xv[j][1] - bf2f(xh.x >> 16)); xl.y = pg8::cvt_pk_bf16(xv[j][2] - bf2f(xh.y & 0xffffu), xv[j][3] - bf2f(xh.y >> 16)); \
              *(u32x2*)(x1h + (size_t)(mb0 + (it)) * D + idx) = xh; *(u32x2*)(x1l + (size_t)(mb0 + (it)) * D + idx) = xl; } \
            *(unsigned*)(h2 + (size_t)(mb0 + (it)) * D + idx) = pk4_fp8(hv[j][0] * H8_SCALE, hv[j][1] * H8_SCALE, hv[j][2] * H8_SCALE, hv[j][3] * H8_SCALE); } \
        if ((it) + 4 < 16) P7_LOAD(Y, X, (it) + 4); } while (0)
#pragma unroll
    for (int j = 0; j < 4; ++j) { const int idx = 4 * lane + 256 * j;
        pg[j] = *(const f32x4*)(F.g_post_mix + idx) * *(const f32x4*)(modb + 2048 + idx);
        pg2[j] = *(const f32x4*)(F.g_pre_ffn + idx) * (*(const f32x4*)(modb + 4096 + idx) + 1.f); psh[j] = *(const f32x4*)(modb + 3072 + idx); }
#pragma unroll 1
    for (int it = 0; it < 16; it += 4) { P7_ROW(ya, xa, it); P7_ROW(yb, xbf, it + 1); P7_ROW(yc, xc, it + 2); P7_ROW(yd, xd, it + 3); }
#undef P7_LOAD
#undef P7_ROW
    asm volatile("s_waitcnt vmcnt(0)" ::: "memory");
    __syncthreads();
    f32x4 acc0 = (f32x4){0.f, 0.f, 0.f, 0.f}, acc1 = (f32x4){0.f, 0.f, 0.f, 0.f};
    { const bf16* aph = x1h + (size_t)(mb0 + fr) * D + 8 * fq; const bf16* apl = x1l + (size_t)(mb0 + fr) * D + 8 * fq;
        LAS const unsigned char* bph = wrh_s + (fq * 32 + fr) * 16; LAS const unsigned char* bpl = wrl_s + (fq * 32 + fr) * 16;
        bf16x8 ab[4][8];
#define P7_RLOAD(B, st) do { _Pragma("unroll") for (int q = 0; q < 4; ++q) { B[2 * q] = *(const bf16x8*)(aph + 32 * (4 * (st) + q)); B[2 * q + 1] = *(const bf16x8*)(apl + 32 * (4 * (st) + q)); } } while (0)
        P7_RLOAD(ab[0], 0); P7_RLOAD(ab[1], 1); P7_RLOAD(ab[2], 2);
#pragma unroll
        for (int st = 0; st < 8; ++st) {
            if (st + 3 < 8) P7_RLOAD(ab[(st + 3) & 3], st + 3);
#pragma unroll
            for (int q = 0; q < 4; ++q) {
                const bf16x8 ah = ab[st & 3][2 * q], al = ab[st & 3][2 * q + 1];
                const int so = (4 * st + q) * 2048;
                const bf16x8 bh0 = *(LAS const bf16x8*)(bph + so), bh1 = *(LAS const bf16x8*)(bph + so + 256), bl0 = *(LAS const bf16x8*)(bpl + so), bl1 = *(LAS const bf16x8*)(bpl + so + 256);
                acc0 = MFMA(ah, bh0, acc0); acc0 = MFMA(al, bh0, acc0); acc0 = MFMA(ah, bl0, acc0);
                acc1 = MFMA(ah, bh1, acc1); acc1 = MFMA(al, bh1, acc1); acc1 = MFMA(ah, bl1, acc1); }
        }
#undef P7_RLOAD
    }
    __syncthreads();
#pragma unroll
    for (int r = 0; r < 4; ++r) { const float rx = rx_s[F.wave * 16 + 4 * fq + r];
        lg_s[(F.wave * 16 + 4 * fq + r) * 32 + fr] = rx * acc0[r] + z_s[fr];
        lg_s[(F.wave * 16 + 4 * fq + r) * 32 + fr + 16] = rx * acc1[r] + z_s[fr + 16]; }
    const float NEG_INF = -__builtin_inff();
    int se[4], lp[4]; float gt[4];
    if (lane < 16) {
        float v[32];
#pragma unroll
        for (int ch = 0; ch < 8; ++ch) { const f32x4 w = *(LAS const f32x4*)(lg_s + (F.wave * 16 + lane) * 32 + 4 * ch); v[4 * ch] = w[0]; v[4 * ch + 1] = w[1]; v[4 * ch + 2] = w[2]; v[4 * ch + 3] = w[3]; }
        float sv[4];
#pragma unroll
        for (int r = 0; r < 4; ++r) { float best = v[0]; int bi = 0;
#pragma unroll
            for (int e = 1; e < 32; ++e) if (v[e] > best) { best = v[e]; bi = e; }
            se[r] = bi; sv[r] = best;
#pragma unroll
            for (int e = 0; e < 32; ++e) v[e] = (e == bi) ? NEG_INF : v[e]; }
        const float p1 = __expf(sv[1] - sv[0]), p2 = __expf(sv[2] - sv[0]), p3 = __expf(sv[3] - sv[0]);
        const float rs = 1.f / (1.f + p1 + p2 + p3);
        gt[0] = rs; gt[1] = p1 * rs; gt[2] = p2 * rs; gt[3] = p3 * rs;
#pragma unroll
        for (int r = 0; r < 4; ++r) lp[r] = __hip_atomic_fetch_add(cnt_s + se[r], 1, __ATOMIC_RELAXED, __HIP_MEMORY_SCOPE_WORKGROUP);
    }
    __syncthreads();
    if (F.tid < 32) base_s[F.tid] = (int)__hip_atomic_fetch_add(ctl + CW_GCNT + 64 * F.tid, (unsigned)cnt_s[F.tid], __ATOMIC_RELAXED, __HIP_MEMORY_SCOPE_AGENT);
    __syncthreads();
    if (lane < 16) { int* la = WSP(int, WS_LIST_A); const int m = mb0 + lane;
#pragma unroll
        for (int r = 0; r < 4; ++r) { const int pos = base_s[se[r]] + lp[r]; la[(size_t)se[r] * T + pos] = m * 4 + r;
            WSP(int, WS_TOK_E)[m * 4 + r] = (se[r] << 20) | pos; WSP(float, WS_TOK_GATE)[m * 4 + r] = gt[r]; } }
}

__device__ __forceinline__ int moe_tables(const Frame& F, volatile LAS unsigned* built) {
    LAS int* cnt_s = (LAS int*)(F.lds + MCNT_OFF); LAS int* off_s = (LAS int*)(F.lds + MOFF_OFF); LAS i32x4* td_s = (LAS i32x4*)(F.lds + TDESC_OFF);
    if (built[0] == 0u) {
        unsigned* ctl = WSP(unsigned, WS_CTL);
        if (F.tid < 64) {
            const int e = F.tid & 31;
            const int c = (int)__hip_atomic_load(ctl + CW_GCNT + 64 * e, __ATOMIC_RELAXED, __HIP_MEMORY_SCOPE_AGENT);
            const int padded = (c + 255) & ~255; int incl = padded;
#pragma unroll
            for (int d = 1; d < 32; d <<= 1) { const int v = __shfl_up(incl, d, 32); incl += (e >= d) ? v : 0; }
            if (F.tid < 32) { cnt_s[e] = c; off_s[e] = incl - padded; if (e == 31) off_s[32] = incl; }
        }
        __syncthreads();
        if (F.tid == 0) built[0] = 1u;
        { const int e = F.tid >> 4, i = F.tid & 15;
            const int o0 = off_s[e], n = (off_s[e + 1] - o0) >> 8, c = cnt_s[e];
            for (int k = i; k < n; k += 16) { i32x4 dsc; dsc.x = e; dsc.y = k * 256; dsc.z = c; dsc.w = 0; td_s[(o0 >> 8) + k] = dsc; } }
        __syncthreads();
    }
    return __builtin_amdgcn_readfirstlane(off_s[32] >> 8);
}

__device__ __forceinline__ f32x4 unpack4_fp8(unsigned w) {
    const auto lo = __builtin_amdgcn_cvt_pk_f32_fp8((int)w, false), hi = __builtin_amdgcn_cvt_pk_f32_fp8((int)w, true);
    return (f32x4){lo[0], lo[1], hi[0], hi[1]};
}
__device__ __forceinline__ void p11_combine(const Frame& F) {
    const float* mod = WSP(float, WS_MOD); const unsigned char* ys = WSP(unsigned char, WS_YS); const bf16* x1 = WSP(bf16, WS_X1);
    const int gw = F.bx * NWAVES + F.wave, m0 = gw * 16, lane = F.lane;
    const float* modb = mod + (m0 >> 14) * 6144;
    LAS int* slot_s = (LAS int*)(F.lds + F.wave * 512); LAS float* gate_s = (LAS float*)(F.lds + F.wave * 512 + 256);
    const bf16* xb = x1 + (size_t)m0 * D + 4 * lane;
    unsigned ya[4][4], ybb[4][4], yc[4][4], yd[4][4]; u32x2 xa[4], xbf[4], xc[4], xd[4]; f32x4 g[4];
#define P11_LOADX(X, r) do { _Pragma("unroll") for (int j = 0; j < 4; ++j) X[j] = __builtin_nontemporal_load((const u32x2*)(xb + (size_t)(r) * D + 256 * j)); } while (0)
#define P11_LOADY(Y, r) do { _Pragma("unroll") for (int k4 = 0; k4 < 4; ++k4) { const unsigned char* yp = ys + (size_t)__builtin_amdgcn_readfirstlane(slot_s[(r) * 4 + k4]) * D + 4 * lane; \
            _Pragma("unroll") for (int j = 0; j < 4; ++j) Y[j][k4] = __builtin_nontemporal_load((const unsigned*)(yp + 256 * j)); } } while (0)
#define P11_LOAD(Y, X, r) do { P11_LOADY(Y, r); P11_LOADX(X, r); } while (0)
    const int ep = WSP(int, WS_TOK_E)[m0 * 4 + lane]; const float gte = WSP(float, WS_TOK_GATE)[m0 * 4 + lane];
    P11_LOADX(xa, 0); P11_LOADX(xbf, 1); P11_LOADX(xc, 2); P11_LOADX(xd, 3);
#pragma unroll
    for (int j = 0; j < 4; ++j) { const int idx = 4 * lane + 256 * j; g[j] = *(const f32x4*)(F.g_post_ffn + idx) * *(const f32x4*)(modb + 5120 + idx); }
    slot_s[lane] = ((LAS const int*)(F.lds + MOFF_OFF))[ep >> 20] + (ep & 0xfffff); gate_s[lane] = gte;
#define P11_ROW(Y, X, it) do { f32x4 yv[4]; float ss = 0.f; const f32x4 gk = *(LAS const f32x4*)(gate_s + (it) * 4); \
        _Pragma("unroll") for (int j = 0; j < 4; ++j) { f32x4 a = unpack4_fp8(Y[j][0]) * gk[0]; a += unpack4_fp8(Y[j][1]) * gk[1]; a += unpack4_fp8(Y[j][2]) * gk[2]; a += unpack4_fp8(Y[j][3]) * gk[3]; \
            yv[j] = a; ss += dot4(a); } \
        const float ry = rsqrtf(wave_sum(ss) * (1.f / D) + EPS * (Y8_SCALE * Y8_SCALE)); \
        _Pragma("unroll") for (int j = 0; j < 4; ++j) __builtin_nontemporal_store(unpack4(X[j]) + yv[j] * ry * g[j], (f32x4*)(F.out + (size_t)(m0 + (it)) * D + 4 * lane + 256 * j)); \
        if ((it) + 4 < 16) P11_LOAD(Y, X, (it) + 4); } while (0)
    P11_LOADY(ya, 0); P11_LOADY(ybb, 1); P11_LOADY(yc, 2); P11_LOADY(yd, 3);
#pragma unroll 1
    for (int it = 0; it < 16; it += 4) { P11_ROW(ya, xa, it); P11_ROW(ybb, xbf, it + 1); P11_ROW(yc, xc, it + 2); P11_ROW(yd, xd, it + 3); }
#undef P11_LOAD
#undef P11_LOADX
#undef P11_LOADY
#undef P11_ROW
}

constexpr int NPHASE = 11;
struct Args { const float* in[20]; float* out; unsigned char* ws; int ph_lo, ph_hi; };
__global__ void __launch_bounds__(NTHREADS, 2) fwd(Args args) {
    extern __shared__ __attribute__((aligned(16))) unsigned char lds[];
    Frame F;
    F.lds = (LAS unsigned char*)lds;
    F.tid = threadIdx.x; F.lane = F.tid & 63; F.wave = __builtin_amdgcn_readfirstlane(F.tid >> 6); F.bx = blockIdx.x; F.G = gridDim.x;
    F.x = args.in[0]; F.c = args.in[1]; F.w_ada = args.in[2]; F.b_ada = args.in[3]; F.g_pre_mix = args.in[4]; F.g_post_mix = args.in[5];
    F.g_pre_ffn = args.in[6]; F.g_post_ffn = args.in[7]; F.w_in = args.in[8]; F.w_gate_up = args.in[9]; F.b_gate = args.in[10]; F.g_gla_norm = args.in[11];
    F.sinks = args.in[12]; F.w_out = args.in[13]; F.w_router = args.in[14]; F.b_router = args.in[15]; F.w_mlp1 = args.in[16]; F.b_mlp1 = args.in[17];
    F.w_mlp2 = args.in[18]; F.b_mlp2 = args.in[19]; F.out = args.out; F.ws = args.ws;
    volatile LAS unsigned* MISC = (volatile LAS unsigned*)(F.lds + MISC_OFF);
    if (F.tid < 32) MISC[F.tid] = 0u;
    __syncthreads();
    const int lo = args.ph_lo, hi = args.ph_hi;
    XcdBarrier bar; bar.bar = (unsigned*)(F.ws + WS_CTL) + CW_BAR; bar.x = 0; bar.st = nullptr;
    if (hi - lo > 1) bar = xcd_barrier_post((unsigned*)(F.ws + WS_CTL) + CW_BAR, MISC + 8);
#define IN(k) (lo <= (k) && (k) < hi)
#define SEAM(k) do { if (IN(k) && IN((k) + 1)) xcd_barrier(bar); } while (0)

    if (IN(0)) { p0_prologue<0>(F); } SEAM(0);
    if (IN(1)) { p1_norm(F); } SEAM(1);
    if (IN(2)) {
        constexpr int I_FIRST = 16 * 80 + 16 * 32, I_PER = (NE * 16 * 64 + NE * 16 * 32) / GRID;
        const int grp = F.bx & 3, pos = grp == 0 ? 0 : grp == 1 ? 1 : grp == 2 ? 3 : 4;
        { pg8::StaticOrder So; So.init(T / 256, INP / 256, F.G, F.bx, 0, pos);
          pg8::gemm_phase<false, 0, 0, 0>(F.lds, D, So, pg8::ABDense{WSP(bf16, WS_H), WSP(bf16, WS_WIN), D}, pg8::EpiStoreT{WSP(bf16, WS_PROJ), 256, PJ_TILE}); }
        __syncthreads();
        tr_range<0>(F, I_FIRST + F.bx * I_PER, I_FIRST + (F.bx + 1) * I_PER);
        __syncthreads();
        { pg8::StaticOrder So; So.init(T / 256, INP / 256, F.G, F.bx, pos);
          pg8::gemm_phase<false, 0, 0, 0>(F.lds, D, So, pg8::ABDense{WSP(bf16, WS_H), WSP(bf16, WS_WIN), D}, pg8::EpiStoreT{WSP(bf16, WS_PROJ), 256, PJ_TILE}); }
    } SEAM(2);
    if (IN(3)) { attn_units(F);
                 for (int u = F.bx; u < 256; u += F.G) gla_super_unit<false>(F, u); } SEAM(3);
    if (IN(4)) { gla_super_scan(F); } SEAM(4);
    if (IN(5)) { for (int u = F.bx; u < 256; u += F.G) gla_super_unit<true>(F, u); } SEAM(5);
    if (IN(6)) { pg8::StaticOrder So; So.init(T / 256, D / 256, F.G, F.bx);
                 pg8::gemm_phase<false, 0, 0, 0>(F.lds, D, So, pg8::ABDense{WSP(bf16, WS_MIX), WSP(bf16, WS_WOUT), D}, pg8::EpiStoreT{WSP(bf16, WS_Y), D, 256}); } SEAM(6);
    if (IN(7)) { p7_norm_router(F); } SEAM(7);
    if (IN(8)) { const int nM = moe_tables(F, MISC + 16); pg8::StaticOrder So; So.init(nM, 2048 / 256, F.G, F.bx, 0, 1 << 30, 1);
                 pg8::gemm_phase<true, 1, W8_E8M0, H8_E8M0>(F.lds, 512, So, pg8::ABMoe1{WSP(unsigned char, WS_H), WSP(unsigned char, WS_W1T), (LAS const i32x4*)(F.lds + TDESC_OFF), WSP(int, WS_LIST_A)},
                                       pg8::EpiSwigluT{WSP(unsigned char, WS_A), F.b_mlp1}); } SEAM(8);
    if (IN(9)) { const int nM = moe_tables(F, MISC + 16); pg8::StaticOrder So; So.init(nM, D / 256, F.G, F.bx, 0, 1 << 30, 1);
                 pg8::gemm_phase<false, 1, W8_E8M0, A8_E8M0>(F.lds, 512, So, pg8::ABMoe2{WSP(unsigned char, WS_A), WSP(unsigned char, WS_W2T), (LAS const i32x4*)(F.lds + TDESC_OFF)},
                                       pg8::EpiMoe2T{WSP(unsigned char, WS_YS), F.b_mlp2}); } SEAM(9);
    if (IN(10)) { (void)moe_tables(F, MISC + 16); p11_combine(F); }
#undef IN
#undef SEAM
}

extern "C" void kernel_launch(void* const* d_in, const int* in_sizes, int n_in, void* d_out, int out_size, void* d_ws, size_t ws_size, hipStream_t stream) {
    static int ready = 0;
    if (ready == 0) {
        if (n_in != 20 || out_size != T * D || ws_size < WS_END) { fprintf(stderr, "kernel_launch: unexpected problem (n_in %d, out %d, ws %zu)\n", n_in, out_size, ws_size); ready = -1; return; }
        if (hipFuncSetAttribute((const void*)fwd, hipFuncAttributeMaxDynamicSharedMemorySize, LDS_BYTES) != hipSuccess) { fprintf(stderr, "kernel_launch: hipFuncSetAttribute failed\n"); ready = -1; return; }
        int per_cu = 0;
        if (hipOccupancyMaxActiveBlocksPerMultiprocessor(&per_cu, (const void*)fwd, NTHREADS, LDS_BYTES) != hipSuccess || per_cu < 1) fprintf(stderr, "kernel_launch: occupancy query says %d\n", per_cu);
        (void)hipGetLastError();
        ready = 1;
    }
    if (ready < 0) return;
    (void)hipMemsetAsync((char*)d_ws + WS_CTL, 0, CTL_ZERO_BYTES, stream);
    Args a{};
    for (int i = 0; i < 20; ++i) a.in[i] = (const float*)d_in[i];
    a.out = (float*)d_out; a.ws = (unsigned char*)d_ws;
#if MK_ONE_LAUNCH
    a.ph_lo = 0; a.ph_hi = NPHASE;
    hipLaunchKernelGGL(fwd, dim3(GRID), dim3(NTHREADS), LDS_BYTES, stream, a);
#else
    for (int p = 0; p < NPHASE; ++p) { a.ph_lo = p; a.ph_hi = p + 1; hipLaunchKernelGGL(fwd, dim3(GRID), dim3(NTHREADS), LDS_BYTES, stream, a); }
#endif
}
```

```cpp
#include <hip/hip_runtime.h>
#include <cstdio>
#include <cstdint>

#ifndef MK_ONE_LAUNCH
#define MK_ONE_LAUNCH 1
#endif
#define LAS __attribute__((address_space(3)))
typedef unsigned short bf16;
typedef short bf16x8 __attribute__((ext_vector_type(8)));
typedef short s16x4 __attribute__((ext_vector_type(4)));
typedef float f32x4 __attribute__((ext_vector_type(4)));
typedef unsigned u32x4 __attribute__((ext_vector_type(4)));
typedef unsigned u32x2 __attribute__((ext_vector_type(2)));

constexpr int D = 1024, NB = 2, S = 16384, T = NB * S;
constexpr int INW = 2320, INP = 2560;
constexpr int AQ_OFF = 0, AK_OFF = 512, AV_OFF = 640, GQ_OFF = 768, GK_OFF = 1024, GV_OFF = 1280, GG_OFF = 1792, GA_OFF = 2304;
constexpr size_t PJ_TILE = (size_t)T * 256;
__device__ __forceinline__ size_t pj(int row, int col) { return (size_t)(col >> 8) * PJ_TILE + (size_t)row * 256 + (col & 255); }
constexpr int NCH = 256;
constexpr int NE = 32, FF = 1024;
constexpr float X1L_SCALE = 4096.f;
constexpr int NSLOT_MAX = T * 4 + NE * 256;
constexpr float EPS = 1e-6f;
constexpr int NWAVES = 8, NTHREADS = 512, GRID = 256;

constexpr size_t MiB = 1u << 20;
constexpr size_t WS_CTL = 0, CTL_ZERO_BYTES = 64 * 1024;
constexpr size_t WS_MOD = 1 * MiB;
constexpr size_t WS_DECAY = 2 * MiB;
constexpr size_t WS_ROUTE = 3 * MiB;
constexpr size_t WS_TOK_E = WS_ROUTE, WS_TOK_LPOS = WS_ROUTE + 512 * 1024, WS_TOK_GATE = WS_ROUTE + 1024 * 1024;
constexpr size_t WS_BLK_CNT = WS_ROUTE + 1536 * 1024, WS_MOE_OFF = WS_BLK_CNT + 32 * 1024, WS_TILE_E = WS_MOE_OFF + 4096;
constexpr size_t WS_TDESC = WS_TILE_E + 4096;
constexpr size_t WS_RIMG = WS_ROUTE + 2 * MiB, WS_ZPART = WS_RIMG + 256 * 1024;
constexpr size_t WS_WIN = 8 * MiB, WS_WOUT = 13 * MiB, WS_W2T = 16 * MiB, WS_W1T = 80 * MiB;
constexpr size_t WS_H = 208 * MiB, WS_KV = 272 * MiB, WS_YS = 80 * MiB;
constexpr size_t WS_X1 = 336 * MiB, WS_PROJ = 464 * MiB, WS_MIX = 624 * MiB, WS_Y = 688 * MiB, WS_A = 464 * MiB;
constexpr size_t WS_LIST_A = 752 * MiB, WS_LIST_G = 756 * MiB;
constexpr size_t WS_XS = 608 * MiB;
constexpr size_t WS_END = 760 * MiB;
constexpr int CW_BAR = 4096, CW_GCNT = 8192  ;

constexpr int TDESC_OFF = 132096, MOFF_OFF = TDESC_OFF + 544 * 16, MCNT_OFF = MOFF_OFF + 256;
constexpr int LDS_BYTES = 163840, SMALL_OFF = 132096, MISC_OFF = 163840 - 256;

__device__ __forceinline__ float bf2f(unsigned v) { return __uint_as_float(v << 16); }
typedef float f32x2_t __attribute__((ext_vector_type(2))); typedef __bf16 bf16x2_t __attribute__((ext_vector_type(2)));
__device__ __forceinline__ unsigned pk2(float lo, float hi) { f32x2_t v = {lo, hi}; return __builtin_bit_cast(unsigned, __builtin_convertvector(v, bf16x2_t)); }
__device__ __forceinline__ unsigned f2bf(float f) { return pk2(f, f) & 0xffffu; }
__device__ __forceinline__ float wave_sum(float v) {
#pragma unroll
    for (int o = 1; o < 64; o <<= 1) v += __shfl_xor(v, o);
    return v;
}
__device__ __forceinline__ f32x4 unpack4(u32x2 r) { return (f32x4){bf2f(r.x & 0xffffu), bf2f(r.x >> 16), bf2f(r.y & 0xffffu), bf2f(r.y >> 16)}; }
__device__ __forceinline__ float dot4(f32x4 a) { return (a[0] * a[0] + a[1] * a[1]) + (a[2] * a[2] + a[3] * a[3]); }
typedef short v4i16_t __attribute__((ext_vector_type(4)));
__device__ __forceinline__ s16x4 trr(LAS const unsigned char* p) { return __builtin_bit_cast(s16x4, __builtin_amdgcn_ds_read_tr16_b64_v4i16((LAS v4i16_t*)p)); }
__device__ __forceinline__ bf16x8 cat8(s16x4 lo, s16x4 hi) { return __builtin_shufflevector(lo, hi, 0, 1, 2, 3, 4, 5, 6, 7); }
__device__ __forceinline__ bf16x8 pack8(f32x4 a, f32x4 b) { u32x4 w; w.x = pk2(a[0], a[1]); w.y = pk2(a[2], a[3]); w.z = pk2(b[0], b[1]); w.w = pk2(b[2], b[3]); return __builtin_bit_cast(bf16x8, w); }
#define MFMA(a, b, c) __builtin_amdgcn_mfma_f32_16x16x32_bf16((a), (b), (c), 0, 0, 0)
typedef int i32x4 __attribute__((ext_vector_type(4)));
typedef int i32x8 __attribute__((ext_vector_type(8)));
__device__ __forceinline__ float clamp8(float v) { return __builtin_amdgcn_fmed3f(v, -448.f, 448.f); }
__device__ __forceinline__ unsigned pk4_fp8(float a, float b, float c, float d) {
    int w = 0; w = __builtin_amdgcn_cvt_pk_fp8_f32(clamp8(a), clamp8(b), w, false); w = __builtin_amdgcn_cvt_pk_fp8_f32(clamp8(c), clamp8(d), w, true); return (unsigned)w; }
constexpr float W8_SCALE = 64.f, H8_SCALE = 16.f, A8_SCALE = 4.f, Y8_SCALE = 16.f;
constexpr int W8_E8M0 = 0x79797979  , H8_E8M0 = 0x7b7b7b7b  , A8_E8M0 = 0x7d7d7d7d  ;

#define XB_TMO      128
#define XB_XCNT(j)  (256  + 64 * (j))
#define XB_XSUB(j)  (1280 + 64 * (j))
#define XB_XGEN(j)  (2304 + 64 * (j))
#define XB_TOP      3328
#define XB_TOPGEN   3392
#define XCD_BAR_WORDS 3456
#define XB_SPIN_CAP (1u << 18)
__device__ __forceinline__ unsigned xb_ld(unsigned* p)              { return __hip_atomic_load(p, __ATOMIC_RELAXED, __HIP_MEMORY_SCOPE_AGENT); }
__device__ __forceinline__ unsigned xb_add(unsigned* p, unsigned v) { return __hip_atomic_fetch_add(p, v, __ATOMIC_RELAXED, __HIP_MEMORY_SCOPE_AGENT); }
__device__ __forceinline__ unsigned xb_xcc_id() { return (unsigned)__builtin_amdgcn_s_getreg((3 << 11) | 20) & 0xFu; }
#define XB_SPIN(cond, bar) do { unsigned _sp = 0; while (cond) { __builtin_amdgcn_s_sleep(1); \
    if ((++_sp & 255u) == 0u) { if (xb_ld(&(bar)[XB_TMO])) break; if (_sp > XB_SPIN_CAP) { atomicAdd(&(bar)[XB_TMO], 1u); break; } } } } while (0)
struct XcdBarrier { unsigned* bar; unsigned x; volatile LAS unsigned* st; };
__device__ __forceinline__ XcdBarrier xcd_barrier_post(unsigned* bar, volatile LAS unsigned* st) {
    XcdBarrier b; b.bar = bar; b.x = xb_xcc_id(); b.st = st;
    if (threadIdx.x == 0) (void)xb_add(&bar[XB_XCNT(b.x)], 1u);
    return b;
}
__device__ __forceinline__ void xcd_barrier_complete(unsigned* bar, unsigned x, unsigned& nloc, unsigned& nx) {
    const unsigned G = gridDim.x * gridDim.y * gridDim.z;
    unsigned sum, cnt, mine, sp = 0u;
    for (;;) {
        sum = 0u; cnt = 0u; mine = 0u;
#pragma unroll
        for (unsigned j = 0; j < 16; ++j) { const unsigned c = xb_ld(&bar[XB_XCNT(j)]); sum += c; cnt += (c > 0u) ? 1u : 0u; mine = (j == x) ? c : mine; }
        if (sum == G) break;
        __builtin_amdgcn_s_sleep(1);
        if ((++sp & 255u) == 0u) { if (xb_ld(&bar[XB_TMO])) break; if (sp > XB_SPIN_CAP) { atomicAdd(&bar[XB_TMO], 1u); break; } }
    }
    nloc = mine > 0u ? mine : 1u; nx = cnt > 0u ? cnt : 1u;
}
__device__ __forceinline__ void xcd_barrier(const XcdBarrier& b) {
    asm volatile("s_waitcnt vmcnt(0)" ::: "memory");
    __syncthreads();
    if (threadIdx.x == 0) {
        unsigned* bar = b.bar;
        __builtin_amdgcn_s_waitcnt(0);
        unsigned nloc = b.st[0], nx = b.st[1];
        if (nloc == 0u) { xcd_barrier_complete(bar, b.x, nloc, nx); b.st[0] = nloc; b.st[1] = nx; }
        const unsigned old = xb_add(&bar[XB_XSUB(b.x)], 1u);
        const unsigned gen = old / nloc;
        if (old + 1u == (gen + 1u) * nloc) {
            __builtin_amdgcn_fence(__ATOMIC_RELEASE, "agent");
            asm volatile("s_waitcnt vmcnt(0)" ::: "memory");
            const unsigned og = xb_add(&bar[XB_TOP], 1u);
            const unsigned tg = og / nx;
            if (og + 1u == (tg + 1u) * nx) xb_add(&bar[XB_TOPGEN], 1u);
            else XB_SPIN(xb_ld(&bar[XB_TOPGEN]) == tg, bar);
            __builtin_amdgcn_fence(__ATOMIC_ACQUIRE, "agent");
            xb_add(&bar[XB_XGEN(b.x)], 1u);
            asm volatile("s_waitcnt vmcnt(0)" ::: "memory");
        } else {
            XB_SPIN(xb_ld(&bar[XB_XGEN(b.x)]) == gen, bar);
            __builtin_amdgcn_fence(__ATOMIC_ACQUIRE, "agent");
            asm volatile("s_waitcnt vmcnt(0)" ::: "memory");
        }
    }
    __syncthreads();
}

struct Frame {
    LAS unsigned char* lds;
    int tid, lane, wave, bx, G;
    const float *x, *c, *w_ada, *b_ada, *g_pre_mix, *g_post_mix, *g_pre_ffn, *g_post_ffn, *w_in, *w_gate_up, *b_gate, *g_gla_norm, *sinks, *w_out,
                *w_router, *b_router, *w_mlp1, *b_mlp1, *w_mlp2, *b_mlp2;
    float* out;
    unsigned char* ws;
};
#define WSP(type, off) ((type*)(F.ws + (off)))

struct TrItem { const float* W; int N; int k0, n0; unsigned char* WT; int kind; };
__device__ __forceinline__ bool tr_decode(const Frame& F, int it, TrItem& t) {
    constexpr int I_IN = 16 * 80, I_OUT = 16 * 32, I_1 = 16 * 64, I_2 = 16 * 32;
    constexpr int NITEMS = I_IN + I_OUT + NE * I_1 + NE * I_2;
    if (it >= NITEMS) return false;
    int r = it, item;
    if (r < I_IN) { t.W = F.w_in; t.N = INW; t.WT = F.ws + WS_WIN; t.kind = 0; item = r; }
    else if ((r -= I_IN) < I_OUT) { t.W = F.w_out; t.N = 1024; t.WT = F.ws + WS_WOUT; t.kind = 0; item = r; }
    else if ((r -= I_OUT) < NE * I_1) { const int e = r / I_1; t.W = F.w_mlp1 + (size_t)e * 1024 * 2048; t.N = 2048; t.WT = F.ws + WS_W1T + (size_t)e * 2048 * 1024; t.kind = 1; item = r % I_1; }
    else { r -= NE * I_1; const int e = r / I_2; t.W = F.w_mlp2 + (size_t)e * 1024 * 1024; t.N = 1024; t.WT = F.ws + WS_W2T + (size_t)e * 1024 * 1024; t.kind = 2; item = r % I_2; }
    const int st = item >> 4, l = item & 15, kb = 2 * (st & 7) + (l >> 3), nb = 8 * (st >> 3) + (l & 7);
    t.k0 = 64 * kb; t.n0 = 32 * nb;
    return true;
}
__device__ __forceinline__ void tr_dma(const TrItem& t, int lane, LAS unsigned char* buf) {
    const int p = lane & 7, rr = lane >> 3;
#pragma unroll
    for (int i = 0; i < 8; ++i) {
        int col = t.n0 + 4 * (p ^ i); col = col + 4 <= t.N ? col : t.N - 4;
        __builtin_amdgcn_global_load_lds((const unsigned*)(t.W + (size_t)(t.k0 + 8 * i + rr) * t.N + col), (LAS unsigned*)(buf + i * 1024), 16, 0, 2);
    }
}
__device__ __forceinline__ void tr_store(const TrItem& t, int lane, LAS const unsigned char* buf) {
    const int c = lane & 7;
#pragma unroll
    for (int j = 0; j < 4; ++j) { const int nn = (lane >> 3) + 8 * j;
        float e[8];
#pragma unroll
        for (int q = 0; q < 8; ++q) e[q] = *(LAS const float*)(buf + (8 * c + q) * 128 + (((nn >> 2) ^ c) << 4) + (nn & 3) * 4);
        const int n = t.n0 + nn; const bool ok = n < t.N;
#pragma unroll
        for (int q = 0; q < 8; ++q) e[q] = ok ? e[q] : 0.f;
        if (t.kind == 0) { u32x4 o; o.x = pk2(e[0], e[1]); o.y = pk2(e[2], e[3]); o.z = pk2(e[4], e[5]); o.w = pk2(e[6], e[7]);
            *(u32x4*)((bf16*)t.WT + (size_t)n * 1024 + t.k0 + 8 * c) = o; }
        else { u32x2 o; o.x = pk4_fp8(e[0] * W8_SCALE, e[1] * W8_SCALE, e[2] * W8_SCALE, e[3] * W8_SCALE); o.y = pk4_fp8(e[4] * W8_SCALE, e[5] * W8_SCALE, e[6] * W8_SCALE, e[7] * W8_SCALE);
            int row = n; if (t.kind == 1) { const int jj = n >> 1; row = 256 * (jj >> 7) + 128 * (n & 1) + (jj & 127); }
            *(u32x2*)(t.WT + (size_t)row * 1024 + t.k0 + 8 * c) = o; } }
}
template <int MODE>
__device__ __forceinline__ void tr_range(const Frame& F, int itB, int itE) {
    LAS unsigned char* buf0 = F.lds + F.wave * 16384; LAS unsigned char* buf1 = buf0 + 8192;
    const int it0 = itB + F.wave;
    TrItem t0, t1;
    bool h0 = (it0 < itE) && tr_decode(F, it0, t0); if (h0) tr_dma(t0, F.lane, buf0);
    bool h1 = (it0 + NWAVES < itE) && tr_decode(F, it0 + NWAVES, t1); if (h1) tr_dma(t1, F.lane, buf1);
    if (h0) { if (h1) asm volatile("s_waitcnt vmcnt(8)" ::: "memory"); else asm volatile("s_waitcnt vmcnt(0)" ::: "memory"); }
#pragma unroll 1
    for (int it = it0; h0; it += 2 * NWAVES) {
        if (MODE != 1) tr_store(t0, F.lane, buf0);
        asm volatile("s_waitcnt lgkmcnt(0)" ::: "memory");
        h0 = (it + 2 * NWAVES < itE) && tr_decode(F, it + 2 * NWAVES, t0); if (h0) tr_dma(t0, F.lane, buf0);
        if (!h1) break;
        if (h0) asm volatile("s_waitcnt vmcnt(12)" ::: "memory"); else asm volatile("s_waitcnt vmcnt(4)" ::: "memory");
        if (MODE != 1) tr_store(t1, F.lane, buf1);
        asm volatile("s_waitcnt lgkmcnt(0)" ::: "memory");
        h1 = (it + 3 * NWAVES < itE) && tr_decode(F, it + 3 * NWAVES, t1); if (h1) tr_dma(t1, F.lane, buf1);
        if (h0) { if (h1) asm volatile("s_waitcnt vmcnt(12)" ::: "memory"); else asm volatile("s_waitcnt vmcnt(4)" ::: "memory"); }
    }
    asm volatile("s_waitcnt vmcnt(0)" ::: "memory");
}
template <int MODE>
__device__ __forceinline__ void p0_prologue(const Frame& F) {
    float* mod = WSP(float, WS_MOD);
    if (F.bx < 192 && MODE != 3 && MODE != 1) {
        LAS float* red = (LAS float*)(F.lds + 98304);
        const int cl = F.tid & 31, ks = F.tid >> 5, col = F.bx * 32 + cl;
        LAS float* sc_s = (LAS float*)(F.lds + 98304 + 4096);
        float a0 = 0.f, a1 = 0.f;
        float wv[64];
#pragma unroll
        for (int i = 0; i < 64; ++i) wv[i] = F.w_ada[(size_t)(ks * 64 + i) * 6144 + col];
#pragma unroll
        for (int i = 0; i < 4; ++i) { const float cv = F.c[F.tid + 512 * i]; sc_s[F.tid + 512 * i] = cv * __builtin_amdgcn_rcpf(1.f + __expf(-cv)); }
        __syncthreads();
#pragma unroll
        for (int i = 0; i < 64; ++i) { const int k = ks * 64 + i; a0 += sc_s[k] * wv[i]; a1 += sc_s[1024 + k] * wv[i]; }
        red[(0 * 16 + ks) * 32 + cl] = a0; red[(1 * 16 + ks) * 32 + cl] = a1;
        __syncthreads();
        if (F.tid < 64) { const int b = F.tid >> 5; float s = 0.f;
#pragma unroll
            for (int i = 0; i < 16; ++i) s += red[(b * 16 + i) * 32 + cl];
            mod[b * 6144 + col] = s + F.b_ada[col]; }
        __syncthreads();
    }
    if (MODE == 2) return;
    if (F.bx >= 192) tr_range<MODE>(F, (F.bx - 192) * 16, (F.bx - 192) * 16 + 16);
    else if (F.bx < 96) tr_range<MODE>(F, 1024 + F.bx * 8, 1024 + F.bx * 8 + 8);
}

__device__ __forceinline__ void p1_norm(const Frame& F) {
    const float* mod = WSP(float, WS_MOD); bf16* h = WSP(bf16, WS_H);
    const int gw = F.bx * NWAVES + F.wave, m0 = gw * 16;
    const float* modb = mod + (m0 >> 14) * 6144;
    const float* xb = F.x + (size_t)m0 * D + 4 * F.lane;
    f32x4 g[4], sh[4], b0[4], b1[4], b2[4], b3[4];
#define P1_LOAD(B, r) do { _Pragma("unroll") for (int j = 0; j < 4; ++j) B[j] = __builtin_nontemporal_load((const f32x4*)(xb + (size_t)(r) * D + 256 * j)); } while (0)
#define P1_ROW(B, it) do { float ss = 0.f; _Pragma("unroll") for (int j = 0; j < 4; ++j) ss += dot4(B[j]); \
        const float r = rsqrtf(wave_sum(ss) * (1.f / D) + EPS); \
        u32x2 o[4]; _Pragma("unroll") for (int j = 0; j < 4; ++j) { const f32x4 hv = B[j] * r * g[j] + sh[j]; o[j].x = pk2(hv[0], hv[1]); o[j].y = pk2(hv[2], hv[3]); } \
          \
        _Pragma("unroll") for (int j = 0; j < 4; j += 2) { const bool odd = F.lane & 1; \
            const u32x2 own = odd ? o[j + 1] : o[j], snd = odd ? o[j] : o[j + 1]; u32x2 rcv; \
            rcv.x = (unsigned)__builtin_amdgcn_mov_dpp((int)snd.x, 0xB1, 0xf, 0xf, true); rcv.y = (unsigned)__builtin_amdgcn_mov_dpp((int)snd.y, 0xB1, 0xf, 0xf, true); \
            u32x4 w; w.x = odd ? rcv.x : own.x; w.y = odd ? rcv.y : own.y; w.z = odd ? own.x : rcv.x; w.w = odd ? own.y : rcv.y; \
            *(u32x4*)(h + (size_t)(m0 + (it)) * D + 4 * (F.lane & ~1) + 256 * (j + (odd ? 1 : 0))) = w; } \
        if ((it) + 4 < 16) P1_LOAD(B, (it) + 4); } while (0)
    P1_LOAD(b0, 0); P1_LOAD(b1, 1); P1_LOAD(b2, 2); P1_LOAD(b3, 3);
#pragma unroll
    for (int j = 0; j < 4; ++j) { const int idx = 4 * F.lane + 256 * j;
        g[j] = *(const f32x4*)(F.g_pre_mix + idx) * (*(const f32x4*)(modb + 1024 + idx) + 1.f); sh[j] = *(const f32x4*)(modb + idx); }
#pragma unroll 1
    for (int it = 0; it < 16; it += 4) { P1_ROW(b0, it); P1_ROW(b1, it + 1); P1_ROW(b2, it + 2); P1_ROW(b3, it + 3); }
#undef P1_LOAD
#undef P1_ROW
}

typedef float f32x2 __attribute__((ext_vector_type(2)));
__device__ __forceinline__ f32x2 swiglu_s2(f32x2 g, f32x2 l) {
    f32x2 xg, xl; xg.x = fminf(g.x, 7.f); xg.y = fminf(g.y, 7.f); xl.x = __builtin_amdgcn_fmed3f(l.x, -7.f, 7.f); xl.y = __builtin_amdgcn_fmed3f(l.y, -7.f, 7.f);
    const f32x2 t = xg * (-1.702f * 1.4426950408889634f);
    f32x2 ex; ex.x = __builtin_amdgcn_exp2f(t.x); ex.y = __builtin_amdgcn_exp2f(t.y);
    const f32x2 den = ex + 1.f;
    f32x2 rc; rc.x = __builtin_amdgcn_rcpf(den.x); rc.y = __builtin_amdgcn_rcpf(den.y);
    return (xg * rc) * (xl * A8_SCALE + A8_SCALE);
}
__device__ __forceinline__ unsigned pk4_fp8_nc(float a, float b, float c, float d) {
    int w = 0; w = __builtin_amdgcn_cvt_pk_fp8_f32(a, b, w, false); w = __builtin_amdgcn_cvt_pk_fp8_f32(c, d, w, true); return (unsigned)w; }
namespace pg8 {
constexpr int BM = 256, BK = 64, HALF = 128, HTB = HALF * BK * 2, NXCD = 8, WGM = 8;
__device__ __forceinline__ int lds_byte(int r, int c) { const int st = (r >> 4) * 2 + (c >> 5), rr = r & 15, cc = c & 31, ob = rr * 64 + cc * 2; return st * 1024 + (ob ^ (((ob >> 9) & 1) << 5)); }
__device__ __forceinline__ void stage_rc(int b, int& R, int& C) { const int st = b / 1024, sb = b % 1024, swz = sb ^ (((sb >> 9) & 1) << 5); R = (st >> 1) * 16 + swz / 64; C = (st & 1) * 32 + (swz % 64) / 2; }
__device__ __forceinline__ int perm32(int rho) { const int n = rho >> 4, i = rho & 15; return 8 * (i >> 2) + 4 * n + (i & 3); }
struct Unit { int pm, pn, e, pos0, cnt, hf; i32x4 dr; };
struct StaticOrder {
    int nM, nN, nwg, G, c, i0, n, split;
    __device__ __forceinline__ void init(int nM_, int nN_, int G_, int c_, int i0_ = 0, int n_ = 1 << 30, int split_ = 0) { nM = nM_; nN = nN_; nwg = nM * nN; G = G_; c = c_; i0 = i0_; n = n_; split = split_; }
    __device__ __forceinline__ bool next(int i, Unit& u) const {
        if (i >= n) return false;
        const int r = i0 + i, R = nwg / G, tail = nwg - R * G;
        long L; u.hf = 0;
        if (split && r == R && tail > 0 && 2 * tail <= G) { if (c >= 2 * tail) return false; L = (long)R * G + (c >> 1); u.hf = 1 + (c & 1); }
        else { L = (long)r * G + c; if (L >= nwg) return false; }
        int wgid = (int)L; { const int q = nwg / NXCD, r = nwg % NXCD, xcd = wgid % NXCD, off = wgid / NXCD; wgid = (xcd < r ? xcd * (q + 1) : r * (q + 1) + (xcd - r) * q) + off; }
        const int nig = WGM * nN, gid = wgid / nig, fm = gid * WGM, gsz = (nM - fm) < WGM ? (nM - fm) : WGM;
        u.pm = fm + ((wgid % nig) % gsz); u.pn = (wgid % nig) / gsz; return true;
    }
};
template <bool GATHER, int FP8, int SCW, int SCX, int ABL = 0, class Epi, class Sched, class AB>
__device__ __forceinline__ void gemm_phase(LAS unsigned char* lds, const int K, const Sched& S, const AB& ab, const Epi& E) {
    const int tid = threadIdx.x, wid = __builtin_amdgcn_readfirstlane(tid >> 6), lane = tid & 63, wr = wid >> 2, wc = wid & 3, fr = lane & 15, fq = lane >> 4;
    const int nt = K / BK;
    int sR[2], sC[2]; unsigned voffB[2], vA[2][2], nvA[2][2];
#pragma unroll
    for (int i = 0; i < 2; ++i) { int R, C; stage_rc(tid * 16 + i * 8192, R, C); sR[i] = R; sC[i] = C; const int Rb = (R & ~31) + perm32(R & 31); voffB[i] = (unsigned)(Rb * K + C) * 2u; }
    const size_t kstep = (size_t)(BK * 2);
    const size_t hstep = (size_t)HALF * K * 2;
    const unsigned ldsw = (unsigned)wid * 1024u;
    const int aoff = lds_byte(wr * 64 + fr, fq * 8), boff = lds_byte(wc * 32 + fr, fq * 8);
#define PG8_SA(b, h) (((b) * 2 + (h)) * HTB)
#define PG8_SB(b, h) ((4 + (b) * 2 + (h)) * HTB)
#define PG8_STAGE(bufoff, gbase, voff) do { if (ABL != 3) _Pragma("unroll") for (int _i = 0; _i < 2; ++_i) \
        __builtin_amdgcn_global_load_lds((const unsigned*)((const char*)(gbase) + (voff)[_i]), (LAS unsigned*)(lds + (bufoff) + ldsw + _i * 8192), 16, 0, 0); } while (0)
#define PG8_LDA(dst, b, h) do { _Pragma("unroll") for (int m = 0; m < 4; ++m) _Pragma("unroll") for (int k = 0; k < 2; ++k) dst[m][k] = *(const LAS bf16x8*)(lds + PG8_SA(b, h) + aoff + m * 2048 + k * 1024); } while (0)
#define PG8_LDB(dst, b, h) do { _Pragma("unroll") for (int n = 0; n < 2; ++n) _Pragma("unroll") for (int k = 0; k < 2; ++k) dst[n][k] = *(const LAS bf16x8*)(lds + PG8_SB(b, h) + boff + n * 2048 + k * 1024); } while (0)
#define PG8_C8(x) __builtin_shufflevector(__builtin_bit_cast(i32x4, (x)[0]), __builtin_bit_cast(i32x4, (x)[1]), 0, 1, 2, 3, 4, 5, 6, 7)
#define PG8_MMA(ai, bj, At, Bt) do { if (ABL == 2) break; __builtin_amdgcn_s_setprio(1); _Pragma("unroll") for (int m = 0; m < 4; ++m) _Pragma("unroll") for (int n = 0; n < 2; ++n) { \
        if (FP8) asm volatile("v_mfma_scale_f32_16x16x128_f8f6f4 %0, %1, %2, %0, %3, %4 op_sel_hi:[0,0,0]" : "+v"(acc[ai][bj][m][n]) : "v"(PG8_C8(Bt[n])), "v"(PG8_C8(At[m])), "v"(scw), "v"(scx)); \
        else { _Pragma("unroll") for (int k = 0; k < 2; ++k) asm volatile("v_mfma_f32_16x16x32_bf16 %0, %1, %2, %0" : "+v"(acc[ai][bj][m][n]) : "v"(Bt[n][k]), "v"(At[m][k])); } } \
        __builtin_amdgcn_s_setprio(0); } while (0)
#define PG8_WAIT_V(n) asm volatile("s_waitcnt vmcnt(" #n ")" ::: "memory")
#define PG8_WAIT_L(n) asm volatile("s_waitcnt lgkmcnt(" #n ")" ::: "memory")
#define PG8_BAR __builtin_amdgcn_s_barrier()
#define PG8_SCHED __builtin_amdgcn_sched_barrier(0)
#define PG8_AOFF(dst, u) do { _Pragma("unroll") for (int _h = 0; _h < 2; ++_h) _Pragma("unroll") for (int _i = 0; _i < 2; ++_i) \
        dst[_h][_i] = GATHER ? (unsigned)(ab.a_row((u), _h * HALF + sR[_i]) * K + sC[_i]) * 2u : (unsigned)((_h * HALF + sR[_i]) * K + sC[_i]) * 2u; } while (0)
    Unit cur, nxt, nn; int ui = 0;
    if (!S.next(0, cur)) return;
    ab.fill_sync(cur);
    bool has_nn = S.next(1, nn); if (has_nn) ab.fill(nn);
    const int scw = SCW, scx = SCX;
    f32x4 acc[2][2][4][2];
#pragma unroll
    for (int a = 0; a < 2; ++a)
#pragma unroll
        for (int b = 0; b < 2; ++b)
#pragma unroll
            for (int m = 0; m < 4; ++m)
#pragma unroll
                for (int n = 0; n < 2; ++n) acc[a][b][m][n] = (f32x4){0.f, 0.f, 0.f, 0.f};
    bf16x8 At[4][2], B0[2][2], B1[2][2];
    const char* cA = ab.a_base(cur); const char* cB = ab.b_base(cur);
    PG8_AOFF(vA, cur);
    PG8_STAGE(PG8_SB(0, 0), cB, voffB); PG8_STAGE(PG8_SB(0, 1), cB + hstep, voffB); PG8_STAGE(PG8_SA(0, 0), cA, vA[0]); PG8_STAGE(PG8_SA(0, 1), cA, vA[1]);
    if (wr == 1) PG8_BAR;
    PG8_WAIT_V(2); PG8_BAR;
    PG8_STAGE(PG8_SB(1, 0), cB + kstep, voffB); PG8_STAGE(PG8_SA(1, 0), cA + kstep, vA[0]); PG8_STAGE(PG8_SB(1, 1), cB + hstep + kstep, voffB);
    PG8_WAIT_V(6); PG8_BAR;
    for (;;) {
        const bool has_next = has_nn; nxt = nn; if (has_next) ab.commit(nxt);
        has_nn = has_next && S.next(ui + 2, nn); if (has_nn) ab.fill(nn);
        const char* nA = has_next ? ab.a_base(nxt) : cA; const char* nB = has_next ? ab.b_base(nxt) : cB;
        int raw[2][2];
        if (GATHER) {
#pragma unroll
            for (int h = 0; h < 2; ++h)
#pragma unroll
                for (int i = 0; i < 2; ++i) { raw[h][i] = 0;
                    if (has_next) { const int* lp_ = ab.a_ptr(nxt, h * HALF + sR[i]); asm volatile("global_load_dword %0, %1, off" : "=v"(raw[h][i]) : "v"(lp_) : "memory"); } } }
        const bool h1 = cur.hf != 2, h2 = cur.hf != 1;
#pragma unroll 1
        for (int t = 0; t < nt; t += 2) {
            const bool last = (t == nt - 2);
            const char* a1 = cA + (size_t)(t + 1) * kstep;
            const char* a2 = last ? nA : cA + (size_t)(t + 2) * kstep; const char* b2 = last ? nB : cB + (size_t)(t + 2) * kstep;
            const char* a3 = a2 + kstep; const char* b3 = b2 + kstep;
            unsigned o2[2][2];
            if (GATHER && last) {
                asm volatile("" : "+v"(raw[0][0]), "+v"(raw[0][1]), "+v"(raw[1][0]), "+v"(raw[1][1]));
#pragma unroll
                for (int h = 0; h < 2; ++h)
#pragma unroll
                    for (int i = 0; i < 2; ++i) nvA[h][i] = has_next ? (unsigned)(ab.a_fin(nxt, h * HALF + sR[i], raw[h][i]) * K + sC[i]) * 2u : vA[h][i]; }
#pragma unroll
            for (int h = 0; h < 2; ++h)
#pragma unroll
                for (int i = 0; i < 2; ++i) o2[h][i] = (GATHER && last) ? nvA[h][i] : vA[h][i];
            PG8_LDB(B0, 0, 0); PG8_LDB(B1, 0, 1); PG8_SCHED; if (h1) PG8_LDA(At, 0, 0); PG8_STAGE(PG8_SA(1, 1), a1, vA[1]);
            PG8_WAIT_V(8); PG8_WAIT_L(0); PG8_BAR; if (h1) { PG8_MMA(0, 0, At, B0); PG8_MMA(0, 1, At, B1); } PG8_BAR; PG8_SCHED;
            if (h2) PG8_LDA(At, 0, 1); PG8_STAGE(PG8_SB(0, 0), b2, voffB); PG8_STAGE(PG8_SB(0, 1), b2 + hstep, voffB); PG8_STAGE(PG8_SA(0, 0), a2, o2[0]);
            PG8_WAIT_V(8); PG8_WAIT_L(0); PG8_BAR; if (h2) { PG8_MMA(1, 0, At, B0); PG8_MMA(1, 1, At, B1); } PG8_BAR; PG8_SCHED;
            PG8_LDB(B0, 1, 0); PG8_LDB(B1, 1, 1); PG8_SCHED; if (h1) PG8_LDA(At, 1, 0); PG8_STAGE(PG8_SA(0, 1), a2, o2[1]);
            PG8_WAIT_V(8); PG8_WAIT_L(0); PG8_BAR; if (h1) { PG8_MMA(0, 0, At, B0); PG8_MMA(0, 1, At, B1); } PG8_BAR; PG8_SCHED;
            if (h2) PG8_LDA(At, 1, 1); PG8_STAGE(PG8_SB(1, 0), b3, voffB); PG8_STAGE(PG8_SB(1, 1), b3 + hstep, voffB); PG8_STAGE(PG8_SA(1, 0), a3, o2[0]);
            PG8_WAIT_V(8); PG8_WAIT_L(0); PG8_BAR; if (h2) { PG8_MMA(1, 0, At, B0); PG8_MMA(1, 1, At, B1); } PG8_BAR; PG8_SCHED;
        }
        if (wr == 0) PG8_BAR;
        asm volatile("s_nop 15\n\ts_nop 15" ::: "memory");
        if (ABL == 1) { _Pragma("unroll") for (int a = 0; a < 2; ++a) _Pragma("unroll") for (int b = 0; b < 2; ++b) _Pragma("unroll") for (int m = 0; m < 4; ++m) _Pragma("unroll") for (int n = 0; n < 2; ++n) asm volatile("" :: "v"(acc[a][b][m][n])); }
        else E(acc, cur, wr, wc, fr, fq);
        if (!has_next) break;
#pragma unroll
        for (int a = 0; a < 2; ++a)
#pragma unroll
            for (int b = 0; b < 2; ++b)
#pragma unroll
                for (int m = 0; m < 4; ++m)
#pragma unroll
                    for (int n = 0; n < 2; ++n) acc[a][b][m][n] = (f32x4){0.f, 0.f, 0.f, 0.f};
        cur = nxt; cA = nA; cB = nB; ++ui;
        if (GATHER) {
#pragma unroll
            for (int h = 0; h < 2; ++h)
#pragma unroll
                for (int i = 0; i < 2; ++i) vA[h][i] = nvA[h][i]; }
        if (wr == 1) PG8_BAR;
    }
    PG8_WAIT_V(0);
    PG8_BAR;
#undef PG8_SA
#undef PG8_SB
#undef PG8_STAGE
#undef PG8_LDA
#undef PG8_LDB
#undef PG8_MMA
#undef PG8_C8
#undef PG8_WAIT_V
#undef PG8_WAIT_L
#undef PG8_BAR
#undef PG8_SCHED
#undef PG8_AOFF
}
__device__ __forceinline__ unsigned cvt_pk_bf16(float lo, float hi) { unsigned r; asm volatile("v_cvt_pk_bf16_f32 %0, %1, %2" : "=v"(r) : "v"(lo), "v"(hi)); return r; }
struct ABDense { const bf16* A; const bf16* Bt; int K;
    __device__ __forceinline__ const char* a_base(const Unit& u) const { return (const char*)(A + (size_t)u.pm * BM * K); }
    __device__ __forceinline__ const char* b_base(const Unit& u) const { return (const char*)(Bt + (size_t)u.pn * BM * K); }
    __device__ __forceinline__ void fill(Unit& u) const { u.e = 0; u.pos0 = 0; u.cnt = 0; }
    __device__ __forceinline__ void fill_sync(Unit& u) const { u.e = 0; u.pos0 = 0; u.cnt = 0; }
    __device__ __forceinline__ void commit(Unit&) const {}
    __device__ __forceinline__ const int* a_ptr(const Unit&, int) const { return nullptr; }
    __device__ __forceinline__ int a_fin(const Unit&, int, int) const { return 0; }
    __device__ __forceinline__ int a_row(const Unit&, int) const { return 0; } };
struct EpiStoreT { bf16* O; int ldo; size_t tst;
    __device__ __forceinline__ void operator()(const f32x4 (&acc)[2][2][4][2], const Unit& u, int wr, int wc, int fr, int fq) const {
        const int row0 = u.pm * BM + wr * 64 + fr, col0 = wc * 32 + 8 * fq;
        bf16* Ot = O + (size_t)u.pn * tst;
#pragma unroll
        for (int ai = 0; ai < 2; ++ai)
#pragma unroll
            for (int m = 0; m < 4; ++m) { bf16* rowp = Ot + (size_t)(row0 + ai * HALF + m * 16) * ldo + col0;
#pragma unroll
                for (int bj = 0; bj < 2; ++bj) { const f32x4 v0 = acc[ai][bj][m][0], v1 = acc[ai][bj][m][1];
                    u32x4 w; w.x = cvt_pk_bf16(v0[0], v0[1]); w.y = cvt_pk_bf16(v0[2], v0[3]); w.z = cvt_pk_bf16(v1[0], v1[1]); w.w = cvt_pk_bf16(v1[2], v1[3]);
                    *(u32x4*)(rowp + bj * HALF) = w; } }
    } };
struct ABMoe1 { const unsigned char* H; const unsigned char* W; LAS const i32x4* tdesc; const int* list_a;
    __device__ __forceinline__ void fill(Unit& u) const { const unsigned a = (unsigned)(size_t)(tdesc + u.pm); asm volatile("ds_read_b128 %0, %1" : "=v"(u.dr) : "v"(a) : "memory"); }
    __device__ __forceinline__ void commit(Unit& u) const { asm volatile("" : "+v"(u.dr)); u.e = __builtin_amdgcn_readfirstlane(u.dr.x); u.pos0 = __builtin_amdgcn_readfirstlane(u.dr.y); u.cnt = __builtin_amdgcn_readfirstlane(u.dr.z); }
    __device__ __forceinline__ void fill_sync(Unit& u) const { fill(u); asm volatile("s_waitcnt lgkmcnt(0)" ::: "memory"); commit(u); }
    __device__ __forceinline__ const char* a_base(const Unit&) const { return (const char*)H; }
    __device__ __forceinline__ const char* b_base(const Unit& u) const { return (const char*)(W + (size_t)u.e * 2048 * 1024 + (size_t)u.pn * BM * 1024); }
    __device__ __forceinline__ int a_row(const Unit& u, int rt) const { const int pos = u.pos0 + rt; const bool ok = pos < u.cnt;
        const int a = list_a[(size_t)u.e * T + (ok ? pos : 0)]; return ok ? (a >> 2) : 0; }
    __device__ __forceinline__ const int* a_ptr(const Unit& u, int rt) const { const int pos = u.pos0 + rt; return list_a + (size_t)u.e * T + (pos < u.cnt ? pos : 0); }
    __device__ __forceinline__ int a_fin(const Unit& u, int rt, int a) const { return (u.pos0 + rt) < u.cnt ? (a >> 2) : 0; } };
struct ABMoe2 { const unsigned char* A; const unsigned char* W; LAS const i32x4* tdesc;
    __device__ __forceinline__ void fill(Unit& u) const { const unsigned a = (unsigned)(size_t)(tdesc + u.pm); asm volatile("ds_read_b128 %0, %1" : "=v"(u.dr) : "v"(a) : "memory"); }
    __device__ __forceinline__ void commit(Unit& u) const { asm volatile("" : "+v"(u.dr)); u.e = __builtin_amdgcn_readfirstlane(u.dr.x); u.pos0 = __builtin_amdgcn_readfirstlane(u.dr.y); u.cnt = __builtin_amdgcn_readfirstlane(u.dr.z); }
    __device__ __forceinline__ void fill_sync(Unit& u) const { fill(u); asm volatile("s_waitcnt lgkmcnt(0)" ::: "memory"); commit(u); }
    __device__ __forceinline__ const char* a_base(const Unit& u) const { return (const char*)(A + (size_t)u.pm * BM * 1024); }
    __device__ __forceinline__ const char* b_base(const Unit& u) const { return (const char*)(W + (size_t)u.e * 1024 * 1024 + (size_t)u.pn * BM * 1024); }
    __device__ __forceinline__ const int* a_ptr(const Unit&, int) const { return nullptr; }
    __device__ __forceinline__ int a_fin(const Unit&, int, int) const { return 0; }
    __device__ __forceinline__ int a_row(const Unit&, int) const { return 0; } };
struct EpiSwigluT { unsigned char* Aout; const float* b1;
    __device__ __forceinline__ void operator()(const f32x4 (&acc)[2][2][4][2], const Unit& u, int wr, int wc, int fr, int fq) const {
        const int row0 = u.pm * BM + wr * 64 + fr, j0 = u.pn * HALF + wc * 32 + 8 * fq;
        const float* bp = b1 + (size_t)u.e * 2048 + 2 * j0;
        f32x2 bg[4], bl[4];
#pragma unroll
        for (int q = 0; q < 4; ++q) { const f32x4 b4 = *(const f32x4*)(bp + 4 * q); bg[q] = (f32x2){b4[0], b4[2]}; bl[q] = (f32x2){b4[1], b4[3]}; }
#pragma unroll
        for (int ai = 0; ai < 2; ++ai) {
            if (u.hf == 2 - ai) continue;
            u32x2 wv[4];
#pragma unroll
            for (int m = 0; m < 4; ++m) {
                const f32x4 g0 = acc[ai][0][m][0], g1 = acc[ai][0][m][1], l0 = acc[ai][1][m][0], l1 = acc[ai][1][m][1];
                const f32x2 r0 = swiglu_s2((f32x2){g0[0], g0[1]} + bg[0], (f32x2){l0[0], l0[1]} + bl[0]), r1 = swiglu_s2((f32x2){g0[2], g0[3]} + bg[1], (f32x2){l0[2], l0[3]} + bl[1]);
                const f32x2 r2 = swiglu_s2((f32x2){g1[0], g1[1]} + bg[2], (f32x2){l1[0], l1[1]} + bl[2]), r3 = swiglu_s2((f32x2){g1[2], g1[3]} + bg[3], (f32x2){l1[2], l1[3]} + bl[3]);
                wv[m].x = pk4_fp8_nc(r0.x, r0.y, r1.x, r1.y); wv[m].y = pk4_fp8_nc(r2.x, r2.y, r3.x, r3.y); }
#pragma unroll
            for (int m = 0; m < 4; m += 2) {
                const auto rx = __builtin_amdgcn_permlane16_swap(wv[m].x, wv[m + 1].x, false, false), ry = __builtin_amdgcn_permlane16_swap(wv[m].y, wv[m + 1].y, false, false);
                u32x4 v; v.x = rx[0]; v.y = ry[0]; v.z = rx[1]; v.w = ry[1];
                *(u32x4*)(Aout + (size_t)(row0 + ai * HALF + (m + (fq & 1)) * 16) * FF + j0 - 8 * (fq & 1)) = v; }
        }
    } };
struct EpiMoe2T { unsigned char* ys; const float* b2;
    __device__ __forceinline__ void operator()(const f32x4 (&acc)[2][2][4][2], const Unit& u, int wr, int wc, int fr, int fq) const {
        const int row0 = u.pm * BM + wr * 64 + fr, col0 = u.pn * BM + wc * 32 + 8 * fq;
        const float* bp = b2 + (size_t)u.e * D + col0;
        f32x4 bv[2][2];
#pragma unroll
        for (int bj = 0; bj < 2; ++bj)
#pragma unroll
            for (int n = 0; n < 2; ++n) bv[bj][n] = *(const f32x4*)(bp + bj * HALF + 4 * n) * Y8_SCALE;
#pragma unroll
        for (int ai = 0; ai < 2; ++ai) {
            if (u.hf == 2 - ai) continue;
#pragma unroll
            for (int m = 0; m < 4; ++m) { unsigned char* rowp = ys + (size_t)(row0 + ai * HALF + m * 16) * D + col0;
                u32x2 w[2];
#pragma unroll
                for (int bj = 0; bj < 2; ++bj) { const f32x4 v0 = acc[ai][bj][m][0] * Y8_SCALE + bv[bj][0], v1 = acc[ai][bj][m][1] * Y8_SCALE + bv[bj][1];
                    w[bj].x = pk4_fp8(v0[0], v0[1], v0[2], v0[3]); w[bj].y = pk4_fp8(v1[0], v1[1], v1[2], v1[3]); }
                const auto rx = __builtin_amdgcn_permlane16_swap(w[0].x, w[1].x, false, false), ry = __builtin_amdgcn_permlane16_swap(w[0].y, w[1].y, false, false);
                u32x4 v; v.x = rx[0]; v.y = ry[0]; v.z = rx[1]; v.w = ry[1];
                *(u32x4*)(rowp + ((fq & 1) ? (HALF - 8) : 0)) = v; } }
    } };
}

__device__ __forceinline__ void attn_issue(const Frame& F, int u, u32x4 (&kr)[4], u32x4 (&vr)[4], bf16x8 (&qr)[4][2]) {
    const int qblk = u & 127, kvh = (u >> 7) & 1, b = u >> 8;
    const bf16* proj = WSP(bf16, WS_PROJ);
    const int tok0 = b * S + qblk * 128;
#pragma unroll
    for (int i = 0; i < 4; ++i) {
        const int cid = F.tid + 512 * i, row = cid >> 3, ch = cid & 7;
        const int tr = tok0 - 128 + ((qblk > 0 || row >= 128) ? row : row + 128);
        kr[i] = *(const u32x4*)(proj + pj(tr, AK_OFF + kvh * 64 + ch * 8));
        vr[i] = *(const u32x4*)(proj + pj(tr, AV_OFF + kvh * 64 + ch * 8));
    }
    const int g = F.wave >> 1, hw = F.wave & 1, hq = kvh * 4 + g, fr = F.lane & 15, fq = F.lane >> 4;
    const bf16* qbase = proj + pj(tok0 + 64 * hw + fr, AQ_OFF + hq * 64 + 8 * fq);
#pragma unroll
    for (int qb = 0; qb < 4; ++qb) { qr[qb][0] = *(const bf16x8*)(qbase + (size_t)(16 * qb) * 256); qr[qb][1] = *(const bf16x8*)(qbase + (size_t)(16 * qb) * 256 + 32); }
}
__device__ __forceinline__ void attn_fill(const Frame& F, LAS unsigned char* Ks, const u32x4 (&kr)[4], const u32x4 (&vr)[4]) {
#pragma unroll
    for (int i = 0; i < 4; ++i) {
        const int cid = F.tid + 512 * i, row = cid >> 3, ch = cid & 7;
        *(LAS u32x4*)(Ks + row * 144 + ch * 16) = kr[i];
        *(LAS u32x4*)(Ks + 256 * 144 + row * 144 + ch * 16) = vr[i];
    }
}
__device__ __forceinline__ void attn_compute(const Frame& F, int u, LAS const unsigned char* Ks, const bf16x8 (&qr)[4][2]) {
    const int qblk = u & 127, kvh = (u >> 7) & 1, b = u >> 8;
    LAS const unsigned char* Vs = Ks + 256 * 144;
    bf16* mix = WSP(bf16, WS_MIX);
    const int tok0 = b * S + qblk * 128;
    const int g = F.wave >> 1, hw = F.wave & 1, hq = kvh * 4 + g;
    const int lane = F.lane, fr = lane & 15, fq = lane >> 4;
    const float NEG_INF = -__builtin_inff();
    const float SC = 0.125f * 1.44269504f, sink2 = F.sinks[hq] * 1.44269504f;
#pragma unroll
    for (int qb = 0; qb < 4; ++qb) {
        const bf16x8 q0 = qr[qb][0], q1 = qr[qb][1];
        f32x4 st[9];
#pragma unroll
        for (int n = 0; n < 9; ++n) {
            LAS const unsigned char* kp = Ks + (64 * hw + 16 * (qb + n) + fr) * 144 + fq * 16;
            const bf16x8 k0 = *(LAS const bf16x8*)kp, k1 = *(LAS const bf16x8*)(kp + 64);
            f32x4 z = (f32x4){0.f, 0.f, 0.f, 0.f}; z = MFMA(k0, q0, z); z = MFMA(k1, q1, z); st[n] = z;
        }
#pragma unroll
        for (int r = 0; r < 4; ++r) { const int c = 4 * fq + r; st[0][r] = (c > fr) ? st[0][r] : NEG_INF; st[8][r] = (c <= fr) ? st[8][r] : NEG_INF; }
        if (qblk == 0) {
#pragma unroll
            for (int n = 0; n < 9; ++n)
#pragma unroll
                for (int r = 0; r < 4; ++r) st[n][r] = (64 * hw + 16 * (qb + n) + 4 * fq + r >= 128) ? st[n][r] : NEG_INF;
        }
        float mx = NEG_INF;
#pragma unroll
        for (int n = 0; n < 9; ++n)
#pragma unroll
            for (int r = 0; r < 4; ++r) mx = fmaxf(mx, st[n][r]);
        mx = fmaxf(mx, __shfl_xor(mx, 16)); mx = fmaxf(mx, __shfl_xor(mx, 32));
        const float m2 = fmaxf(mx * SC, sink2);
        float sum = 0.f;
#pragma unroll
        for (int n = 0; n < 9; ++n)
#pragma unroll
            for (int r = 0; r < 4; ++r) { const float p = __builtin_amdgcn_exp2f(__builtin_fmaf(st[n][r], SC, -m2)); st[n][r] = p; sum += p; }
        sum += __shfl_xor(sum, 16); sum += __shfl_xor(sum, 32); sum += __builtin_amdgcn_exp2f(sink2 - m2);
        const float inv = 1.f / sum;
        f32x4 o[4];
#pragma unroll
        for (int c = 0; c < 4; ++c) o[c] = (f32x4){0.f, 0.f, 0.f, 0.f};
#pragma unroll
        for (int ks = 0; ks < 4; ++ks) {
            const bf16x8 pf = pack8(st[2 * ks], st[2 * ks + 1]);
            const int rb = 64 * hw + 16 * (qb + 2 * ks) + 4 * fq + (fr >> 2);
#pragma unroll
            for (int c = 0; c < 4; ++c) {
                LAS const unsigned char* vp = Vs + rb * 144 + (16 * c + 4 * (lane & 3)) * 2;
                const bf16x8 vf = cat8(trr(vp), trr(vp + 16 * 144));
                o[c] = MFMA(vf, pf, o[c]);
            }
        }
        { u32x2 w; w.x = pk2(st[8][0], st[8][1]); w.y = pk2(st[8][2], st[8][3]);
          const s16x4 pf4 = __builtin_bit_cast(s16x4, w);
          const int rb = 64 * hw + 16 * (qb + 8) + 4 * fq + (fr >> 2);
#pragma unroll
          for (int c = 0; c < 4; ++c) {
              LAS const unsigned char* vp = Vs + rb * 144 + (16 * c + 4 * (lane & 3)) * 2;
              o[c] = __builtin_amdgcn_mfma_f32_16x16x16bf16_1k(trr(vp), pf4, o[c], 0, 0, 0); } }
        { bf16* op = mix + (size_t)(tok0 + 64 * hw + 16 * qb + fr) * D + hq * 64 + 4 * fq;
#pragma unroll
            for (int c = 0; c < 4; ++c) { u32x2 w; w.x = pk2(o[c][0] * inv, o[c][1] * inv); w.y = pk2(o[c][2] * inv, o[c][3] * inv); *(u32x2*)(op + 16 * c) = w; } }
    }
}
__device__ __forceinline__ void attn_units(const Frame& F) {
    int u = F.bx; if (u >= 512) return;
    u32x4 kr[4], vr[4]; bf16x8 qr[4][2];
    attn_issue(F, u, kr, vr, qr);
    int buf = 0;
#pragma unroll 1
    for (; u < 512; u += F.G) {
        LAS unsigned char* Ks = F.lds + buf * 73728;
        attn_fill(F, Ks, kr, vr);
        bf16x8 q[4][2];
#pragma unroll
        for (int i = 0; i < 4; ++i) { q[i][0] = qr[i][0]; q[i][1] = qr[i][1]; }
        __syncthreads();
        if (u + F.G < 512) attn_issue(F, u + F.G, kr, vr, qr);
        attn_compute(F, u, Ks, q);
        buf ^= 1;
    }
    __syncthreads();
}

template <bool OUT>
__device__ __forceinline__ void gla_super_unit(const Frame& F, int u) {
    const int sc = u & 31, h = (u >> 5) & 3, b = u >> 7;
    const bf16* proj = WSP(bf16, WS_PROJ); bf16* mix = WSP(bf16, WS_MIX);
    LAS unsigned char* qd_s = F.lds; LAS unsigned char* kk_s = F.lds + 9216; LAS unsigned char* qe_s = F.lds + 18432;
    LAS unsigned char* v_s0 = F.lds + 27648; LAS unsigned char* st_s = F.lds + 45056; LAS unsigned char* kd_s = F.lds + 63488;
    LAS float* ga_w = (LAS float*)(F.lds + 72704 + F.wave * 512);
    LAS float* tot_s = (LAS float*)(F.lds + 76800); LAS float* ssq_s = (LAS float*)(F.lds + 78848); LAS float* dec_s = (LAS float*)(F.lds + 79360);
    LAS unsigned char* v_s1 = F.lds + 79872;
    LAS unsigned char* kd_s1 = F.lds + 97280;
    float* bglob = WSP(float, WS_H);
    const int lane = F.lane, fr = lane & 15, fq = lane >> 4;
    const int ib = F.wave >> 1, dvh = F.wave & 1;
    float wu[16];
#pragma unroll
    for (int r = 0; r < 16; ++r) wu[r] = OUT ? 0.f : F.w_gate_up[r * 256 + h * 64 + lane];
    const float bg = OUT ? 0.f : F.b_gate[h * 64 + lane];
    f32x4 gn[4];
#pragma unroll
    for (int cc = 0; cc < 4; ++cc) gn[cc] = OUT ? *(const f32x4*)(F.g_gla_norm + 16 * (4 * dvh + cc) + 4 * fq) : (f32x4){0.f, 0.f, 0.f, 0.f};
    float* Sg = WSP(float, WS_KV) + (size_t)u * 8192 + (16 * F.wave + fr) * 64 + 4 * fq;
    f32x4 St[4];
#pragma unroll
    for (int d = 0; d < 4; ++d) St[d] = OUT ? *(const f32x4*)(Sg + 16 * d) : (f32x4){0.f, 0.f, 0.f, 0.f};
    float ltot = 0.f;
    u32x4 v_r[2]; unsigned ga_r = 0u, k_r[8], q_r[8]; u32x2 gg_r[4]; float b_r[8], bm_r = 0.f, bl_r = 0.f;
#define GLA_LOAD_CHUNK(tc0) do { \
        _Pragma("unroll") for (int i = 0; i < 2; ++i) { const int cid = F.tid + 512 * i, row = cid >> 4, ch = cid & 15; v_r[i] = *(const u32x4*)(proj + pj((tc0) + row, GV_OFF + h * 128 + ch * 8)); } \
        if (!OUT) ga_r = *(const unsigned*)(proj + pj((tc0) + 8 * F.wave + (lane >> 3), GA_OFF + 2 * (lane & 7))); \
        _Pragma("unroll") for (int i = 0; i < 8; ++i) { const int rw = (tc0) + 8 * F.wave + i; k_r[i] = proj[pj(rw, GK_OFF + h * 64 + lane)]; \
            if (OUT) { q_r[i] = proj[pj(rw, GQ_OFF + h * 64 + lane)]; b_r[i] = bglob[(size_t)rw * 256 + h * 64 + lane]; } } \
        if (OUT) { bm_r = bglob[(size_t)((tc0) + 31) * 256 + h * 64 + lane]; bl_r = bglob[(size_t)((tc0) + 63) * 256 + h * 64 + lane]; \
            _Pragma("unroll") for (int cc = 0; cc < 4; ++cc) \
            gg_r[cc] = *(const u32x2*)(proj + pj((tc0) + 16 * ib + fr, GG_OFF + h * 128 + 16 * (4 * dvh + cc) + 4 * fq)); } } while (0)
    const int tu0 = b * S + sc * 512;
    GLA_LOAD_CHUNK(tu0);
    for (int c = 0; c < 8; ++c) {
        const int t0 = tu0 + c * 64;
        LAS unsigned char* v_s = (c & 1) ? v_s1 : v_s0;
        LAS unsigned char* kd_c = (OUT && (c & 1)) ? kd_s1 : kd_s; LAS float* dec_c = dec_s + ((OUT && (c & 1)) ? 64 : 0);
#pragma unroll
        for (int i = 0; i < 2; ++i) { const int cid = F.tid + 512 * i, row = cid >> 4, ch = cid & 15; *(LAS u32x4*)(v_s + row * 272 + ch * 16) = v_r[i]; }
        if (!OUT) { typedef float f32x2v __attribute__((ext_vector_type(2))); *(LAS f32x2v*)(ga_w + 2 * lane) = (f32x2v){bf2f(ga_r & 0xffffu), bf2f(ga_r >> 16)}; }
        float kx[8], qx[8], bq[8]; f32x4 ggf[4]; const float bmid_q = bm_r, blast_q = bl_r;
#pragma unroll
        for (int i = 0; i < 8; ++i) bq[i] = OUT ? b_r[i] : 0.f;
#pragma unroll
        for (int i = 0; i < 8; ++i) { kx[i] = bf2f(k_r[i]); qx[i] = OUT ? bf2f(q_r[i]) * 0.125f : 0.f; }
#pragma unroll
        for (int i = 0; i < 4; ++i) ggf[i] = OUT ? unpack4(gg_r[i]) : (f32x4){0.f, 0.f, 0.f, 0.f};
        if (c < 7) GLA_LOAD_CHUNK(t0 + 64);
        float bv[8]; float run = 0.f;
#pragma unroll
        for (int i = 0; i < 8; ++i) bv[i] = 0.f;
        if (!OUT) {
#pragma unroll
        for (int i = 0; i < 8; ++i) {
            float z = bg;
#pragma unroll
            for (int r4 = 0; r4 < 4; ++r4) { const f32x4 g4 = *(LAS const f32x4*)(ga_w + i * 16 + 4 * r4); z += g4[0] * wu[4 * r4] + g4[1] * wu[4 * r4 + 1] + g4[2] * wu[4 * r4 + 2] + g4[3] * wu[4 * r4 + 3]; }
            const float ls = fminf(z, 0.f) - __logf(1.f + __expf(-fabsf(z)));
            run += ls * (1.f / 16.f); bv[i] = run;
        }
        tot_s[F.wave * 64 + lane] = run;
        }
        if (OUT) {
#pragma unroll
            for (int d = 0; d < 4; ++d) { u32x2 w; w.x = pk2(St[d][0], St[d][1]); w.y = pk2(St[d][2], St[d][3]);
                *(LAS u32x2*)(st_s + (16 * F.wave + fr) * 144 + (16 * d + 4 * fq) * 2) = w; }
        }
        float pre = 0.f, b_mid = bmid_q, b_last = blast_q;
        if (!OUT) {
            __syncthreads();
            b_mid = 0.f; b_last = 0.f;
#pragma unroll
            for (int w = 0; w < 8; ++w) { const float tv = tot_s[w * 64 + lane]; pre += (w < F.wave) ? tv : 0.f; b_mid += (w < 4) ? tv : 0.f; b_last += tv; }
        }
        ltot += b_last;
        const float e_lm = __expf(b_last - b_mid), e_mid = __expf(b_mid);
#pragma unroll
        for (int i = 0; i < 8; ++i) { const int t = 8 * F.wave + i; const float bb = OUT ? bq[i] : bv[i] + pre;
            if (!OUT) bglob[(size_t)(t0 + t) * 256 + h * 64 + lane] = bb;
            const float e1 = __expf(bb - b_mid), r1 = __builtin_amdgcn_rcpf(e1);
            const float kk = kx[i] * r1;
            *(LAS bf16*)(kd_c + t * 144 + lane * 2) = (bf16)f2bf(kk * e_lm);
            if (OUT) { const float qd = qx[i] * e1;
                *(LAS bf16*)(qd_s + t * 144 + lane * 2) = (bf16)f2bf(qd);
                *(LAS bf16*)(kk_s + t * 144 + lane * 2) = (bf16)f2bf(kk);
                *(LAS bf16*)(qe_s + t * 144 + lane * 2) = (bf16)f2bf(qd * e_mid); } }
        if (F.wave == 0) dec_c[lane] = e_lm * e_mid;
        __syncthreads();
        if (OUT) {
            bf16x8 qdf[2], qef[2];
#pragma unroll
            for (int ks = 0; ks < 2; ++ks) { qdf[ks] = *(LAS const bf16x8*)(qd_s + (16 * ib + fr) * 144 + (32 * ks + 8 * fq) * 2);
                                             qef[ks] = *(LAS const bf16x8*)(qe_s + (16 * ib + fr) * 144 + (32 * ks + 8 * fq) * 2); }
            f32x4 at[4];
#pragma unroll
            for (int jt = 0; jt < 4; ++jt) {
                LAS const unsigned char* kp = kk_s + (16 * jt + fr) * 144 + (8 * fq) * 2;
                const bf16x8 k0 = *(LAS const bf16x8*)kp, k1 = *(LAS const bf16x8*)(kp + 64);
                f32x4 z = (f32x4){0.f, 0.f, 0.f, 0.f}; z = MFMA(k0, qdf[0], z); z = MFMA(k1, qdf[1], z);
#pragma unroll
                for (int r = 0; r < 4; ++r) if (16 * jt + 4 * fq + r > 16 * ib + fr) z[r] = 0.f;
                at[jt] = z;
            }
            bf16x8 pf[2];
            pf[0] = pack8(at[0], at[1]); pf[1] = pack8(at[2], at[3]);
            f32x4 o[4];
#pragma unroll
            for (int cc = 0; cc < 4; ++cc) {
                const int dvt = 4 * dvh + cc; f32x4 z = (f32x4){0.f, 0.f, 0.f, 0.f};
#pragma unroll
                for (int ks = 0; ks < 2; ++ks) {
                    const int rb = 32 * ks + 4 * fq + (fr >> 2);
                    LAS const unsigned char* vp = v_s + rb * 272 + (16 * dvt + 4 * (lane & 3)) * 2;
                    z = MFMA(cat8(trr(vp), trr(vp + 16 * 272)), pf[ks], z);
                }
#pragma unroll
                for (int ks = 0; ks < 2; ++ks) {
                    const bf16x8 sf = *(LAS const bf16x8*)(st_s + (16 * dvt + fr) * 144 + (32 * ks + 8 * fq) * 2);
                    z = MFMA(sf, qef[ks], z);
                }
                o[cc] = z;
            }
            float sq = 0.f;
#pragma unroll
            for (int cc = 0; cc < 4; ++cc) sq += dot4(o[cc]);
            sq += __shfl_xor(sq, 16); sq += __shfl_xor(sq, 32);
            if (fq == 0) ssq_s[F.wave * 16 + fr] = sq;
            __syncthreads();
            { const float tot = sq + ssq_s[(F.wave ^ 1) * 16 + fr];
              const float rinv = rsqrtf(tot * (1.f / 128.f) + EPS);
              bf16* op = mix + (size_t)(t0 + 16 * ib + fr) * D + 512 + h * 128 + 64 * dvh + 4 * fq;
#pragma unroll
              for (int cc = 0; cc < 4; ++cc) { f32x4 sg;
#pragma unroll
                  for (int r = 0; r < 4; ++r) sg[r] = ggf[cc][r] * __builtin_amdgcn_rcpf(1.f + __expf(-ggf[cc][r]));
                  const f32x4 val = o[cc] * rinv * gn[cc] * sg;
                  u32x2 w; w.x = pk2(val[0], val[1]); w.y = pk2(val[2], val[3]); *(u32x2*)(op + 16 * cc) = w; } }
        }
#pragma unroll
        for (int d = 0; d < 4; ++d) { const f32x4 dc = *(LAS const f32x4*)(dec_c + 16 * d + 4 * fq); St[d] = St[d] * dc; }
#pragma unroll
        for (int ks = 0; ks < 2; ++ks) {
            const int rb = 32 * ks + 8 * fq + (fr >> 2);
            LAS const unsigned char* vp = v_s + rb * 272 + (16 * F.wave + 4 * (lane & 3)) * 2;
            const bf16x8 vf = cat8(trr(vp), trr(vp + 4 * 272));
#pragma unroll
            for (int d = 0; d < 4; ++d) {
                LAS const unsigned char* kp = kd_c + rb * 144 + (16 * d + 4 * (lane & 3)) * 2;
                St[d] = MFMA(cat8(trr(kp), trr(kp + 4 * 144)), vf, St[d]);
            }
        }
    }
#undef GLA_LOAD_CHUNK
    if (!OUT) {
#pragma unroll
        for (int d = 0; d < 4; ++d) *(f32x4*)(Sg + 16 * d) = St[d];
        if (F.wave == 0) WSP(float, WS_DECAY)[u * 64 + lane] = __expf(ltot);
    }
    __syncthreads();
}
__device__ __forceinline__ void gla_super_scan(const Frame& F) {
    float* kv = WSP(float, WS_KV); const float* decay = WSP(float, WS_DECAY);
    if (F.tid >= 256) {
        if (F.tid < 288) { const int e = F.tid - 256; const float* mod = WSP(float, WS_MOD);
            for (int pq = F.bx; pq < 256; pq += F.G) { const int b = pq >> 7, kb = pq & 127; const float* modb = mod + b * 6144;
                float w[8]; float zp = 0.f;
#pragma unroll
                for (int q = 0; q < 8; ++q) { const int k = 8 * kb + q; const float wr = F.w_router[k * 32 + e]; w[q] = wr * (F.g_pre_ffn[k] * (1.f + modb[4096 + k])); zp += modb[3072 + k] * wr; }
                u32x4 hi, lo; unsigned hh[4];
#pragma unroll
                for (int q = 0; q < 4; ++q) { hh[q] = pg8::cvt_pk_bf16(w[2 * q], w[2 * q + 1]); }
                hi.x = hh[0]; hi.y = hh[1]; hi.z = hh[2]; hi.w = hh[3];
#pragma unroll
                for (int q = 0; q < 4; ++q) hh[q] = pg8::cvt_pk_bf16(w[2 * q] - bf2f(hh[q] & 0xffffu), w[2 * q + 1] - bf2f(hh[q] >> 16));
                lo.x = hh[0]; lo.y = hh[1]; lo.z = hh[2]; lo.w = hh[3];
                u32x4* img = WSP(u32x4, WS_RIMG) + (size_t)b * 8192;
                img[kb * 32 + e] = hi; img[4096 + kb * 32 + e] = lo;
                WSP(float, WS_ZPART)[(b * 128 + kb) * 32 + e] = zp; } }
        return;
    }
    for (int idx = F.bx * 256 + F.tid; idx < 65536; idx += F.G * 256) {
        const int bh = idx >> 13, dvdk = idx & 8191, dk = idx & 63;
        float* p = kv + (size_t)(bh * 32) * 8192 + dvdk; const float* dp = decay + (bh * 32) * 64 + dk;
        float tv[32], dv[32];
#pragma unroll
        for (int i = 0; i < 32; ++i) { tv[i] = p[(size_t)i * 8192]; dv[i] = dp[i * 64]; }
        float state = 0.f;
#pragma unroll
        for (int i = 0; i < 32; ++i) { p[(size_t)i * 8192] = state; state = dv[i] * state + tv[i]; }
    }
}

__device__ __forceinline__ void p7_norm_router(const Frame& F) {
    const float* mod = WSP(float, WS_MOD); const bf16* y = WSP(bf16, WS_Y); bf16* x1h = WSP(bf16, WS_X1); unsigned char* x1l = WSP(unsigned char, WS_X1) + (size_t)T * D * 2; unsigned char* h2 = WSP(unsigned char, WS_H);
    unsigned* ctl = WSP(unsigned, WS_CTL);
    LAS unsigned char* wrh_s = F.lds; LAS unsigned char* wrl_s = F.lds + 65536;
    LAS float* lg_s = (LAS float*)(F.lds + SMALL_OFF);
    LAS float* rx_s = (LAS float*)(F.lds + SMALL_OFF + 16384);
    LAS float* z_s = (LAS float*)(F.lds + SMALL_OFF + 16384 + 512);
    LAS int* cnt_s = (LAS int*)(F.lds + SMALL_OFF + 16384 + 640);
    LAS int* base_s = (LAS int*)(F.lds + SMALL_OFF + 16384 + 768);
    LAS float* zr_s = (LAS float*)(F.lds + SMALL_OFF + 16384 + 1024);
    const int lane = F.lane, fr = lane & 15, fq = lane >> 4;
    const int mb0 = F.bx * 128 + F.wave * 16;
    const float* modb = mod + (mb0 >> 14) * 6144;
    f32x4 pg[4], pg2[4], psh[4];
    u32x2 ya[4], yb[4], yc[4], yd[4]; f32x4 xa[4], xbf[4], xc[4], xd[4];
    const bf16* ybase = y + (size_t)mb0 * D + 4 * lane; const float* xbase = F.x + (size_t)mb0 * D + 4 * lane;
#define P7_LOAD(Y, X, r) do { _Pragma("unroll") for (int j = 0; j < 4; ++j) { Y[j] = __builtin_nontemporal_load((const u32x2*)(ybase + (size_t)(r) * D + 256 * j)); X[j] = __builtin_nontemporal_load((const f32x4*)(xbase + (size_t)(r) * D + 256 * j)); } } while (0)
    P7_LOAD(ya, xa, 0); P7_LOAD(yb, xbf, 1); P7_LOAD(yc, xc, 2); P7_LOAD(yd, xd, 3);
    if (F.tid < 32) cnt_s[F.tid] = 0;
    { const int bt = mb0 >> 14; const u32x4* img = WSP(u32x4, WS_RIMG) + (size_t)bt * 8192;
        const int e = F.tid & 31, ks = F.tid >> 5; float zz = 0.f;
#pragma unroll
        for (int i = 0; i < 8; ++i) zz += WSP(float, WS_ZPART)[(bt * 128 + ks * 8 + i) * 32 + e];
        zr_s[ks * 32 + e] = zz;
#pragma unroll
        for (int h = 0; h < 2; ++h) { u32x4 cimg[8];
#pragma unroll
            for (int i = 0; i < 8; ++i) cimg[i] = img[F.tid + 512 * (8 * h + i)];
#pragma unroll
            for (int i = 0; i < 8; ++i) *(LAS u32x4*)(F.lds + (F.tid + 512 * (8 * h + i)) * 16) = cimg[i]; } }
    __syncthreads();
    if (F.tid < 32) { float zz = F.b_router[F.tid];
#pragma unroll
        for (int i = 0; i < 16; ++i) zz += zr_s[i * 32 + F.tid];
        z_s[F.tid] = zz; }
#define P7_ROW(Y, X, it) do { f32x4 xv[4], hv[4]; float ss = 0.f; \
        _Pragma("unroll") for (int j = 0; j < 4; ++j) { hv[j] = unpack4(Y[j]); ss += dot4(hv[j]); } \
        const float ry = rsqrtf(wave_sum(ss) * (1.f / D) + EPS); float s2 = 0.f; \
        _Pragma("unroll") for (int j = 0; j < 4; ++j) { xv[j] = X[j] + hv[j] * ry * pg[j]; s2 += dot4(xv[j]); } \
        const float rx = rsqrtf(wave_sum(s2) * (1.f / D) + EPS); \
        if (lane == 0) rx_s[F.wave * 16 + (it)] = rx; \
        _Pragma("unroll") for (int j = 0; j < 4; ++j) { const int idx = 4 * lane + 256 * j; \
            hv[j] = xv[j] * rx * pg2[j] + psh[j]; \
            { u32x2 xh; xh.x = pg8::cvt_pk_bf16(xv[j][0], xv[j][1]); xh.y = pg8::cvt_pk_bf16(xv[j][2], xv[j][3]); \
              const unsigned xl = pk4_fp8((xv[j][0] - bf2f(xh.x & 0xffffu)) * X1L_SCALE, (xv[j][1] - bf2f(xh.x >> 16)) * X1L_SCALE, (xv[j][2] - bf2f(xh.y & 0xffffu)) * X1L_SCALE, (xv[j][3] - bf2f(xh.y >> 16)) * X1L_SCALE); \
              *(u32x2*)(x1h + (size_t)(mb0 + (it)) * D + idx) = xh; *(unsigned*)(x1l + (size_t)(mb0 + (it)) * D + idx) = xl; } \
            *(unsigned*)(h2 + (size_t)(mb0 + (it)) * D + idx) = pk4_fp8(hv[j][0] * H8_SCALE, hv[j][1] * H8_SCALE, hv[j][2] * H8_SCALE, hv[j][3] * H8_SCALE); } \
        if ((it) + 4 < 16) P7_LOAD(Y, X, (it) + 4); } while (0)
#pragma unroll
    for (int j = 0; j < 4; ++j) { const int idx = 4 * lane + 256 * j;
        pg[j] = *(const f32x4*)(F.g_post_mix + idx) * *(const f32x4*)(modb + 2048 + idx);
        pg2[j] = *(const f32x4*)(F.g_pre_ffn + idx) * (*(const f32x4*)(modb + 4096 + idx) + 1.f); psh[j] = *(const f32x4*)(modb + 3072 + idx); }
#pragma unroll 1
    for (int it = 0; it < 16; it += 4) { P7_ROW(ya, xa, it); P7_ROW(yb, xbf, it + 1); P7_ROW(yc, xc, it + 2); P7_ROW(yd, xd, it + 3); }
#undef P7_LOAD
#undef P7_ROW
    asm volatile("s_waitcnt vmcnt(0)" ::: "memory");
    __syncthreads();
    f32x4 acc0 = (f32x4){0.f, 0.f, 0.f, 0.f}, acc1 = (f32x4){0.f, 0.f, 0.f, 0.f};
    { const bf16* aph = x1h + (size_t)(mb0 + fr) * D + 8 * fq; const unsigned char* apl = x1l + (size_t)(mb0 + fr) * D + 8 * fq;
        LAS const unsigned char* bph = wrh_s + (fq * 32 + fr) * 16; LAS const unsigned char* bpl = wrl_s + (fq * 32 + fr) * 16;
        bf16x8 ab[4][4]; u32x2 al8[4][4];
#define P7_RLOAD(B, L, st) do { _Pragma("unroll") for (int q = 0; q < 4; ++q) { B[q] = *(const bf16x8*)(aph + 32 * (4 * (st) + q)); L[q] = *(const u32x2*)(apl + 32 * (4 * (st) + q)); } } while (0)
        P7_RLOAD(ab[0], al8[0], 0); P7_RLOAD(ab[1], al8[1], 1); P7_RLOAD(ab[2], al8[2], 2);
#pragma unroll
        for (int st = 0; st < 8; ++st) {
            if (st + 3 < 8) P7_RLOAD(ab[(st + 3) & 3], al8[(st + 3) & 3], st + 3);
#pragma unroll
            for (int q = 0; q < 4; ++q) {
                const bf16x8 ah = ab[st & 3][q];
                bf16x8 al; { const u32x2 w8 = al8[st & 3][q]; u32x4 wl;
                  const auto f01 = __builtin_amdgcn_cvt_pk_f32_fp8((int)w8.x, false), f23 = __builtin_amdgcn_cvt_pk_f32_fp8((int)w8.x, true), f45 = __builtin_amdgcn_cvt_pk_f32_fp8((int)w8.y, false), f67 = __builtin_amdgcn_cvt_pk_f32_fp8((int)w8.y, true);
                  wl.x = pg8::cvt_pk_bf16(f01[0] * (1.f / X1L_SCALE), f01[1] * (1.f / X1L_SCALE)); wl.y = pg8::cvt_pk_bf16(f23[0] * (1.f / X1L_SCALE), f23[1] * (1.f / X1L_SCALE));
                  wl.z = pg8::cvt_pk_bf16(f45[0] * (1.f / X1L_SCALE), f45[1] * (1.f / X1L_SCALE)); wl.w = pg8::cvt_pk_bf16(f67[0] * (1.f / X1L_SCALE), f67[1] * (1.f / X1L_SCALE));
                  al = __builtin_bit_cast(bf16x8, wl); }
                const int so = (4 * st + q) * 2048;
                const bf16x8 bh0 = *(LAS const bf16x8*)(bph + so), bh1 = *(LAS const bf16x8*)(bph + so + 256), bl0 = *(LAS const bf16x8*)(bpl + so), bl1 = *(LAS const bf16x8*)(bpl + so + 256);
                acc0 = MFMA(ah, bh0, acc0); acc0 = MFMA(al, bh0, acc0); acc0 = MFMA(ah, bl0, acc0);
                acc1 = MFMA(ah, bh1, acc1); acc1 = MFMA(al, bh1, acc1); acc1 = MFMA(ah, bl1, acc1); }
        }
#undef P7_RLOAD
    }
    __syncthreads();
#pragma unroll
    for (int r = 0; r < 4; ++r) { const float rx = rx_s[F.wave * 16 + 4 * fq + r];
        lg_s[(F.wave * 16 + 4 * fq + r) * 32 + fr] = rx * acc0[r] + z_s[fr];
        lg_s[(F.wave * 16 + 4 * fq + r) * 32 + fr + 16] = rx * acc1[r] + z_s[fr + 16]; }
    const float NEG_INF = -__builtin_inff();
    int se[4], lp[4]; float gt[4];
    if (lane < 16) {
        float v[32];
#pragma unroll
        for (int ch = 0; ch < 8; ++ch) { const f32x4 w = *(LAS const f32x4*)(lg_s + (F.wave * 16 + lane) * 32 + 4 * ch); v[4 * ch] = w[0]; v[4 * ch + 1] = w[1]; v[4 * ch + 2] = w[2]; v[4 * ch + 3] = w[3]; }
        float sv[4];
#pragma unroll
        for (int r = 0; r < 4; ++r) { float best = v[0]; int bi = 0;
#pragma unroll
            for (int e = 1; e < 32; ++e) if (v[e] > best) { best = v[e]; bi = e; }
            se[r] = bi; sv[r] = best;
#pragma unroll
            for (int e = 0; e < 32; ++e) v[e] = (e == bi) ? NEG_INF : v[e]; }
        const float p1 = __expf(sv[1] - sv[0]), p2 = __expf(sv[2] - sv[0]), p3 = __expf(sv[3] - sv[0]);
        const float rs = 1.f / (1.f + p1 + p2 + p3);
        gt[0] = rs; gt[1] = p1 * rs; gt[2] = p2 * rs; gt[3] = p3 * rs;
#pragma unroll
        for (int r = 0; r < 4; ++r) lp[r] = __hip_atomic_fetch_add(cnt_s + se[r], 1, __ATOMIC_RELAXED, __HIP_MEMORY_SCOPE_WORKGROUP);
    }
    __syncthreads();
    if (F.tid < 32) base_s[F.tid] = (int)__hip_atomic_fetch_add(ctl + CW_GCNT + 64 * F.tid, (unsigned)cnt_s[F.tid], __ATOMIC_RELAXED, __HIP_MEMORY_SCOPE_AGENT);
    __syncthreads();
    if (lane < 16) { int* la = WSP(int, WS_LIST_A); const int m = mb0 + lane;
#pragma unroll
        for (int r = 0; r < 4; ++r) { const int pos = base_s[se[r]] + lp[r]; la[(size_t)se[r] * T + pos] = m * 4 + r;
            WSP(int, WS_TOK_E)[m * 4 + r] = (se[r] << 20) | pos; WSP(float, WS_TOK_GATE)[m * 4 + r] = gt[r]; } }
}

__device__ __forceinline__ int moe_tables(const Frame& F, volatile LAS unsigned* built) {
    LAS int* cnt_s = (LAS int*)(F.lds + MCNT_OFF); LAS int* off_s = (LAS int*)(F.lds + MOFF_OFF); LAS i32x4* td_s = (LAS i32x4*)(F.lds + TDESC_OFF);
    if (built[0] == 0u) {
        unsigned* ctl = WSP(unsigned, WS_CTL);
        if (F.tid < 64) {
            const int e = F.tid & 31;
            const int c = (int)__hip_atomic_load(ctl + CW_GCNT + 64 * e, __ATOMIC_RELAXED, __HIP_MEMORY_SCOPE_AGENT);
            const int padded = (c + 255) & ~255; int incl = padded;
#pragma unroll
            for (int d = 1; d < 32; d <<= 1) { const int v = __shfl_up(incl, d, 32); incl += (e >= d) ? v : 0; }
            if (F.tid < 32) { cnt_s[e] = c; off_s[e] = incl - padded; if (e == 31) off_s[32] = incl; }
        }
        __syncthreads();
        if (F.tid == 0) built[0] = 1u;
        { const int e = F.tid >> 4, i = F.tid & 15;
            const int o0 = off_s[e], n = (off_s[e + 1] - o0) >> 8, c = cnt_s[e];
            for (int k = i; k < n; k += 16) { i32x4 dsc; dsc.x = e; dsc.y = k * 256; dsc.z = c; dsc.w = 0; td_s[(o0 >> 8) + k] = dsc; } }
        __syncthreads();
    }
    return __builtin_amdgcn_readfirstlane(off_s[32] >> 8);
}

__device__ __forceinline__ f32x4 unpack4_fp8(unsigned w) {
    const auto lo = __builtin_amdgcn_cvt_pk_f32_fp8((int)w, false), hi = __builtin_amdgcn_cvt_pk_f32_fp8((int)w, true);
    return (f32x4){lo[0], lo[1], hi[0], hi[1]};
}
__device__ __forceinline__ void p11_combine(const Frame& F) {
    const float* mod = WSP(float, WS_MOD); const unsigned char* ys = WSP(unsigned char, WS_YS); const bf16* x1 = WSP(bf16, WS_X1);
    const int gw = F.bx * NWAVES + F.wave, m0 = gw * 16, lane = F.lane;
    const float* modb = mod + (m0 >> 14) * 6144;
    LAS int* slot_s = (LAS int*)(F.lds + F.wave * 512); LAS float* gate_s = (LAS float*)(F.lds + F.wave * 512 + 256);
    const bf16* xb = x1 + (size_t)m0 * D + 4 * lane;
    unsigned ya[4][4], ybb[4][4], yc[4][4], yd[4][4]; u32x2 xa[4], xbf[4], xc[4], xd[4]; f32x4 g[4];
#define P11_LOADX(X, r) do { _Pragma("unroll") for (int j = 0; j < 4; ++j) X[j] = __builtin_nontemporal_load((const u32x2*)(xb + (size_t)(r) * D + 256 * j)); } while (0)
#define P11_LOADY(Y, r) do { _Pragma("unroll") for (int k4 = 0; k4 < 4; ++k4) { const unsigned char* yp = ys + (size_t)__builtin_amdgcn_readfirstlane(slot_s[(r) * 4 + k4]) * D + 4 * lane; \
            _Pragma("unroll") for (int j = 0; j < 4; ++j) Y[j][k4] = __builtin_nontemporal_load((const unsigned*)(yp + 256 * j)); } } while (0)
#define P11_LOAD(Y, X, r) do { P11_LOADY(Y, r); P11_LOADX(X, r); } while (0)
    const int ep = WSP(int, WS_TOK_E)[m0 * 4 + lane]; const float gte = WSP(float, WS_TOK_GATE)[m0 * 4 + lane];
    P11_LOADX(xa, 0); P11_LOADX(xbf, 1); P11_LOADX(xc, 2); P11_LOADX(xd, 3);
#pragma unroll
    for (int j = 0; j < 4; ++j) { const int idx = 4 * lane + 256 * j; g[j] = *(const f32x4*)(F.g_post_ffn + idx) * *(const f32x4*)(modb + 5120 + idx); }
    slot_s[lane] = ((LAS const int*)(F.lds + MOFF_OFF))[ep >> 20] + (ep & 0xfffff); gate_s[lane] = gte;
#define P11_ROW(Y, X, it) do { f32x4 yv[4]; float ss = 0.f; const f32x4 gk = *(LAS const f32x4*)(gate_s + (it) * 4); \
        _Pragma("unroll") for (int j = 0; j < 4; ++j) { f32x4 a = unpack4_fp8(Y[j][0]) * gk[0]; a += unpack4_fp8(Y[j][1]) * gk[1]; a += unpack4_fp8(Y[j][2]) * gk[2]; a += unpack4_fp8(Y[j][3]) * gk[3]; \
            yv[j] = a; ss += dot4(a); } \
        const float ry = rsqrtf(wave_sum(ss) * (1.f / D) + EPS * (Y8_SCALE * Y8_SCALE)); \
        _Pragma("unroll") for (int j = 0; j < 4; ++j) __builtin_nontemporal_store(unpack4(X[j]) + yv[j] * ry * g[j], (f32x4*)(F.out + (size_t)(m0 + (it)) * D + 4 * lane + 256 * j)); \
        if ((it) + 4 < 16) P11_LOAD(Y, X, (it) + 4); } while (0)
    P11_LOADY(ya, 0); P11_LOADY(ybb, 1); P11_LOADY(yc, 2); P11_LOADY(yd, 3);
#pragma unroll 1
    for (int it = 0; it < 16; it += 4) { P11_ROW(ya, xa, it); P11_ROW(ybb, xbf, it + 1); P11_ROW(yc, xc, it + 2); P11_ROW(yd, xd, it + 3); }
#undef P11_LOAD
#undef P11_LOADX
#undef P11_LOADY
#undef P11_ROW
}

constexpr int NPHASE = 11;
struct Args { const float* in[20]; float* out; unsigned char* ws; int ph_lo, ph_hi; };
__global__ void __launch_bounds__(NTHREADS, 2) fwd(Args args) {
    extern __shared__ __attribute__((aligned(16))) unsigned char lds[];
    Frame F;
    F.lds = (LAS unsigned char*)lds;
    F.tid = threadIdx.x; F.lane = F.tid & 63; F.wave = __builtin_amdgcn_readfirstlane(F.tid >> 6); F.bx = blockIdx.x; F.G = gridDim.x;
    F.x = args.in[0]; F.c = args.in[1]; F.w_ada = args.in[2]; F.b_ada = args.in[3]; F.g_pre_mix = args.in[4]; F.g_post_mix = args.in[5];
    F.g_pre_ffn = args.in[6]; F.g_post_ffn = args.in[7]; F.w_in = args.in[8]; F.w_gate_up = args.in[9]; F.b_gate = args.in[10]; F.g_gla_norm = args.in[11];
    F.sinks = args.in[12]; F.w_out = args.in[13]; F.w_router = args.in[14]; F.b_router = args.in[15]; F.w_mlp1 = args.in[16]; F.b_mlp1 = args.in[17];
    F.w_mlp2 = args.in[18]; F.b_mlp2 = args.in[19]; F.out = args.out; F.ws = args.ws;
    volatile LAS unsigned* MISC = (volatile LAS unsigned*)(F.lds + MISC_OFF);
    if (F.tid < 32) MISC[F.tid] = 0u;
    __syncthreads();
    const int lo = args.ph_lo, hi = args.ph_hi;
    XcdBarrier bar; bar.bar = (unsigned*)(F.ws + WS_CTL) + CW_BAR; bar.x = 0; bar.st = nullptr;
    if (hi - lo > 1) bar = xcd_barrier_post((unsigned*)(F.ws + WS_CTL) + CW_BAR, MISC + 8);
#define IN(k) (lo <= (k) && (k) < hi)
#define SEAM(k) do { if (IN(k) && IN((k) + 1)) xcd_barrier(bar); } while (0)

    if (IN(0)) { p0_prologue<0>(F); } SEAM(0);
    if (IN(1)) { p1_norm(F); } SEAM(1);
    if (IN(2)) {
        constexpr int I_FIRST = 16 * 80 + 16 * 32, I_PER = (NE * 16 * 64 + NE * 16 * 32) / GRID;
        const int grp = F.bx & 3, pos = grp == 0 ? 0 : grp == 1 ? 2 : grp == 2 ? 3 : 5;
        { pg8::StaticOrder So; So.init(T / 256, INP / 256, F.G, F.bx, 0, pos);
          pg8::gemm_phase<false, 0, 0, 0>(F.lds, D, So, pg8::ABDense{WSP(bf16, WS_H), WSP(bf16, WS_WIN), D}, pg8::EpiStoreT{WSP(bf16, WS_PROJ), 256, PJ_TILE}); }
        __syncthreads();
        tr_range<0>(F, I_FIRST + F.bx * I_PER, I_FIRST + (F.bx + 1) * I_PER);
        __syncthreads();
        { pg8::StaticOrder So; So.init(T / 256, INP / 256, F.G, F.bx, pos);
          pg8::gemm_phase<false, 0, 0, 0>(F.lds, D, So, pg8::ABDense{WSP(bf16, WS_H), WSP(bf16, WS_WIN), D}, pg8::EpiStoreT{WSP(bf16, WS_PROJ), 256, PJ_TILE}); }
    } SEAM(2);
    if (IN(3)) { attn_units(F);
                 for (int u = F.bx; u < 256; u += F.G) gla_super_unit<false>(F, u); } SEAM(3);
    if (IN(4)) { gla_super_scan(F); } SEAM(4);
    if (IN(5)) { for (int u = F.bx; u < 256; u += F.G) gla_super_unit<true>(F, u); } SEAM(5);
    if (IN(6)) { pg8::StaticOrder So; So.init(T / 256, D / 256, F.G, F.bx);
                 pg8::gemm_phase<false, 0, 0, 0>(F.lds, D, So, pg8::ABDense{WSP(bf16, WS_MIX), WSP(bf16, WS_WOUT), D}, pg8::EpiStoreT{WSP(bf16, WS_Y), D, 256}); } SEAM(6);
    if (IN(7)) { p7_norm_router(F); } SEAM(7);
    if (IN(8)) { const int nM = moe_tables(F, MISC + 16); pg8::StaticOrder So; So.init(nM, 2048 / 256, F.G, F.bx, 0, 1 << 30, 1);
                 pg8::gemm_phase<true, 1, W8_E8M0, H8_E8M0>(F.lds, 512, So, pg8::ABMoe1{WSP(unsigned char, WS_H), WSP(unsigned char, WS_W1T), (LAS const i32x4*)(F.lds + TDESC_OFF), WSP(int, WS_LIST_A)},
                                       pg8::EpiSwigluT{WSP(unsigned char, WS_A), F.b_mlp1}); } SEAM(8);
    if (IN(9)) { const int nM = moe_tables(F, MISC + 16); pg8::StaticOrder So; So.init(nM, D / 256, F.G, F.bx, 0, 1 << 30, 1);
                 pg8::gemm_phase<false, 1, W8_E8M0, A8_E8M0>(F.lds, 512, So, pg8::ABMoe2{WSP(unsigned char, WS_A), WSP(unsigned char, WS_W2T), (LAS const i32x4*)(F.lds + TDESC_OFF)},
                                       pg8::EpiMoe2T{WSP(unsigned char, WS_YS), F.b_mlp2}); } SEAM(9);
    if (IN(10)) { (void)moe_tables(F, MISC + 16); p11_combine(F); }
#undef IN
#undef SEAM
}

extern "C" void kernel_launch(void* const* d_in, const int* in_sizes, int n_in, void* d_out, int out_size, void* d_ws, size_t ws_size, hipStream_t stream) {
    static int ready = 0;
    if (ready == 0) {
        if (n_in != 20 || out_size != T * D || ws_size < WS_END) { fprintf(stderr, "kernel_launch: unexpected problem (n_in %d, out %d, ws %zu)\n", n_in, out_size, ws_size); ready = -1; return; }
        if (hipFuncSetAttribute((const void*)fwd, hipFuncAttributeMaxDynamicSharedMemorySize, LDS_BYTES) != hipSuccess) { fprintf(stderr, "kernel_launch: hipFuncSetAttribute failed\n"); ready = -1; return; }
        int per_cu = 0;
        if (hipOccupancyMaxActiveBlocksPerMultiprocessor(&per_cu, (const void*)fwd, NTHREADS, LDS_BYTES) != hipSuccess || per_cu < 1) fprintf(stderr, "kernel_launch: occupancy query says %d\n", per_cu);
        (void)hipGetLastError();
        ready = 1;
    }
    if (ready < 0) return;
    (void)hipMemsetAsync((char*)d_ws + WS_CTL, 0, CTL_ZERO_BYTES, stream);
    Args a{};
    for (int i = 0; i < 20; ++i) a.in[i] = (const float*)d_in[i];
    a.out = (float*)d_out; a.ws = (unsigned char*)d_ws;
#if MK_ONE_LAUNCH
    a.ph_lo = 0; a.ph_hi = NPHASE;
    hipLaunchKernelGGL(fwd, dim3(GRID), dim3(NTHREADS), LDS_BYTES, stream, a);
#else
    for (int p = 0; p < NPHASE; ++p) { a.ph_lo = p; a.ph_hi = p + 1; hipLaunchKernelGGL(fwd, dim3(GRID), dim3(NTHREADS), LDS_BYTES, stream, a); }
#endif
}
```
